# Optimizing an MI355X kernel written in HIP

```python
import math
import functools
import jax
import jax.numpy as jnp
from jax import lax
import numpy as np

D_MODEL = 1024
BATCH = 8
SEQ = 2048
DEPTH = 2
DEC_BATCH = 128
DEC_SEQ = 4
PAST_LEN = 2048
PAGE_SIZE = 128

N_META = 16
BLOCK = 128
D_FF = 2816
EPS = 1e-6
FOX_HEADS = 4
FOX_HD = 64
FOX_W = FOX_HEADS * FOX_HD
SSD_HEADS = 8
SSD_HD = 64
SSD_W = SSD_HEADS * SSD_HD
SSD_GROUPS = 2
SSD_STATE = 64
SSD_CONV = 4
SSD_CONV_DIM = SSD_W + 2 * SSD_GROUPS * SSD_STATE
GLA_HEADS = 4
GLA_DK = 32
GLA_DV = 64
GLA_KW = GLA_HEADS * GLA_DK
GLA_W = GLA_HEADS * GLA_DV
GLA_RANK = 16
GLA_TAU = 16.0
D_MIX = FOX_W + SSD_W + GLA_W
IN_SIZES = (FOX_W, FOX_W, FOX_W, FOX_HEADS, SSD_W, SSD_CONV_DIM, SSD_HEADS,
            GLA_KW, GLA_KW, GLA_W, GLA_RANK, GLA_W)
N_IN = sum(IN_SIZES)
IN_SPLITS = tuple(int(v) for v in np.cumsum(IN_SIZES)[:-1])

kernel_name = 'hybrid_fox_ssd_gla_decoder_step'


def rmsnorm(x, g):
    xf = x.astype(jnp.float32)
    y = xf * lax.rsqrt(jnp.mean(xf * xf, axis=-1, keepdims=True) + EPS)
    return (y * g.astype(jnp.float32)).astype(x.dtype)


def swiglu(x, w_in, w_out):
    g, u = jnp.split(x @ w_in, 2, axis=-1)
    return (jax.nn.silu(g) * u) @ w_out


def causal_conv(u, buf, w, bias):
    width = w.shape[0]
    full = jnp.concatenate([buf.astype(u.dtype), u], axis=1)
    out = lax.conv_general_dilated(full, w[:, None, :].astype(u.dtype), window_strides=(1,),
                                   padding='VALID', dimension_numbers=('NWC', 'WIO', 'NWC'),
                                   feature_group_count=u.shape[-1])
    return jax.nn.silu(out + bias), full[:, full.shape[1] - (width - 1):]


def fox_block(q, k, v, fq, fk, qpos, kpos):
    s = jnp.einsum('bqhd,bkhd->bhqk', q, k).astype(jnp.float32) * (FOX_HD ** -0.5)
    s = s + (jnp.transpose(fq, (0, 2, 1))[..., :, None] - jnp.transpose(fk, (0, 2, 1))[..., None, :])
    s = jnp.where(kpos[None, :] <= qpos[:, None], s, -jnp.inf)
    p = jax.nn.softmax(s, axis=-1).astype(v.dtype)
    return jnp.einsum('bhqk,bkhd->bqhd', p, v)


def fox_prompt(q, k, v, logf):
    b, t = q.shape[0], q.shape[1]
    F = jnp.cumsum(logf.astype(jnp.float32), axis=1)
    pos = jnp.arange(t)
    o_meta = fox_block(q[:, :N_META], k[:, :N_META], v[:, :N_META], F[:, :N_META], F[:, :N_META],
                       pos[:N_META], pos[:N_META])
    nb = (t - N_META) // BLOCK
    qb = jnp.swapaxes(q[:, N_META:].reshape(b, nb, BLOCK, FOX_HEADS, FOX_HD), 0, 1)
    fb = jnp.swapaxes(F[:, N_META:].reshape(b, nb, BLOCK, FOX_HEADS), 0, 1)
    pb = pos[N_META:].reshape(nb, BLOCK)
    o = lax.map(lambda a: fox_block(a[0], k, v, a[1], F, a[2], pos), (qb, fb, pb))
    o = jnp.swapaxes(o, 0, 1).reshape(b, nb * BLOCK, FOX_HEADS, FOX_HD)
    return jnp.concatenate([o_meta, o], axis=1)


def fox_sample(q, k, v, logf, k_past, v_past, logf_past):
    kk = jnp.concatenate([k_past.astype(k.dtype), k], axis=1)
    vv = jnp.concatenate([v_past.astype(v.dtype), v], axis=1)
    F = jnp.cumsum(jnp.concatenate([logf_past.astype(jnp.float32), logf.astype(jnp.float32)], axis=1), axis=1)
    p_len = k_past.shape[1]
    pos = jnp.arange(kk.shape[1])
    return fox_block(q, kk, vv, F[:, p_len:], F, pos[p_len:], pos)


def ssd_chunks(xdt, da, bh, ch, h, chunk):
    b, L = xdt.shape[0], xdt.shape[1]
    nc = L // chunk
    tri = jnp.tril(jnp.ones((chunk, chunk), dtype=bool))

    def blocks(a):
        return jnp.swapaxes(a.reshape((b, nc, chunk) + a.shape[2:]), 0, 1)

    def step(hc, inp):
        xc, dac, bc, cc = inp
        cs = jnp.cumsum(dac, axis=1)
        seg = jnp.where(tri[None, :, :, None], cs[:, :, None, :] - cs[:, None, :, :], -jnp.inf)
        w_ts = jnp.einsum('bthn,bshn->btsh', cc, bc) * jnp.exp(seg)
        y = jnp.einsum('btsh,bshp->bthp', w_ts, xc) + jnp.einsum('bthn,bhpn->bthp', cc, hc) * jnp.exp(cs)[..., None]
        end = cs[:, -1]
        hc = hc * jnp.exp(end)[:, :, None, None] + jnp.einsum('bshn,bsh,bshp->bhpn', bc, jnp.exp(end[:, None] - cs), xc)
        return hc, y

    h, ys = lax.scan(step, h, (blocks(xdt), blocks(da), blocks(bh), blocks(ch)))
    return jnp.swapaxes(ys, 0, 1).reshape(xdt.shape), h


def ssd_mix(x, dt, a, bm, cm, h0, segments):
    f32 = jnp.float32
    rep = SSD_HEADS // SSD_GROUPS
    xdt = x.astype(f32) * dt[..., None]
    da = dt * a
    bh = jnp.repeat(bm.astype(f32), rep, axis=2)
    ch = jnp.repeat(cm.astype(f32), rep, axis=2)
    h = h0.astype(f32)
    ys, start = [], 0
    for length, chunk in segments:
        sl = slice(start, start + length)
        y, h = ssd_chunks(xdt[:, sl], da[:, sl], bh[:, sl], ch[:, sl], h, chunk)
        ys.append(y)
        start += length
    return jnp.concatenate(ys, axis=1), h


def gla_chunks(q, k, v, g, s, chunk):
    b, L = q.shape[0], q.shape[1]
    nc = L // chunk
    tri = jnp.tril(jnp.ones((chunk, chunk), dtype=bool))

    def blocks(a):
        return jnp.swapaxes(a.reshape((b, nc, chunk) + a.shape[2:]), 0, 1)

    def step(sc, inp):
        qc, kc, vc, gc = inp
        bc = jnp.cumsum(gc, axis=1)
        diff = jnp.where(tri[None, :, :, None, None], bc[:, :, None] - bc[:, None, :], -jnp.inf)
        att = jnp.einsum('bthk,bshk,btshk->btsh', qc, kc, jnp.exp(diff))
        o = jnp.einsum('btsh,bshv->bthv', att, vc) + jnp.einsum('bthk,bhkv->bthv', qc * jnp.exp(bc), sc)
        last = bc[:, -1]
        sc = sc * jnp.exp(last)[..., None] + jnp.einsum('bshk,bshv->bhkv', kc * jnp.exp(last[:, None] - bc), vc)
        return sc, o

    s, os_ = lax.scan(step, s, (blocks(q), blocks(k), blocks(v), blocks(g)))
    return jnp.swapaxes(os_, 0, 1).reshape(v.shape), s


def gla_mix(q, k, v, g, s0, segments):
    f32 = jnp.float32
    q, k, v, g = q.astype(f32), k.astype(f32), v.astype(f32), g.astype(f32)
    s = s0.astype(f32)
    os_, start = [], 0
    for length, chunk in segments:
        sl = slice(start, start + length)
        o, s = gla_chunks(q[:, sl], k[:, sl], v[:, sl], g[:, sl], s, chunk)
        os_.append(o)
        start += length
    return jnp.concatenate(os_, axis=1), s


def trunk_layer(x, lp, conv_buf, h0, s0, segments, fox_fn):
    f32 = jnp.float32
    b, t = x.shape[0], x.shape[1]
    x = x + 0.5 * swiglu(rmsnorm(x, lp['ffn1_norm']), lp['ffn1_w_in'], lp['ffn1_w_out'])
    h = rmsnorm(x, lp['mix_norm'])
    fq, fk, fv, ff, sz, sxbc, sdt, gq, gk, gv, glr, gg = jnp.split(h @ lp['w_mix_in'], IN_SPLITS, axis=-1)
    fq = rmsnorm(fq.reshape(b, t, FOX_HEADS, FOX_HD), lp['fox_q_norm'])
    fk = rmsnorm(fk.reshape(b, t, FOX_HEADS, FOX_HD), lp['fox_k_norm'])
    fv = fv.reshape(b, t, FOX_HEADS, FOX_HD)
    logf = jax.nn.log_sigmoid((ff + lp['fox_f_bias']).astype(f32))
    fox_o = fox_fn(fq, fk, fv, logf).reshape(b, t, FOX_W)
    xbc, conv_new = causal_conv(sxbc, conv_buf, lp['ssd_conv_w'], lp['ssd_conv_b'])
    sx, sb, sc = jnp.split(xbc, (SSD_W, SSD_W + SSD_GROUPS * SSD_STATE), axis=-1)
    sx = sx.reshape(b, t, SSD_HEADS, SSD_HD)
    dt = jax.nn.softplus((sdt + lp['ssd_dt_bias']).astype(f32))
    a = -jnp.exp(lp['ssd_a_log'].astype(f32))
    y, h_new = ssd_mix(sx, dt, a, sb.reshape(b, t, SSD_GROUPS, SSD_STATE),
                       sc.reshape(b, t, SSD_GROUPS, SSD_STATE), h0, segments)
    y = (y + sx.astype(f32) * lp['ssd_d'].astype(f32)[:, None]).astype(x.dtype)
    y = y.reshape(b, t, SSD_W) * jax.nn.silu(sz)
    ssd_o = rmsnorm(y.reshape(b, t, SSD_GROUPS, SSD_W // SSD_GROUPS),
                    lp['ssd_norm'].reshape(SSD_GROUPS, SSD_W // SSD_GROUPS)).reshape(b, t, SSD_W)
    glog = jax.nn.log_sigmoid((glr @ lp['gla_w_gate'] + lp['gla_gate_bias']).astype(f32)) / GLA_TAU
    go, s_new = gla_mix(gq.reshape(b, t, GLA_HEADS, GLA_DK) * (GLA_DK ** -0.5),
                        gk.reshape(b, t, GLA_HEADS, GLA_DK), gv.reshape(b, t, GLA_HEADS, GLA_DV),
                        glog.reshape(b, t, GLA_HEADS, GLA_DK), s0, segments)
    gla_o = rmsnorm(go.astype(x.dtype), lp['gla_norm']).reshape(b, t, GLA_W) * jax.nn.silu(gg)
    x = x + jnp.concatenate([fox_o, ssd_o, gla_o], axis=-1) @ lp['w_mix_out']
    x = x + 0.5 * swiglu(rmsnorm(x, lp['ffn2_norm']), lp['ffn2_w_in'], lp['ffn2_w_out'])
    return x, (fk, fv, logf, conv_new, h_new, s_new)


def setup_inputs(seed: int = 0) -> dict:
    key = jax.random.key(seed)
    keys = iter(jax.random.split(key, 48))
    f32 = jnp.float32

    def nrm(shape, scale=1.0):
        return jax.random.normal(next(keys), shape, f32) * scale

    def gain(shape):
        return 1.0 + nrm(shape, 0.02)

    n_pages = PAST_LEN // PAGE_SIZE
    n_used = DEC_BATCH * n_pages
    n_pool = n_used + n_used // 4
    page_table = jax.random.permutation(next(keys), n_pool)[:n_used].reshape(DEC_BATCH, n_pages).astype(jnp.int32)
    dt0 = jnp.exp(jax.random.uniform(next(keys), (DEPTH, SSD_HEADS), f32, math.log(1e-3), math.log(1e-1)))
    ssd_dt_bias = dt0 + jnp.log(-jnp.expm1(-dt0))
    return {
        'x_prompt': nrm((BATCH, SEQ, D_MODEL)),
        'x_sample': nrm((DEC_BATCH, DEC_SEQ, D_MODEL)),
        'cache_fox_k': nrm((DEPTH, n_pool, PAGE_SIZE, FOX_HEADS, FOX_HD)),
        'cache_fox_v': nrm((DEPTH, n_pool, PAGE_SIZE, FOX_HEADS, FOX_HD)),
        'cache_fox_logf': jax.nn.log_sigmoid(nrm((DEPTH, n_pool, PAGE_SIZE, FOX_HEADS)) + 3.0),
        'state_ssm': nrm((DEPTH, DEC_BATCH, SSD_HEADS, SSD_HD, SSD_STATE), 0.1),
        'state_conv': nrm((DEPTH, DEC_BATCH, SSD_CONV - 1, SSD_CONV_DIM)),
        'state_gla': nrm((DEPTH, DEC_BATCH, GLA_HEADS, GLA_DK, GLA_DV), 0.3),
        'page_table': page_table,
        'meta_tokens': nrm((N_META, D_MODEL)),
        'ffn1_norm': gain((DEPTH, D_MODEL)),
        'ffn1_w_in': nrm((DEPTH, D_MODEL, 2 * D_FF), D_MODEL ** -0.5),
        'ffn1_w_out': nrm((DEPTH, D_FF, D_MODEL), D_FF ** -0.5),
        'mix_norm': gain((DEPTH, D_MODEL)),
        'w_mix_in': nrm((DEPTH, D_MODEL, N_IN), D_MODEL ** -0.5),
        'fox_q_norm': gain((DEPTH, FOX_HD)),
        'fox_k_norm': gain((DEPTH, FOX_HD)),
        'fox_f_bias': jax.random.uniform(next(keys), (DEPTH, FOX_HEADS), f32, 1.0, 4.0),
        'ssd_conv_w': nrm((DEPTH, SSD_CONV, SSD_CONV_DIM), SSD_CONV ** -0.5),
        'ssd_conv_b': nrm((DEPTH, SSD_CONV_DIM), 0.02),
        'ssd_dt_bias': ssd_dt_bias,
        'ssd_a_log': jnp.log(jax.random.uniform(next(keys), (DEPTH, SSD_HEADS), f32, 1.0, 16.0)),
        'ssd_d': gain((DEPTH, SSD_HEADS)),
        'ssd_norm': gain((DEPTH, SSD_W)),
        'gla_w_gate': nrm((DEPTH, GLA_RANK, GLA_KW), GLA_RANK ** -0.5),
        'gla_gate_bias': nrm((DEPTH, GLA_KW), 0.1),
        'gla_norm': gain((DEPTH, GLA_DV)),
        'w_mix_out': nrm((DEPTH, D_MIX, D_MODEL), D_MIX ** -0.5),
        'ffn2_norm': gain((DEPTH, D_MODEL)),
        'ffn2_w_in': nrm((DEPTH, D_MODEL, 2 * D_FF), D_MODEL ** -0.5),
        'ffn2_w_out': nrm((DEPTH, D_FF, D_MODEL), D_FF ** -0.5),
    }


def reference(x_prompt, x_sample, cache_fox_k, cache_fox_v, cache_fox_logf, state_ssm, state_conv,
              state_gla, page_table, meta_tokens, ffn1_norm, ffn1_w_in, ffn1_w_out, mix_norm, w_mix_in,
              fox_q_norm, fox_k_norm, fox_f_bias, ssd_conv_w, ssd_conv_b, ssd_dt_bias, ssd_a_log, ssd_d,
              ssd_norm, gla_w_gate, gla_gate_bias, gla_norm, w_mix_out, ffn2_norm, ffn2_w_in, ffn2_w_out):
    bp, seq = x_prompt.shape[0], x_prompt.shape[1]
    db, dseq = x_sample.shape[0], x_sample.shape[1]
    meta = jnp.broadcast_to(meta_tokens.astype(x_prompt.dtype)[None], (bp, N_META, D_MODEL))
    xp = jnp.concatenate([meta, x_prompt], axis=1)
    xs = x_sample
    seg_p = ((N_META, N_META), (seq, BLOCK))
    seg_s = ((dseq, dseq),)
    zero_conv = jnp.zeros((bp, SSD_CONV - 1, SSD_CONV_DIM), xp.dtype)
    zero_ssm = jnp.zeros((bp, SSD_HEADS, SSD_HD, SSD_STATE), jnp.float32)
    zero_gla = jnp.zeros((bp, GLA_HEADS, GLA_DK, GLA_DV), jnp.float32)
    new_p = [[] for _ in range(6)]
    new_s = [[] for _ in range(6)]
    for l in range(DEPTH):
        lp = dict(ffn1_norm=ffn1_norm[l], ffn1_w_in=ffn1_w_in[l], ffn1_w_out=ffn1_w_out[l],
                  mix_norm=mix_norm[l], w_mix_in=w_mix_in[l], fox_q_norm=fox_q_norm[l],
                  fox_k_norm=fox_k_norm[l], fox_f_bias=fox_f_bias[l], ssd_conv_w=ssd_conv_w[l],
                  ssd_conv_b=ssd_conv_b[l], ssd_dt_bias=ssd_dt_bias[l], ssd_a_log=ssd_a_log[l],
                  ssd_d=ssd_d[l], ssd_norm=ssd_norm[l], gla_w_gate=gla_w_gate[l],
                  gla_gate_bias=gla_gate_bias[l], gla_norm=gla_norm[l], w_mix_out=w_mix_out[l],
                  ffn2_norm=ffn2_norm[l], ffn2_w_in=ffn2_w_in[l], ffn2_w_out=ffn2_w_out[l])
        xp, st_p = trunk_layer(xp, lp, zero_conv, zero_ssm, zero_gla, seg_p, fox_prompt)
        k_past = cache_fox_k[l, page_table].reshape(db, -1, FOX_HEADS, FOX_HD)
        v_past = cache_fox_v[l, page_table].reshape(db, -1, FOX_HEADS, FOX_HD)
        lf_past = cache_fox_logf[l, page_table].reshape(db, -1, FOX_HEADS)
        fox_s = functools.partial(fox_sample, k_past=k_past, v_past=v_past, logf_past=lf_past)
        xs, st_s = trunk_layer(xs, lp, state_conv[l], state_ssm[l], state_gla[l], seg_s, fox_s)
        for i in range(6):
            new_p[i].append(st_p[i])
            new_s[i].append(st_s[i])
    k_p, v_p, lf_p, conv_p, ssm_p, gla_p = [jnp.stack(a) for a in new_p]
    k_s, v_s, lf_s, conv_s, ssm_s, gla_s = [jnp.stack(a) for a in new_s]
    return (xp[:, N_META:], xs, k_p, v_p, lf_p, ssm_p, conv_p, gla_p, k_s, v_s, lf_s, ssm_s, conv_s, gla_s)
```

```cpp
#include <hip/hip_runtime.h>
#include <cstdio>
#include <cstdint>

constexpr int D_MODEL = 1024, BATCH = 8, SEQ = 2048, DEPTH = 2, DEC_BATCH = 128, DEC_SEQ = 4, PAST = 2048, PAGE = 128, NPAGES = 16, NPOOL = 2560;
constexpr int N_META = 16, TP = N_META + SEQ;
constexpr int D_FF = 2816;
constexpr float EPS = 1e-6f;
constexpr int N_IN = 2844, LDMI = 2848;
constexpr int C_FQ = 0, C_FK = 256, C_FV = 512, C_FF = 768, C_SZ = 772, C_XBC = 1284, C_DT = 2052, C_GQ = 2060, C_GK = 2188, C_GV = 2316, C_LR = 2572, C_GG = 2588;
constexpr int N_MAIN = 2816, CM_SZ = 768, CM_XBC = 1280, CM_GQ = 2048, CM_GK = 2176, CM_GV = 2304, CM_GG = 2560;
__host__ __device__ constexpr int main2ref(int c) { return c < 768 ? c : (c < 2048 ? c + 4 : (c < 2560 ? c + 12 : c + 28)); }
__host__ __device__ constexpr int small2ref(int j) { return j < 4 ? C_FF + j : (j < 12 ? C_DT + (j - 4) : (j < 28 ? C_LR + (j - 12) : -1)); }
constexpr int MP = BATCH * SEQ, MS = DEC_BATCH * DEC_SEQ, R_S = MP, R_META = MP + MS, M_REAL = R_META + N_META, M_PAD = 17152;
constexpr size_t O_YP = 0;
constexpr size_t O_YS = O_YP + (size_t)BATCH * SEQ * D_MODEL;
constexpr size_t O_KP = O_YS + (size_t)MS * D_MODEL;
constexpr size_t O_VP = O_KP + (size_t)DEPTH * BATCH * TP * 256;
constexpr size_t O_LFP = O_VP + (size_t)DEPTH * BATCH * TP * 256;
constexpr size_t O_SSMP = O_LFP + (size_t)DEPTH * BATCH * TP * 4;
constexpr size_t O_CONVP = O_SSMP + (size_t)DEPTH * BATCH * 8 * 64 * 64;
constexpr size_t O_GLAP = O_CONVP + (size_t)DEPTH * BATCH * 3 * 768;
constexpr size_t O_KS = O_GLAP + (size_t)DEPTH * BATCH * 4 * 32 * 64;
constexpr size_t O_VS = O_KS + (size_t)DEPTH * MS * 256;
constexpr size_t O_LFS = O_VS + (size_t)DEPTH * MS * 256;
constexpr size_t O_SSMS = O_LFS + (size_t)DEPTH * MS * 4;
constexpr size_t O_CONVS = O_SSMS + (size_t)DEPTH * DEC_BATCH * 8 * 64 * 64;
constexpr size_t O_GLAS = O_CONVS + (size_t)DEPTH * DEC_BATCH * 3 * 768;
constexpr size_t O_END = O_GLAS + (size_t)DEPTH * DEC_BATCH * 4 * 32 * 64;
static_assert(O_END == 46638080, "output size");

constexpr size_t MiB = 1u << 20;
constexpr size_t WS_CTL = 0, CTL_ZERO_BYTES = 1 * MiB;
constexpr size_t SZ_W1 = (size_t)5632 * 1024 * 2, SZ_W2 = (size_t)1024 * 2816 * 2, SZ_W3 = (size_t)2816 * 1024 * 2, SZ_W7 = (size_t)32 * 1024 * 2, SZ_W4 = (size_t)1024 * 1024 * 2;
constexpr size_t WL_W1 = 0, WL_W2 = WL_W1 + SZ_W1, WL_W3 = WL_W2 + SZ_W2, WL_W4 = WL_W3 + SZ_W3, WL_W5 = WL_W4 + SZ_W4, WL_W6 = WL_W5 + SZ_W1, WL_W7 = WL_W6 + SZ_W2, WL_SIZE = WL_W7 + SZ_W7;
constexpr size_t WS_WT = 2 * MiB;
constexpr size_t WS_X = WS_WT + 2 * WL_SIZE;
constexpr size_t WS_XB = WS_X + (size_t)M_PAD * 1024 * 4;
constexpr size_t WS_SSQ = WS_XB + (size_t)M_PAD * 1024 * 2;
constexpr size_t WS_HB = WS_SSQ + (size_t)M_PAD * 16 * 4;
constexpr size_t WS_MIXB = WS_HB + (size_t)M_PAD * 2816 * 2;
constexpr size_t WS_MI = WS_MIXB + (size_t)M_PAD * 1024 * 2;
constexpr size_t WS_QN = WS_MI + (size_t)M_PAD * LDMI * 4;
constexpr size_t WS_KN = WS_QN + (size_t)M_PAD * 256 * 4;
constexpr size_t WS_LF = WS_KN + (size_t)M_PAD * 256 * 4;
constexpr size_t WS_FC = WS_LF + (size_t)M_PAD * 4 * 4;
constexpr size_t WS_FCS = WS_FC + (size_t)M_PAD * 4 * 4;
constexpr size_t WS_XBC = WS_FCS + (size_t)128 * 4 * 2052 * 4 + 4096;
constexpr size_t WS_DT = WS_XBC + (size_t)M_PAD * 768 * 4;
constexpr size_t WS_GLOG = WS_DT + (size_t)M_PAD * 8 * 4;
constexpr size_t WS_YS = WS_GLOG + (size_t)M_PAD * 128 * 4;
constexpr size_t WS_GO = WS_YS + (size_t)M_PAD * 512 * 4;
constexpr size_t WS_QF = WS_GO + (size_t)M_PAD * 256 * 4;
constexpr size_t WS_KF = WS_QF + (size_t)32 * 2048 * 64 * 2;
constexpr size_t WS_VT = WS_KF + (size_t)32 * 2112 * 64 * 2;
constexpr size_t WS_SSQH = WS_VT + (size_t)32 * 2112 * 64 * 2;
constexpr size_t WS_XC = WS_SSQH + (size_t)M_PAD * 8 * 4;
constexpr size_t WS_MIB = WS_XC + (size_t)M_PAD * 768 * 2;
constexpr size_t WS_END = WS_MIB + (size_t)M_PAD * LDMI * 2;
static_assert(WS_X % 256 == 0 && WS_XB % 256 == 0 && WS_SSQ % 256 == 0 && WS_HB % 256 == 0 && WS_MIXB % 256 == 0 && WS_MI % 256 == 0, "alignment");

#ifndef R_P0
#define R_P0 1
#endif
#ifndef R_G1
#define R_G1 1
#endif
#ifndef R_G3
#define R_G3 1
#endif
#ifndef R_PREP
#define R_PREP 1
#endif
#ifndef R_MIX
#define R_MIX 1
#endif
#ifndef R_BAR
#define R_BAR 0
#endif
constexpr int CW_BAR = 4096, CW_Q = 8192;
constexpr int NWAVES = 8;
constexpr int LDS_BYTES = 147456;
constexpr int MISC_OFF = 131072 + 320;

#define LAS __attribute__((address_space(3)))
#define GAS __attribute__((address_space(1)))
#define LDS_WAIT() asm volatile("s_waitcnt lgkmcnt(0)" ::: "memory")
typedef unsigned short bf16;
typedef unsigned v4u __attribute__((ext_vector_type(4)));
__device__ __forceinline__ unsigned f2bf(float f) { unsigned u = __builtin_bit_cast(unsigned, f); return (u + 0x7fffu + ((u >> 16) & 1u)) >> 16; }
__device__ __forceinline__ unsigned pk2(float lo, float hi) { return f2bf(lo) | (f2bf(hi) << 16); }

__device__ __forceinline__ float bperm(float x, int srclane);
namespace pg8 {
#define PG8_LAS __attribute__((address_space(3)))
typedef unsigned short bf16_t;
typedef short bf16x8 __attribute__((ext_vector_type(8)));
typedef float f32x4 __attribute__((ext_vector_type(4)));
typedef unsigned u32x4 __attribute__((ext_vector_type(4)));
constexpr int BM = 256, BK = 64, HALF = 128, HTB = HALF * BK * 2  , STAGE_BYTES = 8 * HTB, NXCD = 8, WGM = 8;

__host__ __device__ __forceinline__ int lds_byte(int r, int c) { const int st = (r >> 4) * 2 + (c >> 5), rr = r & 15, cc = c & 31, ob = rr * 64 + cc * 2; return st * 1024 + (ob ^ (((ob >> 9) & 1) << 5)); }
__host__ __device__ __forceinline__ void stage_rc(int b, int& R, int& C) { const int st = b / 1024, sb = b % 1024, swz = sb ^ (((sb >> 9) & 1) << 5); R = (st >> 1) * 16 + swz / 64; C = (st & 1) * 32 + (swz % 64) / 2; }
__host__ __device__ __forceinline__ int perm32(int rho) { const int n = rho >> 4, i = rho & 15; return 8 * (i >> 2) + 4 * n + (i & 3); }

struct Unit { int pm, pn; };
struct Gemm { const bf16_t* A; const bf16_t* Bt; int M, N, K; };

struct StaticOrder {
    int nM, nN, nwg, G, c;
    __host__ __device__ void init(int M, int N, int G_, int c_) { nM = M / BM; nN = N / BM; nwg = nM * nN; G = G_; c = c_; }
    __host__ __device__ bool next(int i, Unit& u) const {
        const long L = (long)i * G + c; if (L >= nwg) return false;
        int wgid = (int)L; { const int q = nwg / NXCD, r = nwg % NXCD, xcd = wgid % NXCD, off = wgid / NXCD; wgid = (xcd < r ? xcd * (q + 1) : r * (q + 1) + (xcd - r) * q) + off; }
        const int nig = WGM * nN, gid = wgid / nig, fm = gid * WGM, gsz = (nM - fm) < WGM ? (nM - fm) : WGM;
        u.pm = fm + ((wgid % nig) % gsz); u.pn = (wgid % nig) / gsz; return true;
    }
    __device__ __forceinline__ void a_ready(const Unit&) const {}
    __device__ __forceinline__ void done(const Unit&) const {}
};

__device__ __forceinline__ unsigned cvt_pk_bf16(float lo, float hi) { unsigned r; asm volatile("v_cvt_pk_bf16_f32 %0, %1, %2" : "=v"(r) : "v"(lo), "v"(hi)); return r; }
typedef float f32x2 __attribute__((ext_vector_type(2)));
__device__ __forceinline__ f32x2 gelu_pk(f32x2 v) {
    const f32x2 av = __builtin_elementwise_abs(v), d = av * 0.2316418882f + 1.0f;
    f32x2 t; t.x = __builtin_amdgcn_rcpf(d.x); t.y = __builtin_amdgcn_rcpf(d.y);
    f32x2 q = t * 0.5307027145f + (-0.7265760135f); q = q * t + 0.7107068705f; q = q * t + (-0.142248368f); q = q * t + 0.127414796f; q = q * t;
    const f32x2 s = (v * v) * (-0.72134752044f);
    f32x2 e; e.x = __builtin_amdgcn_exp2f(s.x); e.y = __builtin_amdgcn_exp2f(s.y);
    const f32x2 m = v * (q * e), r = v - m;
    f32x2 o; o.x = v.x < 0.f ? m.x : r.x; o.y = v.y < 0.f ? m.y : r.y; return o;
}


__device__ __forceinline__ float rstd_of(const float* SSQP, int row) {
    const f32x4* p = (const f32x4*)(SSQP + (size_t)row * 16);
    const f32x4 a = p[0], b = p[1], c = p[2], d = p[3];
    const float s = ((a[0] + a[1]) + (a[2] + a[3])) + ((b[0] + b[1]) + (b[2] + b[3])) + ((c[0] + c[1]) + (c[2] + c[3])) + ((d[0] + d[1]) + (d[2] + d[3]));
    return __builtin_amdgcn_rsqf(s * (1.0f / 1024.0f) + 1e-6f);
}
__device__ __forceinline__ float silu_fast(float x) { return x * __builtin_amdgcn_rcpf(1.0f + __expf(-x)); }
struct EpiSwiglu {
    static constexpr bool PERM = true, AFTER_DRAIN = false;
    bf16_t* H; const float* SSQP;
    __device__ __forceinline__ void operator()(const f32x4 (&acc)[2][2][4][2], const Unit& u, int wr, int wc, int fr, int fq) const {
        const int row0 = u.pm * BM + wr * 64 + fr, col0 = u.pn * 128 + wc * 32 + 8 * fq;
#pragma unroll
        for (int ai = 0; ai < 2; ++ai)
#pragma unroll
            for (int m = 0; m < 4; ++m) { const int row = row0 + ai * HALF + m * 16; const float rs = rstd_of(SSQP, row);
                const f32x4 g0 = acc[ai][0][m][0], g1 = acc[ai][0][m][1], u0 = acc[ai][1][m][0], u1 = acc[ai][1][m][1]; const float rs2 = rs * rs;
#define SWG(g, u) (silu_fast((g) * rs) * (u) * rs)
                u32x4 w; w.x = cvt_pk_bf16(SWG(g0[0], u0[0]), SWG(g0[1], u0[1])); w.y = cvt_pk_bf16(SWG(g0[2], u0[2]), SWG(g0[3], u0[3]));
                w.z = cvt_pk_bf16(SWG(g1[0], u1[0]), SWG(g1[1], u1[1])); w.w = cvt_pk_bf16(SWG(g1[2], u1[2]), SWG(g1[3], u1[3])); (void)rs2;
#undef SWG
                *(u32x4*)(H + (size_t)row * 2816 + col0) = w; }
    }
};
struct EpiResid {
    static constexpr bool PERM = true, AFTER_DRAIN = false;
    const GAS float* Xin; float* X; bf16_t* XB; float* SSQP; float scale; float* out; int final_;
    __device__ __forceinline__ void operator()(const f32x4 (&acc)[2][2][4][2], const Unit& u, int wr, int wc, int fr, int fq) const {
        const int row0 = u.pm * BM + wr * 64 + fr;
#pragma unroll
        for (int ai = 0; ai < 2; ++ai)
#pragma unroll
            for (int m = 0; m < 4; ++m) { const int row = row0 + ai * HALF + m * 16; float ss = 0.f;
#pragma unroll
                for (int bj = 0; bj < 2; ++bj) { const int col = u.pn * BM + bj * HALF + wc * 32 + 8 * fq;
                    const f32x4 a0 = acc[ai][bj][m][0], a1 = acc[ai][bj][m][1]; f32x4 x0, x1;
                    if (Xin) { const GAS f32x4* xi = (const GAS f32x4*)(Xin + (size_t)row * 1024 + col); x0 = xi[0]; x1 = xi[1]; }
                    else { const u32x4 wb = *(const u32x4*)(XB + (size_t)row * 1024 + col);
                        x0[0] = __uint_as_float(wb.x << 16); x0[1] = __uint_as_float(wb.x & 0xffff0000u); x0[2] = __uint_as_float(wb.y << 16); x0[3] = __uint_as_float(wb.y & 0xffff0000u);
                        x1[0] = __uint_as_float(wb.z << 16); x1[1] = __uint_as_float(wb.z & 0xffff0000u); x1[2] = __uint_as_float(wb.w << 16); x1[3] = __uint_as_float(wb.w & 0xffff0000u); }
                    x0[0] += a0[0] * scale; x0[1] += a0[1] * scale; x0[2] += a0[2] * scale; x0[3] += a0[3] * scale; x1[0] += a1[0] * scale; x1[1] += a1[1] * scale; x1[2] += a1[2] * scale; x1[3] += a1[3] * scale;
                    if (!final_) {
                    u32x4 w; w.x = cvt_pk_bf16(x0[0], x0[1]); w.y = cvt_pk_bf16(x0[2], x0[3]); w.z = cvt_pk_bf16(x1[0], x1[1]); w.w = cvt_pk_bf16(x1[2], x1[3]);
                    *(u32x4*)(XB + (size_t)row * 1024 + col) = w;
                    ss += (x0[0] * x0[0] + x0[1] * x0[1]) + (x0[2] * x0[2] + x0[3] * x0[3]) + (x1[0] * x1[0] + x1[1] * x1[1]) + (x1[2] * x1[2] + x1[3] * x1[3]); }
                    if (final_) { float* o = nullptr; if (row < MP) o = out + O_YP + (size_t)row * 1024 + col; else if (row < R_META) o = out + O_YS + (size_t)(row - R_S) * 1024 + col;
                        if (o) { ((f32x4*)o)[0] = x0; ((f32x4*)o)[1] = x1; } } }
                ss += bperm(ss, (fq * 16 + fr) ^ 16); ss += bperm(ss, (fq * 16 + fr) ^ 32);
                if (fq == 0 && !final_) SSQP[(size_t)row * 16 + u.pn * 4 + wc] = ss; }
    }
};
struct EpiMix {
    static constexpr bool PERM = true, AFTER_DRAIN = false;
    float* MI; bf16_t* MIB; const float* SSQP; bf16_t* QF; bf16_t* KF; bf16_t* VT; const float* qg; const float* kg; const float* fbias; float* LF; float* out; int l;
    __device__ __forceinline__ void operator()(const f32x4 (&acc)[2][2][4][2], const Unit& u, int wr, int wc, int fr_, int fq_) const {
        int ln_; asm volatile("v_mbcnt_lo_u32_b32 %0, -1, 0\n\tv_mbcnt_hi_u32_b32 %0, -1, %0" : "=v"(ln_)); const int fr = ln_ & 15, fq = ln_ >> 4; (void)fr_; (void)fq_;
        const int row0 = u.pm * BM + wr * 64 + fr;
        if (u.pn < 3) {
            f32x4 gn[2][2];
            const float* gp = u.pn == 0 ? qg : kg;
#pragma unroll
            for (int bj = 0; bj < 2; ++bj)
#pragma unroll
                for (int n = 0; n < 2; ++n) gn[bj][n] = u.pn < 2 ? *(const f32x4*)(gp + 32 * bj + 8 * fq + 4 * n) : (f32x4){1.f, 1.f, 1.f, 1.f};
            const float qs = u.pn == 0 ? 0.18033688011112042f : 1.0f;
#pragma unroll
            for (int ai = 0; ai < 2; ++ai)
#pragma unroll
                for (int m = 0; m < 4; ++m) { const int row = row0 + ai * HALF + m * 16; const float rs = rstd_of(SSQP, row);
                    float v[2][8]; float ss = 0.f;
#pragma unroll
                    for (int bj = 0; bj < 2; ++bj) { const f32x4 a0 = acc[ai][bj][m][0], a1 = acc[ai][bj][m][1];
                        v[bj][0] = a0[0] * rs; v[bj][1] = a0[1] * rs; v[bj][2] = a0[2] * rs; v[bj][3] = a0[3] * rs; v[bj][4] = a1[0] * rs; v[bj][5] = a1[1] * rs; v[bj][6] = a1[2] * rs; v[bj][7] = a1[3] * rs;
                        if (row >= MP) { f32x4* o = (f32x4*)(MI + (size_t)row * LDMI + u.pn * 256 + wc * 64 + bj * 32 + 8 * fq);
                            o[0] = (f32x4){v[bj][0], v[bj][1], v[bj][2], v[bj][3]}; o[1] = (f32x4){v[bj][4], v[bj][5], v[bj][6], v[bj][7]}; }
#pragma unroll
                        for (int e = 0; e < 8; ++e) ss += v[bj][e] * v[bj][e]; }
                    if (u.pn < 2) { ss += bperm(ss, (fq * 16 + fr) ^ 16); ss += bperm(ss, (fq * 16 + fr) ^ 32); const float hn = __builtin_amdgcn_rsqf(ss * (1.0f / 64.0f) + 1e-6f) * qs;
#pragma unroll
                        for (int bj = 0; bj < 2; ++bj)
#pragma unroll
                            for (int e = 0; e < 8; ++e) v[bj][e] *= hn * gn[bj][e >> 2][e & 3]; }
                    const bool isP = row < MP, isM = row >= R_META && row < M_REAL;
                    if (u.pn > 0 && row < M_REAL) {
                        float* ob; int nc = 1; size_t cs_ = 0;
                        if (isP) ob = out + (u.pn == 1 ? O_KP : O_VP) + ((size_t)(l * BATCH + (row >> 11)) * TP + 16 + (row & 2047)) * 256;
                        else if (isM) { ob = out + (u.pn == 1 ? O_KP : O_VP) + ((size_t)(l * BATCH) * TP + (row - R_META)) * 256; nc = BATCH; cs_ = (size_t)TP * 256; }
                        else ob = out + (u.pn == 1 ? O_KS : O_VS) + ((size_t)l * MS + (row - R_S)) * 256;
                        for (int c = 0; c < nc; ++c)
#pragma unroll
                            for (int bj = 0; bj < 2; ++bj) { f32x4* o = (f32x4*)(ob + c * cs_ + wc * 64 + bj * 32 + 8 * fq);
                                o[0] = (f32x4){v[bj][0], v[bj][1], v[bj][2], v[bj][3]}; o[1] = (f32x4){v[bj][4], v[bj][5], v[bj][6], v[bj][7]}; }
                    }
                    if (isP || (isM && u.pn > 0)) {
                        const int b0 = isP ? (row >> 11) : 0, nb = isP ? 1 : 8, slot = isP ? 64 + (row & 2047) : row - R_META;
                        for (int bb = b0; bb < b0 + nb; ++bb) { const int bh = bb * 4 + wc;
                            if (u.pn < 2) {
                                bf16_t* dst = u.pn == 0 ? QF + ((size_t)bh * 2048 + (row & 2047)) * 64 : KF + ((size_t)bh * 2112 + slot) * 64;
#pragma unroll
                                for (int bj = 0; bj < 2; ++bj) { u32x4 w; w.x = cvt_pk_bf16(v[bj][0], v[bj][1]); w.y = cvt_pk_bf16(v[bj][2], v[bj][3]); w.z = cvt_pk_bf16(v[bj][4], v[bj][5]); w.w = cvt_pk_bf16(v[bj][6], v[bj][7]);
                                    *(u32x4*)(dst + 32 * bj + 8 * fq) = w; }
                            } else {
#pragma unroll
                                for (int bj = 0; bj < 2; ++bj)
#pragma unroll
                                    for (int e = 0; e < 8; e += 2) { const unsigned w = cvt_pk_bf16(v[bj][e], v[bj][e + 1]); const int d = 32 * bj + 8 * fq + e;
                                        VT[((size_t)bh * 64 + d) * 2112 + slot] = (bf16_t)(w & 0xffffu); VT[((size_t)bh * 64 + d + 1) * 2112 + slot] = (bf16_t)(w >> 16); }
                            } } } }
        } else {
#pragma unroll
            for (int ai = 0; ai < 2; ++ai)
#pragma unroll
                for (int m = 0; m < 4; ++m) { const int row = row0 + ai * HALF + m * 16; const float rs = rstd_of(SSQP, row);
#pragma unroll
                    for (int bj = 0; bj < 2; ++bj) { const int colm = u.pn * BM + bj * HALF + wc * 32 + 8 * fq, col = main2ref(colm);
                        const f32x4 a0 = acc[ai][bj][m][0], a1 = acc[ai][bj][m][1];
                        f32x4 r0v = (f32x4){a0[0] * rs, a0[1] * rs, a0[2] * rs, a0[3] * rs}, r1v = (f32x4){a1[0] * rs, a1[1] * rs, a1[2] * rs, a1[3] * rs};
                        if ((colm >= CM_SZ && colm < CM_SZ + 512) || colm >= CM_GG) {
#pragma unroll
                            for (int e = 0; e < 4; ++e) { r0v[e] = silu_fast(r0v[e]); r1v[e] = silu_fast(r1v[e]); } }
                        { u32x4 w; w.x = cvt_pk_bf16(r0v[0], r0v[1]); w.y = cvt_pk_bf16(r0v[2], r0v[3]); w.z = cvt_pk_bf16(r1v[0], r1v[1]); w.w = cvt_pk_bf16(r1v[2], r1v[3]); *(u32x4*)(MIB + (size_t)row * N_MAIN + colm) = w; }
                        if (row >= MP) { f32x4* o = (f32x4*)(MI + (size_t)row * LDMI + col); o[0] = r0v; o[1] = r1v; }
                        if (colm >= CM_XBC && colm < CM_XBC + 768) {
                            float* cvo = nullptr;
                            if (row < MP) { if ((row & 2047) >= 2045) cvo = out + O_CONVP + ((size_t)(l * BATCH + (row >> 11)) * 3 + ((row & 2047) - 2045)) * 768; }
                            else if (row < R_META) { if (((row - R_S) & 3) >= 1) cvo = out + O_CONVS + ((size_t)(l * DEC_BATCH + ((row - R_S) >> 2)) * 3 + (((row - R_S) & 3) - 1)) * 768; }
                            if (cvo) { *(f32x4*)(cvo + colm - CM_XBC) = r0v; *(f32x4*)(cvo + colm - CM_XBC + 4) = r1v; } }
                    } }
        }
    }
};

template <class Epi, class Sched, bool ALIGN_EPI = false, bool SP2 = false>
__device__ __forceinline__ void gemm_phase(PG8_LAS unsigned char* lds, const Gemm g, const Sched& S, const Epi& E, const int tid) {
    const int wid = __builtin_amdgcn_readfirstlane(tid >> 6), lane = tid & 63, wr = wid >> 2, wc = wid & 3, fr = lane & 15, fq = lane >> 4;
    const int K = g.K, nt = K / BK;
    unsigned voffA[2], voffB[2];
#pragma unroll
    for (int i = 0; i < 2; ++i) { int R, C; stage_rc(tid * 16 + i * 8192, R, C); const int Rb = Epi::PERM ? ((R & ~31) + perm32(R & 31)) : R;
        voffA[i] = (unsigned)(R * K + C) * 2u; voffB[i] = (unsigned)(Rb * K + C) * 2u; }
    const size_t kstep = (size_t)(BK * 2);
    const size_t hstep = (size_t)HALF * K * 2;
    const size_t tstep = 2 * hstep;
    const unsigned ldsw = (unsigned)wid * 1024u;
    const int aoff = lds_byte(wr * 64 + fr, fq * 8), boff = lds_byte(wc * 32 + fr, fq * 8);
#define PG8_SA(b, h) (((b) * 2 + (h)) * HTB)
#define PG8_SB(b, h) ((4 + (b) * 2 + (h)) * HTB)
#define PG8_STAGE(bufoff, gbase, voff) do { _Pragma("unroll") for (int _i = 0; _i < 2; ++_i) \
        __builtin_amdgcn_global_load_lds((const unsigned*)((const char*)(gbase) + (voff)[_i]), (PG8_LAS unsigned*)(lds + (bufoff) + ldsw + _i * 8192), 16, 0, 0); } while (0)
#define PG8_LDA(dst, b, h) do { _Pragma("unroll") for (int m = 0; m < 4; ++m) _Pragma("unroll") for (int k = 0; k < 2; ++k) dst[m][k] = *(const PG8_LAS bf16x8*)(lds + PG8_SA(b, h) + aoff + m * 2048 + k * 1024); } while (0)
#define PG8_LDB(dst, b, h) do { _Pragma("unroll") for (int n = 0; n < 2; ++n) _Pragma("unroll") for (int k = 0; k < 2; ++k) dst[n][k] = *(const PG8_LAS bf16x8*)(lds + PG8_SB(b, h) + boff + n * 2048 + k * 1024); } while (0)
#define PG8_MMA(ai, bj, At, Bt) do { __builtin_amdgcn_s_setprio(1); _Pragma("unroll") for (int m = 0; m < 4; ++m) _Pragma("unroll") for (int n = 0; n < 2; ++n) _Pragma("unroll") for (int k = 0; k < 2; ++k) \
        acc[ai][bj][m][n] = __builtin_amdgcn_mfma_f32_16x16x32_bf16(Bt[n][k], At[m][k], acc[ai][bj][m][n], 0, 0, 0); __builtin_amdgcn_s_setprio(0); } while (0)
#define PG8_WAIT_V(n) asm volatile("s_waitcnt vmcnt(" #n ")" ::: "memory")
#define PG8_WAIT_L(n) asm volatile("s_waitcnt lgkmcnt(" #n ")" ::: "memory")
#define PG8_BAR __builtin_amdgcn_s_barrier()
#define PG8_SCHED __builtin_amdgcn_sched_barrier(0)
    Unit cur, nxt; int ui = 0;
    if (!S.next(0, cur)) return;
    f32x4 acc[2][2][4][2];
#pragma unroll
    for (int a = 0; a < 2; ++a)
#pragma unroll
        for (int b = 0; b < 2; ++b)
#pragma unroll
            for (int m = 0; m < 4; ++m)
#pragma unroll
                for (int n = 0; n < 2; ++n) acc[a][b][m][n] = (f32x4){0.f, 0.f, 0.f, 0.f};
    bf16x8 At[4][2], B0[2][2], B1[2][2];
    const char* cA = (const char*)g.A + (size_t)cur.pm * tstep; const char* cB = (const char*)g.Bt + (size_t)cur.pn * tstep;
    S.a_ready(cur);
    if constexpr (SP2) {
        PG8_STAGE(PG8_SB(0, 0), cB, voffB); PG8_STAGE(PG8_SB(0, 1), cB + hstep, voffB); PG8_STAGE(PG8_SA(0, 0), cA, voffA); PG8_STAGE(PG8_SA(0, 1), cA + hstep, voffA);
        if (wr == 1) PG8_BAR;
        PG8_WAIT_V(2); PG8_BAR;
        PG8_STAGE(PG8_SB(1, 0), cB + kstep, voffB); PG8_STAGE(PG8_SA(1, 0), cA + kstep, voffA); PG8_STAGE(PG8_SB(1, 1), cB + hstep + kstep, voffB);
        PG8_WAIT_V(6); PG8_BAR;
    } else {
        PG8_STAGE(PG8_SB(0, 0), cB, voffB); PG8_STAGE(PG8_SA(0, 0), cA, voffA); PG8_STAGE(PG8_SB(0, 1), cB + hstep, voffB); PG8_STAGE(PG8_SA(0, 1), cA + hstep, voffA);
        if (wr == 1) PG8_BAR;
        PG8_WAIT_V(4); PG8_BAR;
        PG8_STAGE(PG8_SB(1, 0), cB + kstep, voffB); PG8_STAGE(PG8_SA(1, 0), cA + kstep, voffA); PG8_STAGE(PG8_SB(1, 1), cB + hstep + kstep, voffB);
        PG8_WAIT_V(6); PG8_BAR;
    }
    for (;;) {
        const bool has_next = S.next(ui + 1, nxt);
        const char* nA = has_next ? (const char*)g.A + (size_t)nxt.pm * tstep : cA; const char* nB = has_next ? (const char*)g.Bt + (size_t)nxt.pn * tstep : cB;
        for (int t = 0; t < nt; t += 2) {
            const bool last = (t == nt - 2);
            const char* a1 = cA + (size_t)(t + 1) * kstep;
            const char* a2 = last ? nA : cA + (size_t)(t + 2) * kstep; const char* b2 = last ? nB : cB + (size_t)(t + 2) * kstep;
            const char* a3 = a2 + kstep; const char* b3 = b2 + kstep;
            if (last && has_next) S.a_ready(nxt);
            if constexpr (SP2) {
            PG8_LDB(B0, 0, 0); PG8_LDB(B1, 0, 1); PG8_SCHED; PG8_LDA(At, 0, 0); PG8_STAGE(PG8_SA(1, 1), a1 + hstep, voffA);
            PG8_WAIT_V(8); PG8_WAIT_L(0); PG8_BAR; PG8_MMA(0, 0, At, B0); PG8_MMA(0, 1, At, B1); PG8_BAR; PG8_SCHED;
            PG8_LDA(At, 0, 1); PG8_STAGE(PG8_SB(0, 0), b2, voffB); PG8_STAGE(PG8_SB(0, 1), b2 + hstep, voffB); PG8_STAGE(PG8_SA(0, 0), a2, voffA);
            PG8_WAIT_V(8); PG8_WAIT_L(0); PG8_BAR; PG8_MMA(1, 0, At, B0); PG8_MMA(1, 1, At, B1); PG8_BAR; PG8_SCHED;
            PG8_LDB(B0, 1, 0); PG8_LDB(B1, 1, 1); PG8_SCHED; PG8_LDA(At, 1, 0); PG8_STAGE(PG8_SA(0, 1), a2 + hstep, voffA);
            PG8_WAIT_V(8); PG8_WAIT_L(0); PG8_BAR; PG8_MMA(0, 0, At, B0); PG8_MMA(0, 1, At, B1); PG8_BAR; PG8_SCHED;
            PG8_LDA(At, 1, 1); PG8_STAGE(PG8_SB(1, 0), b3, voffB); PG8_STAGE(PG8_SB(1, 1), b3 + hstep, voffB); PG8_STAGE(PG8_SA(1, 0), a3, voffA);
            PG8_WAIT_V(8); PG8_WAIT_L(0); PG8_BAR; PG8_MMA(1, 0, At, B0); PG8_MMA(1, 1, At, B1); PG8_BAR; PG8_SCHED;
            } else {
            PG8_LDB(B0, 0, 0); PG8_SCHED; PG8_LDA(At, 0, 0); PG8_STAGE(PG8_SA(1, 1), a1 + hstep, voffA);
            PG8_WAIT_L(8); PG8_BAR; PG8_WAIT_L(0); PG8_MMA(0, 0, At, B0); PG8_BAR; PG8_SCHED;
            PG8_LDB(B1, 0, 1); PG8_STAGE(PG8_SB(0, 0), b2, voffB);
            PG8_BAR; PG8_WAIT_L(0); PG8_MMA(0, 1, At, B1); PG8_BAR;
            PG8_LDA(At, 0, 1); PG8_STAGE(PG8_SA(0, 0), a2, voffA);
            PG8_BAR; PG8_WAIT_L(0); PG8_MMA(1, 0, At, B0); PG8_BAR; PG8_SCHED;
            PG8_STAGE(PG8_SB(0, 1), b2 + hstep, voffB);
            PG8_WAIT_V(6); PG8_BAR; PG8_MMA(1, 1, At, B1); PG8_BAR;
            PG8_LDB(B0, 1, 0); PG8_SCHED; PG8_LDA(At, 1, 0); PG8_STAGE(PG8_SA(0, 1), a2 + hstep, voffA);
            PG8_WAIT_L(8); PG8_BAR; PG8_WAIT_L(0); PG8_MMA(0, 0, At, B0); PG8_BAR; PG8_SCHED;
            PG8_LDB(B1, 1, 1); PG8_STAGE(PG8_SB(1, 0), b3, voffB);
            PG8_BAR; PG8_WAIT_L(0); PG8_MMA(0, 1, At, B1); PG8_BAR;
            PG8_LDA(At, 1, 1); PG8_STAGE(PG8_SA(1, 0), a3, voffA);
            PG8_BAR; PG8_WAIT_L(0); PG8_MMA(1, 0, At, B0); PG8_BAR; PG8_SCHED;
            PG8_STAGE(PG8_SB(1, 1), b3 + hstep, voffB);
            PG8_WAIT_V(6); PG8_BAR; PG8_MMA(1, 1, At, B1); PG8_BAR;
            }
        }
        if constexpr (ALIGN_EPI) { if (wr == 0) PG8_BAR; }
        if constexpr (!Epi::AFTER_DRAIN) { E(acc, cur, wr, wc, fr, fq); S.done(cur); }
        if (!has_next) break;
#pragma unroll
        for (int a = 0; a < 2; ++a)
#pragma unroll
            for (int b = 0; b < 2; ++b)
#pragma unroll
                for (int m = 0; m < 4; ++m)
#pragma unroll
                    for (int n = 0; n < 2; ++n) acc[a][b][m][n] = (f32x4){0.f, 0.f, 0.f, 0.f};
        cur = nxt; cA = nA; cB = nB; ++ui;
        if constexpr (ALIGN_EPI) { if (wr == 1) PG8_BAR; }
    }
    PG8_WAIT_V(0);
    if constexpr (!ALIGN_EPI) { if (wr == 0) PG8_BAR; }
    PG8_BAR;
    if constexpr (Epi::AFTER_DRAIN) { E.fused(acc, cur, wr, wc, fr, fq, lds, wid, lane); S.done(cur); }
#undef PG8_SA
#undef PG8_SB
#undef PG8_STAGE
#undef PG8_LDA
#undef PG8_LDB
#undef PG8_MMA
#undef PG8_WAIT_V
#undef PG8_WAIT_L
#undef PG8_BAR
#undef PG8_SCHED
}
}

#define XB_TMO      128
#define XB_XCNT(j)  (256  + 64 * (j))
#define XB_XSUB(j)  (1280 + 64 * (j))
#define XB_XGEN(j)  (2304 + 64 * (j))
#define XB_TOP      3328
#define XB_TOPGEN   3392
#define XCD_BAR_WORDS 3456
#define XB_SPIN_CAP (1u << 23)
__device__ __forceinline__ unsigned xb_ld(unsigned* p)              { return __hip_atomic_load(p, __ATOMIC_RELAXED, __HIP_MEMORY_SCOPE_AGENT); }
__device__ __forceinline__ unsigned xb_add(unsigned* p, unsigned v) { return __hip_atomic_fetch_add(p, v, __ATOMIC_RELAXED, __HIP_MEMORY_SCOPE_AGENT); }
__device__ __forceinline__ unsigned xb_xcc_id() { return (unsigned)__builtin_amdgcn_s_getreg((3 << 11) | 20) & 0xFu; }
#define XB_SPIN(cond, bar) do { unsigned _sp = 0; while (cond) { __builtin_amdgcn_s_sleep(1); \
    if ((++_sp & 255u) == 0u) { if (xb_ld(&(bar)[XB_TMO])) break; if (_sp > XB_SPIN_CAP) { atomicAdd(&(bar)[XB_TMO], 1u); break; } } } } while (0)
struct XcdBarrier { unsigned* bar; unsigned x; volatile LAS unsigned* st; };
__device__ __forceinline__ XcdBarrier xcd_barrier_post(unsigned* bar, volatile LAS unsigned* st) {
    XcdBarrier b; b.bar = bar; b.x = xb_xcc_id(); b.st = st;
    if (threadIdx.x == 0) (void)xb_add(&bar[XB_XCNT(b.x)], 1u);
    return b;
}
__device__ __forceinline__ void xcd_barrier_complete(unsigned* bar, unsigned x, unsigned& nloc, unsigned& nx) {
    const unsigned G = gridDim.x * gridDim.y * gridDim.z;
    unsigned sum, cnt, mine, sp = 0u;
    for (;;) {
        sum = 0u; cnt = 0u; mine = 0u;
#pragma unroll
        for (unsigned j = 0; j < 16; ++j) { const unsigned c = xb_ld(&bar[XB_XCNT(j)]); sum += c; cnt += (c > 0u) ? 1u : 0u; mine = (j == x) ? c : mine; }
        if (sum == G) break;
        __builtin_amdgcn_s_sleep(1);
        if ((++sp & 255u) == 0u) { if (xb_ld(&bar[XB_TMO])) break; if (sp > XB_SPIN_CAP) { atomicAdd(&bar[XB_TMO], 1u); break; } }
    }
    nloc = mine > 0u ? mine : 1u; nx = cnt > 0u ? cnt : 1u;
}
__device__ __forceinline__ void xcd_barrier(const XcdBarrier& b, const int tid_) {
    asm volatile("s_waitcnt vmcnt(0)" ::: "memory");
    __syncthreads();
    if (tid_ == 0) {
        unsigned* bar = b.bar; asm volatile("" : "+s"(bar));
        __builtin_amdgcn_s_waitcnt(0);
        unsigned nloc = b.st[0], nx = b.st[1];
        if (nloc == 0u) { xcd_barrier_complete(bar, b.x, nloc, nx); b.st[0] = nloc; b.st[1] = nx; }
        const unsigned old = xb_add(&bar[XB_XSUB(b.x)], 1u);
        const unsigned gen = old / nloc;
        if (old + 1u == (gen + 1u) * nloc) {
            __builtin_amdgcn_fence(__ATOMIC_RELEASE, "agent");
            asm volatile("s_waitcnt vmcnt(0)" ::: "memory");
            const unsigned og = xb_add(&bar[XB_TOP], 1u);
            const unsigned tg = og / nx;
            if (og + 1u == (tg + 1u) * nx) xb_add(&bar[XB_TOPGEN], 1u);
            else XB_SPIN(xb_ld(&bar[XB_TOPGEN]) == tg, bar);
            __builtin_amdgcn_fence(__ATOMIC_ACQUIRE, "agent");
            xb_add(&bar[XB_XGEN(b.x)], 1u);
            asm volatile("s_waitcnt vmcnt(0)" ::: "memory");
        } else {
            XB_SPIN(xb_ld(&bar[XB_XGEN(b.x)]) == gen, bar);
            __builtin_amdgcn_fence(__ATOMIC_ACQUIRE, "agent");
            asm volatile("s_waitcnt vmcnt(0)" ::: "memory");
        }
    }
    __syncthreads();
}

__device__ __forceinline__ float wave_sum(float v) {
#pragma unroll
    for (int o = 1; o < 64; o <<= 1) v += __shfl_xor(v, o);
    return v;
}
__device__ __forceinline__ float wave_max(float v) {
#pragma unroll
    for (int o = 1; o < 64; o <<= 1) v = fmaxf(v, __shfl_xor(v, o));
    return v;
}
__device__ __forceinline__ float bperm(float x, int srclane) { return __builtin_bit_cast(float, __builtin_amdgcn_ds_bpermute(srclane << 2, __builtin_bit_cast(int, x))); }
__device__ __forceinline__ float wave_sum_l(float v, int lane) {
#pragma unroll
    for (int o = 1; o < 64; o <<= 1) v += bperm(v, lane ^ o);
    return v;
}
__device__ __forceinline__ float wave_max_l(float v, int lane) {
#pragma unroll
    for (int o = 1; o < 64; o <<= 1) v = fmaxf(v, bperm(v, lane ^ o));
    return v;
}
__device__ __forceinline__ float siluf(float x) { return x / (1.f + expf(-x)); }
__device__ __forceinline__ float log_sigmoidf(float x) { return fminf(x, 0.f) - log1pf(expf(-fabsf(x))); }
__device__ __forceinline__ float softplusf(float x) { return fmaxf(x, 0.f) + log1pf(expf(-fabsf(x))); }

__device__ __forceinline__ const float* conv_prev(const float* MI, const float* state_conv_l, int r, int j) {
    if (r < MP) { const int b = r >> 11, i = r & 2047; const int p = i - j; if (p >= 0) return MI + (size_t)(b * 2048 + p) * LDMI + C_XBC; return MI + (size_t)(R_META + 16 + p) * LDMI + C_XBC; }
    if (r < R_META) { const int s = r - R_S, b = s >> 2, i = s & 3; const int p = i - j; if (p >= 0) return MI + (size_t)(R_S + b * 4 + p) * LDMI + C_XBC; return state_conv_l + (size_t)(b * 3 + 3 + p) * 768; }
    const int i = r - R_META, p = i - j; if (p >= 0) return MI + (size_t)(R_META + p) * LDMI + C_XBC; return nullptr;
}

struct PromptKeys { const float* KN; const float* MI; const float* FC; int b, h;
    __device__ __forceinline__ void get(int j, const float*& kp, const float*& vp, float& Fk) const { const int row = j < 16 ? R_META + j : b * 2048 + (j - 16);
        kp = KN + (size_t)row * 256 + h * 64; vp = MI + (size_t)row * LDMI + C_FV + h * 64; Fk = FC[row * 4 + h]; } };
struct SampleKeys { const float* KN; const float* MI; const float* FCS; const float* ck; const float* cv; const int* pt; int b, h, l;
    __device__ __forceinline__ void get(int j, const float*& kp, const float*& vp, float& Fk) const {
        Fk = FCS[(size_t)(b * 4 + h) * 2052 + j];
        if (j < 2048) { const int page = pt[b * 16 + (j >> 7)]; const size_t off = (((size_t)l * NPOOL + page) * 128 + (j & 127)) * 256 + h * 64; kp = ck + off; vp = cv + off; }
        else { const int row = R_S + b * 4 + (j - 2048); kp = KN + (size_t)row * 256 + h * 64; vp = MI + (size_t)row * LDMI + C_FV + h * 64; } } };

template <class Keys>
__device__ __forceinline__ void attn_row(const float* qg, float Fq, int nk, const Keys& K, bf16* outp, float* sq, float* sc, int lane) {
    sq[lane] = qg[lane];
    LDS_WAIT();
    float mx = -INFINITY;
    for (int j = lane; j < nk; j += 64) {
        const float* kp; const float* vp; float Fk; K.get(j, kp, vp, Fk);
        float s = 0.f;
#pragma unroll
        for (int d4 = 0; d4 < 16; ++d4) { const float4 a = ((const float4*)sq)[d4]; const float4 b = ((const float4*)kp)[d4]; s += a.x * b.x + a.y * b.y + a.z * b.z + a.w * b.w; }
        s = s * 0.125f + (Fq - Fk);
        sc[j] = s; mx = fmaxf(mx, s);
    }
    mx = wave_max_l(mx, lane);
    float sum = 0.f;
    for (int j = lane; j < nk; j += 64) { const float p = expf(sc[j] - mx); sc[j] = p; sum += p; }
    sum = wave_sum_l(sum, lane);
    LDS_WAIT();
    float o = 0.f;
    for (int j = 0; j < nk; ++j) { const float* kp; const float* vp; float Fk; K.get(j, kp, vp, Fk); o += sc[j] * vp[lane]; }
    outp[lane] = (bf16)f2bf(o / sum);
    LDS_WAIT();
}

namespace fa {
typedef short bf16x8 __attribute__((ext_vector_type(8)));
typedef short s16x4 __attribute__((ext_vector_type(4)));
typedef float f4 __attribute__((ext_vector_type(4)));
typedef float f32x16 __attribute__((ext_vector_type(16)));
typedef float f32x2_t __attribute__((ext_vector_type(2)));
typedef __bf16 bf16x2_t __attribute__((ext_vector_type(2)));
__device__ __forceinline__ unsigned cvtpk(float lo, float hi) { f32x2_t v = {lo, hi}; bf16x2_t b = __builtin_convertvector(v, bf16x2_t); return __builtin_bit_cast(unsigned, b); }
__device__ __forceinline__ int crow(int r, int hi) { return (r & 3) + 8 * (r >> 2) + 4 * hi; }
template <int CTRL> __device__ __forceinline__ float dpp(float x) { return __builtin_bit_cast(float, __builtin_amdgcn_mov_dpp(__builtin_bit_cast(int, x), CTRL, 0xf, 0xf, true)); }
constexpr int XOR1 = 0xB1, XOR2 = 0x4E, XOR7 = 0x141, XOR8 = 0x128;
__device__ __forceinline__ float row16_sum(float s) { s += dpp<XOR1>(s); s += dpp<XOR2>(s); s += dpp<XOR7>(s); s += dpp<XOR8>(s); return s; }
#define MFMA32(a, b, c) __builtin_amdgcn_mfma_f32_32x32x16_bf16((a), (b), (c), 0, 0, 0)

constexpr int KSTR = 144;
constexpr int L_K0 = 0, L_V0 = 2 * 64 * KSTR, L_KB = 4 * 64 * KSTR, L_WS = L_KB + 2112 * 4, L_END = L_WS + 64;
constexpr float LOG2E = 1.4426950408889634f;

__device__ __forceinline__ void fox_prompt_unit(int b, int h, int qb, const bf16* QF, const bf16* KF, const bf16* VT, const float* LF, bf16* MIXB, LAS unsigned char* lds, int tid) {
    const int lane = tid & 63, wave = __builtin_amdgcn_readfirstlane(tid >> 6), r32 = lane & 31, hi = lane >> 5;
    const int ntile = 5 + 4 * qb, nslots = 64 * ntile;
    LAS float* kb = (LAS float*)(lds + L_KB); LAS float* wsum = (LAS float*)(lds + L_WS);
    {
        float v[5]; float run = 0.f;
#pragma unroll
        for (int e = 0; e < 5; ++e) { const int slot = 5 * tid + e; float lf = 0.f;
            if (slot < 16) lf = LF[(R_META + slot) * 4 + h]; else if (slot >= 64 && slot < nslots) lf = LF[(b * 2048 + slot - 64) * 4 + h];
            run += lf; v[e] = run; }
        float x = run;
#pragma unroll
        for (int o = 1; o < 64; o <<= 1) { const float y = bperm(x, lane - o); if (lane >= o) x += y; }
        if (lane == 63) wsum[wave] = x;
        __syncthreads();
        float off = x - run;
        for (int w = 0; w < wave; ++w) off += wsum[w];
#pragma unroll
        for (int e = 0; e < 5; ++e) { const int slot = 5 * tid + e; if (slot < 2112) kb[slot] = (slot >= 16 && slot < 64) ? -INFINITY : -(off + v[e]) * LOG2E; }
    }
    const bf16* Qw = QF + ((size_t)(b * 4 + h) * 2048 + 256 * qb + 32 * wave) * 64;
    bf16x8 qr[4];
#pragma unroll
    for (int d0 = 0; d0 < 4; ++d0) qr[d0] = *(const bf16x8*)(Qw + r32 * 64 + d0 * 16 + hi * 8);
    const bf16* Kg = KF + (size_t)(b * 4 + h) * 2112 * 64 + (size_t)(tid >> 3) * 64 + (tid & 7) * 8;
    const bf16* Vg = VT + (size_t)(b * 4 + h) * 64 * 2112 + (size_t)(tid >> 3) * 2112 + (tid & 7) * 8;
    const int soff = (tid >> 3) * KSTR + (tid & 7) * 16;
    v4u kreg = *(const v4u*)Kg, vreg = *(const v4u*)Vg;
    *(LAS v4u*)(lds + L_K0 + soff) = kreg; *(LAS v4u*)(lds + L_V0 + soff) = vreg;
    __syncthreads();
    asm volatile("" : "+v"(qr[0]), "+v"(qr[1]), "+v"(qr[2]), "+v"(qr[3]));
    float m = -INFINITY, l = 0.f; f32x16 o0, o1;
#pragma unroll
    for (int i = 0; i < 16; ++i) { o0[i] = 0.f; o1[i] = 0.f; }
    const int qrow = 256 * qb + 32 * wave + r32;
    const int wave_last = 1 + (256 * qb + 32 * wave + 31) / 64;
    for (int t = 0; t < ntile; ++t) {
        const int cur = t & 1;
        if (t + 1 < ntile) { kreg = *(const v4u*)(Kg + (size_t)(t + 1) * 64 * 64); vreg = *(const v4u*)(Vg + (t + 1) * 64); }
        if (t <= wave_last) {
            LAS unsigned char* Kc = lds + L_K0 + cur * 64 * KSTR; LAS unsigned char* Vc = lds + L_V0 + cur * 64 * KSTR;
            f32x16 p0, p1;
#pragma unroll
            for (int g = 0; g < 4; ++g) { const f4 b0 = *(const LAS f4*)(kb + 64 * t + 8 * g + 4 * hi); const f4 b1 = *(const LAS f4*)(kb + 64 * t + 32 + 8 * g + 4 * hi);
                p0[4 * g + 0] = b0[0]; p0[4 * g + 1] = b0[1]; p0[4 * g + 2] = b0[2]; p0[4 * g + 3] = b0[3]; p1[4 * g + 0] = b1[0]; p1[4 * g + 1] = b1[1]; p1[4 * g + 2] = b1[2]; p1[4 * g + 3] = b1[3]; }
#pragma unroll
            for (int d0 = 0; d0 < 4; ++d0) {
                const bf16x8 a0 = *(const LAS bf16x8*)(Kc + r32 * KSTR + (d0 * 16 + hi * 8) * 2);
                const bf16x8 a1 = *(const LAS bf16x8*)(Kc + (32 + r32) * KSTR + (d0 * 16 + hi * 8) * 2);
                p0 = MFMA32(a0, qr[d0], p0); p1 = MFMA32(a1, qr[d0], p1);
            }
            if (t >= 4 * qb + 1) {
                const int kbase = 64 * (t - 1);
#pragma unroll
                for (int i = 0; i < 16; ++i) { const int pk = kbase + crow(i, hi); if (pk > qrow) p0[i] = -INFINITY; if (pk + 32 > qrow) p1[i] = -INFINITY; }
            }
            float rm = fmaxf(p0[0], p1[0]);
#pragma unroll
            for (int i = 1; i < 16; ++i) rm = fmaxf(rm, fmaxf(p0[i], p1[i]));
            rm = fmaxf(rm, bperm(rm, lane ^ 32));
            const float mn = fmaxf(m, rm); const float sc = __builtin_amdgcn_exp2f(m - mn); m = mn;
            float rsum = 0.f;
#pragma unroll
            for (int i = 0; i < 16; ++i) { p0[i] = __builtin_amdgcn_exp2f(p0[i] - mn); p1[i] = __builtin_amdgcn_exp2f(p1[i] - mn); rsum += p0[i] + p1[i]; }
            l = l * sc + rsum;
            if (__builtin_amdgcn_ballot_w64(sc != 1.0f) != 0ull) {
#pragma unroll
                for (int i = 0; i < 16; ++i) { o0[i] *= sc; o1[i] *= sc; } }
#pragma unroll
            for (int blk = 0; blk < 2; ++blk)
#pragma unroll
                for (int s2 = 0; s2 < 2; ++s2) {
                    v4u pw;
                    if (blk == 0) { pw.x = cvtpk(p0[8 * s2 + 0], p0[8 * s2 + 1]); pw.y = cvtpk(p0[8 * s2 + 2], p0[8 * s2 + 3]); pw.z = cvtpk(p0[8 * s2 + 4], p0[8 * s2 + 5]); pw.w = cvtpk(p0[8 * s2 + 6], p0[8 * s2 + 7]); }
                    else          { pw.x = cvtpk(p1[8 * s2 + 0], p1[8 * s2 + 1]); pw.y = cvtpk(p1[8 * s2 + 2], p1[8 * s2 + 3]); pw.z = cvtpk(p1[8 * s2 + 4], p1[8 * s2 + 5]); pw.w = cvtpk(p1[8 * s2 + 6], p1[8 * s2 + 7]); }
                    const bf16x8 pb = __builtin_bit_cast(bf16x8, pw);
                    const int koff = (32 * blk + 16 * s2 + 4 * hi) * 2;
                    { const s16x4 lo = *(const LAS s16x4*)(Vc + r32 * KSTR + koff), hh = *(const LAS s16x4*)(Vc + r32 * KSTR + koff + 16);
                      const bf16x8 va = {lo[0], lo[1], lo[2], lo[3], hh[0], hh[1], hh[2], hh[3]}; o0 = MFMA32(va, pb, o0); }
                    { const s16x4 lo = *(const LAS s16x4*)(Vc + (32 + r32) * KSTR + koff), hh = *(const LAS s16x4*)(Vc + (32 + r32) * KSTR + koff + 16);
                      const bf16x8 va = {lo[0], lo[1], lo[2], lo[3], hh[0], hh[1], hh[2], hh[3]}; o1 = MFMA32(va, pb, o1); }
                }
        }
        if (t + 1 < ntile) { *(LAS v4u*)(lds + L_K0 + (cur ^ 1) * 64 * KSTR + soff) = kreg; *(LAS v4u*)(lds + L_V0 + (cur ^ 1) * 64 * KSTR + soff) = vreg; }
        __syncthreads();
    }
    l += bperm(l, lane ^ 32);
    const float inv = 1.0f / l;
    bf16* orow = MIXB + (size_t)(b * 2048 + qrow) * 1024 + h * 64;
#pragma unroll
    for (int g = 0; g < 4; ++g) {
        *(uint2*)(orow + 8 * g + 4 * hi) = make_uint2(cvtpk(o0[4 * g] * inv, o0[4 * g + 1] * inv), cvtpk(o0[4 * g + 2] * inv, o0[4 * g + 3] * inv));
        *(uint2*)(orow + 32 + 8 * g + 4 * hi) = make_uint2(cvtpk(o1[4 * g] * inv, o1[4 * g + 1] * inv), cvtpk(o1[4 * g + 2] * inv, o1[4 * g + 3] * inv));
    }
}

constexpr int S_D = 0, S_WS = 32768, S_PART = 33024, S_PSTR = 68;
__device__ __forceinline__ void fox_sample_unit(int b, int l, const float* QN, const float* KN, const float* MI, const float* LF, const float* ck, const float* cv, const float* clf, const int* pt,
                                                bf16* MIXB, LAS unsigned char* lds, int tid) {
    const int lane = tid & 63, wave = __builtin_amdgcn_readfirstlane(tid >> 6), h = lane >> 4, d4 = lane & 15;
    LAS f4* Dl = (LAS f4*)(lds + S_D); LAS f4* wsum = (LAS f4*)(lds + S_WS);
    {
        const int page = pt[b * 16 + (tid >> 5)];
        const f4* src = (const f4*)(clf + (((size_t)l * NPOOL + page) * 128 + 4 * (tid & 31)) * 4);
        const f4 v0 = src[0], v1 = src[1], v2 = src[2], v3 = src[3];
        const f4 s2 = v3, s1 = v3 + v2, s0 = s1 + v1, tot = s0 + v0;
        f4 x = tot;
#pragma unroll
        for (int o = 1; o < 64; o <<= 1) { f4 y; y[0] = bperm(x[0], lane + o); y[1] = bperm(x[1], lane + o); y[2] = bperm(x[2], lane + o); y[3] = bperm(x[3], lane + o); if (lane + o < 64) x += y; }
        if (lane == 0) wsum[wave] = x;
        __syncthreads();
        f4 off = x - tot;
        for (int w = wave + 1; w < 8; ++w) off += wsum[w];
        Dl[4 * tid + 0] = s0 + off; Dl[4 * tid + 1] = s1 + off; Dl[4 * tid + 2] = s2 + off; Dl[4 * tid + 3] = off;
        __syncthreads();
    }
    float4 q[4];
#pragma unroll
    for (int i = 0; i < 4; ++i) { const float4 t = *(const float4*)(QN + (size_t)(R_S + b * 4 + i) * 256 + h * 64 + 4 * d4); q[i] = make_float4(t.x * 0.125f, t.y * 0.125f, t.z * 0.125f, t.w * 0.125f); }
    float m[4], ls[4]; float4 o[4];
#pragma unroll
    for (int i = 0; i < 4; ++i) { m[i] = -INFINITY; ls[i] = 0.f; o[i] = make_float4(0.f, 0.f, 0.f, 0.f); }
    const LAS float* Df = (const LAS float*)Dl;
    for (int p = 0; p < 16; ++p) {
        const int page = pt[b * 16 + p];
        const size_t base = (((size_t)l * NPOOL + page) * 128 + 16 * wave) * 256 + lane * 4;
#pragma unroll
        for (int hf = 0; hf < 2; ++hf) {
            pg8::f32x4 kk[8], vv[8];
#pragma unroll
            for (int j = 0; j < 8; ++j) { kk[j] = __builtin_nontemporal_load((const pg8::f32x4*)(ck + base + (size_t)(hf * 8 + j) * 256)); vv[j] = __builtin_nontemporal_load((const pg8::f32x4*)(cv + base + (size_t)(hf * 8 + j) * 256)); }
            float s[4][8];
#pragma unroll
            for (int j = 0; j < 8; ++j) { const float dk = Df[(p * 128 + 16 * wave + hf * 8 + j) * 4 + h];
#pragma unroll
                for (int i = 0; i < 4; ++i) s[i][j] = row16_sum(q[i].x * kk[j][0] + q[i].y * kk[j][1] + q[i].z * kk[j][2] + q[i].w * kk[j][3]) + dk; }
#pragma unroll
            for (int i = 0; i < 4; ++i) {
                float mx = s[i][0];
#pragma unroll
                for (int j = 1; j < 8; ++j) mx = fmaxf(mx, s[i][j]);
                const float mn = fmaxf(m[i], mx); const float sc = __expf(m[i] - mn); m[i] = mn;
                ls[i] *= sc; o[i].x *= sc; o[i].y *= sc; o[i].z *= sc; o[i].w *= sc;
#pragma unroll
                for (int j = 0; j < 8; ++j) { const float pj = __expf(s[i][j] - mn); ls[i] += pj; o[i].x += pj * vv[j][0]; o[i].y += pj * vv[j][1]; o[i].z += pj * vv[j][2]; o[i].w += pj * vv[j][3]; }
            }
        }
    }
    LAS float* part = (LAS float*)(lds + S_PART);
#pragma unroll
    for (int i = 0; i < 4; ++i) { LAS float* pp = part + ((wave * 16) + h * 4 + i) * S_PSTR; *(LAS f4*)(pp + 4 + 4 * d4) = (f4){o[i].x, o[i].y, o[i].z, o[i].w}; if (d4 == 0) { pp[0] = m[i]; pp[1] = ls[i]; } }
    __syncthreads();
    for (int u = tid; u < 1024; u += 512) {
        const int hh = u >> 8, i = (u >> 6) & 3, d = u & 63;
        const int rowq = R_S + b * 4 + i;
        float sn[4]; float G = 0.f;
#pragma unroll
        for (int j = 0; j < 4; ++j) { const int rowk = R_S + b * 4 + j; G -= LF[rowk * 4 + hh]; float dot = 0.f;
            const float* qp = QN + (size_t)rowq * 256 + hh * 64; const float* kp = KN + (size_t)rowk * 256 + hh * 64;
            for (int c = 0; c < 64; ++c) dot += qp[c] * kp[c];
            sn[j] = j <= i ? dot * 0.125f + G : -INFINITY; }
        float mt = fmaxf(fmaxf(sn[0], sn[1]), fmaxf(sn[2], sn[3]));
        for (int w = 0; w < 8; ++w) mt = fmaxf(mt, part[(w * 16 + hh * 4 + i) * S_PSTR]);
        float lt = 0.f, ot = 0.f;
        for (int w = 0; w < 8; ++w) { const LAS float* pp = part + (w * 16 + hh * 4 + i) * S_PSTR; const float e = __expf(pp[0] - mt); lt += e * pp[1]; ot += e * pp[4 + d]; }
#pragma unroll
        for (int j = 0; j < 4; ++j) { const float e = __expf(sn[j] - mt); lt += e; ot += e * MI[(size_t)(R_S + b * 4 + j) * LDMI + C_FV + hh * 64 + d]; }
        MIXB[(size_t)rowq * 1024 + hh * 64 + d] = (bf16)f2bf(ot / lt);
    }
    __syncthreads();
}
#undef MFMA32
}

namespace la {
using fa::bf16x8; using fa::s16x4; using fa::f32x16; using fa::f4; using fa::cvtpk; using fa::crow;
#define MFMA32(a, b, c) __builtin_amdgcn_mfma_f32_32x32x16_bf16((a), (b), (c), 0, 0, 0)
#define LDS_BARRIER() asm volatile("s_waitcnt lgkmcnt(0)\n\ts_barrier" ::: "memory")
__device__ __forceinline__ int seq_row(int b, int c, int t) { const int sg = 128 * c - 112 + t; return sg < 0 ? -1 : (sg < 16 ? R_META + sg : b * 2048 + sg - 16); }
__device__ __forceinline__ bf16x8 pack8(const f32x16& x, int s) { v4u p; p.x = cvtpk(x[8 * s], x[8 * s + 1]); p.y = cvtpk(x[8 * s + 2], x[8 * s + 3]); p.z = cvtpk(x[8 * s + 4], x[8 * s + 5]); p.w = cvtpk(x[8 * s + 6], x[8 * s + 7]); return __builtin_bit_cast(bf16x8, p); }
__device__ __forceinline__ bf16x8 ld16(const LAS unsigned char* p) { return *(const LAS bf16x8*)p; }
__device__ __forceinline__ bf16x8 ld8x2(const LAS unsigned char* p) { const s16x4 lo = *(const LAS s16x4*)p, hh = *(const LAS s16x4*)(p + 16); return (bf16x8){lo[0], lo[1], lo[2], lo[3], hh[0], hh[1], hh[2], hh[3]}; }
__device__ __forceinline__ float silu_f(float x) { return x * __builtin_amdgcn_rcpf(1.0f + __expf(-x)); }
__device__ __forceinline__ float bf2f(unsigned short v) { return __uint_as_float((unsigned)v << 16); }
typedef unsigned u2v __attribute__((ext_vector_type(2)));
constexpr int TPITCH = 272;
constexpr int OPITCH = 68;

constexpr int G_QL = 0, G_KL = 10240, G_KT = 20480, G_VT = 29184, G_OUT = 46592, G_BC = 81408, G_SEG = 98304, G_BL = 100352, G_BLR = 100480;
__device__ __forceinline__ void gla_prompt_unit(int b, int h, const GAS bf16* MIB, const GAS float* GLOG, const GAS float* gnorm, GAS bf16* MIXB, GAS float* state_out, LAS unsigned char* lds, int tid0) {
    int tid = tid0;
    int lane = tid & 63, wave = __builtin_amdgcn_readfirstlane(tid >> 6), r32 = lane & 31, hi = lane >> 5, vt = wave & 1, tt = wave < 4 ? (wave >> 1) : 3 - ((wave - 4) >> 1);
    LAS unsigned char* QL = lds + G_QL; LAS unsigned char* KL = lds + G_KL; LAS unsigned char* KT = lds + G_KT; LAS unsigned char* VT = lds + G_VT;
    LAS float* OUT = (LAS float*)(lds + G_OUT); LAS float* BC = (LAS float*)(lds + G_BC); LAS float* SEG = (LAS float*)(lds + G_SEG); LAS float* BL = (LAS float*)(lds + G_BL); LAS float* BLR = (LAS float*)(lds + G_BLR);
    f32x16 SK;
#pragma unroll
    for (int i = 0; i < 16; ++i) SK[i] = 0.f;
    int kk = tid & 31, seg = tid >> 5;
    f4 q0, q1, k0, k1, v4[4]; float gl[8];
#define BF4(w_) ((f4){__uint_as_float((w_)[0] << 16), __uint_as_float((w_)[0] & 0xffff0000u), __uint_as_float((w_)[1] << 16), __uint_as_float((w_)[1] & 0xffff0000u)})
#define GLA_LOAD(cc) do { const int row = seq_row(b, (cc), tid >> 2); const GAS bf16* mr = MIB + (size_t)(row >= 0 ? row : 0) * N_MAIN; const int qd_ = tid & 3; \
        const u2v a0_ = *(const GAS u2v*)(mr + CM_GQ + h * 32 + 8 * qd_), a1_ = *(const GAS u2v*)(mr + CM_GQ + h * 32 + 8 * qd_ + 4), b0_ = *(const GAS u2v*)(mr + CM_GK + h * 32 + 8 * qd_), b1_ = *(const GAS u2v*)(mr + CM_GK + h * 32 + 8 * qd_ + 4); \
        u2v c_[4]; _Pragma("unroll") for (int j4 = 0; j4 < 4; ++j4) c_[j4] = *(const GAS u2v*)(mr + CM_GV + h * 64 + 16 * qd_ + 4 * j4); \
        _Pragma("unroll") for (int e_ = 0; e_ < 8; ++e_) { const int rg_ = seq_row(b, (cc), 8 * (tid >> 5) + e_); gl[e_] = GLOG[(size_t)(rg_ >= 0 ? rg_ : 0) * 128 + h * 32 + (tid & 31)]; } \
        q0 = BF4(a0_); q1 = BF4(a1_); k0 = BF4(b0_); k1 = BF4(b1_); _Pragma("unroll") for (int j4 = 0; j4 < 4; ++j4) v4[j4] = BF4(c_[j4]); } while (0)
    GLA_LOAD(0);
    for (int c = 0; c < 17; ++c) {
        tid = tid0; asm volatile("" : "+v"(tid)); lane = tid & 63; wave = __builtin_amdgcn_readfirstlane(tid >> 6); r32 = lane & 31; hi = lane >> 5; vt = wave & 1; tt = wave < 4 ? (wave >> 1) : 3 - ((wave - 4) >> 1); kk = tid & 31; seg = tid >> 5;
        if (c == 0 && (tid >> 2) < 112) { const f4 z = (f4){0.f, 0.f, 0.f, 0.f}; q0 = z; q1 = z; k0 = z; k1 = z; v4[0] = z; v4[1] = z; v4[2] = z; v4[3] = z; }
        {
            float bcl[8]; float run = 0.f;
#pragma unroll
            for (int e = 0; e < 8; ++e) { const float gv = (c == 0 && 8 * seg + e < 112) ? 0.f : gl[e]; run += gv; bcl[e] = run; }
            SEG[seg * 32 + kk] = run;
            LDS_BARRIER();
            float off = 0.f, tot = 0.f;
#pragma unroll
            for (int s = 0; s < 16; ++s) { const float v = SEG[s * 32 + kk]; tot += v; if (s < seg) off += v; }
#pragma unroll
            for (int e = 0; e < 8; ++e) BC[(8 * seg + e) * 33 + kk] = bcl[e] + off;
            if (seg == 0) { BL[kk] = __expf(tot); BLR[kk] = tot; }
            LDS_BARRIER();
        }
        {
            const int t = tid >> 2, qd = tid & 3;
            const float q[8] = {q0[0], q0[1], q0[2], q0[3], q1[0], q1[1], q1[2], q1[3]}, k[8] = {k0[0], k0[1], k0[2], k0[3], k1[0], k1[1], k1[2], k1[3]};
            float qv[8], kv[8];
#pragma unroll
            for (int j = 0; j < 8; ++j) { const float bcv = BC[t * 33 + 8 * qd + j]; qv[j] = q[j] * 0.17677669529663687f * __expf(bcv); kv[j] = k[j] * __expf(-bcv);
                *(LAS bf16*)(KT + (8 * qd + j) * TPITCH + 2 * t) = (bf16)(cvtpk(k[j] * __expf(BLR[8 * qd + j] - bcv), 0.f) & 0xffffu); }
            *(LAS v4u*)(QL + t * 80 + qd * 16) = (v4u){cvtpk(qv[0], qv[1]), cvtpk(qv[2], qv[3]), cvtpk(qv[4], qv[5]), cvtpk(qv[6], qv[7])};
            *(LAS v4u*)(KL + t * 80 + qd * 16) = (v4u){cvtpk(kv[0], kv[1]), cvtpk(kv[2], kv[3]), cvtpk(kv[4], kv[5]), cvtpk(kv[6], kv[7])};
#pragma unroll
            for (int j4 = 0; j4 < 4; ++j4)
#pragma unroll
                for (int e = 0; e < 4; e += 2) { const unsigned w_ = cvtpk(v4[j4][e], v4[j4][e + 1]); *(LAS bf16*)(VT + (16 * qd + 4 * j4 + e) * TPITCH + 2 * t) = (bf16)(w_ & 0xffffu); *(LAS bf16*)(VT + (16 * qd + 4 * j4 + e + 1) * TPITCH + 2 * t) = (bf16)(w_ >> 16); }
        }
        float zz[16];
#pragma unroll
        for (int i = 0; i < 16; ++i) { const int row = seq_row(b, c, 16 * wave + i); zz[i] = bf2f(MIB[(size_t)(row >= 0 ? row : 0) * N_MAIN + CM_GG + h * 64 + lane]); }
        if (c + 1 < 17) GLA_LOAD(c + 1);
        LDS_BARRIER();
        {
            f32x16 y;
#pragma unroll
            for (int i = 0; i < 16; ++i) y[i] = 0.f;
            const LAS unsigned char* qrow = QL + (32 * tt + r32) * 80;
#pragma unroll
            for (int s2 = 0; s2 < 2; ++s2) y = MFMA32(pack8(SK, s2), ld8x2(qrow + (16 * s2 + 4 * hi) * 2), y);
            for (int i = 0; i <= tt; ++i) {
                f32x16 gt;
#pragma unroll
                for (int r = 0; r < 16; ++r) gt[r] = 0.f;
#pragma unroll
                for (int ks = 0; ks < 2; ++ks) gt = MFMA32(ld16(KL + (32 * i + r32) * 80 + (16 * ks + 8 * hi) * 2), ld16(qrow + (16 * ks + 8 * hi) * 2), gt);
                if (i == tt) {
#pragma unroll
                    for (int r = 0; r < 16; ++r) if (crow(r, hi) > r32) gt[r] = 0.f; }
#pragma unroll
                for (int s2 = 0; s2 < 2; ++s2) y = MFMA32(ld8x2(VT + (32 * vt + r32) * TPITCH + (32 * i + 16 * s2 + 4 * hi) * 2), pack8(gt, s2), y);
            }
#pragma unroll
            for (int r = 0; r < 16; ++r) SK[r] *= BL[crow(r, hi)];
#pragma unroll
            for (int ks = 0; ks < 8; ++ks) SK = MFMA32(ld16(KT + r32 * TPITCH + (16 * ks + 8 * hi) * 2), ld16(VT + (32 * vt + r32) * TPITCH + (16 * ks + 8 * hi) * 2), SK);
#pragma unroll
            for (int g4 = 0; g4 < 4; ++g4) *(LAS f4*)(OUT + (32 * tt + r32) * OPITCH + 32 * vt + 8 * g4 + 4 * hi) = (f4){y[4 * g4], y[4 * g4 + 1], y[4 * g4 + 2], y[4 * g4 + 3]};
        }
        LDS_BARRIER();
        {
            const float gnl = gnorm[lane];
            float ov[16], ss[16];
#pragma unroll
            for (int i = 0; i < 16; ++i) { ov[i] = OUT[(16 * wave + i) * OPITCH + lane]; ss[i] = fa::row16_sum(ov[i] * ov[i]); }
#pragma unroll
            for (int i = 0; i < 16; ++i) ss[i] += bperm(ss[i], lane ^ 16);
#pragma unroll
            for (int i = 0; i < 16; ++i) ss[i] += bperm(ss[i], lane ^ 32);
#pragma unroll
            for (int i = 0; i < 16; ++i) { const int row = seq_row(b, c, 16 * wave + i);
                if (row >= 0 && (row < MP || b == 0)) MIXB[(size_t)row * 1024 + 768 + h * 64 + lane] = (bf16)(cvtpk(ov[i] * rsqrtf(ss[i] * (1.0f / 64.0f) + EPS) * gnl * zz[i], 0.f) & 0xffffu); }
        }
        LDS_BARRIER();
    }
#undef GLA_LOAD
    if (tt == 0) {
#pragma unroll
        for (int r = 0; r < 16; ++r) state_out[crow(r, hi) * 64 + 32 * vt + r32] = SK[r]; }
}

constexpr int S_QL = 0, S_KL = 18432, S_KT = 36864, S_VT = 54272, S_OUT = 71680, S_CS = 106496, S_DT = 107008, S_TOT = 107520, S_FS = 107776;
__device__ __forceinline__ void ssd_prompt_unit(int b, int h, const GAS bf16* MIB, const GAS bf16* XC, const GAS float* DTS, float A, float Dh, GAS bf16* MIXB, GAS float* SSQH, GAS float* state_out, LAS unsigned char* lds, int tid0) {
    int tid = tid0; const int g = h >> 2;
    int lane = tid & 63, wave = __builtin_amdgcn_readfirstlane(tid >> 6), r32 = lane & 31, hi = lane >> 5, vt = wave & 1, tt = wave < 4 ? (wave >> 1) : 3 - ((wave - 4) >> 1);
    LAS unsigned char* QL = lds + S_QL; LAS unsigned char* KL = lds + S_KL; LAS unsigned char* KT = lds + S_KT; LAS unsigned char* VT = lds + S_VT;
    LAS float* OUT = (LAS float*)(lds + S_OUT); LAS float* CS = (LAS float*)(lds + S_CS); LAS float* DT = (LAS float*)(lds + S_DT); LAS float* TOT = (LAS float*)(lds + S_TOT);
    f32x16 SK0, SK1;
#pragma unroll
    for (int i = 0; i < 16; ++i) { SK0[i] = 0.f; SK1[i] = 0.f; }
    v4u pb0, pb1, pc0, pc1, px0, px1; float dr0, dr1;
#define SSD_LOAD(cc) do { const int row_ = seq_row(b, (cc), tid >> 2); const GAS bf16* xr_ = XC + (size_t)(row_ >= 0 ? row_ : 0) * 768; const int q_ = tid & 3; \
        pb0 = *(const GAS v4u*)(xr_ + 512 + 64 * g + 8 * q_); pb1 = *(const GAS v4u*)(xr_ + 512 + 64 * g + 32 + 8 * q_); pc0 = *(const GAS v4u*)(xr_ + 640 + 64 * g + 8 * q_); pc1 = *(const GAS v4u*)(xr_ + 640 + 64 * g + 32 + 8 * q_); \
        px0 = *(const GAS v4u*)(xr_ + 64 * h + 8 * q_); px1 = *(const GAS v4u*)(xr_ + 64 * h + 32 + 8 * q_); \
        const int ra_ = seq_row(b, (cc), 2 * lane), rb_ = seq_row(b, (cc), 2 * lane + 1); dr0 = DTS[(size_t)(ra_ >= 0 ? ra_ : 0) * 8 + h]; dr1 = DTS[(size_t)(rb_ >= 0 ? rb_ : 0) * 8 + h]; } while (0)
    SSD_LOAD(0);
    for (int c = 0; c < 17; ++c) {
        tid = tid0; asm volatile("" : "+v"(tid)); lane = tid & 63; wave = __builtin_amdgcn_readfirstlane(tid >> 6); r32 = lane & 31; hi = lane >> 5; vt = wave & 1; tt = wave < 4 ? (wave >> 1) : 3 - ((wave - 4) >> 1);
        {
            const int t = tid >> 2, q = tid & 3;
            const bool pad0 = c == 0 && 2 * lane < 112, pad1 = c == 0 && 2 * lane + 1 < 112;
            const float d0 = pad0 ? 0.f : dr0, d1 = pad1 ? 0.f : dr1;
            const float a0 = d0 * A, a1 = d1 * A; float x = a0 + a1;
#pragma unroll
            for (int o = 1; o < 64; o <<= 1) { const float y = bperm(x, lane - o); if (lane >= o) x += y; }
            const float csl = bperm(x, 63);
            const float cs1 = x, cs0 = x - a1;
            if (tt > 0) {
                const float R = bperm(cs1, 16 * tt - 1);
                LAS float* FSw = (LAS float*)(lds + S_FS) + wave * 128;
                *(LAS u2v*)(FSw + 2 * lane) = (u2v){__float_as_uint(__expf(fminf(R - cs0, 0.f)) * d0), __float_as_uint(__expf(fminf(R - cs1, 0.f)) * d1)}; }
            if (wave == 0) { *(LAS u2v*)(CS + 2 * lane) = (u2v){__float_as_uint(cs0), __float_as_uint(cs1)}; *(LAS u2v*)(DT + 2 * lane) = (u2v){__float_as_uint(d0), __float_as_uint(d1)}; if (lane == 0) TOT[0] = csl; }
            const int src = t >> 1; const float csa = bperm(cs0, src), csb = bperm(cs1, src), dta = bperm(d0, src), dtb_ = bperm(d1, src);
            const float cst = (t & 1) ? csb : csa, dtt = (t & 1) ? dtb_ : dta;
            const float wgt = dtt * __expf(csl - cst);
            const bool padt = c == 0 && t < 112;
            if (padt) { const v4u z = (v4u){0u, 0u, 0u, 0u}; pb0 = z; pb1 = z; pc0 = z; pc1 = z; px0 = z; px1 = z; }
            *(LAS v4u*)(KL + t * 144 + q * 16) = pb0; *(LAS v4u*)(KL + t * 144 + 64 + q * 16) = pb1;
            *(LAS v4u*)(QL + t * 144 + q * 16) = pc0; *(LAS v4u*)(QL + t * 144 + 64 + q * 16) = pc1;
            const unsigned xw[8] = {px0.x, px0.y, px0.z, px0.w, px1.x, px1.y, px1.z, px1.w};
            const unsigned bw[8] = {pb0.x, pb0.y, pb0.z, pb0.w, pb1.x, pb1.y, pb1.z, pb1.w};
#pragma unroll
            for (int j = 0; j < 8; ++j) { const int p = (j < 4 ? 8 * q : 32 + 8 * q) + 2 * (j & 3);
                *(LAS bf16*)(VT + p * TPITCH + 2 * t) = (bf16)(xw[j] & 0xffffu); *(LAS bf16*)(VT + (p + 1) * TPITCH + 2 * t) = (bf16)(xw[j] >> 16);
                const unsigned wb = cvtpk(__uint_as_float(bw[j] << 16) * wgt, __uint_as_float(bw[j] & 0xffff0000u) * wgt);
                *(LAS bf16*)(KT + p * TPITCH + 2 * t) = (bf16)(wb & 0xffffu); *(LAS bf16*)(KT + (p + 1) * TPITCH + 2 * t) = (bf16)(wb >> 16); }
        }
        LDS_BARRIER();
        float zz[16];
#pragma unroll
        for (int i = 0; i < 16; ++i) { const int row = seq_row(b, c, 16 * wave + i); zz[i] = bf2f(MIB[(size_t)(row >= 0 ? row : 0) * N_MAIN + CM_SZ + h * 64 + lane]); }
        if (c + 1 < 17) SSD_LOAD(c + 1);
        {
            f32x16 y;
#pragma unroll
            for (int i = 0; i < 16; ++i) y[i] = 0.f;
            const LAS unsigned char* qrow = QL + (32 * tt + r32) * 144;
#pragma unroll
            for (int s2 = 0; s2 < 2; ++s2) { y = MFMA32(pack8(SK0, s2), ld8x2(qrow + (16 * s2 + 4 * hi) * 2), y); y = MFMA32(pack8(SK1, s2), ld8x2(qrow + (32 + 16 * s2 + 4 * hi) * 2), y); }
            const float cst = CS[32 * tt + r32]; const float ect = __expf(cst);
#pragma unroll
            for (int i = 0; i < 16; ++i) y[i] *= ect;
            if (tt > 0) {
                const LAS float* FSw = (const LAS float*)(lds + S_FS) + wave * 128;
                f32x16 y2;
#pragma unroll
                for (int r = 0; r < 16; ++r) y2[r] = 0.f;
                for (int i = 0; i < tt; ++i) {
                    f32x16 gt;
#pragma unroll
                    for (int r = 0; r < 16; ++r) gt[r] = 0.f;
#pragma unroll
                    for (int ks = 0; ks < 4; ++ks) gt = MFMA32(ld16(KL + (32 * i + r32) * 144 + (16 * ks + 8 * hi) * 2), ld16(qrow + (16 * ks + 8 * hi) * 2), gt);
#pragma unroll
                    for (int g4 = 0; g4 < 4; ++g4) { const f4 fs4 = *(const LAS f4*)(FSw + 32 * i + 8 * g4 + 4 * hi); gt[4 * g4] *= fs4[0]; gt[4 * g4 + 1] *= fs4[1]; gt[4 * g4 + 2] *= fs4[2]; gt[4 * g4 + 3] *= fs4[3]; }
#pragma unroll
                    for (int s2 = 0; s2 < 2; ++s2) y2 = MFMA32(ld8x2(VT + (32 * vt + r32) * TPITCH + (32 * i + 16 * s2 + 4 * hi) * 2), pack8(gt, s2), y2);
                }
                const float et = __expf(fminf(cst - CS[32 * tt - 1], 0.f));
#pragma unroll
                for (int r = 0; r < 16; ++r) y[r] += et * y2[r];
            }
            {
                const int i = tt;
                f32x16 gt;
#pragma unroll
                for (int r = 0; r < 16; ++r) gt[r] = 0.f;
#pragma unroll
                for (int ks = 0; ks < 4; ++ks) gt = MFMA32(ld16(KL + (32 * i + r32) * 144 + (16 * ks + 8 * hi) * 2), ld16(qrow + (16 * ks + 8 * hi) * 2), gt);
#pragma unroll
                for (int g4 = 0; g4 < 4; ++g4) { const f4 cs4 = *(const LAS f4*)(CS + 32 * i + 8 * g4 + 4 * hi), dt4 = *(const LAS f4*)(DT + 32 * i + 8 * g4 + 4 * hi);
#pragma unroll
                    for (int e = 0; e < 4; ++e) { const bool vis = 8 * g4 + 4 * hi + e <= r32; const float wv = vis ? __expf(fminf(cst - cs4[e], 0.f)) * dt4[e] : 0.f; gt[4 * g4 + e] *= wv; } }
#pragma unroll
                for (int s2 = 0; s2 < 2; ++s2) y = MFMA32(ld8x2(VT + (32 * vt + r32) * TPITCH + (32 * i + 16 * s2 + 4 * hi) * 2), pack8(gt, s2), y);
            }
            const float ecl = __expf(TOT[0]);
#pragma unroll
            for (int r = 0; r < 16; ++r) { SK0[r] *= ecl; SK1[r] *= ecl; }
#pragma unroll 2
            for (int ks = 0; ks < 8; ++ks) { const bf16x8 xb = ld16(VT + (32 * vt + r32) * TPITCH + (16 * ks + 8 * hi) * 2);
                SK0 = MFMA32(ld16(KT + r32 * TPITCH + (16 * ks + 8 * hi) * 2), xb, SK0); SK1 = MFMA32(ld16(KT + (32 + r32) * TPITCH + (16 * ks + 8 * hi) * 2), xb, SK1); }
#pragma unroll
            for (int g4 = 0; g4 < 4; ++g4) { f4 o;
#pragma unroll
                for (int e = 0; e < 4; ++e) o[e] = y[4 * g4 + e] + Dh * bf2f(*(const LAS bf16*)(VT + (32 * vt + 8 * g4 + 4 * hi + e) * TPITCH + 2 * (32 * tt + r32)));
                *(LAS f4*)(OUT + (32 * tt + r32) * OPITCH + 32 * vt + 8 * g4 + 4 * hi) = o; }
        }
        LDS_BARRIER();
        {
            float yv[16], ss[16];
#pragma unroll
            for (int i = 0; i < 16; ++i) { yv[i] = OUT[(16 * wave + i) * OPITCH + lane] * zz[i]; ss[i] = fa::row16_sum(yv[i] * yv[i]); }
#pragma unroll
            for (int i = 0; i < 16; ++i) ss[i] += bperm(ss[i], lane ^ 16);
#pragma unroll
            for (int i = 0; i < 16; ++i) ss[i] += bperm(ss[i], lane ^ 32);
            if (c > 0) {
                const size_t row0 = (size_t)b * 2048 + 128 * (c - 1) + 16 * wave;
#pragma unroll
                for (int i = 0; i < 16; ++i) { if (lane == 0) SSQH[(row0 + i) * 8 + h] = ss[i]; MIXB[(row0 + i) * 1024 + 256 + h * 64 + lane] = (bf16)(cvtpk(yv[i], 0.f) & 0xffffu); }
            } else if (b == 0 && wave == 7) {
#pragma unroll
                for (int i = 0; i < 16; ++i) { if (lane == 0) SSQH[(size_t)(R_META + i) * 8 + h] = ss[i]; MIXB[(size_t)(R_META + i) * 1024 + 256 + h * 64 + lane] = (bf16)(cvtpk(yv[i], 0.f) & 0xffffu); }
            }
        }
        LDS_BARRIER();
    }
#undef SSD_LOAD
    if (tt == 0) {
#pragma unroll
        for (int g4 = 0; g4 < 4; ++g4) { *(GAS f4*)(state_out + (32 * vt + r32) * 64 + 8 * g4 + 4 * hi) = (f4){SK0[4 * g4], SK0[4 * g4 + 1], SK0[4 * g4 + 2], SK0[4 * g4 + 3]};
            *(GAS f4*)(state_out + (32 * vt + r32) * 64 + 32 + 8 * g4 + 4 * hi) = (f4){SK1[4 * g4], SK1[4 * g4 + 1], SK1[4 * g4 + 2], SK1[4 * g4 + 3]}; } }
}
#undef MFMA32
}

namespace eu {
using fa::f4;
constexpr int E_Q = 67840, E_K = 71936, E_V = 76032, E_LF = 80128, E_XBC = 80256, E_DT = 92544, E_GLOG = 92672, E_YS = 94720, E_GO = 102912, E_END = 107008;

__device__ __forceinline__ void sample_unit(int b, int l, const float* MI, const float* ck, const float* cv, const float* clf, const int* pt, const float* st_ssm, const float* st_conv, const float* st_gla,
        const float* qg, const float* kg, const float* fbias, const float* cw, const float* cb, const float* dtb, const float* alog, const float* dsk, const float* snorm,
        const float* wg, const float* gbias, const float* gnorm, bf16* MIXB, float* out, LAS unsigned char* lds, int tid) {
    const int lane = tid & 63, wave = __builtin_amdgcn_readfirstlane(tid >> 6);
    LAS float* EQ = (LAS float*)(lds + E_Q); LAS float* EK = (LAS float*)(lds + E_K); LAS float* EV = (LAS float*)(lds + E_V); LAS float* ELF = (LAS float*)(lds + E_LF);
    LAS float* EX = (LAS float*)(lds + E_XBC); LAS float* EDT = (LAS float*)(lds + E_DT); LAS float* EG = (LAS float*)(lds + E_GLOG); LAS float* EYS = (LAS float*)(lds + E_YS); LAS float* EGO = (LAS float*)(lds + E_GO);
    const int r0 = R_S + 4 * b;
    if (wave < 4) { const float* mi = MI + (size_t)(r0 + wave) * LDMI;
#pragma unroll
        for (int h = 0; h < 4; ++h) { const float q = mi[C_FQ + h * 64 + lane], k = mi[C_FK + h * 64 + lane], v = mi[C_FV + h * 64 + lane];
            const float qs = rsqrtf(wave_sum_l(q * q, lane) * (1.f / 64.f) + EPS), ks = rsqrtf(wave_sum_l(k * k, lane) * (1.f / 64.f) + EPS);
            EQ[wave * 256 + h * 64 + lane] = q * qs * qg[lane]; EK[wave * 256 + h * 64 + lane] = k * ks * kg[lane]; EV[wave * 256 + h * 64 + lane] = v; }
        if (lane < 4) ELF[wave * 4 + lane] = log_sigmoidf(mi[C_FF + lane] + fbias[lane]);
    }
    for (int idx = tid; idx < 3072; idx += 512) { const int i = idx / 768, c = idx - i * 768; float u[4];
#pragma unroll
        for (int j = 0; j < 4; ++j) { const int p = i - j; u[j] = p >= 0 ? MI[(size_t)(r0 + p) * LDMI + C_XBC + c] : st_conv[(size_t)(b * 3 + 3 + p) * 768 + c]; }
        const float o = cw[3 * 768 + c] * u[0] + cw[2 * 768 + c] * u[1] + cw[768 + c] * u[2] + cw[c] * u[3] + cb[c];
        EX[i * 768 + c] = siluf(o); }
    if (tid < 32) EDT[tid] = softplusf(MI[(size_t)(r0 + (tid >> 3)) * LDMI + C_DT + (tid & 7)] + dtb[tid & 7]);
    { const int i = tid >> 7, c = tid & 127; const float* lr = MI + (size_t)(r0 + i) * LDMI + C_LR; float a = gbias[c];
#pragma unroll
        for (int r = 0; r < 16; ++r) a += lr[r] * wg[r * 128 + c];
        EG[i * 128 + c] = log_sigmoidf(a) * (1.0f / 16.0f); }
    {
        const int h = lane >> 4, d4 = lane & 15;
        LAS f4* Dl = (LAS f4*)(lds + fa::S_D); LAS f4* wsum = (LAS f4*)(lds + fa::S_WS);
        {
            const int page = pt[b * 16 + (tid >> 5)];
            const f4* src = (const f4*)(clf + (((size_t)l * NPOOL + page) * 128 + 4 * (tid & 31)) * 4);
            const f4 v0 = src[0], v1 = src[1], v2 = src[2], v3 = src[3];
            const f4 s2 = v3, s1 = v3 + v2, s0 = s1 + v1, tot = s0 + v0;
            f4 x = tot;
#pragma unroll
            for (int o = 1; o < 64; o <<= 1) { f4 y; y[0] = bperm(x[0], lane + o); y[1] = bperm(x[1], lane + o); y[2] = bperm(x[2], lane + o); y[3] = bperm(x[3], lane + o); if (lane + o < 64) x += y; }
            if (lane == 0) wsum[wave] = x;
            __syncthreads();
            f4 off = x - tot;
            for (int w = wave + 1; w < 8; ++w) off += wsum[w];
            Dl[4 * tid + 0] = s0 + off; Dl[4 * tid + 1] = s1 + off; Dl[4 * tid + 2] = s2 + off; Dl[4 * tid + 3] = off;
            __syncthreads();
        }
        const int r16 = lane & 15, q4 = lane >> 4, hp = r16 >> 2, iq = lane & 3;
        f4 q[4];
#pragma unroll
        for (int i = 0; i < 4; ++i) q[i] = *(const LAS f4*)(EQ + i * 256 + h * 64 + 4 * d4) * 0.125f;
        float m = -INFINITY, ls = 0.f; f4 oc[4];
#pragma unroll
        for (int c = 0; c < 4; ++c) oc[c] = (f4){0.f, 0.f, 0.f, 0.f};
        const LAS float* Df = (const LAS float*)Dl;
        const bool b0 = lane & 1, b1 = lane & 2, mine = hp == q4;
        for (int p = 0; p < 16; ++p) {
            const int page = pt[b * 16 + p];
            const size_t base = (((size_t)l * NPOOL + page) * 128 + 16 * wave) * 256 + lane * 4;
            f4 kk[16], vv[16];
#pragma unroll
            for (int j = 0; j < 16; ++j) { kk[j] = __builtin_nontemporal_load((const f4*)(ck + base + (size_t)j * 256)); vv[j] = __builtin_nontemporal_load((const f4*)(cv + base + (size_t)j * 256)); }
            float sj[16];
#pragma unroll
            for (int j = 0; j < 16; ++j) {
                float pq[4];
#pragma unroll
                for (int i = 0; i < 4; ++i) pq[i] = q[i][0] * kk[j][0] + q[i][1] * kk[j][1] + q[i][2] * kk[j][2] + q[i][3] * kk[j][3];
                const float k0 = b0 ? pq[1] : pq[0], g0 = b0 ? pq[0] : pq[1], k1 = b0 ? pq[3] : pq[2], g1 = b0 ? pq[2] : pq[3];
                const float r0 = k0 + fa::dpp<fa::XOR1>(g0), r1 = k1 + fa::dpp<fa::XOR1>(g1);
                float t = (b1 ? r1 : r0) + fa::dpp<fa::XOR2>(b1 ? r0 : r1);
                t += fa::dpp<0x124>(t); t += fa::dpp<0x128>(t);
                sj[j] = t + Df[(p * 128 + 16 * wave + j) * 4 + h];
            }
            float mx = sj[0];
#pragma unroll
            for (int j = 1; j < 16; ++j) mx = fmaxf(mx, sj[j]);
            const float mn = fmaxf(m, mx); const float sc = __expf(m - mn); m = mn;
            float rs = 0.f;
#pragma unroll
            for (int j = 0; j < 16; ++j) { sj[j] = __expf(sj[j] - mn); rs += sj[j]; }
            ls = ls * sc + rs;
            const float scc = bperm(sc, 16 * hp + iq);
#pragma unroll
            for (int c = 0; c < 4; ++c) { oc[c][0] *= scc; oc[c][1] *= scc; oc[c][2] *= scc; oc[c][3] *= scc; }
#pragma unroll
            for (int g = 0; g < 2; ++g) {
                v4u w = (v4u){fa::cvtpk(sj[8 * g], sj[8 * g + 1]), fa::cvtpk(sj[8 * g + 2], sj[8 * g + 3]), fa::cvtpk(sj[8 * g + 4], sj[8 * g + 5]), fa::cvtpk(sj[8 * g + 6], sj[8 * g + 7])};
                if (!mine) w = (v4u){0u, 0u, 0u, 0u};
                const fa::bf16x8 pbv = __builtin_bit_cast(fa::bf16x8, w);
#pragma unroll
                for (int c = 0; c < 4; ++c) {
                    const v4u a = (v4u){fa::cvtpk(vv[8 * g][c], vv[8 * g + 1][c]), fa::cvtpk(vv[8 * g + 2][c], vv[8 * g + 3][c]), fa::cvtpk(vv[8 * g + 4][c], vv[8 * g + 5][c]), fa::cvtpk(vv[8 * g + 6][c], vv[8 * g + 7][c])};
                    oc[c] = __builtin_amdgcn_mfma_f32_16x16x32_bf16(__builtin_bit_cast(fa::bf16x8, a), pbv, oc[c], 0, 0, 0); }
            }
        }
        m = bperm(m, 16 * hp + iq); ls = bperm(ls, 16 * hp + iq);
        LAS float* part = (LAS float*)(lds + fa::S_PART);
        { LAS float* pp = part + (wave * 16 + r16) * fa::S_PSTR;
#pragma unroll
            for (int e = 0; e < 4; ++e) *(LAS f4*)(pp + 4 + 16 * q4 + 4 * e) = (f4){oc[0][e], oc[1][e], oc[2][e], oc[3][e]};
            if (q4 == 0) { pp[0] = m; pp[1] = ls; } }
        __syncthreads();
        for (int u = tid; u < 1024; u += 512) {
            const int hh = u >> 8, i = (u >> 6) & 3, d = u & 63;
            float sn[4]; float G = 0.f;
#pragma unroll
            for (int j = 0; j < 4; ++j) { G -= ELF[j * 4 + hh]; float dot = 0.f;
                for (int c = 0; c < 64; ++c) dot += EQ[i * 256 + hh * 64 + c] * EK[j * 256 + hh * 64 + c];
                sn[j] = j <= i ? dot * 0.125f + G : -INFINITY; }
            float mt = fmaxf(fmaxf(sn[0], sn[1]), fmaxf(sn[2], sn[3]));
            for (int w = 0; w < 8; ++w) mt = fmaxf(mt, part[(w * 16 + hh * 4 + i) * fa::S_PSTR]);
            float lt = 0.f, ot = 0.f;
            for (int w = 0; w < 8; ++w) { const LAS float* pp = part + (w * 16 + hh * 4 + i) * fa::S_PSTR; const float e = __expf(pp[0] - mt); lt += e * pp[1]; ot += e * pp[4 + d]; }
#pragma unroll
            for (int j = 0; j < 4; ++j) { const float e = __expf(sn[j] - mt); lt += e; ot += e * EV[j * 256 + hh * 64 + d]; }
            MIXB[(size_t)(r0 + i) * 1024 + hh * 64 + d] = (bf16)f2bf(ot / lt);
        }
    }
    {
        const int h = wave, g = h >> 2, p = lane;
        const f4* h0 = (const f4*)(st_ssm + (((size_t)b * 8 + h) * 64 + p) * 64);
        f4 hs[16];
#pragma unroll
        for (int n4 = 0; n4 < 16; ++n4) hs[n4] = h0[n4];
        const float A = -expf(alog[h]);
        for (int i = 0; i < 4; ++i) {
            const float dt = EDT[i * 8 + h]; const float dec = expf(dt * A); const float xdt = EX[i * 768 + h * 64 + p] * dt;
            float y = 0.f;
#pragma unroll
            for (int n4 = 0; n4 < 16; ++n4) { const f4 Bv = *(const LAS f4*)(EX + i * 768 + 512 + g * 64 + 4 * n4), Cv = *(const LAS f4*)(EX + i * 768 + 640 + g * 64 + 4 * n4);
                hs[n4] = hs[n4] * dec + Bv * xdt; y += Cv[0] * hs[n4][0] + Cv[1] * hs[n4][1] + Cv[2] * hs[n4][2] + Cv[3] * hs[n4][3]; }
            EYS[i * 512 + h * 64 + p] = y;
        }
        f4* ho = (f4*)(out + O_SSMS + (((size_t)(l * DEC_BATCH + b) * 8 + h) * 64 + p) * 64);
#pragma unroll
        for (int n4 = 0; n4 < 16; ++n4) ho[n4] = hs[n4];
    }
    if (wave < 4) {
        const int h = wave, v = lane;
        const float* s0 = st_gla + ((size_t)b * 4 + h) * 2048;
        float S[32];
#pragma unroll
        for (int k = 0; k < 32; ++k) S[k] = s0[k * 64 + v];
        for (int i = 0; i < 4; ++i) {
            const float* mi = MI + (size_t)(r0 + i) * LDMI;
            const float vv = mi[C_GV + h * 64 + v];
            float o = 0.f;
#pragma unroll
            for (int k4 = 0; k4 < 8; ++k4) { const f4 q4 = *(const f4*)(mi + C_GQ + h * 32 + 4 * k4), k4v = *(const f4*)(mi + C_GK + h * 32 + 4 * k4), g4 = *(const LAS f4*)(EG + i * 128 + h * 32 + 4 * k4);
#pragma unroll
                for (int e = 0; e < 4; ++e) { S[4 * k4 + e] = S[4 * k4 + e] * __expf(g4[e]) + k4v[e] * vv; o += q4[e] * 0.17677669529663687f * S[4 * k4 + e]; } }
            EGO[i * 256 + h * 64 + v] = o;
        }
        float* so = out + O_GLAS + ((size_t)(l * DEC_BATCH + b) * 4 + h) * 2048;
#pragma unroll
        for (int k = 0; k < 32; ++k) so[k * 64 + v] = S[k];
    }
    __syncthreads();
    if (wave < 4) { const int i = wave; const float* mi = MI + (size_t)(r0 + i) * LDMI;
#pragma unroll
        for (int g = 0; g < 2; ++g) { float y[4]; float s = 0.f;
#pragma unroll
            for (int e = 0; e < 4; ++e) { const int c = g * 256 + lane * 4 + e; y[e] = (EYS[i * 512 + c] + EX[i * 768 + c] * dsk[c >> 6]) * mi[C_SZ + c]; s += y[e] * y[e]; }
            const float rs = rsqrtf(wave_sum_l(s, lane) * (1.f / 256.f) + EPS);
            *(uint2*)(MIXB + (size_t)(r0 + i) * 1024 + 256 + g * 256 + lane * 4) = make_uint2(pk2(y[0] * rs * snorm[g * 256 + lane * 4], y[1] * rs * snorm[g * 256 + lane * 4 + 1]), pk2(y[2] * rs * snorm[g * 256 + lane * 4 + 2], y[3] * rs * snorm[g * 256 + lane * 4 + 3])); }
#pragma unroll
        for (int hh = 0; hh < 4; ++hh) { const float o = EGO[i * 256 + hh * 64 + lane]; const float rs = rsqrtf(wave_sum_l(o * o, lane) * (1.f / 64.f) + EPS);
            MIXB[(size_t)(r0 + i) * 1024 + 768 + hh * 64 + lane] = (bf16)f2bf(o * rs * gnorm[lane] * mi[C_GG + hh * 64 + lane]); }
    }
    __syncthreads();
}

constexpr int M_Q = 0, M_K = 16384, M_LF = 32768, M_F = 33024;
__device__ __forceinline__ void meta_unit(const float* MI, const float* qg, const float* kg, const float* fbias, bf16* MIXB, LAS unsigned char* lds, int tid) {
    const int lane = tid & 63, wave = __builtin_amdgcn_readfirstlane(tid >> 6);
    LAS float* MQ = (LAS float*)(lds + M_Q); LAS float* MK = (LAS float*)(lds + M_K); LAS float* MLF = (LAS float*)(lds + M_LF); LAS float* MF = (LAS float*)(lds + M_F);
    for (int j = wave; j < 16; j += 8) { const float* mi = MI + (size_t)(R_META + j) * LDMI;
#pragma unroll
        for (int h = 0; h < 4; ++h) { const float q = mi[C_FQ + h * 64 + lane], k = mi[C_FK + h * 64 + lane];
            const float qs = rsqrtf(wave_sum_l(q * q, lane) * (1.f / 64.f) + EPS), ks = rsqrtf(wave_sum_l(k * k, lane) * (1.f / 64.f) + EPS);
            MQ[j * 256 + h * 64 + lane] = q * qs * qg[lane]; MK[j * 256 + h * 64 + lane] = k * ks * kg[lane]; }
        if (lane < 4) MLF[j * 4 + lane] = log_sigmoidf(mi[C_FF + lane] + fbias[lane]); }
    __syncthreads();
    if (tid < 4) { float F = 0.f; for (int j = 0; j < 16; ++j) { F += MLF[j * 4 + tid]; MF[j * 4 + tid] = F; } }
    __syncthreads();
    for (int pr = wave; pr < 64; pr += 8) { const int h = pr >> 4, j = pr & 15;
        const float qv = MQ[j * 256 + h * 64 + lane];
        float sc[16]; float mx = -INFINITY;
#pragma unroll
        for (int k = 0; k < 16; ++k) { const float s = wave_sum_l(qv * MK[k * 256 + h * 64 + lane], lane) * 0.125f + (MF[j * 4 + h] - MF[k * 4 + h]); sc[k] = k <= j ? s : -INFINITY; mx = fmaxf(mx, sc[k]); }
        float sum = 0.f, o = 0.f;
#pragma unroll
        for (int k = 0; k < 16; ++k) { const float p = __expf(sc[k] - mx); sum += p; o += p * MI[(size_t)(R_META + k) * LDMI + C_FV + h * 64 + lane]; }
        MIXB[(size_t)(R_META + j) * 1024 + h * 64 + lane] = (bf16)f2bf(o / sum); }
    __syncthreads();
}
}

namespace eg {
using fa::bf16x8; using fa::f32x16; using fa::f4; using fa::crow;
template <int K, int NB>
__device__ __forceinline__ f4 egemm_tile(const bf16* A, const bf16* Bt, int row0, int col0, LAS unsigned char* lds, int tid) {
    const int lane = tid & 63, wave = __builtin_amdgcn_readfirstlane(tid >> 6), r32 = lane & 31, hi = lane >> 5;
    constexpr int KW = K / 8, NS = KW / 16, NBAT = (NS + NB - 1) / NB;
    const GAS bf16* ap = (const GAS bf16*)A + (size_t)(row0 + r32) * K + wave * KW + 8 * hi;
    const GAS bf16* bp0 = (const GAS bf16*)Bt + (size_t)(col0 + r32) * K + wave * KW + 8 * hi; const GAS bf16* bp1 = bp0 + (size_t)32 * K;
    f32x16 c0, c1;
#pragma unroll
    for (int i = 0; i < 16; ++i) { c0[i] = 0.f; c1[i] = 0.f; }
    bf16x8 fa_[2][NB], fb0[2][NB], fb1[2][NB];
#define EG_LOAD(buf, bat) do { _Pragma("unroll") for (int j = 0; j < NB; ++j) if ((bat) * NB + j < NS) { fa_[buf][j] = *(const GAS bf16x8*)(ap + ((bat) * NB + j) * 16); fb0[buf][j] = *(const GAS bf16x8*)(bp0 + ((bat) * NB + j) * 16); fb1[buf][j] = *(const GAS bf16x8*)(bp1 + ((bat) * NB + j) * 16); } } while (0)
#define EG_MMA(buf, bat) do { _Pragma("unroll") for (int j = 0; j < NB; ++j) if ((bat) * NB + j < NS) { c0 = __builtin_amdgcn_mfma_f32_32x32x16_bf16(fa_[buf][j], fb0[buf][j], c0, 0, 0, 0); c1 = __builtin_amdgcn_mfma_f32_32x32x16_bf16(fa_[buf][j], fb1[buf][j], c1, 0, 0, 0); } } while (0)
    EG_LOAD(0, 0);
#pragma unroll
    for (int bat = 0; bat < NBAT; ++bat) { if (bat + 1 < NBAT) { if ((bat + 1) & 1) EG_LOAD(1, bat + 1); else EG_LOAD(0, bat + 1); } if (bat & 1) EG_MMA(1, bat); else EG_MMA(0, bat); }
#undef EG_LOAD
#undef EG_MMA
    LAS float* red = (LAS float*)lds + wave * 2048;
#pragma unroll
    for (int i = 0; i < 16; ++i) { red[crow(i, hi) * 64 + r32] = c0[i]; red[crow(i, hi) * 64 + 32 + r32] = c1[i]; }
    __syncthreads();
    const LAS float* rp = (const LAS float*)lds + (tid >> 4) * 64 + (tid & 15) * 4;
    f4 s = *(const LAS f4*)rp;
#pragma unroll
    for (int w = 1; w < 8; ++w) s += *(const LAS f4*)(rp + w * 2048);
    __syncthreads();
    return s;
}
template <int K, int NB>
__device__ __forceinline__ void egemm_resid(const bf16* A, const bf16* Bt, float* X, bf16* XB, float* SSQP, float scale, float* out, int final_, LAS unsigned char* lds, int tid) {
    const int lane = tid & 63, wave = __builtin_amdgcn_readfirstlane(tid >> 6), r32 = lane & 31, hi = lane >> 5;
    constexpr int KW = K / 8, NS = KW / 16, NBAT = (NS + NB - 1) / NB;
    for (int u = blockIdx.x; u < 11 * 16; u += gridDim.x) {
        const int rt = u >> 4, ct = u & 15, row0 = MP + 48 * rt, col0 = 64 * ct;
        const int ra = row0 + (tid >> 4), col = col0 + (tid & 15) * 4; const bool hasb = (tid >> 4) < 16;
        GAS f4* xpa = (GAS f4*)(X + (size_t)ra * 1024 + col); GAS f4* xpb = (GAS f4*)(X + (size_t)(ra + 32) * 1024 + col);
        f4 xa = *xpa, xb = *xpb;
        const GAS bf16* ap0 = (const GAS bf16*)A + (size_t)(row0 + r32) * K + wave * KW + 8 * hi; const GAS bf16* ap1 = ap0 + (size_t)32 * K;
        const GAS bf16* bp0 = (const GAS bf16*)Bt + (size_t)(col0 + r32) * K + wave * KW + 8 * hi; const GAS bf16* bp1 = bp0 + (size_t)32 * K;
        f32x16 c00, c01, c10, c11;
#pragma unroll
        for (int i = 0; i < 16; ++i) { c00[i] = 0.f; c01[i] = 0.f; c10[i] = 0.f; c11[i] = 0.f; }
        constexpr int QB = 4, NQ = (NS + QB - 1) / QB;
        bf16x8 fa0[2][QB], fa1[2][QB], fb0[2][QB], fb1[2][QB];
#define EGR_LOAD(buf, bat) do { \
            _Pragma("unroll") for (int j = 0; j < QB; ++j) if ((bat) * QB + j < NS) fa0[buf][j] = *(const GAS bf16x8*)(ap0 + ((bat) * QB + j) * 16); \
            _Pragma("unroll") for (int j = 0; j < QB; ++j) if ((bat) * QB + j < NS) fb0[buf][j] = *(const GAS bf16x8*)(bp0 + ((bat) * QB + j) * 16); \
            _Pragma("unroll") for (int j = 0; j < QB; ++j) if ((bat) * QB + j < NS) fa1[buf][j] = *(const GAS bf16x8*)(ap1 + ((bat) * QB + j) * 16); \
            _Pragma("unroll") for (int j = 0; j < QB; ++j) if ((bat) * QB + j < NS) fb1[buf][j] = *(const GAS bf16x8*)(bp1 + ((bat) * QB + j) * 16); } while (0)
#define EGR_MMA(buf, bat) do { _Pragma("unroll") for (int j = 0; j < QB; ++j) if ((bat) * QB + j < NS) { \
            c00 = __builtin_amdgcn_mfma_f32_32x32x16_bf16(fa0[buf][j], fb0[buf][j], c00, 0, 0, 0); c01 = __builtin_amdgcn_mfma_f32_32x32x16_bf16(fa0[buf][j], fb1[buf][j], c01, 0, 0, 0); \
            c10 = __builtin_amdgcn_mfma_f32_32x32x16_bf16(fa1[buf][j], fb0[buf][j], c10, 0, 0, 0); c11 = __builtin_amdgcn_mfma_f32_32x32x16_bf16(fa1[buf][j], fb1[buf][j], c11, 0, 0, 0); } } while (0)
        EGR_LOAD(0, 0);
#pragma unroll
        for (int bat = 0; bat < NQ; ++bat) {
            if (bat + 1 < NQ) { if ((bat + 1) & 1) EGR_LOAD(1, bat + 1); else EGR_LOAD(0, bat + 1); }
            if (bat & 1) EGR_MMA(1, bat); else EGR_MMA(0, bat);
        }
#undef EGR_LOAD
#undef EGR_MMA
        LAS float* red = (LAS float*)lds + wave * 4096;
#pragma unroll
        for (int i = 0; i < 16; ++i) { red[crow(i, hi) * 64 + r32] = c00[i]; red[crow(i, hi) * 64 + 32 + r32] = c01[i]; red[(32 + crow(i, hi)) * 64 + r32] = c10[i]; red[(32 + crow(i, hi)) * 64 + 32 + r32] = c11[i]; }
        __syncthreads();
        const LAS float* rp = (const LAS float*)lds + (tid >> 4) * 64 + (tid & 15) * 4;
        f4 sa = *(const LAS f4*)rp, sb = *(const LAS f4*)(rp + 32 * 64);
#pragma unroll
        for (int w = 1; w < 8; ++w) { sa += *(const LAS f4*)(rp + w * 4096); sb += *(const LAS f4*)(rp + w * 4096 + 32 * 64); }
        __syncthreads();
#pragma unroll
        for (int hb = 0; hb < 2; ++hb) {
            if (hb == 1 && !hasb) break;
            const int row = hb ? ra + 32 : ra; f4 x = hb ? xb : xa; const f4 acc = hb ? sb : sa;
            x[0] += acc[0] * scale; x[1] += acc[1] * scale; x[2] += acc[2] * scale; x[3] += acc[3] * scale;
            *(hb ? xpb : xpa) = x;
            *(GAS la::u2v*)(XB + (size_t)row * 1024 + col) = (la::u2v){fa::cvtpk(x[0], x[1]), fa::cvtpk(x[2], x[3])};
            const float ss = fa::row16_sum((x[0] * x[0] + x[1] * x[1]) + (x[2] * x[2] + x[3] * x[3]));
            if ((tid & 15) == 0) SSQP[(size_t)row * 16 + ct] = ss;
            if (final_ && row < R_META) *(GAS f4*)(out + O_YS + (size_t)(row - R_S) * 1024 + col) = x;
        }
    }
}
}

namespace sm {
using fa::bf16x8; using fa::f32x16; using fa::crow;
__device__ __forceinline__ void smalls_gemm(const bf16* XB, const bf16* Wt, const float* SSQP, float* MI, float* LF, const float* fbias, float* out, int l, LAS unsigned char* lds, int tid, int u0, int ustep, int uend) {
    const int lane = tid & 63, wave = __builtin_amdgcn_readfirstlane(tid >> 6), r32 = lane & 31, hi = lane >> 5;
    constexpr int NU = (M_REAL + 31) / 32;
    const GAS bf16* bp = (const GAS bf16*)Wt + (size_t)r32 * 1024 + wave * 128 + 8 * hi;
    const GAS bf16* ap = (const GAS bf16*)XB + (size_t)r32 * 1024 + wave * 128 + 8 * hi;
    bf16x8 fa_[8], fb_[8];
    if (u0 < uend) {
#pragma unroll
        for (int j = 0; j < 8; ++j) fa_[j] = *(const GAS bf16x8*)(ap + (size_t)u0 * 32 * 1024 + 16 * j);
#pragma unroll
        for (int j = 0; j < 8; ++j) fb_[j] = *(const GAS bf16x8*)(bp + 16 * j); }
    for (int u = u0; u < uend; u += ustep) {
        const int row0 = 32 * u;
        f32x16 c;
#pragma unroll
        for (int i = 0; i < 16; ++i) c[i] = 0.f;
#pragma unroll
        for (int j = 0; j < 8; ++j) c = __builtin_amdgcn_mfma_f32_32x32x16_bf16(fa_[j], fb_[j], c, 0, 0, 0);
        if (u + ustep < uend) {
#pragma unroll
            for (int j = 0; j < 8; ++j) fa_[j] = *(const GAS bf16x8*)(ap + (size_t)(u + ustep) * 32 * 1024 + 16 * j); }
        const float rs = pg8::rstd_of(SSQP, row0 + (tid >> 4));
        LAS float* red = (LAS float*)lds + wave * 1024;
#pragma unroll
        for (int i = 0; i < 16; ++i) red[crow(i, hi) * 32 + r32] = c[i];
        __syncthreads();
        const int rr = tid >> 4, c0 = (tid & 15) * 2; const int row = row0 + rr;
        float v0 = 0.f, v1 = 0.f;
#pragma unroll
        for (int w = 0; w < 8; ++w) { v0 += ((const LAS float*)lds)[w * 1024 + rr * 32 + c0]; v1 += ((const LAS float*)lds)[w * 1024 + rr * 32 + c0 + 1]; }
        __syncthreads();
        v0 *= rs; v1 *= rs;
        if (c0 < 28) { MI[(size_t)row * LDMI + small2ref(c0)] = v0; MI[(size_t)row * LDMI + small2ref(c0 + 1)] = v1; }
        if (c0 < 4 && row < M_REAL) {
            const float x0 = v0 + fbias[c0], x1 = v1 + fbias[c0 + 1];
            const float l0 = fminf(x0, 0.f) - log1pf(__expf(-fabsf(x0))), l1 = fminf(x1, 0.f) - log1pf(__expf(-fabsf(x1)));
            LF[(size_t)row * 4 + c0] = l0; LF[(size_t)row * 4 + c0 + 1] = l1;
            if (row < MP) { float* o = out + O_LFP + ((size_t)(l * BATCH + (row >> 11)) * TP + 16 + (row & 2047)) * 4 + c0; o[0] = l0; o[1] = l1; }
            else if (row < R_META) { float* o = out + O_LFS + ((size_t)l * MS + (row - R_S)) * 4 + c0; o[0] = l0; o[1] = l1; }
            else for (int cc = 0; cc < BATCH; ++cc) { float* o = out + O_LFP + ((size_t)(l * BATCH + cc) * TP + (row - R_META)) * 4 + c0; o[0] = l0; o[1] = l1; }
        }
    }
}
}

struct Args { const float* in[31]; float* out; unsigned char* ws; int ph_lo, ph_hi; };

__device__ __forceinline__ void transpose_item(const float* W, int ldw, int K, const float* g, bf16* WT, int mapkind, int nblk, int item, LAS float* scr, int lane) {
    const int kb = item / nblk, nb = item % nblk, k0 = 64 * kb, n0 = 32 * nb;
    const int kr = lane >> 3, n4 = (lane & 7) * 4;
    const int nd = n0 + n4;
    int src;
    if (mapkind == 1) { const int pn = nd >> 8, s = nd & 255; src = s < 128 ? 128 * pn + s : 2816 + 128 * pn + (s - 128); }
    else if (mapkind == 2) { const int pn = nd >> 8, sl = nd & 255; src = pn < 3 ? 256 * pn + 64 * ((sl >> 5) & 3) + 32 * (sl >> 7) + (sl & 31) : main2ref(nd); if (src >= ldw) src = -1; }
    else if (mapkind == 3) src = small2ref(nd);
    else src = nd < ldw ? nd : -1;
    typedef float f4t __attribute__((ext_vector_type(4)));
    f4t wv[8];
#pragma unroll
    for (int i = 0; i < 8; ++i) wv[i] = *(const f4t*)(W + (size_t)(k0 + kr + 8 * i) * ldw + (src >= 0 ? src : 0));
#pragma unroll
    for (int i = 0; i < 8; ++i) { const int kk = kr + 8 * i; const float gv = g ? g[k0 + kk] : 1.f;
#pragma unroll
        for (int e = 0; e < 4; ++e) scr[kk * 33 + n4 + e] = src >= 0 ? wv[i][e] * gv : 0.f; }
    LDS_WAIT();
    const int c = lane & 7;
#pragma unroll
    for (int j = 0; j < 4; ++j) { const int n = (lane >> 3) + 8 * j; const LAS float* s = scr + (8 * c) * 33 + n;
        v4u o; o.x = pk2(s[0 * 33], s[1 * 33]); o.y = pk2(s[2 * 33], s[3 * 33]); o.z = pk2(s[4 * 33], s[5 * 33]); o.w = pk2(s[6 * 33], s[7 * 33]);
        *(v4u*)(WT + (size_t)(n0 + n) * K + k0 + 8 * c) = o; }
    LDS_WAIT();
}

template <class T> __device__ __forceinline__ T* as_global(T* p) { return (T*)(__attribute__((address_space(1))) T*)p; }
__device__ __forceinline__ int tid_now(int wave_s) { int t; asm volatile("v_mbcnt_lo_u32_b32 %0, -1, 0\n\tv_mbcnt_hi_u32_b32 %0, -1, %0" : "=v"(t)); return t | (wave_s << 6); }
__global__ void __launch_bounds__(NWAVES * 64, 2) fwd(Args args) {
    extern __shared__ __attribute__((aligned(16))) unsigned char lds[];
    volatile LAS unsigned* MISC = (volatile LAS unsigned*)((LAS unsigned char*)lds + MISC_OFF);
    if (threadIdx.x < 32) MISC[threadIdx.x] = 0u;
    __syncthreads();
    XcdBarrier bar = xcd_barrier_post((unsigned*)(args.ws + WS_CTL) + CW_BAR, MISC + 8);
    volatile LAS unsigned long long* PT = (volatile LAS unsigned long long*)((LAS unsigned char*)lds + MISC_OFF + 256);
    if (threadIdx.x < 31) PT[threadIdx.x] = (unsigned long long)args.in[threadIdx.x];
    __syncthreads();
#define INP(i) ((const float*)(const GAS float*)PT[i])
    const int lo = args.ph_lo, hi = args.ph_hi;
    const int wave_s = __builtin_amdgcn_readfirstlane((int)threadIdx.x >> 6);
    int ph = 0;
#define BUF(name, off) float* name = (float*)(ws_ + (off))
#define BUFH(name, off) bf16* name = (bf16*)(ws_ + (off))
#define PHASE_BEGIN_R(R) if (lo <= ph && ph < hi) for (int rep_ = 0; rep_ < (R); ++rep_) { GAS unsigned char* wsg_ = (GAS unsigned char*)args.ws; GAS float* outg_ = (GAS float*)args.out; int tid = tid_now(wave_s); asm volatile("" : "+s"(wsg_), "+s"(outg_)); unsigned char* ws_ = (unsigned char*)wsg_;         \
        const int lane = tid & 63, wave = tid >> 6; const int gw = blockIdx.x * NWAVES + wave, NGW = gridDim.x * NWAVES; float* smem = (float*)lds; float* out = (float*)outg_; (void)lane; (void)wave; (void)gw; (void)NGW; (void)smem; (void)out; \
        BUF(X, WS_X); BUFH(XB, WS_XB); BUF(SSQP, WS_SSQ); BUFH(HB, WS_HB); BUFH(MIXB, WS_MIXB); BUF(MI, WS_MI); BUF(QN, WS_QN); BUF(KN, WS_KN); BUF(LF, WS_LF); BUF(FC, WS_FC); BUF(FCS, WS_FCS); \
        BUF(XBC, WS_XBC); BUF(DTB, WS_DT); BUF(GLOG, WS_GLOG); BUF(YS, WS_YS); BUF(GO, WS_GO); BUFH(QF, WS_QF); BUFH(KF, WS_KF); BUFH(VT, WS_VT); BUF(SSQH, WS_SSQH); BUFH(XC, WS_XC); BUFH(MIB, WS_MIB); (void)MIB; (void)QF; (void)KF; (void)VT; (void)SSQH; (void)XC; \
        (void)X; (void)XB; (void)SSQP; (void)HB; (void)MIXB; (void)MI; (void)QN; (void)KN; (void)LF; (void)FC; (void)FCS; (void)XBC; (void)DTB; (void)GLOG; (void)YS; (void)GO;
#define PHASE_END_R(R) if (ph + 1 < hi || rep_ + 1 < (R)) xcd_barrier(bar, tid_now(wave_s)); } ++ph;
#define PHASE_BEGIN PHASE_BEGIN_R(1)
#define PHASE_END PHASE_END_R(1)
#define WT_(l, off) ((bf16*)(ws_ + WS_WT + (size_t)(l) * WL_SIZE + (off)))

#define CONVERT_ITEM(it_, scr_, ln_) do { constexpr int I1 = 16 * 176, I2 = 44 * 32, I3 = 16 * 88, I4 = 16 * 32, I7 = 16, IL = 2 * I1 + 2 * I2 + I3 + I4 + I7; static_assert(IL == 10384, "item space"); \
        const int lw = (it_) / IL; int r = (it_) % IL; \
        if (r < I1) { transpose_item(INP(11) + (size_t)lw * 1024 * 5632, 5632, 1024, INP(10) + lw * 1024, WT_(lw, WL_W1), 1, 176, r, scr_, ln_); break; } r -= I1; \
        if (r < I2) { transpose_item(INP(12) + (size_t)lw * 2816 * 1024, 1024, 2816, nullptr, WT_(lw, WL_W2), 0, 32, r, scr_, ln_); break; } r -= I2; \
        if (r < I3) { transpose_item(INP(14) + (size_t)lw * 1024 * N_IN, N_IN, 1024, INP(13) + lw * 1024, WT_(lw, WL_W3), 2, 88, r, scr_, ln_); break; } r -= I3; \
        if (r < I4) { transpose_item(INP(27) + (size_t)lw * 1024 * 1024, 1024, 1024, nullptr, WT_(lw, WL_W4), 0, 32, r, scr_, ln_); break; } r -= I4; \
        if (r < I1) { transpose_item(INP(29) + (size_t)lw * 1024 * 5632, 5632, 1024, INP(28) + lw * 1024, WT_(lw, WL_W5), 1, 176, r, scr_, ln_); break; } r -= I1; \
        if (r < I2) { transpose_item(INP(30) + (size_t)lw * 2816 * 1024, 1024, 2816, nullptr, WT_(lw, WL_W6), 0, 32, r, scr_, ln_); break; } r -= I2; \
        transpose_item(INP(14) + (size_t)lw * 1024 * N_IN, N_IN, 1024, INP(13) + lw * 1024, WT_(lw, WL_W7), 3, 1, r, scr_, ln_); } while (0)
#define CONVERT_RANGE(lo_, hi_, gwv_, ngwv_) do { const int tn_ = tid_now(wave_s); const int lnr_ = tn_ & 63; LAS float* scrr_ = (LAS float*)((LAS unsigned char*)lds + wave_s * 16384); \
        for (int itr_ = (lo_) + (gwv_); itr_ < (hi_); itr_ += (ngwv_)) CONVERT_ITEM(itr_, scrr_, lnr_); } while (0)
    PHASE_BEGIN_R(R_P0)
        CONVERT_RANGE(0, 2816, gw, NGW);
        for (int i = blockIdx.x * 512 + tid; i < 2 * 12288; i += gridDim.x * 512) { const int j = i % 12288;
            if (i < 12288) { const int bh = j / 384, sl = (j % 384) >> 3, ch = j & 7; *(v4u*)(KF + ((size_t)bh * 2112 + 16 + sl) * 64 + ch * 8) = (v4u){0u, 0u, 0u, 0u}; }
            else { const int bh = j / 384, d = (j % 384) / 6, ch = j % 6; *(v4u*)(VT + ((size_t)bh * 64 + d) * 2112 + 16 + ch * 8) = (v4u){0u, 0u, 0u, 0u}; } }
        for (int r0 = gw * 2; r0 < M_PAD; r0 += NGW * 2) {
            float4 v[2][4];
#pragma unroll
            for (int q = 0; q < 2; ++q) { const int r = r0 + q;
                const float* src = r < MP ? INP(0) + (size_t)r * 1024 : r < R_META ? INP(1) + (size_t)(r - R_S) * 1024 : r < M_REAL ? INP(9) + (size_t)(r - R_META) * 1024 : nullptr;
#pragma unroll
                for (int j = 0; j < 4; ++j) v[q][j] = src ? ((const float4*)src)[lane + 64 * j] : make_float4(0.f, 0.f, 0.f, 0.f); }
#pragma unroll
            for (int q = 0; q < 2; ++q) { const int r = r0 + q;
                float4* o = (float4*)(X + (size_t)r * 1024) + lane; uint2* ob = (uint2*)(XB + (size_t)r * 1024) + lane; float s = 0.f;
#pragma unroll
                for (int j = 0; j < 4; ++j) { const float4 w = v[q][j]; if (r >= MP) o[64 * j] = w; ob[64 * j] = make_uint2(pk2(w.x, w.y), pk2(w.z, w.w)); s += (w.x * w.x + w.y * w.y) + (w.z * w.z + w.w * w.w); }
                s = wave_sum(s);
                if (lane < 16) SSQP[(size_t)r * 16 + lane] = lane == 0 ? s : 0.f;
                if (r >= M_REAL) { uint2* m = (uint2*)(MIXB + (size_t)r * 1024) + lane;
#pragma unroll
                    for (int j = 0; j < 4; ++j) m[64 * j] = make_uint2(0u, 0u); } }
        }
    PHASE_END_R(R_P0)

    for (int l = 0; l < DEPTH; ++l) {
#define mix_norm (INP(13) + l * 1024)
#define fox_q_norm (INP(15) + l * 64)
#define fox_k_norm (INP(16) + l * 64)
#define fox_f_bias (INP(17) + l * 4)
#define conv_w (INP(18) + l * 4 * 768)
#define conv_b (INP(19) + l * 768)
#define dt_bias (INP(20) + l * 8)
#define a_log (INP(21) + l * 8)
#define ssd_d (INP(22) + l * 8)
#define ssd_norm (INP(23) + l * 512)
#define w_gate (INP(24) + l * 16 * 128)
#define gate_bias (INP(25) + l * 128)
#define gla_norm (INP(26) + l * 64)
#define cache_k (INP(2))
#define cache_v (INP(3))
#define cache_lf (INP(4))
#define state_ssm (INP(5) + (size_t)l * DEC_BATCH * 8 * 4096)
#define state_conv (INP(6) + (size_t)l * DEC_BATCH * 3 * 768)
#define state_gla (INP(7) + (size_t)l * DEC_BATCH * 4 * 2048)
#define pt ((const int*)INP(8))
        for (int half = 0; half < 2; ++half) {
            PHASE_BEGIN_R(R_G1) { pg8::Gemm g{XB, WT_(l, half ? WL_W5 : WL_W1), M_PAD, 5632, 1024}; pg8::StaticOrder S; S.init(M_PAD, 5632, (int)gridDim.x, (int)blockIdx.x);
                pg8::EpiSwiglu E{HB, SSQP}; pg8::gemm_phase<pg8::EpiSwiglu, pg8::StaticOrder, true, true>((LAS unsigned char*)lds, g, S, E, tid);
                if (l == 0 && half == 0) {
                    if (gridDim.x == 256) { if (blockIdx.x >= 194) CONVERT_RANGE(2816, 4224, ((int)blockIdx.x - 194) * NWAVES + wave_s, 62 * NWAVES); }
                    else CONVERT_RANGE(2816, 4224, (int)blockIdx.x * NWAVES + wave_s, (int)gridDim.x * NWAVES); } } PHASE_END_R(R_G1)
            PHASE_BEGIN { pg8::Gemm g{HB, WT_(l, half ? WL_W6 : WL_W2), MP, 1024, 2816}; pg8::StaticOrder S; S.init(MP, 1024, (int)gridDim.x, (int)blockIdx.x);
                pg8::EpiResid E{(const GAS float*)nullptr, X, XB, SSQP, 0.5f, out, (l == DEPTH - 1 && half == 1) ? 1 : 0};     pg8::gemm_phase<pg8::EpiResid, pg8::StaticOrder, true, true>((LAS unsigned char*)lds, g, S, E, tid);
                eg::egemm_resid<2816, 8>(HB, WT_(l, half ? WL_W6 : WL_W2), X, XB, SSQP, 0.5f, out, (l == DEPTH - 1 && half == 1) ? 1 : 0, (LAS unsigned char*)lds, tid_now(wave_s));
                if (l == 0 && half == 0) {
                    if (gridDim.x == 256) { if (blockIdx.x >= 176) { CONVERT_RANGE(4224, 5632, ((int)blockIdx.x - 176) * NWAVES + wave_s, 80 * NWAVES); CONVERT_RANGE(10368, 10384, ((int)blockIdx.x - 176) * NWAVES + wave_s, 80 * NWAVES); } }
                    else { CONVERT_RANGE(4224, 5632, (int)blockIdx.x * NWAVES + wave_s, (int)gridDim.x * NWAVES); CONVERT_RANGE(10368, 10384, (int)blockIdx.x * NWAVES + wave_s, (int)gridDim.x * NWAVES); } }     } PHASE_END
            if (half == 1) break;

            PHASE_BEGIN_R(R_G3) { pg8::Gemm g{XB, WT_(l, WL_W3), M_PAD, N_MAIN, 1024}; pg8::StaticOrder S; S.init(M_PAD, N_MAIN, (int)gridDim.x, (int)blockIdx.x);
                pg8::EpiMix E{MI, MIB, SSQP, QF, KF, VT, fox_q_norm, fox_k_norm, fox_f_bias, LF, out, l}; pg8::gemm_phase<pg8::EpiMix, pg8::StaticOrder, true, true>((LAS unsigned char*)lds, g, S, E, tid);
                {
                    constexpr int NUS = (M_REAL + 31) / 32; int u0 = blockIdx.x, us = gridDim.x, ue = NUS;
                    if (gridDim.x == 256) { if (blockIdx.x >= 225) { u0 = (int)blockIdx.x - 225; us = 31; ue = 310; } else { u0 = 310 + (int)blockIdx.x; us = 1024; } }
                    sm::smalls_gemm(XB, WT_(l, WL_W7), SSQP, MI, LF, fox_f_bias, out, l, (LAS unsigned char*)lds, tid_now(wave_s), u0, us, ue); }
                if (l == 0) {
                    if (gridDim.x == 256) { if (blockIdx.x >= 225) CONVERT_RANGE(5632, 6144, ((int)blockIdx.x - 225) * NWAVES + wave_s, 31 * NWAVES); }
                    else CONVERT_RANGE(5632, 6144, (int)blockIdx.x * NWAVES + wave_s, (int)gridDim.x * NWAVES); } } PHASE_END_R(R_G3)
            PHASE_BEGIN
            {
                typedef float f4v __attribute__((ext_vector_type(4)));
                LAS float* lrs = (LAS float*)((LAS unsigned char*)lds + wave * 1024);
                for (int blk = gw; blk < (NGW == 2048 ? 2048 : 2048 + 2); blk += NGW) {
                    const bool isP = blk < 2048; const int bb = blk >> 8, i0 = isP ? 8 * (blk & 255) : 8 * (blk - 2048);
                    const int rowb = isP ? bb * 2048 + i0 : R_META + i0;
                    f4v u[3][11];
#pragma unroll
                    for (int j = 0; j < 11; ++j) { const int i = i0 + j - 3; int pr;
                        if (isP) pr = i >= 0 ? bb * 2048 + i : R_META + 16 + i; else pr = i >= 0 ? R_META + i : -1;
#pragma unroll
                        for (int k = 0; k < 3; ++k) { const uint2 w = *(const uint2*)(MIB + (size_t)(pr >= 0 ? pr : 0) * N_MAIN + CM_XBC + 4 * (lane + 64 * k));
                            const f4v v = (f4v){__uint_as_float(w.x << 16), __uint_as_float(w.x & 0xffff0000u), __uint_as_float(w.y << 16), __uint_as_float(w.y & 0xffff0000u)}; u[k][j] = pr >= 0 ? v : (f4v){0.f, 0.f, 0.f, 0.f}; } }
                    const f4v lrv = lane < 32 ? *(const f4v*)(MI + (size_t)(rowb + (lane >> 2)) * LDMI + C_LR + 4 * (lane & 3)) : (f4v){0.f, 0.f, 0.f, 0.f};
                    const float dtr = MI[(size_t)(rowb + (lane >> 3)) * LDMI + C_DT + (lane & 7)];
                    if (lane < 32) *(LAS f4v*)(lrs + (lane >> 2) * 16 + 4 * (lane & 3)) = lrv;
                    DTB[(size_t)(rowb + (lane >> 3)) * 8 + (lane & 7)] = softplusf(dtr + dt_bias[lane & 7]);
#pragma unroll
                    for (int k = 0; k < 3; ++k) { const int col = 4 * (lane + 64 * k);
                        const f4v w0 = *(const f4v*)(conv_w + col), w1 = *(const f4v*)(conv_w + 768 + col), w2 = *(const f4v*)(conv_w + 2 * 768 + col), w3 = *(const f4v*)(conv_w + 3 * 768 + col), bs = *(const f4v*)(conv_b + col);
#pragma unroll
                        for (int j = 0; j < 8; ++j) { const f4v o = w3 * u[k][j + 3] + w2 * u[k][j + 2] + w1 * u[k][j + 1] + w0 * u[k][j] + bs;
                            *(uint2*)(XC + (size_t)(rowb + j) * 768 + col) = make_uint2(fa::cvtpk(pg8::silu_fast(o[0]), pg8::silu_fast(o[1])), fa::cvtpk(pg8::silu_fast(o[2]), pg8::silu_fast(o[3]))); } }
                    LDS_WAIT();
                    float wc0[16], wc1[16];
#pragma unroll
                    for (int r = 0; r < 16; ++r) { wc0[r] = w_gate[r * 128 + lane]; wc1[r] = w_gate[r * 128 + 64 + lane]; }
                    const float gb0 = gate_bias[lane], gb1 = gate_bias[64 + lane];
#pragma unroll
                    for (int j = 0; j < 8; ++j) { float a0 = gb0, a1 = gb1;
#pragma unroll
                        for (int r4 = 0; r4 < 4; ++r4) { const f4v x = *(const LAS f4v*)(lrs + j * 16 + 4 * r4);
                            a0 += x[0] * wc0[4 * r4] + x[1] * wc0[4 * r4 + 1] + x[2] * wc0[4 * r4 + 2] + x[3] * wc0[4 * r4 + 3]; a1 += x[0] * wc1[4 * r4] + x[1] * wc1[4 * r4 + 1] + x[2] * wc1[4 * r4 + 2] + x[3] * wc1[4 * r4 + 3]; }
                        GLOG[(size_t)(rowb + j) * 128 + lane] = (fminf(a0, 0.f) - __logf(1.0f + __expf(-fabsf(a0)))) * (1.0f / 16.0f);
                        GLOG[(size_t)(rowb + j) * 128 + 64 + lane] = (fminf(a1, 0.f) - __logf(1.0f + __expf(-fabsf(a1)))) * (1.0f / 16.0f); }
                    LDS_WAIT();
                }
                if (NGW == 2048 && gw < 16) {
                    const int m = gw, row = R_META + m;
                    f4v um[3][4];
#pragma unroll
                    for (int j = 0; j < 4; ++j) { const int i = m + j - 3;
#pragma unroll
                        for (int k = 0; k < 3; ++k) { const uint2 w = *(const uint2*)(MIB + (size_t)(R_META + (i >= 0 ? i : 0)) * N_MAIN + CM_XBC + 4 * (lane + 64 * k));
                            const f4v v = (f4v){__uint_as_float(w.x << 16), __uint_as_float(w.x & 0xffff0000u), __uint_as_float(w.y << 16), __uint_as_float(w.y & 0xffff0000u)}; um[k][j] = i >= 0 ? v : (f4v){0.f, 0.f, 0.f, 0.f}; } }
                    if (lane < 8) DTB[(size_t)row * 8 + lane] = softplusf(MI[(size_t)row * LDMI + C_DT + lane] + dt_bias[lane]);
#pragma unroll
                    for (int k = 0; k < 3; ++k) { const int col = 4 * (lane + 64 * k);
                        const f4v w0 = *(const f4v*)(conv_w + col), w1 = *(const f4v*)(conv_w + 768 + col), w2 = *(const f4v*)(conv_w + 2 * 768 + col), w3 = *(const f4v*)(conv_w + 3 * 768 + col), bs = *(const f4v*)(conv_b + col);
                        const f4v o = w3 * um[k][3] + w2 * um[k][2] + w1 * um[k][1] + w0 * um[k][0] + bs;
                        *(uint2*)(XC + (size_t)row * 768 + col) = make_uint2(fa::cvtpk(pg8::silu_fast(o[0]), pg8::silu_fast(o[1])), fa::cvtpk(pg8::silu_fast(o[2]), pg8::silu_fast(o[3]))); }
                    float a0 = gate_bias[lane], a1 = gate_bias[64 + lane];
#pragma unroll
                    for (int r = 0; r < 16; ++r) { const float x = MI[(size_t)row * LDMI + C_LR + r]; a0 += x * w_gate[r * 128 + lane]; a1 += x * w_gate[r * 128 + 64 + lane]; }
                    GLOG[(size_t)row * 128 + lane] = (fminf(a0, 0.f) - __logf(1.0f + __expf(-fabsf(a0)))) * (1.0f / 16.0f);
                    GLOG[(size_t)row * 128 + 64 + lane] = (fminf(a1, 0.f) - __logf(1.0f + __expf(-fabsf(a1)))) * (1.0f / 16.0f);
                }
            }
            PHASE_END
            PHASE_BEGIN_R(R_MIX)
            {
                volatile LAS unsigned* qslot = (volatile LAS unsigned*)((LAS unsigned char*)lds + MISC_OFF + 64);
                unsigned* qhead = (unsigned*)(ws_ + WS_CTL) + CW_Q + 64 * l + 8 * rep_;
                constexpr int U_SSDP = 0, U_GLAP = 64, U_SAMP = 96, U_PATT = 224, U_META = 480, U_END = 481;
                for (;;) {
                    __syncthreads();
                    if (tid == 0) *qslot = atomicAdd(qhead, 1u);
                    __syncthreads();
                    const int u = (int)*qslot;
                    constexpr int N_CVU = (14608 + 15) / 16;
                    if (u >= U_END) {
                        if (l != 0 || u >= U_END + N_CVU) break;
                        const int j = 16 * (u - U_END) + 2 * wave_s; LAS float* scrq_ = (LAS float*)((LAS unsigned char*)lds + wave_s * 16384); const int lnq_ = tid_now(wave_s) & 63;
                        for (int e = 0; e < 2; ++e) { const int jj = j + e; if (jj < 14608) { const int itq_ = jj < 4224 ? 6144 + jj : 10384 + (jj - 4224); CONVERT_ITEM(itq_, scrq_, lnq_); } }
                        continue;
                    }
                    int tidu = tid; asm volatile("" : "+v"(tidu));
                    if (u < U_GLAP) {
                        const int b = u >> 3, h = u & 7;
                        la::ssd_prompt_unit(b, h, (const GAS bf16*)MIB, (const GAS bf16*)XC, (const GAS float*)DTB, -expf(a_log[h]), ssd_d[h], (GAS bf16*)MIXB, (GAS float*)SSQH, (GAS float*)(out + O_SSMP + ((size_t)(l * BATCH + b) * 8 + h) * 4096), (LAS unsigned char*)lds, tidu);
                    } else if (u < U_SAMP) {
                        const int b = (u - U_GLAP) >> 2, h = (u - U_GLAP) & 3;
                        la::gla_prompt_unit(b, h, (const GAS bf16*)MIB, (const GAS float*)GLOG, (const GAS float*)gla_norm, (GAS bf16*)MIXB, (GAS float*)(out + O_GLAP + ((size_t)(l * BATCH + b) * 4 + h) * 2048), (LAS unsigned char*)lds, tidu);
                    } else if (u < U_META) {
                        const int k = u - U_SAMP;
                        const int su = k < 64 ? k : ((k >= 160 && k < 224) ? k - 96 : -1);
                        if (su >= 0) {
                            eu::sample_unit(su, l, MI, cache_k, cache_v, cache_lf, pt, state_ssm, state_conv, state_gla, fox_q_norm, fox_k_norm, fox_f_bias, conv_w, conv_b, dt_bias, a_log, ssd_d, ssd_norm,
                                            w_gate, gate_bias, gla_norm, MIXB, out, (LAS unsigned char*)lds, tidu);
                        } else {
                            const int j = k < 160 ? k - 64 : k - 128; fa::fox_prompt_unit((j & 31) >> 2, j & 3, 7 - (j >> 5), QF, KF, VT, LF, MIXB, (LAS unsigned char*)lds, tidu);
                        }
                    } else {
                        eu::meta_unit(MI, fox_q_norm, fox_k_norm, fox_f_bias, MIXB, (LAS unsigned char*)lds, tidu);
                    }
                }
            }
            PHASE_END_R(R_MIX)
            PHASE_BEGIN
                { const float4 gn0 = *(const float4*)(ssd_norm + lane * 4), gn1 = *(const float4*)(ssd_norm + 256 + lane * 4);
                for (int i0 = gw * 4; i0 < MP + 16; i0 += NGW * 4) {
                    const int r0 = i0 < MP ? i0 : i0 + (R_META - MP);
                    uint2 w[4][2]; float4 q[4][2];
#pragma unroll
                    for (int j = 0; j < 4; ++j) { const size_t r = (size_t)(r0 + j);
                        q[j][0] = *(const float4*)(SSQH + r * 8); q[j][1] = *(const float4*)(SSQH + r * 8 + 4);
                        w[j][0] = *(const uint2*)(MIXB + r * 1024 + 256 + lane * 4); w[j][1] = *(const uint2*)(MIXB + r * 1024 + 512 + lane * 4); }
#pragma unroll
                    for (int j = 0; j < 4; ++j) { const size_t r = (size_t)(r0 + j);
#pragma unroll
                        for (int g = 0; g < 2; ++g) { const float4 qq = q[j][g]; const float rs = rsqrtf((qq.x + qq.y + qq.z + qq.w) * (1.f / 256.f) + EPS); const float4 gn = g ? gn1 : gn0; const uint2 ww = w[j][g];
                            const float y0 = __uint_as_float(ww.x << 16) * rs * gn.x, y1 = __uint_as_float(ww.x & 0xffff0000u) * rs * gn.y, y2 = __uint_as_float(ww.y << 16) * rs * gn.z, y3 = __uint_as_float(ww.y & 0xffff0000u) * rs * gn.w;
                            *(uint2*)(MIXB + r * 1024 + 256 + g * 256 + lane * 4) = make_uint2(pk2(y0, y1), pk2(y2, y3)); } }
                } }
            PHASE_END
            PHASE_BEGIN { pg8::Gemm g{MIXB, WT_(l, WL_W4), MP, 1024, 1024}; pg8::StaticOrder S; S.init(MP, 1024, (int)gridDim.x, (int)blockIdx.x);
                pg8::EpiResid E{(const GAS float*)nullptr, X, XB, SSQP, 1.0f, out, 0}; pg8::gemm_phase<pg8::EpiResid, pg8::StaticOrder, true, true>((LAS unsigned char*)lds, g, S, E, tid);
                eg::egemm_resid<1024, 8>(MIXB, WT_(l, WL_W4), X, XB, SSQP, 1.0f, out, 0, (LAS unsigned char*)lds, tid_now(wave_s)); } PHASE_END
        }
    }
}

extern "C" void kernel_launch(void* const* d_in, const int* in_sizes, int n_in, void* d_out, int out_size, void* d_ws, size_t ws_size, hipStream_t stream) {
    static int grid = 0;
    if (grid == 0) {
        if (n_in != 31 || out_size != (int)O_END || ws_size < WS_END) { fprintf(stderr, "kernel_launch: unexpected sizes n_in %d out %d ws %zu (need %zu)\n", n_in, out_size, ws_size, (size_t)WS_END); grid = -1; return; }
        int dev = 0, cus = 0;
        if (hipGetDevice(&dev) != hipSuccess || hipDeviceGetAttribute(&cus, hipDeviceAttributeMultiprocessorCount, dev) != hipSuccess) { grid = -1; return; }
        if (hipFuncSetAttribute((const void*)fwd, hipFuncAttributeMaxDynamicSharedMemorySize, LDS_BYTES) != hipSuccess) { fprintf(stderr, "kernel_launch: hipFuncSetAttribute failed\n"); grid = -1; return; }
        (void)hipGetLastError();
        grid = cus;
    }
    if (grid < 0) return;
    (void)hipMemsetAsync((char*)d_ws + WS_CTL, 0, CTL_ZERO_BYTES, stream);
    Args a{};
    for (int i = 0; i < 31; ++i) a.in[i] = (const float*)d_in[i];
    a.out = (float*)d_out; a.ws = (unsigned char*)d_ws; a.ph_lo = 0; a.ph_hi = 1000;
    hipLaunchKernelGGL(fwd, dim3(grid), dim3(NWAVES * 64), LDS_BYTES, stream, a);
}
```

```cpp
#include <hip/hip_runtime.h>
#include <cstdio>
#include <cstdint>

constexpr int D_MODEL = 1024, BATCH = 8, SEQ = 2048, DEPTH = 2, DEC_BATCH = 128, DEC_SEQ = 4, PAST = 2048, PAGE = 128, NPAGES = 16, NPOOL = 2560;
constexpr int N_META = 16, TP = N_META + SEQ;
constexpr int D_FF = 2816;
constexpr float EPS = 1e-6f;
constexpr int N_IN = 2844, LDMI = 2848;
constexpr int C_FQ = 0, C_FK = 256, C_FV = 512, C_FF = 768, C_SZ = 772, C_XBC = 1284, C_DT = 2052, C_GQ = 2060, C_GK = 2188, C_GV = 2316, C_LR = 2572, C_GG = 2588;
constexpr int N_MAIN = 2816, CM_SZ = 768, CM_XBC = 1280, CM_GQ = 2048, CM_GK = 2176, CM_GV = 2304, CM_GG = 2560;
__host__ __device__ constexpr int main2ref(int c) { return c < 768 ? c : (c < 2048 ? c + 4 : (c < 2560 ? c + 12 : c + 28)); }
__host__ __device__ constexpr int small2ref(int j) { return j < 4 ? C_FF + j : (j < 12 ? C_DT + (j - 4) : (j < 28 ? C_LR + (j - 12) : -1)); }
constexpr int MP = BATCH * SEQ, MS = DEC_BATCH * DEC_SEQ, R_S = MP, R_META = MP + MS, M_REAL = R_META + N_META, M_PAD = 17152;
constexpr size_t O_YP = 0;
constexpr size_t O_YS = O_YP + (size_t)BATCH * SEQ * D_MODEL;
constexpr size_t O_KP = O_YS + (size_t)MS * D_MODEL;
constexpr size_t O_VP = O_KP + (size_t)DEPTH * BATCH * TP * 256;
constexpr size_t O_LFP = O_VP + (size_t)DEPTH * BATCH * TP * 256;
constexpr size_t O_SSMP = O_LFP + (size_t)DEPTH * BATCH * TP * 4;
constexpr size_t O_CONVP = O_SSMP + (size_t)DEPTH * BATCH * 8 * 64 * 64;
constexpr size_t O_GLAP = O_CONVP + (size_t)DEPTH * BATCH * 3 * 768;
constexpr size_t O_KS = O_GLAP + (size_t)DEPTH * BATCH * 4 * 32 * 64;
constexpr size_t O_VS = O_KS + (size_t)DEPTH * MS * 256;
constexpr size_t O_LFS = O_VS + (size_t)DEPTH * MS * 256;
constexpr size_t O_SSMS = O_LFS + (size_t)DEPTH * MS * 4;
constexpr size_t O_CONVS = O_SSMS + (size_t)DEPTH * DEC_BATCH * 8 * 64 * 64;
constexpr size_t O_GLAS = O_CONVS + (size_t)DEPTH * DEC_BATCH * 3 * 768;
constexpr size_t O_END = O_GLAS + (size_t)DEPTH * DEC_BATCH * 4 * 32 * 64;
static_assert(O_END == 46638080, "output size");

constexpr size_t MiB = 1u << 20;
constexpr size_t WS_CTL = 0, CTL_ZERO_BYTES = 1 * MiB;
constexpr size_t SZ_W1 = (size_t)5632 * 1024 * 2, SZ_W2 = (size_t)1024 * 2816 * 2, SZ_W3 = (size_t)2816 * 1024 * 2, SZ_W7 = (size_t)32 * 1024 * 2, SZ_W4 = (size_t)1024 * 1024 * 2;
constexpr size_t WL_W1 = 0, WL_W2 = WL_W1 + SZ_W1, WL_W3 = WL_W2 + SZ_W2, WL_W4 = WL_W3 + SZ_W3, WL_W5 = WL_W4 + SZ_W4, WL_W6 = WL_W5 + SZ_W1, WL_W7 = WL_W6 + SZ_W2, WL_SIZE = WL_W7 + SZ_W7;
constexpr size_t WS_WT = 2 * MiB;
constexpr size_t WS_X = WS_WT + 2 * WL_SIZE;
constexpr size_t WS_XB = WS_X + (size_t)M_PAD * 1024 * 4;
constexpr size_t WS_SSQ = WS_XB + (size_t)M_PAD * 1024 * 2;
constexpr size_t WS_HB = WS_SSQ + (size_t)M_PAD * 16 * 4;
constexpr size_t WS_MIXB = WS_HB + (size_t)M_PAD * 2816 * 2;
constexpr size_t WS_MI = WS_MIXB + (size_t)M_PAD * 1024 * 2;
constexpr size_t WS_QN = WS_MI + (size_t)M_PAD * LDMI * 4;
constexpr size_t WS_KN = WS_QN + (size_t)M_PAD * 256 * 4;
constexpr size_t WS_LF = WS_KN + (size_t)M_PAD * 256 * 4;
constexpr size_t WS_FC = WS_LF + (size_t)M_PAD * 4 * 4;
constexpr size_t WS_FCS = WS_FC + (size_t)M_PAD * 4 * 4;
constexpr size_t WS_XBC = WS_FCS + (size_t)128 * 4 * 2052 * 4 + 4096;
constexpr size_t WS_DT = WS_XBC + (size_t)M_PAD * 768 * 4;
constexpr size_t WS_GLOG = WS_DT + (size_t)M_PAD * 8 * 4;
constexpr size_t WS_YS = WS_GLOG + (size_t)M_PAD * 128 * 4;
constexpr size_t WS_GO = WS_YS + (size_t)M_PAD * 512 * 4;
constexpr size_t WS_QF = WS_GO + (size_t)M_PAD * 256 * 4;
constexpr size_t WS_KF = WS_QF + (size_t)32 * 2048 * 64 * 2;
constexpr size_t WS_VT = WS_KF + (size_t)32 * 2112 * 64 * 2;
constexpr size_t WS_SSQH = WS_VT + (size_t)32 * 2112 * 64 * 2;
constexpr size_t WS_XC = WS_SSQH + (size_t)M_PAD * 8 * 4;
constexpr size_t WS_MIB = WS_XC + (size_t)M_PAD * 768 * 2;
constexpr size_t WS_END = WS_MIB + (size_t)M_PAD * LDMI * 2;
static_assert(WS_X % 256 == 0 && WS_XB % 256 == 0 && WS_SSQ % 256 == 0 && WS_HB % 256 == 0 && WS_MIXB % 256 == 0 && WS_MI % 256 == 0, "alignment");

#ifndef R_P0
#define R_P0 1
#endif
#ifndef R_G1
#define R_G1 1
#endif
#ifndef R_G3
#define R_G3 1
#endif
#ifndef R_PREP
#define R_PREP 1
#endif
#ifndef R_MIX
#define R_MIX 1
#endif
#ifndef R_BAR
#define R_BAR 0
#endif
constexpr int CW_BAR = 4096, CW_Q = 8192;
constexpr int NWAVES = 8;
constexpr int LDS_BYTES = 147456;
constexpr int MISC_OFF = 131072 + 320;

#define LAS __attribute__((address_space(3)))
#define GAS __attribute__((address_space(1)))
#define LDS_WAIT() asm volatile("s_waitcnt lgkmcnt(0)" ::: "memory")
typedef unsigned short bf16;
typedef unsigned v4u __attribute__((ext_vector_type(4)));
__device__ __forceinline__ unsigned f2bf(float f) { unsigned u = __builtin_bit_cast(unsigned, f); return (u + 0x7fffu + ((u >> 16) & 1u)) >> 16; }
__device__ __forceinline__ unsigned pk2(float lo, float hi) { return f2bf(lo) | (f2bf(hi) << 16); }

__device__ __forceinline__ float bperm(float x, int srclane);
namespace pg8 {
#define PG8_LAS __attribute__((address_space(3)))
typedef unsigned short bf16_t;
typedef short bf16x8 __attribute__((ext_vector_type(8)));
typedef float f32x4 __attribute__((ext_vector_type(4)));
typedef unsigned u32x4 __attribute__((ext_vector_type(4)));
constexpr int BM = 256, BK = 64, HALF = 128, HTB = HALF * BK * 2  , STAGE_BYTES = 8 * HTB, NXCD = 8, WGM = 8;

__host__ __device__ __forceinline__ int lds_byte(int r, int c) { const int st = (r >> 4) * 2 + (c >> 5), rr = r & 15, cc = c & 31, ob = rr * 64 + cc * 2; return st * 1024 + (ob ^ (((ob >> 9) & 1) << 5)); }
__host__ __device__ __forceinline__ void stage_rc(int b, int& R, int& C) { const int st = b / 1024, sb = b % 1024, swz = sb ^ (((sb >> 9) & 1) << 5); R = (st >> 1) * 16 + swz / 64; C = (st & 1) * 32 + (swz % 64) / 2; }
__host__ __device__ __forceinline__ int perm32(int rho) { const int n = rho >> 4, i = rho & 15; return 8 * (i >> 2) + 4 * n + (i & 3); }

struct Unit { int pm, pn; };
struct Gemm { const bf16_t* A; const bf16_t* Bt; int M, N, K; };

struct StaticOrder {
    int nM, nN, nwg, G, c;
    __host__ __device__ void init(int M, int N, int G_, int c_) { nM = M / BM; nN = N / BM; nwg = nM * nN; G = G_; c = c_; }
    __host__ __device__ bool next(int i, Unit& u) const {
        const long L = (long)i * G + c; if (L >= nwg) return false;
        int wgid = (int)L; { const int q = nwg / NXCD, r = nwg % NXCD, xcd = wgid % NXCD, off = wgid / NXCD; wgid = (xcd < r ? xcd * (q + 1) : r * (q + 1) + (xcd - r) * q) + off; }
        const int nig = WGM * nN, gid = wgid / nig, fm = gid * WGM, gsz = (nM - fm) < WGM ? (nM - fm) : WGM;
        u.pm = fm + ((wgid % nig) % gsz); u.pn = (wgid % nig) / gsz; return true;
    }
    __device__ __forceinline__ void a_ready(const Unit&) const {}
    __device__ __forceinline__ void done(const Unit&) const {}
};

__device__ __forceinline__ unsigned cvt_pk_bf16(float lo, float hi) { unsigned r; asm volatile("v_cvt_pk_bf16_f32 %0, %1, %2" : "=v"(r) : "v"(lo), "v"(hi)); return r; }
typedef float f32x2 __attribute__((ext_vector_type(2)));
__device__ __forceinline__ f32x2 gelu_pk(f32x2 v) {
    const f32x2 av = __builtin_elementwise_abs(v), d = av * 0.2316418882f + 1.0f;
    f32x2 t; t.x = __builtin_amdgcn_rcpf(d.x); t.y = __builtin_amdgcn_rcpf(d.y);
    f32x2 q = t * 0.5307027145f + (-0.7265760135f); q = q * t + 0.7107068705f; q = q * t + (-0.142248368f); q = q * t + 0.127414796f; q = q * t;
    const f32x2 s = (v * v) * (-0.72134752044f);
    f32x2 e; e.x = __builtin_amdgcn_exp2f(s.x); e.y = __builtin_amdgcn_exp2f(s.y);
    const f32x2 m = v * (q * e), r = v - m;
    f32x2 o; o.x = v.x < 0.f ? m.x : r.x; o.y = v.y < 0.f ? m.y : r.y; return o;
}


__device__ __forceinline__ float rstd_of(const float* SSQP, int row) {
    const f32x4* p = (const f32x4*)(SSQP + (size_t)row * 16);
    const f32x4 a = p[0], b = p[1], c = p[2], d = p[3];
    const float s = ((a[0] + a[1]) + (a[2] + a[3])) + ((b[0] + b[1]) + (b[2] + b[3])) + ((c[0] + c[1]) + (c[2] + c[3])) + ((d[0] + d[1]) + (d[2] + d[3]));
    return __builtin_amdgcn_rsqf(s * (1.0f / 1024.0f) + 1e-6f);
}
__device__ __forceinline__ float silu_fast(float x) { return x * __builtin_amdgcn_rcpf(1.0f + __expf(-x)); }
struct EpiSwiglu {
    static constexpr bool PERM = true, AFTER_DRAIN = false;
    bf16_t* H; const float* SSQP;
    __device__ __forceinline__ void operator()(const f32x4 (&acc)[2][2][4][2], const Unit& u, int wr, int wc, int fr, int fq) const {
        const int row0 = u.pm * BM + wr * 64 + fr, col0 = u.pn * 128 + wc * 32 + 8 * fq;
#pragma unroll
        for (int ai = 0; ai < 2; ++ai)
#pragma unroll
            for (int m = 0; m < 4; ++m) { const int row = row0 + ai * HALF + m * 16; const float rs = rstd_of(SSQP, row);
                const f32x4 g0 = acc[ai][0][m][0], g1 = acc[ai][0][m][1], u0 = acc[ai][1][m][0], u1 = acc[ai][1][m][1]; const float rs2 = rs * rs;
#define SWG(g, u) (silu_fast((g) * rs) * (u) * rs)
                u32x4 w; w.x = cvt_pk_bf16(SWG(g0[0], u0[0]), SWG(g0[1], u0[1])); w.y = cvt_pk_bf16(SWG(g0[2], u0[2]), SWG(g0[3], u0[3]));
                w.z = cvt_pk_bf16(SWG(g1[0], u1[0]), SWG(g1[1], u1[1])); w.w = cvt_pk_bf16(SWG(g1[2], u1[2]), SWG(g1[3], u1[3])); (void)rs2;
#undef SWG
                *(u32x4*)(H + (size_t)row * 2816 + col0) = w; }
    }
};
struct EpiResid {
    static constexpr bool PERM = true, AFTER_DRAIN = false;
    const GAS float* Xin; float* X; bf16_t* XB; float* SSQP; float scale; float* out; int final_;
    __device__ __forceinline__ void operator()(const f32x4 (&acc)[2][2][4][2], const Unit& u, int wr, int wc, int fr, int fq) const {
        const int row0 = u.pm * BM + wr * 64 + fr;
#pragma unroll
        for (int ai = 0; ai < 2; ++ai)
#pragma unroll
            for (int m = 0; m < 4; ++m) { const int row = row0 + ai * HALF + m * 16; float ss = 0.f;
#pragma unroll
                for (int bj = 0; bj < 2; ++bj) { const int col = u.pn * BM + bj * HALF + wc * 32 + 8 * fq;
                    const f32x4 a0 = acc[ai][bj][m][0], a1 = acc[ai][bj][m][1]; f32x4 x0, x1;
                    if (Xin) { const GAS f32x4* xi = (const GAS f32x4*)(Xin + (size_t)row * 1024 + col); x0 = xi[0]; x1 = xi[1]; }
                    else { const u32x4 wb = *(const u32x4*)(XB + (size_t)row * 1024 + col);
                        x0[0] = __uint_as_float(wb.x << 16); x0[1] = __uint_as_float(wb.x & 0xffff0000u); x0[2] = __uint_as_float(wb.y << 16); x0[3] = __uint_as_float(wb.y & 0xffff0000u);
                        x1[0] = __uint_as_float(wb.z << 16); x1[1] = __uint_as_float(wb.z & 0xffff0000u); x1[2] = __uint_as_float(wb.w << 16); x1[3] = __uint_as_float(wb.w & 0xffff0000u); }
                    x0[0] += a0[0] * scale; x0[1] += a0[1] * scale; x0[2] += a0[2] * scale; x0[3] += a0[3] * scale; x1[0] += a1[0] * scale; x1[1] += a1[1] * scale; x1[2] += a1[2] * scale; x1[3] += a1[3] * scale;
                    if (!final_) {
                    u32x4 w; w.x = cvt_pk_bf16(x0[0], x0[1]); w.y = cvt_pk_bf16(x0[2], x0[3]); w.z = cvt_pk_bf16(x1[0], x1[1]); w.w = cvt_pk_bf16(x1[2], x1[3]);
                    *(u32x4*)(XB + (size_t)row * 1024 + col) = w;
                    ss += (x0[0] * x0[0] + x0[1] * x0[1]) + (x0[2] * x0[2] + x0[3] * x0[3]) + (x1[0] * x1[0] + x1[1] * x1[1]) + (x1[2] * x1[2] + x1[3] * x1[3]); }
                    if (final_) { float* o = nullptr; if (row < MP) o = out + O_YP + (size_t)row * 1024 + col; else if (row < R_META) o = out + O_YS + (size_t)(row - R_S) * 1024 + col;
                        if (o) { ((f32x4*)o)[0] = x0; ((f32x4*)o)[1] = x1; } } }
                ss += bperm(ss, (fq * 16 + fr) ^ 16); ss += bperm(ss, (fq * 16 + fr) ^ 32);
                if (fq == 0 && !final_) SSQP[(size_t)row * 16 + u.pn * 4 + wc] = ss; }
    }
};
struct EpiMix {
    static constexpr bool PERM = true, AFTER_DRAIN = false;
    float* MI; bf16_t* MIB; const float* SSQP; bf16_t* QF; bf16_t* KF; bf16_t* VT; const float* qg; const float* kg; const float* fbias; float* LF; float* out; int l;
    __device__ __forceinline__ void operator()(const f32x4 (&acc)[2][2][4][2], const Unit& u, int wr, int wc, int fr_, int fq_) const {
        int ln_; asm volatile("v_mbcnt_lo_u32_b32 %0, -1, 0\n\tv_mbcnt_hi_u32_b32 %0, -1, %0" : "=v"(ln_)); const int fr = ln_ & 15, fq = ln_ >> 4; (void)fr_; (void)fq_;
        const int row0 = u.pm * BM + wr * 64 + fr;
        if (u.pn < 3) {
            f32x4 gn[2][2];
            const float* gp = u.pn == 0 ? qg : kg;
#pragma unroll
            for (int bj = 0; bj < 2; ++bj)
#pragma unroll
                for (int n = 0; n < 2; ++n) gn[bj][n] = u.pn < 2 ? *(const f32x4*)(gp + 32 * bj + 8 * fq + 4 * n) : (f32x4){1.f, 1.f, 1.f, 1.f};
            const float qs = u.pn == 0 ? 0.18033688011112042f : 1.0f;
#pragma unroll
            for (int ai = 0; ai < 2; ++ai)
#pragma unroll
                for (int m = 0; m < 4; ++m) { const int row = row0 + ai * HALF + m * 16; const float rs = rstd_of(SSQP, row);
                    float v[2][8]; float ss = 0.f;
#pragma unroll
                    for (int bj = 0; bj < 2; ++bj) { const f32x4 a0 = acc[ai][bj][m][0], a1 = acc[ai][bj][m][1];
                        v[bj][0] = a0[0] * rs; v[bj][1] = a0[1] * rs; v[bj][2] = a0[2] * rs; v[bj][3] = a0[3] * rs; v[bj][4] = a1[0] * rs; v[bj][5] = a1[1] * rs; v[bj][6] = a1[2] * rs; v[bj][7] = a1[3] * rs;
                        if (row >= MP) { f32x4* o = (f32x4*)(MI + (size_t)row * LDMI + u.pn * 256 + wc * 64 + bj * 32 + 8 * fq);
                            o[0] = (f32x4){v[bj][0], v[bj][1], v[bj][2], v[bj][3]}; o[1] = (f32x4){v[bj][4], v[bj][5], v[bj][6], v[bj][7]}; }
#pragma unroll
                        for (int e = 0; e < 8; ++e) ss += v[bj][e] * v[bj][e]; }
                    if (u.pn < 2) { ss += bperm(ss, (fq * 16 + fr) ^ 16); ss += bperm(ss, (fq * 16 + fr) ^ 32); const float hn = __builtin_amdgcn_rsqf(ss * (1.0f / 64.0f) + 1e-6f) * qs;
#pragma unroll
                        for (int bj = 0; bj < 2; ++bj)
#pragma unroll
                            for (int e = 0; e < 8; ++e) v[bj][e] *= hn * gn[bj][e >> 2][e & 3]; }
                    const bool isP = row < MP, isM = row >= R_META && row < M_REAL;
                    if (u.pn > 0 && row < M_REAL) {
                        float* ob; int nc = 1; size_t cs_ = 0;
                        if (isP) ob = out + (u.pn == 1 ? O_KP : O_VP) + ((size_t)(l * BATCH + (row >> 11)) * TP + 16 + (row & 2047)) * 256;
                        else if (isM) { ob = out + (u.pn == 1 ? O_KP : O_VP) + ((size_t)(l * BATCH) * TP + (row - R_META)) * 256; nc = BATCH; cs_ = (size_t)TP * 256; }
                        else ob = out + (u.pn == 1 ? O_KS : O_VS) + ((size_t)l * MS + (row - R_S)) * 256;
                        for (int c = 0; c < nc; ++c)
#pragma unroll
                            for (int bj = 0; bj < 2; ++bj) { f32x4* o = (f32x4*)(ob + c * cs_ + wc * 64 + bj * 32 + 8 * fq);
                                o[0] = (f32x4){v[bj][0], v[bj][1], v[bj][2], v[bj][3]}; o[1] = (f32x4){v[bj][4], v[bj][5], v[bj][6], v[bj][7]}; }
                    }
                    if (isP || (isM && u.pn > 0)) {
                        const int b0 = isP ? (row >> 11) : 0, nb = isP ? 1 : 8, slot = isP ? 64 + (row & 2047) : row - R_META;
                        for (int bb = b0; bb < b0 + nb; ++bb) { const int bh = bb * 4 + wc;
                            if (u.pn < 2) {
                                bf16_t* dst = u.pn == 0 ? QF + ((size_t)bh * 2048 + (row & 2047)) * 64 : KF + ((size_t)bh * 2112 + slot) * 64;
#pragma unroll
                                for (int bj = 0; bj < 2; ++bj) { u32x4 w; w.x = cvt_pk_bf16(v[bj][0], v[bj][1]); w.y = cvt_pk_bf16(v[bj][2], v[bj][3]); w.z = cvt_pk_bf16(v[bj][4], v[bj][5]); w.w = cvt_pk_bf16(v[bj][6], v[bj][7]);
                                    *(u32x4*)(dst + 32 * bj + 8 * fq) = w; }
                            } else {
#pragma unroll
                                for (int bj = 0; bj < 2; ++bj)
#pragma unroll
                                    for (int e = 0; e < 8; e += 2) { const unsigned w = cvt_pk_bf16(v[bj][e], v[bj][e + 1]); const int d = 32 * bj + 8 * fq + e;
                                        VT[((size_t)bh * 64 + d) * 2112 + slot] = (bf16_t)(w & 0xffffu); VT[((size_t)bh * 64 + d + 1) * 2112 + slot] = (bf16_t)(w >> 16); }
                            } } } }
        } else {
#pragma unroll
            for (int ai = 0; ai < 2; ++ai)
#pragma unroll
                for (int m = 0; m < 4; ++m) { const int row = row0 + ai * HALF + m * 16; const float rs = rstd_of(SSQP, row);
#pragma unroll
                    for (int bj = 0; bj < 2; ++bj) { const int colm = u.pn * BM + bj * HALF + wc * 32 + 8 * fq, col = main2ref(colm);
                        const f32x4 a0 = acc[ai][bj][m][0], a1 = acc[ai][bj][m][1];
                        f32x4 r0v = (f32x4){a0[0] * rs, a0[1] * rs, a0[2] * rs, a0[3] * rs}, r1v = (f32x4){a1[0] * rs, a1[1] * rs, a1[2] * rs, a1[3] * rs};
                        if ((colm >= CM_SZ && colm < CM_SZ + 512) || colm >= CM_GG) {
#pragma unroll
                            for (int e = 0; e < 4; ++e) { r0v[e] = silu_fast(r0v[e]); r1v[e] = silu_fast(r1v[e]); } }
                        { u32x4 w; w.x = cvt_pk_bf16(r0v[0], r0v[1]); w.y = cvt_pk_bf16(r0v[2], r0v[3]); w.z = cvt_pk_bf16(r1v[0], r1v[1]); w.w = cvt_pk_bf16(r1v[2], r1v[3]); *(u32x4*)(MIB + (size_t)row * N_MAIN + colm) = w; }
                        if (row >= MP) { f32x4* o = (f32x4*)(MI + (size_t)row * LDMI + col); o[0] = r0v; o[1] = r1v; }
                        if (colm >= CM_XBC && colm < CM_XBC + 768) {
                            float* cvo = nullptr;
                            if (row < MP) { if ((row & 2047) >= 2045) cvo = out + O_CONVP + ((size_t)(l * BATCH + (row >> 11)) * 3 + ((row & 2047) - 2045)) * 768; }
                            else if (row < R_META) { if (((row - R_S) & 3) >= 1) cvo = out + O_CONVS + ((size_t)(l * DEC_BATCH + ((row - R_S) >> 2)) * 3 + (((row - R_S) & 3) - 1)) * 768; }
                            if (cvo) { *(f32x4*)(cvo + colm - CM_XBC) = r0v; *(f32x4*)(cvo + colm - CM_XBC + 4) = r1v; } }
                    } }
        }
    }
};

template <class Epi, class Sched, bool ALIGN_EPI = false, bool SP2 = false>
__device__ __forceinline__ void gemm_phase(PG8_LAS unsigned char* lds, const Gemm g, const Sched& S, const Epi& E, const int tid) {
    const int wid = __builtin_amdgcn_readfirstlane(tid >> 6), lane = tid & 63, wr = wid >> 2, wc = wid & 3, fr = lane & 15, fq = lane >> 4;
    const int K = g.K, nt = K / BK;
    unsigned voffA[2], voffB[2];
#pragma unroll
    for (int i = 0; i < 2; ++i) { int R, C; stage_rc(tid * 16 + i * 8192, R, C); const int Rb = Epi::PERM ? ((R & ~31) + perm32(R & 31)) : R;
        voffA[i] = (unsigned)(R * K + C) * 2u; voffB[i] = (unsigned)(Rb * K + C) * 2u; }
    const size_t kstep = (size_t)(BK * 2);
    const size_t hstep = (size_t)HALF * K * 2;
    const size_t tstep = 2 * hstep;
    const unsigned ldsw = (unsigned)wid * 1024u;
    const int aoff = lds_byte(wr * 64 + fr, fq * 8), boff = lds_byte(wc * 32 + fr, fq * 8);
#define PG8_SA(b, h) (((b) * 2 + (h)) * HTB)
#define PG8_SB(b, h) ((4 + (b) * 2 + (h)) * HTB)
#define PG8_STAGE(bufoff, gbase, voff) do { _Pragma("unroll") for (int _i = 0; _i < 2; ++_i) \
        __builtin_amdgcn_global_load_lds((const unsigned*)((const char*)(gbase) + (voff)[_i]), (PG8_LAS unsigned*)(lds + (bufoff) + ldsw + _i * 8192), 16, 0, 0); } while (0)
#define PG8_LDA(dst, b, h) do { _Pragma("unroll") for (int m = 0; m < 4; ++m) _Pragma("unroll") for (int k = 0; k < 2; ++k) dst[m][k] = *(const PG8_LAS bf16x8*)(lds + PG8_SA(b, h) + aoff + m * 2048 + k * 1024); } while (0)
#define PG8_LDB(dst, b, h) do { _Pragma("unroll") for (int n = 0; n < 2; ++n) _Pragma("unroll") for (int k = 0; k < 2; ++k) dst[n][k] = *(const PG8_LAS bf16x8*)(lds + PG8_SB(b, h) + boff + n * 2048 + k * 1024); } while (0)
#define PG8_MMA(ai, bj, At, Bt) do { __builtin_amdgcn_s_setprio(1); _Pragma("unroll") for (int m = 0; m < 4; ++m) _Pragma("unroll") for (int n = 0; n < 2; ++n) _Pragma("unroll") for (int k = 0; k < 2; ++k) \
        acc[ai][bj][m][n] = __builtin_amdgcn_mfma_f32_16x16x32_bf16(Bt[n][k], At[m][k], acc[ai][bj][m][n], 0, 0, 0); __builtin_amdgcn_s_setprio(0); } while (0)
#define PG8_WAIT_V(n) asm volatile("s_waitcnt vmcnt(" #n ")" ::: "memory")
#define PG8_WAIT_L(n) asm volatile("s_waitcnt lgkmcnt(" #n ")" ::: "memory")
#define PG8_BAR __builtin_amdgcn_s_barrier()
#define PG8_SCHED __builtin_amdgcn_sched_barrier(0)
    Unit cur, nxt; int ui = 0;
    if (!S.next(0, cur)) return;
    f32x4 acc[2][2][4][2];
#pragma unroll
    for (int a = 0; a < 2; ++a)
#pragma unroll
        for (int b = 0; b < 2; ++b)
#pragma unroll
            for (int m = 0; m < 4; ++m)
#pragma unroll
                for (int n = 0; n < 2; ++n) acc[a][b][m][n] = (f32x4){0.f, 0.f, 0.f, 0.f};
    bf16x8 At[4][2], B0[2][2], B1[2][2];
    const char* cA = (const char*)g.A + (size_t)cur.pm * tstep; const char* cB = (const char*)g.Bt + (size_t)cur.pn * tstep;
    S.a_ready(cur);
    if constexpr (SP2) {
        PG8_STAGE(PG8_SB(0, 0), cB, voffB); PG8_STAGE(PG8_SB(0, 1), cB + hstep, voffB); PG8_STAGE(PG8_SA(0, 0), cA, voffA); PG8_STAGE(PG8_SA(0, 1), cA + hstep, voffA);
        if (wr == 1) PG8_BAR;
        PG8_WAIT_V(2); PG8_BAR;
        PG8_STAGE(PG8_SB(1, 0), cB + kstep, voffB); PG8_STAGE(PG8_SA(1, 0), cA + kstep, voffA); PG8_STAGE(PG8_SB(1, 1), cB + hstep + kstep, voffB);
        PG8_WAIT_V(6); PG8_BAR;
    } else {
        PG8_STAGE(PG8_SB(0, 0), cB, voffB); PG8_STAGE(PG8_SA(0, 0), cA, voffA); PG8_STAGE(PG8_SB(0, 1), cB + hstep, voffB); PG8_STAGE(PG8_SA(0, 1), cA + hstep, voffA);
        if (wr == 1) PG8_BAR;
        PG8_WAIT_V(4); PG8_BAR;
        PG8_STAGE(PG8_SB(1, 0), cB + kstep, voffB); PG8_STAGE(PG8_SA(1, 0), cA + kstep, voffA); PG8_STAGE(PG8_SB(1, 1), cB + hstep + kstep, voffB);
        PG8_WAIT_V(6); PG8_BAR;
    }
    for (;;) {
        const bool has_next = S.next(ui + 1, nxt);
        const char* nA = has_next ? (const char*)g.A + (size_t)nxt.pm * tstep : cA; const char* nB = has_next ? (const char*)g.Bt + (size_t)nxt.pn * tstep : cB;
        for (int t = 0; t < nt; t += 2) {
            const bool last = (t == nt - 2);
            const char* a1 = cA + (size_t)(t + 1) * kstep;
            const char* a2 = last ? nA : cA + (size_t)(t + 2) * kstep; const char* b2 = last ? nB : cB + (size_t)(t + 2) * kstep;
            const char* a3 = a2 + kstep; const char* b3 = b2 + kstep;
            if (last && has_next) S.a_ready(nxt);
            if constexpr (SP2) {
            PG8_LDB(B0, 0, 0); PG8_LDB(B1, 0, 1); PG8_SCHED; PG8_LDA(At, 0, 0); PG8_STAGE(PG8_SA(1, 1), a1 + hstep, voffA);
            PG8_WAIT_V(8); PG8_WAIT_L(0); PG8_BAR; PG8_MMA(0, 0, At, B0); PG8_MMA(0, 1, At, B1); PG8_BAR; PG8_SCHED;
            PG8_LDA(At, 0, 1); PG8_STAGE(PG8_SB(0, 0), b2, voffB); PG8_STAGE(PG8_SB(0, 1), b2 + hstep, voffB); PG8_STAGE(PG8_SA(0, 0), a2, voffA);
            PG8_WAIT_V(8); PG8_WAIT_L(0); PG8_BAR; PG8_MMA(1, 0, At, B0); PG8_MMA(1, 1, At, B1); PG8_BAR; PG8_SCHED;
            PG8_LDB(B0, 1, 0); PG8_LDB(B1, 1, 1); PG8_SCHED; PG8_LDA(At, 1, 0); PG8_STAGE(PG8_SA(0, 1), a2 + hstep, voffA);
            PG8_WAIT_V(8); PG8_WAIT_L(0); PG8_BAR; PG8_MMA(0, 0, At, B0); PG8_MMA(0, 1, At, B1); PG8_BAR; PG8_SCHED;
            PG8_LDA(At, 1, 1); PG8_STAGE(PG8_SB(1, 0), b3, voffB); PG8_STAGE(PG8_SB(1, 1), b3 + hstep, voffB); PG8_STAGE(PG8_SA(1, 0), a3, voffA);
            PG8_WAIT_V(8); PG8_WAIT_L(0); PG8_BAR; PG8_MMA(1, 0, At, B0); PG8_MMA(1, 1, At, B1); PG8_BAR; PG8_SCHED;
            } else {
            PG8_LDB(B0, 0, 0); PG8_SCHED; PG8_LDA(At, 0, 0); PG8_STAGE(PG8_SA(1, 1), a1 + hstep, voffA);
            PG8_WAIT_L(8); PG8_BAR; PG8_WAIT_L(0); PG8_MMA(0, 0, At, B0); PG8_BAR; PG8_SCHED;
            PG8_LDB(B1, 0, 1); PG8_STAGE(PG8_SB(0, 0), b2, voffB);
            PG8_BAR; PG8_WAIT_L(0); PG8_MMA(0, 1, At, B1); PG8_BAR;
            PG8_LDA(At, 0, 1); PG8_STAGE(PG8_SA(0, 0), a2, voffA);
            PG8_BAR; PG8_WAIT_L(0); PG8_MMA(1, 0, At, B0); PG8_BAR; PG8_SCHED;
            PG8_STAGE(PG8_SB(0, 1), b2 + hstep, voffB);
            PG8_WAIT_V(6); PG8_BAR; PG8_MMA(1, 1, At, B1); PG8_BAR;
            PG8_LDB(B0, 1, 0); PG8_SCHED; PG8_LDA(At, 1, 0); PG8_STAGE(PG8_SA(0, 1), a2 + hstep, voffA);
            PG8_WAIT_L(8); PG8_BAR; PG8_WAIT_L(0); PG8_MMA(0, 0, At, B0); PG8_BAR; PG8_SCHED;
            PG8_LDB(B1, 1, 1); PG8_STAGE(PG8_SB(1, 0), b3, voffB);
            PG8_BAR; PG8_WAIT_L(0); PG8_MMA(0, 1, At, B1); PG8_BAR;
            PG8_LDA(At, 1, 1); PG8_STAGE(PG8_SA(1, 0), a3, voffA);
            PG8_BAR; PG8_WAIT_L(0); PG8_MMA(1, 0, At, B0); PG8_BAR; PG8_SCHED;
            PG8_STAGE(PG8_SB(1, 1), b3 + hstep, voffB);
            PG8_WAIT_V(6); PG8_BAR; PG8_MMA(1, 1, At, B1); PG8_BAR;
            }
        }
        if constexpr (ALIGN_EPI) { if (wr == 0) PG8_BAR; }
        if constexpr (!Epi::AFTER_DRAIN) { E(acc, cur, wr, wc, fr, fq); S.done(cur); }
        if (!has_next) break;
#pragma unroll
        for (int a = 0; a < 2; ++a)
#pragma unroll
            for (int b = 0; b < 2; ++b)
#pragma unroll
                for (int m = 0; m < 4; ++m)
#pragma unroll
                    for (int n = 0; n < 2; ++n) acc[a][b][m][n] = (f32x4){0.f, 0.f, 0.f, 0.f};
        cur = nxt; cA = nA; cB = nB; ++ui;
        if constexpr (ALIGN_EPI) { if (wr == 1) PG8_BAR; }
    }
    PG8_WAIT_V(0);
    if constexpr (!ALIGN_EPI) { if (wr == 0) PG8_BAR; }
    PG8_BAR;
    if constexpr (Epi::AFTER_DRAIN) { E.fused(acc, cur, wr, wc, fr, fq, lds, wid, lane); S.done(cur); }
#undef PG8_SA
#undef PG8_SB
#undef PG8_STAGE
#undef PG8_LDA
#undef PG8_LDB
#undef PG8_MMA
#undef PG8_WAIT_V
#undef PG8_WAIT_L
#undef PG8_BAR
#undef PG8_SCHED
}
}

#define XB_TMO      128
#define XB_XCNT(j)  (256  + 64 * (j))
#define XB_XSUB(j)  (1280 + 64 * (j))
#define XB_XGEN(j)  (2304 + 64 * (j))
#define XB_TOP      3328
#define XB_TOPGEN   3392
#define XCD_BAR_WORDS 3456
#define XB_SPIN_CAP (1u << 23)
__device__ __forceinline__ unsigned xb_ld(unsigned* p)              { return __hip_atomic_load(p, __ATOMIC_RELAXED, __HIP_MEMORY_SCOPE_AGENT); }
__device__ __forceinline__ unsigned xb_add(unsigned* p, unsigned v) { return __hip_atomic_fetch_add(p, v, __ATOMIC_RELAXED, __HIP_MEMORY_SCOPE_AGENT); }
__device__ __forceinline__ unsigned xb_xcc_id() { return (unsigned)__builtin_amdgcn_s_getreg((3 << 11) | 20) & 0xFu; }
#define XB_SPIN(cond, bar) do { unsigned _sp = 0; while (cond) { __builtin_amdgcn_s_sleep(1); \
    if ((++_sp & 255u) == 0u) { if (xb_ld(&(bar)[XB_TMO])) break; if (_sp > XB_SPIN_CAP) { atomicAdd(&(bar)[XB_TMO], 1u); break; } } } } while (0)
struct XcdBarrier { unsigned* bar; unsigned x; volatile LAS unsigned* st; };
__device__ __forceinline__ XcdBarrier xcd_barrier_post(unsigned* bar, volatile LAS unsigned* st) {
    XcdBarrier b; b.bar = bar; b.x = xb_xcc_id(); b.st = st;
    if (threadIdx.x == 0) (void)xb_add(&bar[XB_XCNT(b.x)], 1u);
    return b;
}
__device__ __forceinline__ void xcd_barrier_complete(unsigned* bar, unsigned x, unsigned& nloc, unsigned& nx) {
    const unsigned G = gridDim.x * gridDim.y * gridDim.z;
    unsigned sum, cnt, mine, sp = 0u;
    for (;;) {
        sum = 0u; cnt = 0u; mine = 0u;
#pragma unroll
        for (unsigned j = 0; j < 16; ++j) { const unsigned c = xb_ld(&bar[XB_XCNT(j)]); sum += c; cnt += (c > 0u) ? 1u : 0u; mine = (j == x) ? c : mine; }
        if (sum == G) break;
        __builtin_amdgcn_s_sleep(1);
        if ((++sp & 255u) == 0u) { if (xb_ld(&bar[XB_TMO])) break; if (sp > XB_SPIN_CAP) { atomicAdd(&bar[XB_TMO], 1u); break; } }
    }
    nloc = mine > 0u ? mine : 1u; nx = cnt > 0u ? cnt : 1u;
}
__device__ __forceinline__ void xcd_barrier(const XcdBarrier& b, const int tid_) {
    asm volatile("s_waitcnt vmcnt(0)" ::: "memory");
    __syncthreads();
    if (tid_ == 0) {
        unsigned* bar = b.bar; asm volatile("" : "+s"(bar));
        __builtin_amdgcn_s_waitcnt(0);
        unsigned nloc = b.st[0], nx = b.st[1];
        if (nloc == 0u) { xcd_barrier_complete(bar, b.x, nloc, nx); b.st[0] = nloc; b.st[1] = nx; }
        const unsigned old = xb_add(&bar[XB_XSUB(b.x)], 1u);
        const unsigned gen = old / nloc;
        if (old + 1u == (gen + 1u) * nloc) {
            __builtin_amdgcn_fence(__ATOMIC_RELEASE, "agent");
            asm volatile("s_waitcnt vmcnt(0)" ::: "memory");
            const unsigned og = xb_add(&bar[XB_TOP], 1u);
            const unsigned tg = og / nx;
            if (og + 1u == (tg + 1u) * nx) xb_add(&bar[XB_TOPGEN], 1u);
            else XB_SPIN(xb_ld(&bar[XB_TOPGEN]) == tg, bar);
            __builtin_amdgcn_fence(__ATOMIC_ACQUIRE, "agent");
            xb_add(&bar[XB_XGEN(b.x)], 1u);
            asm volatile("s_waitcnt vmcnt(0)" ::: "memory");
        } else {
            XB_SPIN(xb_ld(&bar[XB_XGEN(b.x)]) == gen, bar);
            __builtin_amdgcn_fence(__ATOMIC_ACQUIRE, "agent");
            asm volatile("s_waitcnt vmcnt(0)" ::: "memory");
        }
    }
    __syncthreads();
}

__device__ __forceinline__ float wave_sum(float v) {
#pragma unroll
    for (int o = 1; o < 64; o <<= 1) v += __shfl_xor(v, o);
    return v;
}
__device__ __forceinline__ float wave_max(float v) {
#pragma unroll
    for (int o = 1; o < 64; o <<= 1) v = fmaxf(v, __shfl_xor(v, o));
    return v;
}
__device__ __forceinline__ float bperm(float x, int srclane) { return __builtin_bit_cast(float, __builtin_amdgcn_ds_bpermute(srclane << 2, __builtin_bit_cast(int, x))); }
__device__ __forceinline__ float wave_sum_l(float v, int lane) {
#pragma unroll
    for (int o = 1; o < 64; o <<= 1) v += bperm(v, lane ^ o);
    return v;
}
__device__ __forceinline__ float wave_max_l(float v, int lane) {
#pragma unroll
    for (int o = 1; o < 64; o <<= 1) v = fmaxf(v, bperm(v, lane ^ o));
    return v;
}
__device__ __forceinline__ float siluf(float x) { return x / (1.f + expf(-x)); }
__device__ __forceinline__ float log_sigmoidf(float x) { return fminf(x, 0.f) - log1pf(expf(-fabsf(x))); }
__device__ __forceinline__ float softplusf(float x) { return fmaxf(x, 0.f) + log1pf(expf(-fabsf(x))); }

__device__ __forceinline__ const float* conv_prev(const float* MI, const float* state_conv_l, int r, int j) {
    if (r < MP) { const int b = r >> 11, i = r & 2047; const int p = i - j; if (p >= 0) return MI + (size_t)(b * 2048 + p) * LDMI + C_XBC; return MI + (size_t)(R_META + 16 + p) * LDMI + C_XBC; }
    if (r < R_META) { const int s = r - R_S, b = s >> 2, i = s & 3; const int p = i - j; if (p >= 0) return MI + (size_t)(R_S + b * 4 + p) * LDMI + C_XBC; return state_conv_l + (size_t)(b * 3 + 3 + p) * 768; }
    const int i = r - R_META, p = i - j; if (p >= 0) return MI + (size_t)(R_META + p) * LDMI + C_XBC; return nullptr;
}

struct PromptKeys { const float* KN; const float* MI; const float* FC; int b, h;
    __device__ __forceinline__ void get(int j, const float*& kp, const float*& vp, float& Fk) const { const int row = j < 16 ? R_META + j : b * 2048 + (j - 16);
        kp = KN + (size_t)row * 256 + h * 64; vp = MI + (size_t)row * LDMI + C_FV + h * 64; Fk = FC[row * 4 + h]; } };
struct SampleKeys { const float* KN; const float* MI; const float* FCS; const float* ck; const float* cv; const int* pt; int b, h, l;
    __device__ __forceinline__ void get(int j, const float*& kp, const float*& vp, float& Fk) const {
        Fk = FCS[(size_t)(b * 4 + h) * 2052 + j];
        if (j < 2048) { const int page = pt[b * 16 + (j >> 7)]; const size_t off = (((size_t)l * NPOOL + page) * 128 + (j & 127)) * 256 + h * 64; kp = ck + off; vp = cv + off; }
        else { const int row = R_S + b * 4 + (j - 2048); kp = KN + (size_t)row * 256 + h * 64; vp = MI + (size_t)row * LDMI + C_FV + h * 64; } } };

template <class Keys>
__device__ __forceinline__ void attn_row(const float* qg, float Fq, int nk, const Keys& K, bf16* outp, float* sq, float* sc, int lane) {
    sq[lane] = qg[lane];
    LDS_WAIT();
    float mx = -INFINITY;
    for (int j = lane; j < nk; j += 64) {
        const float* kp; const float* vp; float Fk; K.get(j, kp, vp, Fk);
        float s = 0.f;
#pragma unroll
        for (int d4 = 0; d4 < 16; ++d4) { const float4 a = ((const float4*)sq)[d4]; const float4 b = ((const float4*)kp)[d4]; s += a.x * b.x + a.y * b.y + a.z * b.z + a.w * b.w; }
        s = s * 0.125f + (Fq - Fk);
        sc[j] = s; mx = fmaxf(mx, s);
    }
    mx = wave_max_l(mx, lane);
    float sum = 0.f;
    for (int j = lane; j < nk; j += 64) { const float p = expf(sc[j] - mx); sc[j] = p; sum += p; }
    sum = wave_sum_l(sum, lane);
    LDS_WAIT();
    float o = 0.f;
    for (int j = 0; j < nk; ++j) { const float* kp; const float* vp; float Fk; K.get(j, kp, vp, Fk); o += sc[j] * vp[lane]; }
    outp[lane] = (bf16)f2bf(o / sum);
    LDS_WAIT();
}

namespace fa {
typedef short bf16x8 __attribute__((ext_vector_type(8)));
typedef short s16x4 __attribute__((ext_vector_type(4)));
typedef float f4 __attribute__((ext_vector_type(4)));
typedef float f32x16 __attribute__((ext_vector_type(16)));
typedef float f32x2_t __attribute__((ext_vector_type(2)));
typedef __bf16 bf16x2_t __attribute__((ext_vector_type(2)));
__device__ __forceinline__ unsigned cvtpk(float lo, float hi) { f32x2_t v = {lo, hi}; bf16x2_t b = __builtin_convertvector(v, bf16x2_t); return __builtin_bit_cast(unsigned, b); }
__device__ __forceinline__ int crow(int r, int hi) { return (r & 3) + 8 * (r >> 2) + 4 * hi; }
template <int CTRL> __device__ __forceinline__ float dpp(float x) { return __builtin_bit_cast(float, __builtin_amdgcn_mov_dpp(__builtin_bit_cast(int, x), CTRL, 0xf, 0xf, true)); }
constexpr int XOR1 = 0xB1, XOR2 = 0x4E, XOR7 = 0x141, XOR8 = 0x128;
__device__ __forceinline__ float row16_sum(float s) { s += dpp<XOR1>(s); s += dpp<XOR2>(s); s += dpp<XOR7>(s); s += dpp<XOR8>(s); return s; }
#define MFMA32(a, b, c) __builtin_amdgcn_mfma_f32_32x32x16_bf16((a), (b), (c), 0, 0, 0)

constexpr int KSTR = 144;
constexpr int L_K0 = 0, L_V0 = 2 * 64 * KSTR, L_KB = 4 * 64 * KSTR, L_WS = L_KB + 2112 * 4, L_END = L_WS + 64;
constexpr float LOG2E = 1.4426950408889634f;

__device__ __forceinline__ void fox_prompt_unit(int b, int h, int qb, const bf16* QF, const bf16* KF, const bf16* VT, const float* LF, bf16* MIXB, LAS unsigned char* lds, int tid) {
    const int lane = tid & 63, wave = __builtin_amdgcn_readfirstlane(tid >> 6), r32 = lane & 31, hi = lane >> 5;
    const int ntile = 5 + 4 * qb, nslots = 64 * ntile;
    LAS float* kb = (LAS float*)(lds + L_KB); LAS float* wsum = (LAS float*)(lds + L_WS);
    {
        float v[5]; float run = 0.f;
#pragma unroll
        for (int e = 0; e < 5; ++e) { const int slot = 5 * tid + e; float lf = 0.f;
            if (slot < 16) lf = LF[(R_META + slot) * 4 + h]; else if (slot >= 64 && slot < nslots) lf = LF[(b * 2048 + slot - 64) * 4 + h];
            run += lf; v[e] = run; }
        float x = run;
#pragma unroll
        for (int o = 1; o < 64; o <<= 1) { const float y = bperm(x, lane - o); if (lane >= o) x += y; }
        if (lane == 63) wsum[wave] = x;
        __syncthreads();
        float off = x - run;
        for (int w = 0; w < wave; ++w) off += wsum[w];
#pragma unroll
        for (int e = 0; e < 5; ++e) { const int slot = 5 * tid + e; if (slot < 2112) kb[slot] = (slot >= 16 && slot < 64) ? -INFINITY : -(off + v[e]) * LOG2E; }
    }
    const bf16* Qw = QF + ((size_t)(b * 4 + h) * 2048 + 256 * qb + 32 * wave) * 64;
    bf16x8 qr[4];
#pragma unroll
    for (int d0 = 0; d0 < 4; ++d0) qr[d0] = *(const bf16x8*)(Qw + r32 * 64 + d0 * 16 + hi * 8);
    const bf16* Kg = KF + (size_t)(b * 4 + h) * 2112 * 64 + (size_t)(tid >> 3) * 64 + (tid & 7) * 8;
    const bf16* Vg = VT + (size_t)(b * 4 + h) * 64 * 2112 + (size_t)(tid >> 3) * 2112 + (tid & 7) * 8;
    const int soff = (tid >> 3) * KSTR + (tid & 7) * 16;
    v4u kreg = *(const v4u*)Kg, vreg = *(const v4u*)Vg;
    *(LAS v4u*)(lds + L_K0 + soff) = kreg; *(LAS v4u*)(lds + L_V0 + soff) = vreg;
    __syncthreads();
    asm volatile("" : "+v"(qr[0]), "+v"(qr[1]), "+v"(qr[2]), "+v"(qr[3]));
    float m = -INFINITY, l = 0.f; f32x16 o0, o1;
#pragma unroll
    for (int i = 0; i < 16; ++i) { o0[i] = 0.f; o1[i] = 0.f; }
    const int qrow = 256 * qb + 32 * wave + r32;
    const int wave_last = 1 + (256 * qb + 32 * wave + 31) / 64;
    for (int t = 0; t < ntile; ++t) {
        const int cur = t & 1;
        if (t + 1 < ntile) { kreg = *(const v4u*)(Kg + (size_t)(t + 1) * 64 * 64); vreg = *(const v4u*)(Vg + (t + 1) * 64); }
        if (t <= wave_last) {
            LAS unsigned char* Kc = lds + L_K0 + cur * 64 * KSTR; LAS unsigned char* Vc = lds + L_V0 + cur * 64 * KSTR;
            f32x16 p0, p1;
#pragma unroll
            for (int i = 0; i < 16; ++i) { p0[i] = 0.f; p1[i] = 0.f; }
#pragma unroll
            for (int d0 = 0; d0 < 4; ++d0) {
                const bf16x8 a0 = *(const LAS bf16x8*)(Kc + r32 * KSTR + (d0 * 16 + hi * 8) * 2);
                const bf16x8 a1 = *(const LAS bf16x8*)(Kc + (32 + r32) * KSTR + (d0 * 16 + hi * 8) * 2);
                p0 = MFMA32(a0, qr[d0], p0); p1 = MFMA32(a1, qr[d0], p1);
            }
#pragma unroll
            for (int g = 0; g < 4; ++g) { const f4 b0 = *(const LAS f4*)(kb + 64 * t + 8 * g + 4 * hi); const f4 b1 = *(const LAS f4*)(kb + 64 * t + 32 + 8 * g + 4 * hi);
                p0[4 * g + 0] += b0[0]; p0[4 * g + 1] += b0[1]; p0[4 * g + 2] += b0[2]; p0[4 * g + 3] += b0[3]; p1[4 * g + 0] += b1[0]; p1[4 * g + 1] += b1[1]; p1[4 * g + 2] += b1[2]; p1[4 * g + 3] += b1[3]; }
            if (t >= 4 * qb + 1) {
                const int kbase = 64 * (t - 1);
#pragma unroll
                for (int i = 0; i < 16; ++i) { const int pk = kbase + crow(i, hi); if (pk > qrow) p0[i] = -INFINITY; if (pk + 32 > qrow) p1[i] = -INFINITY; }
            }
            float rm = fmaxf(p0[0], p1[0]);
#pragma unroll
            for (int i = 1; i < 16; ++i) rm = fmaxf(rm, fmaxf(p0[i], p1[i]));
            rm = fmaxf(rm, bperm(rm, lane ^ 32));
            const float mn = fmaxf(m, rm); const float sc = __builtin_amdgcn_exp2f(m - mn); m = mn;
            float rsum = 0.f;
#pragma unroll
            for (int i = 0; i < 16; ++i) { p0[i] = __builtin_amdgcn_exp2f(p0[i] - mn); p1[i] = __builtin_amdgcn_exp2f(p1[i] - mn); rsum += p0[i] + p1[i]; }
            l = l * sc + rsum;
#pragma unroll
            for (int i = 0; i < 16; ++i) { o0[i] *= sc; o1[i] *= sc; }
#pragma unroll
            for (int blk = 0; blk < 2; ++blk)
#pragma unroll
                for (int s2 = 0; s2 < 2; ++s2) {
                    v4u pw;
                    if (blk == 0) { pw.x = cvtpk(p0[8 * s2 + 0], p0[8 * s2 + 1]); pw.y = cvtpk(p0[8 * s2 + 2], p0[8 * s2 + 3]); pw.z = cvtpk(p0[8 * s2 + 4], p0[8 * s2 + 5]); pw.w = cvtpk(p0[8 * s2 + 6], p0[8 * s2 + 7]); }
                    else          { pw.x = cvtpk(p1[8 * s2 + 0], p1[8 * s2 + 1]); pw.y = cvtpk(p1[8 * s2 + 2], p1[8 * s2 + 3]); pw.z = cvtpk(p1[8 * s2 + 4], p1[8 * s2 + 5]); pw.w = cvtpk(p1[8 * s2 + 6], p1[8 * s2 + 7]); }
                    const bf16x8 pb = __builtin_bit_cast(bf16x8, pw);
                    const int koff = (32 * blk + 16 * s2 + 4 * hi) * 2;
                    { const s16x4 lo = *(const LAS s16x4*)(Vc + r32 * KSTR + koff), hh = *(const LAS s16x4*)(Vc + r32 * KSTR + koff + 16);
                      const bf16x8 va = {lo[0], lo[1], lo[2], lo[3], hh[0], hh[1], hh[2], hh[3]}; o0 = MFMA32(va, pb, o0); }
                    { const s16x4 lo = *(const LAS s16x4*)(Vc + (32 + r32) * KSTR + koff), hh = *(const LAS s16x4*)(Vc + (32 + r32) * KSTR + koff + 16);
                      const bf16x8 va = {lo[0], lo[1], lo[2], lo[3], hh[0], hh[1], hh[2], hh[3]}; o1 = MFMA32(va, pb, o1); }
                }
        }
        if (t + 1 < ntile) { *(LAS v4u*)(lds + L_K0 + (cur ^ 1) * 64 * KSTR + soff) = kreg; *(LAS v4u*)(lds + L_V0 + (cur ^ 1) * 64 * KSTR + soff) = vreg; }
        __syncthreads();
    }
    l += bperm(l, lane ^ 32);
    const float inv = 1.0f / l;
    bf16* orow = MIXB + (size_t)(b * 2048 + qrow) * 1024 + h * 64;
#pragma unroll
    for (int g = 0; g < 4; ++g) {
        *(uint2*)(orow + 8 * g + 4 * hi) = make_uint2(cvtpk(o0[4 * g] * inv, o0[4 * g + 1] * inv), cvtpk(o0[4 * g + 2] * inv, o0[4 * g + 3] * inv));
        *(uint2*)(orow + 32 + 8 * g + 4 * hi) = make_uint2(cvtpk(o1[4 * g] * inv, o1[4 * g + 1] * inv), cvtpk(o1[4 * g + 2] * inv, o1[4 * g + 3] * inv));
    }
}

constexpr int S_D = 0, S_WS = 32768, S_PART = 33024, S_PSTR = 68;
__device__ __forceinline__ void fox_sample_unit(int b, int l, const float* QN, const float* KN, const float* MI, const float* LF, const float* ck, const float* cv, const float* clf, const int* pt,
                                                bf16* MIXB, LAS unsigned char* lds, int tid) {
    const int lane = tid & 63, wave = __builtin_amdgcn_readfirstlane(tid >> 6), h = lane >> 4, d4 = lane & 15;
    LAS f4* Dl = (LAS f4*)(lds + S_D); LAS f4* wsum = (LAS f4*)(lds + S_WS);
    {
        const int page = pt[b * 16 + (tid >> 5)];
        const f4* src = (const f4*)(clf + (((size_t)l * NPOOL + page) * 128 + 4 * (tid & 31)) * 4);
        const f4 v0 = src[0], v1 = src[1], v2 = src[2], v3 = src[3];
        const f4 s2 = v3, s1 = v3 + v2, s0 = s1 + v1, tot = s0 + v0;
        f4 x = tot;
#pragma unroll
        for (int o = 1; o < 64; o <<= 1) { f4 y; y[0] = bperm(x[0], lane + o); y[1] = bperm(x[1], lane + o); y[2] = bperm(x[2], lane + o); y[3] = bperm(x[3], lane + o); if (lane + o < 64) x += y; }
        if (lane == 0) wsum[wave] = x;
        __syncthreads();
        f4 off = x - tot;
        for (int w = wave + 1; w < 8; ++w) off += wsum[w];
        Dl[4 * tid + 0] = s0 + off; Dl[4 * tid + 1] = s1 + off; Dl[4 * tid + 2] = s2 + off; Dl[4 * tid + 3] = off;
        __syncthreads();
    }
    float4 q[4];
#pragma unroll
    for (int i = 0; i < 4; ++i) { const float4 t = *(const float4*)(QN + (size_t)(R_S + b * 4 + i) * 256 + h * 64 + 4 * d4); q[i] = make_float4(t.x * 0.125f, t.y * 0.125f, t.z * 0.125f, t.w * 0.125f); }
    float m[4], ls[4]; float4 o[4];
#pragma unroll
    for (int i = 0; i < 4; ++i) { m[i] = -INFINITY; ls[i] = 0.f; o[i] = make_float4(0.f, 0.f, 0.f, 0.f); }
    const LAS float* Df = (const LAS float*)Dl;
    for (int p = 0; p < 16; ++p) {
        const int page = pt[b * 16 + p];
        const size_t base = (((size_t)l * NPOOL + page) * 128 + 16 * wave) * 256 + lane * 4;
#pragma unroll
        for (int hf = 0; hf < 2; ++hf) {
            pg8::f32x4 kk[8], vv[8];
#pragma unroll
            for (int j = 0; j < 8; ++j) { kk[j] = __builtin_nontemporal_load((const pg8::f32x4*)(ck + base + (size_t)(hf * 8 + j) * 256)); vv[j] = __builtin_nontemporal_load((const pg8::f32x4*)(cv + base + (size_t)(hf * 8 + j) * 256)); }
            float s[4][8];
#pragma unroll
            for (int j = 0; j < 8; ++j) { const float dk = Df[(p * 128 + 16 * wave + hf * 8 + j) * 4 + h];
#pragma unroll
                for (int i = 0; i < 4; ++i) s[i][j] = row16_sum(q[i].x * kk[j][0] + q[i].y * kk[j][1] + q[i].z * kk[j][2] + q[i].w * kk[j][3]) + dk; }
#pragma unroll
            for (int i = 0; i < 4; ++i) {
                float mx = s[i][0];
#pragma unroll
                for (int j = 1; j < 8; ++j) mx = fmaxf(mx, s[i][j]);
                const float mn = fmaxf(m[i], mx); const float sc = __expf(m[i] - mn); m[i] = mn;
                ls[i] *= sc; o[i].x *= sc; o[i].y *= sc; o[i].z *= sc; o[i].w *= sc;
#pragma unroll
                for (int j = 0; j < 8; ++j) { const float pj = __expf(s[i][j] - mn); ls[i] += pj; o[i].x += pj * vv[j][0]; o[i].y += pj * vv[j][1]; o[i].z += pj * vv[j][2]; o[i].w += pj * vv[j][3]; }
            }
        }
    }
    LAS float* part = (LAS float*)(lds + S_PART);
#pragma unroll
    for (int i = 0; i < 4; ++i) { LAS float* pp = part + ((wave * 16) + h * 4 + i) * S_PSTR; *(LAS f4*)(pp + 4 + 4 * d4) = (f4){o[i].x, o[i].y, o[i].z, o[i].w}; if (d4 == 0) { pp[0] = m[i]; pp[1] = ls[i]; } }
    __syncthreads();
    for (int u = tid; u < 1024; u += 512) {
        const int hh = u >> 8, i = (u >> 6) & 3, d = u & 63;
        const int rowq = R_S + b * 4 + i;
        float sn[4]; float G = 0.f;
#pragma unroll
        for (int j = 0; j < 4; ++j) { const int rowk = R_S + b * 4 + j; G -= LF[rowk * 4 + hh]; float dot = 0.f;
            const float* qp = QN + (size_t)rowq * 256 + hh * 64; const float* kp = KN + (size_t)rowk * 256 + hh * 64;
            for (int c = 0; c < 64; ++c) dot += qp[c] * kp[c];
            sn[j] = j <= i ? dot * 0.125f + G : -INFINITY; }
        float mt = fmaxf(fmaxf(sn[0], sn[1]), fmaxf(sn[2], sn[3]));
        for (int w = 0; w < 8; ++w) mt = fmaxf(mt, part[(w * 16 + hh * 4 + i) * S_PSTR]);
        float lt = 0.f, ot = 0.f;
        for (int w = 0; w < 8; ++w) { const LAS float* pp = part + (w * 16 + hh * 4 + i) * S_PSTR; const float e = __expf(pp[0] - mt); lt += e * pp[1]; ot += e * pp[4 + d]; }
#pragma unroll
        for (int j = 0; j < 4; ++j) { const float e = __expf(sn[j] - mt); lt += e; ot += e * MI[(size_t)(R_S + b * 4 + j) * LDMI + C_FV + hh * 64 + d]; }
        MIXB[(size_t)rowq * 1024 + hh * 64 + d] = (bf16)f2bf(ot / lt);
    }
    __syncthreads();
}
#undef MFMA32
}

namespace la {
using fa::bf16x8; using fa::s16x4; using fa::f32x16; using fa::f4; using fa::cvtpk; using fa::crow;
#define MFMA32(a, b, c) __builtin_amdgcn_mfma_f32_32x32x16_bf16((a), (b), (c), 0, 0, 0)
#define LDS_BARRIER() asm volatile("s_waitcnt lgkmcnt(0)\n\ts_barrier" ::: "memory")
__device__ __forceinline__ int seq_row(int b, int c, int t) { const int sg = 128 * c - 112 + t; return sg < 0 ? -1 : (sg < 16 ? R_META + sg : b * 2048 + sg - 16); }
__device__ __forceinline__ bf16x8 pack8(const f32x16& x, int s) { v4u p; p.x = cvtpk(x[8 * s], x[8 * s + 1]); p.y = cvtpk(x[8 * s + 2], x[8 * s + 3]); p.z = cvtpk(x[8 * s + 4], x[8 * s + 5]); p.w = cvtpk(x[8 * s + 6], x[8 * s + 7]); return __builtin_bit_cast(bf16x8, p); }
__device__ __forceinline__ bf16x8 ld16(const LAS unsigned char* p) { return *(const LAS bf16x8*)p; }
__device__ __forceinline__ bf16x8 ld8x2(const LAS unsigned char* p) { const s16x4 lo = *(const LAS s16x4*)p, hh = *(const LAS s16x4*)(p + 16); return (bf16x8){lo[0], lo[1], lo[2], lo[3], hh[0], hh[1], hh[2], hh[3]}; }
__device__ __forceinline__ float silu_f(float x) { return x * __builtin_amdgcn_rcpf(1.0f + __expf(-x)); }
__device__ __forceinline__ float bf2f(unsigned short v) { return __uint_as_float((unsigned)v << 16); }
typedef unsigned u2v __attribute__((ext_vector_type(2)));
constexpr int TPITCH = 272;
constexpr int OPITCH = 68;

constexpr int G_QL = 0, G_KL = 10240, G_KT = 20480, G_VT = 29184, G_OUT = 46592, G_BC = 81408, G_SEG = 98304, G_BL = 100352, G_BLR = 100480;
__device__ __forceinline__ void gla_prompt_unit(int b, int h, const GAS bf16* MIB, const GAS float* GLOG, const GAS float* gnorm, GAS bf16* MIXB, GAS float* state_out, LAS unsigned char* lds, int tid0) {
    int tid = tid0;
    int lane = tid & 63, wave = __builtin_amdgcn_readfirstlane(tid >> 6), r32 = lane & 31, hi = lane >> 5, vt = wave & 1, tt = wave < 4 ? (wave >> 1) : 3 - ((wave - 4) >> 1);
    LAS unsigned char* QL = lds + G_QL; LAS unsigned char* KL = lds + G_KL; LAS unsigned char* KT = lds + G_KT; LAS unsigned char* VT = lds + G_VT;
    LAS float* OUT = (LAS float*)(lds + G_OUT); LAS float* BC = (LAS float*)(lds + G_BC); LAS float* SEG = (LAS float*)(lds + G_SEG); LAS float* BL = (LAS float*)(lds + G_BL); LAS float* BLR = (LAS float*)(lds + G_BLR);
    f32x16 SK;
#pragma unroll
    for (int i = 0; i < 16; ++i) SK[i] = 0.f;
    int kk = tid & 31, seg = tid >> 5;
    f4 q0, q1, k0, k1, v4[4]; float gl[8];
#define BF4(w_) ((f4){__uint_as_float((w_)[0] << 16), __uint_as_float((w_)[0] & 0xffff0000u), __uint_as_float((w_)[1] << 16), __uint_as_float((w_)[1] & 0xffff0000u)})
#define GLA_LOAD(cc) do { const int row = seq_row(b, (cc), tid >> 2); const GAS bf16* mr = MIB + (size_t)(row >= 0 ? row : 0) * N_MAIN; const int qd_ = tid & 3; \
        const u2v a0_ = *(const GAS u2v*)(mr + CM_GQ + h * 32 + 8 * qd_), a1_ = *(const GAS u2v*)(mr + CM_GQ + h * 32 + 8 * qd_ + 4), b0_ = *(const GAS u2v*)(mr + CM_GK + h * 32 + 8 * qd_), b1_ = *(const GAS u2v*)(mr + CM_GK + h * 32 + 8 * qd_ + 4); \
        u2v c_[4]; _Pragma("unroll") for (int j4 = 0; j4 < 4; ++j4) c_[j4] = *(const GAS u2v*)(mr + CM_GV + h * 64 + 16 * qd_ + 4 * j4); \
        _Pragma("unroll") for (int e_ = 0; e_ < 8; ++e_) { const int rg_ = seq_row(b, (cc), 8 * (tid >> 5) + e_); gl[e_] = GLOG[(size_t)(rg_ >= 0 ? rg_ : 0) * 128 + h * 32 + (tid & 31)]; } \
        q0 = BF4(a0_); q1 = BF4(a1_); k0 = BF4(b0_); k1 = BF4(b1_); _Pragma("unroll") for (int j4 = 0; j4 < 4; ++j4) v4[j4] = BF4(c_[j4]); } while (0)
    GLA_LOAD(0);
    for (int c = 0; c < 17; ++c) {
        tid = tid0; asm volatile("" : "+v"(tid)); lane = tid & 63; wave = __builtin_amdgcn_readfirstlane(tid >> 6); r32 = lane & 31; hi = lane >> 5; vt = wave & 1; tt = wave < 4 ? (wave >> 1) : 3 - ((wave - 4) >> 1); kk = tid & 31; seg = tid >> 5;
        if (c == 0 && (tid >> 2) < 112) { const f4 z = (f4){0.f, 0.f, 0.f, 0.f}; q0 = z; q1 = z; k0 = z; k1 = z; v4[0] = z; v4[1] = z; v4[2] = z; v4[3] = z; }
        {
            float bcl[8]; float run = 0.f;
#pragma unroll
            for (int e = 0; e < 8; ++e) { const float gv = (c == 0 && 8 * seg + e < 112) ? 0.f : gl[e]; run += gv; bcl[e] = run; }
            SEG[seg * 32 + kk] = run;
            LDS_BARRIER();
            float off = 0.f, tot = 0.f;
#pragma unroll
            for (int s = 0; s < 16; ++s) { const float v = SEG[s * 32 + kk]; tot += v; if (s < seg) off += v; }
#pragma unroll
            for (int e = 0; e < 8; ++e) BC[(8 * seg + e) * 33 + kk] = bcl[e] + off;
            if (seg == 0) { BL[kk] = __expf(tot); BLR[kk] = tot; }
            LDS_BARRIER();
        }
        {
            const int t = tid >> 2, qd = tid & 3;
            const float q[8] = {q0[0], q0[1], q0[2], q0[3], q1[0], q1[1], q1[2], q1[3]}, k[8] = {k0[0], k0[1], k0[2], k0[3], k1[0], k1[1], k1[2], k1[3]};
            float qv[8], kv[8];
#pragma unroll
            for (int j = 0; j < 8; ++j) { const float bcv = BC[t * 33 + 8 * qd + j]; qv[j] = q[j] * 0.17677669529663687f * __expf(bcv); kv[j] = k[j] * __expf(-bcv);
                *(LAS bf16*)(KT + (8 * qd + j) * TPITCH + 2 * t) = (bf16)(cvtpk(k[j] * __expf(BLR[8 * qd + j] - bcv), 0.f) & 0xffffu); }
            *(LAS v4u*)(QL + t * 80 + qd * 16) = (v4u){cvtpk(qv[0], qv[1]), cvtpk(qv[2], qv[3]), cvtpk(qv[4], qv[5]), cvtpk(qv[6], qv[7])};
            *(LAS v4u*)(KL + t * 80 + qd * 16) = (v4u){cvtpk(kv[0], kv[1]), cvtpk(kv[2], kv[3]), cvtpk(kv[4], kv[5]), cvtpk(kv[6], kv[7])};
#pragma unroll
            for (int j4 = 0; j4 < 4; ++j4)
#pragma unroll
                for (int e = 0; e < 4; e += 2) { const unsigned w_ = cvtpk(v4[j4][e], v4[j4][e + 1]); *(LAS bf16*)(VT + (16 * qd + 4 * j4 + e) * TPITCH + 2 * t) = (bf16)(w_ & 0xffffu); *(LAS bf16*)(VT + (16 * qd + 4 * j4 + e + 1) * TPITCH + 2 * t) = (bf16)(w_ >> 16); }
        }
        float zz[16];
#pragma unroll
        for (int i = 0; i < 16; ++i) { const int row = seq_row(b, c, 16 * wave + i); zz[i] = bf2f(MIB[(size_t)(row >= 0 ? row : 0) * N_MAIN + CM_GG + h * 64 + lane]); }
        if (c + 1 < 17) GLA_LOAD(c + 1);
        LDS_BARRIER();
        {
            f32x16 y;
#pragma unroll
            for (int i = 0; i < 16; ++i) y[i] = 0.f;
            const LAS unsigned char* qrow = QL + (32 * tt + r32) * 80;
#pragma unroll
            for (int s2 = 0; s2 < 2; ++s2) y = MFMA32(pack8(SK, s2), ld8x2(qrow + (16 * s2 + 4 * hi) * 2), y);
            for (int i = 0; i <= tt; ++i) {
                f32x16 gt;
#pragma unroll
                for (int r = 0; r < 16; ++r) gt[r] = 0.f;
#pragma unroll
                for (int ks = 0; ks < 2; ++ks) gt = MFMA32(ld16(KL + (32 * i + r32) * 80 + (16 * ks + 8 * hi) * 2), ld16(qrow + (16 * ks + 8 * hi) * 2), gt);
                if (i == tt) {
#pragma unroll
                    for (int r = 0; r < 16; ++r) if (crow(r, hi) > r32) gt[r] = 0.f; }
#pragma unroll
                for (int s2 = 0; s2 < 2; ++s2) y = MFMA32(ld8x2(VT + (32 * vt + r32) * TPITCH + (32 * i + 16 * s2 + 4 * hi) * 2), pack8(gt, s2), y);
            }
#pragma unroll
            for (int r = 0; r < 16; ++r) SK[r] *= BL[crow(r, hi)];
#pragma unroll
            for (int ks = 0; ks < 8; ++ks) SK = MFMA32(ld16(KT + r32 * TPITCH + (16 * ks + 8 * hi) * 2), ld16(VT + (32 * vt + r32) * TPITCH + (16 * ks + 8 * hi) * 2), SK);
#pragma unroll
            for (int g4 = 0; g4 < 4; ++g4) *(LAS f4*)(OUT + (32 * tt + r32) * OPITCH + 32 * vt + 8 * g4 + 4 * hi) = (f4){y[4 * g4], y[4 * g4 + 1], y[4 * g4 + 2], y[4 * g4 + 3]};
        }
        LDS_BARRIER();
        {
            const float gnl = gnorm[lane];
            float ov[16], ss[16];
#pragma unroll
            for (int i = 0; i < 16; ++i) { ov[i] = OUT[(16 * wave + i) * OPITCH + lane]; ss[i] = fa::row16_sum(ov[i] * ov[i]); }
#pragma unroll
            for (int i = 0; i < 16; ++i) ss[i] += bperm(ss[i], lane ^ 16);
#pragma unroll
            for (int i = 0; i < 16; ++i) ss[i] += bperm(ss[i], lane ^ 32);
#pragma unroll
            for (int i = 0; i < 16; ++i) { const int row = seq_row(b, c, 16 * wave + i);
                if (row >= 0 && (row < MP || b == 0)) MIXB[(size_t)row * 1024 + 768 + h * 64 + lane] = (bf16)(cvtpk(ov[i] * rsqrtf(ss[i] * (1.0f / 64.0f) + EPS) * gnl * zz[i], 0.f) & 0xffffu); }
        }
        LDS_BARRIER();
    }
#undef GLA_LOAD
    if (tt == 0) {
#pragma unroll
        for (int r = 0; r < 16; ++r) state_out[crow(r, hi) * 64 + 32 * vt + r32] = SK[r]; }
}

constexpr int S_QL = 0, S_KL = 18432, S_KT = 36864, S_VT = 54272, S_OUT = 71680, S_CS = 106496, S_DT = 107008, S_TOT = 107520, S_FS = 107776;
__device__ __forceinline__ void ssd_prompt_unit(int b, int h, const GAS bf16* MIB, const GAS bf16* XC, const GAS float* DTS, float A, float Dh, GAS bf16* MIXB, GAS float* SSQH, GAS float* state_out, LAS unsigned char* lds, int tid0) {
    int tid = tid0; const int g = h >> 2;
    int lane = tid & 63, wave = __builtin_amdgcn_readfirstlane(tid >> 6), r32 = lane & 31, hi = lane >> 5, vt = wave & 1, tt = wave < 4 ? (wave >> 1) : 3 - ((wave - 4) >> 1);
    LAS unsigned char* QL = lds + S_QL; LAS unsigned char* KL = lds + S_KL; LAS unsigned char* KT = lds + S_KT; LAS unsigned char* VT = lds + S_VT;
    LAS float* OUT = (LAS float*)(lds + S_OUT); LAS float* CS = (LAS float*)(lds + S_CS); LAS float* DT = (LAS float*)(lds + S_DT); LAS float* TOT = (LAS float*)(lds + S_TOT);
    f32x16 SK0, SK1;
#pragma unroll
    for (int i = 0; i < 16; ++i) { SK0[i] = 0.f; SK1[i] = 0.f; }
    v4u pb0, pb1, pc0, pc1, px0, px1; float dr0, dr1;
#define SSD_LOAD(cc) do { const int row_ = seq_row(b, (cc), tid >> 2); const GAS bf16* xr_ = XC + (size_t)(row_ >= 0 ? row_ : 0) * 768; const int q_ = tid & 3; \
        pb0 = *(const GAS v4u*)(xr_ + 512 + 64 * g + 8 * q_); pb1 = *(const GAS v4u*)(xr_ + 512 + 64 * g + 32 + 8 * q_); pc0 = *(const GAS v4u*)(xr_ + 640 + 64 * g + 8 * q_); pc1 = *(const GAS v4u*)(xr_ + 640 + 64 * g + 32 + 8 * q_); \
        px0 = *(const GAS v4u*)(xr_ + 64 * h + 8 * q_); px1 = *(const GAS v4u*)(xr_ + 64 * h + 32 + 8 * q_); \
        const int ra_ = seq_row(b, (cc), 2 * lane), rb_ = seq_row(b, (cc), 2 * lane + 1); dr0 = DTS[(size_t)(ra_ >= 0 ? ra_ : 0) * 8 + h]; dr1 = DTS[(size_t)(rb_ >= 0 ? rb_ : 0) * 8 + h]; } while (0)
    SSD_LOAD(0);
    for (int c = 0; c < 17; ++c) {
        tid = tid0; asm volatile("" : "+v"(tid)); lane = tid & 63; wave = __builtin_amdgcn_readfirstlane(tid >> 6); r32 = lane & 31; hi = lane >> 5; vt = wave & 1; tt = wave < 4 ? (wave >> 1) : 3 - ((wave - 4) >> 1);
        {
            const int t = tid >> 2, q = tid & 3;
            const bool pad0 = c == 0 && 2 * lane < 112, pad1 = c == 0 && 2 * lane + 1 < 112;
            const float d0 = pad0 ? 0.f : dr0, d1 = pad1 ? 0.f : dr1;
            const float a0 = d0 * A, a1 = d1 * A; float x = a0 + a1;
#pragma unroll
            for (int o = 1; o < 64; o <<= 1) { const float y = bperm(x, lane - o); if (lane >= o) x += y; }
            const float csl = bperm(x, 63);
            const float cs1 = x, cs0 = x - a1;
            if (tt > 0) {
                const float R = bperm(cs1, 16 * tt - 1);
                LAS float* FSw = (LAS float*)(lds + S_FS) + wave * 128;
                *(LAS u2v*)(FSw + 2 * lane) = (u2v){__float_as_uint(__expf(fminf(R - cs0, 0.f)) * d0), __float_as_uint(__expf(fminf(R - cs1, 0.f)) * d1)}; }
            if (wave == 0) { *(LAS u2v*)(CS + 2 * lane) = (u2v){__float_as_uint(cs0), __float_as_uint(cs1)}; *(LAS u2v*)(DT + 2 * lane) = (u2v){__float_as_uint(d0), __float_as_uint(d1)}; if (lane == 0) TOT[0] = csl; }
            const int src = t >> 1; const float csa = bperm(cs0, src), csb = bperm(cs1, src), dta = bperm(d0, src), dtb_ = bperm(d1, src);
            const float cst = (t & 1) ? csb : csa, dtt = (t & 1) ? dtb_ : dta;
            const float wgt = dtt * __expf(csl - cst);
            const bool padt = c == 0 && t < 112;
            if (padt) { const v4u z = (v4u){0u, 0u, 0u, 0u}; pb0 = z; pb1 = z; pc0 = z; pc1 = z; px0 = z; px1 = z; }
            *(LAS v4u*)(KL + t * 144 + q * 16) = pb0; *(LAS v4u*)(KL + t * 144 + 64 + q * 16) = pb1;
            *(LAS v4u*)(QL + t * 144 + q * 16) = pc0; *(LAS v4u*)(QL + t * 144 + 64 + q * 16) = pc1;
            const unsigned xw[8] = {px0.x, px0.y, px0.z, px0.w, px1.x, px1.y, px1.z, px1.w};
            const unsigned bw[8] = {pb0.x, pb0.y, pb0.z, pb0.w, pb1.x, pb1.y, pb1.z, pb1.w};
#pragma unroll
            for (int j = 0; j < 8; ++j) { const int p = (j < 4 ? 8 * q : 32 + 8 * q) + 2 * (j & 3);
                *(LAS bf16*)(VT + p * TPITCH + 2 * t) = (bf16)(xw[j] & 0xffffu); *(LAS bf16*)(VT + (p + 1) * TPITCH + 2 * t) = (bf16)(xw[j] >> 16);
                const unsigned wb = cvtpk(__uint_as_float(bw[j] << 16) * wgt, __uint_as_float(bw[j] & 0xffff0000u) * wgt);
                *(LAS bf16*)(KT + p * TPITCH + 2 * t) = (bf16)(wb & 0xffffu); *(LAS bf16*)(KT + (p + 1) * TPITCH + 2 * t) = (bf16)(wb >> 16); }
        }
        LDS_BARRIER();
        float zz[16];
#pragma unroll
        for (int i = 0; i < 16; ++i) { const int row = seq_row(b, c, 16 * wave + i); zz[i] = bf2f(MIB[(size_t)(row >= 0 ? row : 0) * N_MAIN + CM_SZ + h * 64 + lane]); }
        if (c + 1 < 17) SSD_LOAD(c + 1);
        {
            f32x16 y;
#pragma unroll
            for (int i = 0; i < 16; ++i) y[i] = 0.f;
            const LAS unsigned char* qrow = QL + (32 * tt + r32) * 144;
#pragma unroll
            for (int s2 = 0; s2 < 2; ++s2) { y = MFMA32(pack8(SK0, s2), ld8x2(qrow + (16 * s2 + 4 * hi) * 2), y); y = MFMA32(pack8(SK1, s2), ld8x2(qrow + (32 + 16 * s2 + 4 * hi) * 2), y); }
            const float cst = CS[32 * tt + r32]; const float ect = __expf(cst);
#pragma unroll
            for (int i = 0; i < 16; ++i) y[i] *= ect;
            if (tt > 0) {
                const LAS float* FSw = (const LAS float*)(lds + S_FS) + wave * 128;
                f32x16 y2;
#pragma unroll
                for (int r = 0; r < 16; ++r) y2[r] = 0.f;
                for (int i = 0; i < tt; ++i) {
                    f32x16 gt;
#pragma unroll
                    for (int r = 0; r < 16; ++r) gt[r] = 0.f;
#pragma unroll
                    for (int ks = 0; ks < 4; ++ks) gt = MFMA32(ld16(KL + (32 * i + r32) * 144 + (16 * ks + 8 * hi) * 2), ld16(qrow + (16 * ks + 8 * hi) * 2), gt);
#pragma unroll
                    for (int g4 = 0; g4 < 4; ++g4) { const f4 fs4 = *(const LAS f4*)(FSw + 32 * i + 8 * g4 + 4 * hi); gt[4 * g4] *= fs4[0]; gt[4 * g4 + 1] *= fs4[1]; gt[4 * g4 + 2] *= fs4[2]; gt[4 * g4 + 3] *= fs4[3]; }
#pragma unroll
                    for (int s2 = 0; s2 < 2; ++s2) y2 = MFMA32(ld8x2(VT + (32 * vt + r32) * TPITCH + (32 * i + 16 * s2 + 4 * hi) * 2), pack8(gt, s2), y2);
                }
                const float et = __expf(fminf(cst - CS[32 * tt - 1], 0.f));
#pragma unroll
                for (int r = 0; r < 16; ++r) y[r] += et * y2[r];
            }
            {
                const int i = tt;
                f32x16 gt;
#pragma unroll
                for (int r = 0; r < 16; ++r) gt[r] = 0.f;
#pragma unroll
                for (int ks = 0; ks < 4; ++ks) gt = MFMA32(ld16(KL + (32 * i + r32) * 144 + (16 * ks + 8 * hi) * 2), ld16(qrow + (16 * ks + 8 * hi) * 2), gt);
#pragma unroll
                for (int g4 = 0; g4 < 4; ++g4) { const f4 cs4 = *(const LAS f4*)(CS + 32 * i + 8 * g4 + 4 * hi), dt4 = *(const LAS f4*)(DT + 32 * i + 8 * g4 + 4 * hi);
#pragma unroll
                    for (int e = 0; e < 4; ++e) { const bool vis = 8 * g4 + 4 * hi + e <= r32; const float wv = vis ? __expf(fminf(cst - cs4[e], 0.f)) * dt4[e] : 0.f; gt[4 * g4 + e] *= wv; } }
#pragma unroll
                for (int s2 = 0; s2 < 2; ++s2) y = MFMA32(ld8x2(VT + (32 * vt + r32) * TPITCH + (32 * i + 16 * s2 + 4 * hi) * 2), pack8(gt, s2), y);
            }
            const float ecl = __expf(TOT[0]);
#pragma unroll
            for (int r = 0; r < 16; ++r) { SK0[r] *= ecl; SK1[r] *= ecl; }
#pragma unroll 2
            for (int ks = 0; ks < 8; ++ks) { const bf16x8 xb = ld16(VT + (32 * vt + r32) * TPITCH + (16 * ks + 8 * hi) * 2);
                SK0 = MFMA32(ld16(KT + r32 * TPITCH + (16 * ks + 8 * hi) * 2), xb, SK0); SK1 = MFMA32(ld16(KT + (32 + r32) * TPITCH + (16 * ks + 8 * hi) * 2), xb, SK1); }
#pragma unroll
            for (int g4 = 0; g4 < 4; ++g4) { f4 o;
#pragma unroll
                for (int e = 0; e < 4; ++e) o[e] = y[4 * g4 + e] + Dh * bf2f(*(const LAS bf16*)(VT + (32 * vt + 8 * g4 + 4 * hi + e) * TPITCH + 2 * (32 * tt + r32)));
                *(LAS f4*)(OUT + (32 * tt + r32) * OPITCH + 32 * vt + 8 * g4 + 4 * hi) = o; }
        }
        LDS_BARRIER();
        {
            float yv[16], ss[16];
#pragma unroll
            for (int i = 0; i < 16; ++i) { yv[i] = OUT[(16 * wave + i) * OPITCH + lane] * zz[i]; ss[i] = fa::row16_sum(yv[i] * yv[i]); }
#pragma unroll
            for (int i = 0; i < 16; ++i) ss[i] += bperm(ss[i], lane ^ 16);
#pragma unroll
            for (int i = 0; i < 16; ++i) ss[i] += bperm(ss[i], lane ^ 32);
            if (c > 0) {
                const size_t row0 = (size_t)b * 2048 + 128 * (c - 1) + 16 * wave;
#pragma unroll
                for (int i = 0; i < 16; ++i) { if (lane == 0) SSQH[(row0 + i) * 8 + h] = ss[i]; MIXB[(row0 + i) * 1024 + 256 + h * 64 + lane] = (bf16)(cvtpk(yv[i], 0.f) & 0xffffu); }
            } else if (b == 0 && wave == 7) {
#pragma unroll
                for (int i = 0; i < 16; ++i) { if (lane == 0) SSQH[(size_t)(R_META + i) * 8 + h] = ss[i]; MIXB[(size_t)(R_META + i) * 1024 + 256 + h * 64 + lane] = (bf16)(cvtpk(yv[i], 0.f) & 0xffffu); }
            }
        }
        LDS_BARRIER();
    }
#undef SSD_LOAD
    if (tt == 0) {
#pragma unroll
        for (int g4 = 0; g4 < 4; ++g4) { *(GAS f4*)(state_out + (32 * vt + r32) * 64 + 8 * g4 + 4 * hi) = (f4){SK0[4 * g4], SK0[4 * g4 + 1], SK0[4 * g4 + 2], SK0[4 * g4 + 3]};
            *(GAS f4*)(state_out + (32 * vt + r32) * 64 + 32 + 8 * g4 + 4 * hi) = (f4){SK1[4 * g4], SK1[4 * g4 + 1], SK1[4 * g4 + 2], SK1[4 * g4 + 3]}; } }
}
#undef MFMA32
}

namespace eu {
using fa::f4;
constexpr int E_Q = 67840, E_K = 71936, E_V = 76032, E_LF = 80128, E_XBC = 80256, E_DT = 92544, E_GLOG = 92672, E_YS = 94720, E_GO = 102912, E_END = 107008;

__device__ __forceinline__ void sample_unit(int b, int l, const float* MI, const float* ck, const float* cv, const float* clf, const int* pt, const float* st_ssm, const float* st_conv, const float* st_gla,
        const float* qg, const float* kg, const float* fbias, const float* cw, const float* cb, const float* dtb, const float* alog, const float* dsk, const float* snorm,
        const float* wg, const float* gbias, const float* gnorm, bf16* MIXB, float* out, LAS unsigned char* lds, int tid) {
    const int lane = tid & 63, wave = __builtin_amdgcn_readfirstlane(tid >> 6);
    LAS float* EQ = (LAS float*)(lds + E_Q); LAS float* EK = (LAS float*)(lds + E_K); LAS float* EV = (LAS float*)(lds + E_V); LAS float* ELF = (LAS float*)(lds + E_LF);
    LAS float* EX = (LAS float*)(lds + E_XBC); LAS float* EDT = (LAS float*)(lds + E_DT); LAS float* EG = (LAS float*)(lds + E_GLOG); LAS float* EYS = (LAS float*)(lds + E_YS); LAS float* EGO = (LAS float*)(lds + E_GO);
    const int r0 = R_S + 4 * b;
    if (wave < 4) { const float* mi = MI + (size_t)(r0 + wave) * LDMI;
#pragma unroll
        for (int h = 0; h < 4; ++h) { const float q = mi[C_FQ + h * 64 + lane], k = mi[C_FK + h * 64 + lane], v = mi[C_FV + h * 64 + lane];
            const float qs = rsqrtf(wave_sum_l(q * q, lane) * (1.f / 64.f) + EPS), ks = rsqrtf(wave_sum_l(k * k, lane) * (1.f / 64.f) + EPS);
            EQ[wave * 256 + h * 64 + lane] = q * qs * qg[lane]; EK[wave * 256 + h * 64 + lane] = k * ks * kg[lane]; EV[wave * 256 + h * 64 + lane] = v; }
        if (lane < 4) ELF[wave * 4 + lane] = log_sigmoidf(mi[C_FF + lane] + fbias[lane]);
    }
    for (int idx = tid; idx < 3072; idx += 512) { const int i = idx / 768, c = idx - i * 768; float u[4];
#pragma unroll
        for (int j = 0; j < 4; ++j) { const int p = i - j; u[j] = p >= 0 ? MI[(size_t)(r0 + p) * LDMI + C_XBC + c] : st_conv[(size_t)(b * 3 + 3 + p) * 768 + c]; }
        const float o = cw[3 * 768 + c] * u[0] + cw[2 * 768 + c] * u[1] + cw[768 + c] * u[2] + cw[c] * u[3] + cb[c];
        EX[i * 768 + c] = siluf(o); }
    if (tid < 32) EDT[tid] = softplusf(MI[(size_t)(r0 + (tid >> 3)) * LDMI + C_DT + (tid & 7)] + dtb[tid & 7]);
    { const int i = tid >> 7, c = tid & 127; const float* lr = MI + (size_t)(r0 + i) * LDMI + C_LR; float a = gbias[c];
#pragma unroll
        for (int r = 0; r < 16; ++r) a += lr[r] * wg[r * 128 + c];
        EG[i * 128 + c] = log_sigmoidf(a) * (1.0f / 16.0f); }
    {
        const int h = lane >> 4, d4 = lane & 15;
        LAS f4* Dl = (LAS f4*)(lds + fa::S_D); LAS f4* wsum = (LAS f4*)(lds + fa::S_WS);
        {
            const int page = pt[b * 16 + (tid >> 5)];
            const f4* src = (const f4*)(clf + (((size_t)l * NPOOL + page) * 128 + 4 * (tid & 31)) * 4);
            const f4 v0 = src[0], v1 = src[1], v2 = src[2], v3 = src[3];
            const f4 s2 = v3, s1 = v3 + v2, s0 = s1 + v1, tot = s0 + v0;
            f4 x = tot;
#pragma unroll
            for (int o = 1; o < 64; o <<= 1) { f4 y; y[0] = bperm(x[0], lane + o); y[1] = bperm(x[1], lane + o); y[2] = bperm(x[2], lane + o); y[3] = bperm(x[3], lane + o); if (lane + o < 64) x += y; }
            if (lane == 0) wsum[wave] = x;
            __syncthreads();
            f4 off = x - tot;
            for (int w = wave + 1; w < 8; ++w) off += wsum[w];
            Dl[4 * tid + 0] = s0 + off; Dl[4 * tid + 1] = s1 + off; Dl[4 * tid + 2] = s2 + off; Dl[4 * tid + 3] = off;
            __syncthreads();
        }
        const int r16 = lane & 15, q4 = lane >> 4, hp = r16 >> 2, iq = lane & 3;
        f4 q[4];
#pragma unroll
        for (int i = 0; i < 4; ++i) q[i] = *(const LAS f4*)(EQ + i * 256 + h * 64 + 4 * d4) * 0.125f;
        float m = -INFINITY, ls = 0.f; f4 oc[4];
#pragma unroll
        for (int c = 0; c < 4; ++c) oc[c] = (f4){0.f, 0.f, 0.f, 0.f};
        const LAS float* Df = (const LAS float*)Dl;
        const bool b0 = lane & 1, b1 = lane & 2, mine = hp == q4;
        for (int p = 0; p < 16; ++p) {
            const int page = pt[b * 16 + p];
            const size_t base = (((size_t)l * NPOOL + page) * 128 + 16 * wave) * 256 + lane * 4;
            f4 kk[16], vv[16];
#pragma unroll
            for (int j = 0; j < 16; ++j) { kk[j] = __builtin_nontemporal_load((const f4*)(ck + base + (size_t)j * 256)); vv[j] = __builtin_nontemporal_load((const f4*)(cv + base + (size_t)j * 256)); }
            float sj[16];
#pragma unroll
            for (int j = 0; j < 16; ++j) {
                float pq[4];
#pragma unroll
                for (int i = 0; i < 4; ++i) pq[i] = q[i][0] * kk[j][0] + q[i][1] * kk[j][1] + q[i][2] * kk[j][2] + q[i][3] * kk[j][3];
                const float k0 = b0 ? pq[1] : pq[0], g0 = b0 ? pq[0] : pq[1], k1 = b0 ? pq[3] : pq[2], g1 = b0 ? pq[2] : pq[3];
                const float r0 = k0 + fa::dpp<fa::XOR1>(g0), r1 = k1 + fa::dpp<fa::XOR1>(g1);
                float t = (b1 ? r1 : r0) + fa::dpp<fa::XOR2>(b1 ? r0 : r1);
                t += fa::dpp<0x124>(t); t += fa::dpp<0x128>(t);
                sj[j] = t + Df[(p * 128 + 16 * wave + j) * 4 + h];
            }
            float mx = sj[0];
#pragma unroll
            for (int j = 1; j < 16; ++j) mx = fmaxf(mx, sj[j]);
            const float mn = fmaxf(m, mx); const float sc = __expf(m - mn); m = mn;
            float rs = 0.f;
#pragma unroll
            for (int j = 0; j < 16; ++j) { sj[j] = __expf(sj[j] - mn); rs += sj[j]; }
            ls = ls * sc + rs;
            const float scc = bperm(sc, 16 * hp + iq);
#pragma unroll
            for (int c = 0; c < 4; ++c) { oc[c][0] *= scc; oc[c][1] *= scc; oc[c][2] *= scc; oc[c][3] *= scc; }
#pragma unroll
            for (int g = 0; g < 2; ++g) {
                v4u w = (v4u){fa::cvtpk(sj[8 * g], sj[8 * g + 1]), fa::cvtpk(sj[8 * g + 2], sj[8 * g + 3]), fa::cvtpk(sj[8 * g + 4], sj[8 * g + 5]), fa::cvtpk(sj[8 * g + 6], sj[8 * g + 7])};
                if (!mine) w = (v4u){0u, 0u, 0u, 0u};
                const fa::bf16x8 pbv = __builtin_bit_cast(fa::bf16x8, w);
#pragma unroll
                for (int c = 0; c < 4; ++c) {
                    const v4u a = (v4u){fa::cvtpk(vv[8 * g][c], vv[8 * g + 1][c]), fa::cvtpk(vv[8 * g + 2][c], vv[8 * g + 3][c]), fa::cvtpk(vv[8 * g + 4][c], vv[8 * g + 5][c]), fa::cvtpk(vv[8 * g + 6][c], vv[8 * g + 7][c])};
                    oc[c] = __builtin_amdgcn_mfma_f32_16x16x32_bf16(__builtin_bit_cast(fa::bf16x8, a), pbv, oc[c], 0, 0, 0); }
            }
        }
        m = bperm(m, 16 * hp + iq); ls = bperm(ls, 16 * hp + iq);
        LAS float* part = (LAS float*)(lds + fa::S_PART);
        { LAS float* pp = part + (wave * 16 + r16) * fa::S_PSTR;
#pragma unroll
            for (int e = 0; e < 4; ++e) *(LAS f4*)(pp + 4 + 16 * q4 + 4 * e) = (f4){oc[0][e], oc[1][e], oc[2][e], oc[3][e]};
            if (q4 == 0) { pp[0] = m; pp[1] = ls; } }
        __syncthreads();
        for (int u = tid; u < 1024; u += 512) {
            const int hh = u >> 8, i = (u >> 6) & 3, d = u & 63;
            float sn[4]; float G = 0.f;
#pragma unroll
            for (int j = 0; j < 4; ++j) { G -= ELF[j * 4 + hh]; float dot = 0.f;
                for (int c = 0; c < 64; ++c) dot += EQ[i * 256 + hh * 64 + c] * EK[j * 256 + hh * 64 + c];
                sn[j] = j <= i ? dot * 0.125f + G : -INFINITY; }
            float mt = fmaxf(fmaxf(sn[0], sn[1]), fmaxf(sn[2], sn[3]));
            for (int w = 0; w < 8; ++w) mt = fmaxf(mt, part[(w * 16 + hh * 4 + i) * fa::S_PSTR]);
            float lt = 0.f, ot = 0.f;
            for (int w = 0; w < 8; ++w) { const LAS float* pp = part + (w * 16 + hh * 4 + i) * fa::S_PSTR; const float e = __expf(pp[0] - mt); lt += e * pp[1]; ot += e * pp[4 + d]; }
#pragma unroll
            for (int j = 0; j < 4; ++j) { const float e = __expf(sn[j] - mt); lt += e; ot += e * EV[j * 256 + hh * 64 + d]; }
            MIXB[(size_t)(r0 + i) * 1024 + hh * 64 + d] = (bf16)f2bf(ot / lt);
        }
    }
    {
        const int h = wave, g = h >> 2, p = lane;
        const f4* h0 = (const f4*)(st_ssm + (((size_t)b * 8 + h) * 64 + p) * 64);
        f4 hs[16];
#pragma unroll
        for (int n4 = 0; n4 < 16; ++n4) hs[n4] = h0[n4];
        const float A = -expf(alog[h]);
        for (int i = 0; i < 4; ++i) {
            const float dt = EDT[i * 8 + h]; const float dec = expf(dt * A); const float xdt = EX[i * 768 + h * 64 + p] * dt;
            float y = 0.f;
#pragma unroll
            for (int n4 = 0; n4 < 16; ++n4) { const f4 Bv = *(const LAS f4*)(EX + i * 768 + 512 + g * 64 + 4 * n4), Cv = *(const LAS f4*)(EX + i * 768 + 640 + g * 64 + 4 * n4);
                hs[n4] = hs[n4] * dec + Bv * xdt; y += Cv[0] * hs[n4][0] + Cv[1] * hs[n4][1] + Cv[2] * hs[n4][2] + Cv[3] * hs[n4][3]; }
            EYS[i * 512 + h * 64 + p] = y;
        }
        f4* ho = (f4*)(out + O_SSMS + (((size_t)(l * DEC_BATCH + b) * 8 + h) * 64 + p) * 64);
#pragma unroll
        for (int n4 = 0; n4 < 16; ++n4) ho[n4] = hs[n4];
    }
    if (wave < 4) {
        const int h = wave, v = lane;
        const float* s0 = st_gla + ((size_t)b * 4 + h) * 2048;
        float S[32];
#pragma unroll
        for (int k = 0; k < 32; ++k) S[k] = s0[k * 64 + v];
        for (int i = 0; i < 4; ++i) {
            const float* mi = MI + (size_t)(r0 + i) * LDMI;
            const float vv = mi[C_GV + h * 64 + v];
            float o = 0.f;
#pragma unroll
            for (int k4 = 0; k4 < 8; ++k4) { const f4 q4 = *(const f4*)(mi + C_GQ + h * 32 + 4 * k4), k4v = *(const f4*)(mi + C_GK + h * 32 + 4 * k4), g4 = *(const LAS f4*)(EG + i * 128 + h * 32 + 4 * k4);
#pragma unroll
                for (int e = 0; e < 4; ++e) { S[4 * k4 + e] = S[4 * k4 + e] * __expf(g4[e]) + k4v[e] * vv; o += q4[e] * 0.17677669529663687f * S[4 * k4 + e]; } }
            EGO[i * 256 + h * 64 + v] = o;
        }
        float* so = out + O_GLAS + ((size_t)(l * DEC_BATCH + b) * 4 + h) * 2048;
#pragma unroll
        for (int k = 0; k < 32; ++k) so[k * 64 + v] = S[k];
    }
    __syncthreads();
    if (wave < 4) { const int i = wave; const float* mi = MI + (size_t)(r0 + i) * LDMI;
#pragma unroll
        for (int g = 0; g < 2; ++g) { float y[4]; float s = 0.f;
#pragma unroll
            for (int e = 0; e < 4; ++e) { const int c = g * 256 + lane * 4 + e; y[e] = (EYS[i * 512 + c] + EX[i * 768 + c] * dsk[c >> 6]) * mi[C_SZ + c]; s += y[e] * y[e]; }
            const float rs = rsqrtf(wave_sum_l(s, lane) * (1.f / 256.f) + EPS);
            *(uint2*)(MIXB + (size_t)(r0 + i) * 1024 + 256 + g * 256 + lane * 4) = make_uint2(pk2(y[0] * rs * snorm[g * 256 + lane * 4], y[1] * rs * snorm[g * 256 + lane * 4 + 1]), pk2(y[2] * rs * snorm[g * 256 + lane * 4 + 2], y[3] * rs * snorm[g * 256 + lane * 4 + 3])); }
#pragma unroll
        for (int hh = 0; hh < 4; ++hh) { const float o = EGO[i * 256 + hh * 64 + lane]; const float rs = rsqrtf(wave_sum_l(o * o, lane) * (1.f / 64.f) + EPS);
            MIXB[(size_t)(r0 + i) * 1024 + 768 + hh * 64 + lane] = (bf16)f2bf(o * rs * gnorm[lane] * mi[C_GG + hh * 64 + lane]); }
    }
    __syncthreads();
}

constexpr int M_Q = 0, M_K = 16384, M_LF = 32768, M_F = 33024;
__device__ __forceinline__ void meta_unit(const float* MI, const float* qg, const float* kg, const float* fbias, bf16* MIXB, LAS unsigned char* lds, int tid) {
    const int lane = tid & 63, wave = __builtin_amdgcn_readfirstlane(tid >> 6);
    LAS float* MQ = (LAS float*)(lds + M_Q); LAS float* MK = (LAS float*)(lds + M_K); LAS float* MLF = (LAS float*)(lds + M_LF); LAS float* MF = (LAS float*)(lds + M_F);
    for (int j = wave; j < 16; j += 8) { const float* mi = MI + (size_t)(R_META + j) * LDMI;
#pragma unroll
        for (int h = 0; h < 4; ++h) { const float q = mi[C_FQ + h * 64 + lane], k = mi[C_FK + h * 64 + lane];
            const float qs = rsqrtf(wave_sum_l(q * q, lane) * (1.f / 64.f) + EPS), ks = rsqrtf(wave_sum_l(k * k, lane) * (1.f / 64.f) + EPS);
            MQ[j * 256 + h * 64 + lane] = q * qs * qg[lane]; MK[j * 256 + h * 64 + lane] = k * ks * kg[lane]; }
        if (lane < 4) MLF[j * 4 + lane] = log_sigmoidf(mi[C_FF + lane] + fbias[lane]); }
    __syncthreads();
    if (tid < 4) { float F = 0.f; for (int j = 0; j < 16; ++j) { F += MLF[j * 4 + tid]; MF[j * 4 + tid] = F; } }
    __syncthreads();
    for (int pr = wave; pr < 64; pr += 8) { const int h = pr >> 4, j = pr & 15;
        const float qv = MQ[j * 256 + h * 64 + lane];
        float sc[16]; float mx = -INFINITY;
#pragma unroll
        for (int k = 0; k < 16; ++k) { const float s = wave_sum_l(qv * MK[k * 256 + h * 64 + lane], lane) * 0.125f + (MF[j * 4 + h] - MF[k * 4 + h]); sc[k] = k <= j ? s : -INFINITY; mx = fmaxf(mx, sc[k]); }
        float sum = 0.f, o = 0.f;
#pragma unroll
        for (int k = 0; k < 16; ++k) { const float p = __expf(sc[k] - mx); sum += p; o += p * MI[(size_t)(R_META + k) * LDMI + C_FV + h * 64 + lane]; }
        MIXB[(size_t)(R_META + j) * 1024 + h * 64 + lane] = (bf16)f2bf(o / sum); }
    __syncthreads();
}
}

namespace eg {
using fa::bf16x8; using fa::f32x16; using fa::f4; using fa::crow;
template <int K, int NB>
__device__ __forceinline__ f4 egemm_tile(const bf16* A, const bf16* Bt, int row0, int col0, LAS unsigned char* lds, int tid) {
    const int lane = tid & 63, wave = __builtin_amdgcn_readfirstlane(tid >> 6), r32 = lane & 31, hi = lane >> 5;
    constexpr int KW = K / 8, NS = KW / 16, NBAT = (NS + NB - 1) / NB;
    const GAS bf16* ap = (const GAS bf16*)A + (size_t)(row0 + r32) * K + wave * KW + 8 * hi;
    const GAS bf16* bp0 = (const GAS bf16*)Bt + (size_t)(col0 + r32) * K + wave * KW + 8 * hi; const GAS bf16* bp1 = bp0 + (size_t)32 * K;
    f32x16 c0, c1;
#pragma unroll
    for (int i = 0; i < 16; ++i) { c0[i] = 0.f; c1[i] = 0.f; }
    bf16x8 fa_[2][NB], fb0[2][NB], fb1[2][NB];
#define EG_LOAD(buf, bat) do { _Pragma("unroll") for (int j = 0; j < NB; ++j) if ((bat) * NB + j < NS) { fa_[buf][j] = *(const GAS bf16x8*)(ap + ((bat) * NB + j) * 16); fb0[buf][j] = *(const GAS bf16x8*)(bp0 + ((bat) * NB + j) * 16); fb1[buf][j] = *(const GAS bf16x8*)(bp1 + ((bat) * NB + j) * 16); } } while (0)
#define EG_MMA(buf, bat) do { _Pragma("unroll") for (int j = 0; j < NB; ++j) if ((bat) * NB + j < NS) { c0 = __builtin_amdgcn_mfma_f32_32x32x16_bf16(fa_[buf][j], fb0[buf][j], c0, 0, 0, 0); c1 = __builtin_amdgcn_mfma_f32_32x32x16_bf16(fa_[buf][j], fb1[buf][j], c1, 0, 0, 0); } } while (0)
    EG_LOAD(0, 0);
#pragma unroll
    for (int bat = 0; bat < NBAT; ++bat) { if (bat + 1 < NBAT) { if ((bat + 1) & 1) EG_LOAD(1, bat + 1); else EG_LOAD(0, bat + 1); } if (bat & 1) EG_MMA(1, bat); else EG_MMA(0, bat); }
#undef EG_LOAD
#undef EG_MMA
    LAS float* red = (LAS float*)lds + wave * 2048;
#pragma unroll
    for (int i = 0; i < 16; ++i) { red[crow(i, hi) * 64 + r32] = c0[i]; red[crow(i, hi) * 64 + 32 + r32] = c1[i]; }
    __syncthreads();
    const LAS float* rp = (const LAS float*)lds + (tid >> 4) * 64 + (tid & 15) * 4;
    f4 s = *(const LAS f4*)rp;
#pragma unroll
    for (int w = 1; w < 8; ++w) s += *(const LAS f4*)(rp + w * 2048);
    __syncthreads();
    return s;
}
template <int K, int NB>
__device__ __forceinline__ void egemm_resid(const bf16* A, const bf16* Bt, float* X, bf16* XB, float* SSQP, float scale, float* out, int final_, LAS unsigned char* lds, int tid) {
    const int lane = tid & 63, wave = __builtin_amdgcn_readfirstlane(tid >> 6), r32 = lane & 31, hi = lane >> 5;
    constexpr int KW = K / 8, NS = KW / 16, NBAT = (NS + NB - 1) / NB;
    for (int u = blockIdx.x; u < 11 * 16; u += gridDim.x) {
        const int rt = u >> 4, ct = u & 15, row0 = MP + 48 * rt, col0 = 64 * ct;
        const int ra = row0 + (tid >> 4), col = col0 + (tid & 15) * 4; const bool hasb = (tid >> 4) < 16;
        GAS f4* xpa = (GAS f4*)(X + (size_t)ra * 1024 + col); GAS f4* xpb = (GAS f4*)(X + (size_t)(ra + 32) * 1024 + col);
        f4 xa = *xpa, xb = *xpb;
        const GAS bf16* ap0 = (const GAS bf16*)A + (size_t)(row0 + r32) * K + wave * KW + 8 * hi; const GAS bf16* ap1 = ap0 + (size_t)32 * K;
        const GAS bf16* bp0 = (const GAS bf16*)Bt + (size_t)(col0 + r32) * K + wave * KW + 8 * hi; const GAS bf16* bp1 = bp0 + (size_t)32 * K;
        f32x16 c00, c01, c10, c11;
#pragma unroll
        for (int i = 0; i < 16; ++i) { c00[i] = 0.f; c01[i] = 0.f; c10[i] = 0.f; c11[i] = 0.f; }
        constexpr int QB = 4, NQ = (NS + QB - 1) / QB;
        bf16x8 fa0[2][QB], fa1[2][QB], fb0[2][QB], fb1[2][QB];
#define EGR_LOAD(buf, bat) do { \
            _Pragma("unroll") for (int j = 0; j < QB; ++j) if ((bat) * QB + j < NS) fa0[buf][j] = *(const GAS bf16x8*)(ap0 + ((bat) * QB + j) * 16); \
            _Pragma("unroll") for (int j = 0; j < QB; ++j) if ((bat) * QB + j < NS) fb0[buf][j] = *(const GAS bf16x8*)(bp0 + ((bat) * QB + j) * 16); \
            _Pragma("unroll") for (int j = 0; j < QB; ++j) if ((bat) * QB + j < NS) fa1[buf][j] = *(const GAS bf16x8*)(ap1 + ((bat) * QB + j) * 16); \
            _Pragma("unroll") for (int j = 0; j < QB; ++j) if ((bat) * QB + j < NS) fb1[buf][j] = *(const GAS bf16x8*)(bp1 + ((bat) * QB + j) * 16); } while (0)
#define EGR_MMA(buf, bat) do { _Pragma("unroll") for (int j = 0; j < QB; ++j) if ((bat) * QB + j < NS) { \
            c00 = __builtin_amdgcn_mfma_f32_32x32x16_bf16(fa0[buf][j], fb0[buf][j], c00, 0, 0, 0); c01 = __builtin_amdgcn_mfma_f32_32x32x16_bf16(fa0[buf][j], fb1[buf][j], c01, 0, 0, 0); \
            c10 = __builtin_amdgcn_mfma_f32_32x32x16_bf16(fa1[buf][j], fb0[buf][j], c10, 0, 0, 0); c11 = __builtin_amdgcn_mfma_f32_32x32x16_bf16(fa1[buf][j], fb1[buf][j], c11, 0, 0, 0); } } while (0)
        EGR_LOAD(0, 0);
#pragma unroll
        for (int bat = 0; bat < NQ; ++bat) {
            if (bat + 1 < NQ) { if ((bat + 1) & 1) EGR_LOAD(1, bat + 1); else EGR_LOAD(0, bat + 1); }
            if (bat & 1) EGR_MMA(1, bat); else EGR_MMA(0, bat);
        }
#undef EGR_LOAD
#undef EGR_MMA
        LAS float* red = (LAS float*)lds + wave * 4096;
#pragma unroll
        for (int i = 0; i < 16; ++i) { red[crow(i, hi) * 64 + r32] = c00[i]; red[crow(i, hi) * 64 + 32 + r32] = c01[i]; red[(32 + crow(i, hi)) * 64 + r32] = c10[i]; red[(32 + crow(i, hi)) * 64 + 32 + r32] = c11[i]; }
        __syncthreads();
        const LAS float* rp = (const LAS float*)lds + (tid >> 4) * 64 + (tid & 15) * 4;
        f4 sa = *(const LAS f4*)rp, sb = *(const LAS f4*)(rp + 32 * 64);
#pragma unroll
        for (int w = 1; w < 8; ++w) { sa += *(const LAS f4*)(rp + w * 4096); sb += *(const LAS f4*)(rp + w * 4096 + 32 * 64); }
        __syncthreads();
#pragma unroll
        for (int hb = 0; hb < 2; ++hb) {
            if (hb == 1 && !hasb) break;
            const int row = hb ? ra + 32 : ra; f4 x = hb ? xb : xa; const f4 acc = hb ? sb : sa;
            x[0] += acc[0] * scale; x[1] += acc[1] * scale; x[2] += acc[2] * scale; x[3] += acc[3] * scale;
            *(hb ? xpb : xpa) = x;
            *(GAS la::u2v*)(XB + (size_t)row * 1024 + col) = (la::u2v){fa::cvtpk(x[0], x[1]), fa::cvtpk(x[2], x[3])};
            const float ss = fa::row16_sum((x[0] * x[0] + x[1] * x[1]) + (x[2] * x[2] + x[3] * x[3]));
            if ((tid & 15) == 0) SSQP[(size_t)row * 16 + ct] = ss;
            if (final_ && row < R_META) *(GAS f4*)(out + O_YS + (size_t)(row - R_S) * 1024 + col) = x;
        }
    }
}
}

namespace sm {
using fa::bf16x8; using fa::f32x16; using fa::crow;
__device__ __forceinline__ void smalls_gemm(const bf16* XB, const bf16* Wt, const float* SSQP, float* MI, float* LF, const float* fbias, float* out, int l, LAS unsigned char* lds, int tid, int u0, int ustep, int uend) {
    const int lane = tid & 63, wave = __builtin_amdgcn_readfirstlane(tid >> 6), r32 = lane & 31, hi = lane >> 5;
    constexpr int NU = (M_REAL + 31) / 32;
    const GAS bf16* bp = (const GAS bf16*)Wt + (size_t)r32 * 1024 + wave * 128 + 8 * hi;
    const GAS bf16* ap = (const GAS bf16*)XB + (size_t)r32 * 1024 + wave * 128 + 8 * hi;
    bf16x8 fa_[8], fb_[8];
    if (u0 < uend) {
#pragma unroll
        for (int j = 0; j < 8; ++j) fa_[j] = *(const GAS bf16x8*)(ap + (size_t)u0 * 32 * 1024 + 16 * j);
#pragma unroll
        for (int j = 0; j < 8; ++j) fb_[j] = *(const GAS bf16x8*)(bp + 16 * j); }
    for (int u = u0; u < uend; u += ustep) {
        const int row0 = 32 * u;
        f32x16 c;
#pragma unroll
        for (int i = 0; i < 16; ++i) c[i] = 0.f;
#pragma unroll
        for (int j = 0; j < 8; ++j) c = __builtin_amdgcn_mfma_f32_32x32x16_bf16(fa_[j], fb_[j], c, 0, 0, 0);
        if (u + ustep < uend) {
#pragma unroll
            for (int j = 0; j < 8; ++j) fa_[j] = *(const GAS bf16x8*)(ap + (size_t)(u + ustep) * 32 * 1024 + 16 * j); }
        const float rs = pg8::rstd_of(SSQP, row0 + (tid >> 4));
        LAS float* red = (LAS float*)lds + wave * 1024;
#pragma unroll
        for (int i = 0; i < 16; ++i) red[crow(i, hi) * 32 + r32] = c[i];
        __syncthreads();
        const int rr = tid >> 4, c0 = (tid & 15) * 2; const int row = row0 + rr;
        float v0 = 0.f, v1 = 0.f;
#pragma unroll
        for (int w = 0; w < 8; ++w) { v0 += ((const LAS float*)lds)[w * 1024 + rr * 32 + c0]; v1 += ((const LAS float*)lds)[w * 1024 + rr * 32 + c0 + 1]; }
        __syncthreads();
        v0 *= rs; v1 *= rs;
        if (c0 < 28) { MI[(size_t)row * LDMI + small2ref(c0)] = v0; MI[(size_t)row * LDMI + small2ref(c0 + 1)] = v1; }
        if (c0 < 4 && row < M_REAL) {
            const float x0 = v0 + fbias[c0], x1 = v1 + fbias[c0 + 1];
            const float l0 = fminf(x0, 0.f) - log1pf(__expf(-fabsf(x0))), l1 = fminf(x1, 0.f) - log1pf(__expf(-fabsf(x1)));
            LF[(size_t)row * 4 + c0] = l0; LF[(size_t)row * 4 + c0 + 1] = l1;
            if (row < MP) { float* o = out + O_LFP + ((size_t)(l * BATCH + (row >> 11)) * TP + 16 + (row & 2047)) * 4 + c0; o[0] = l0; o[1] = l1; }
            else if (row < R_META) { float* o = out + O_LFS + ((size_t)l * MS + (row - R_S)) * 4 + c0; o[0] = l0; o[1] = l1; }
            else for (int cc = 0; cc < BATCH; ++cc) { float* o = out + O_LFP + ((size_t)(l * BATCH + cc) * TP + (row - R_META)) * 4 + c0; o[0] = l0; o[1] = l1; }
        }
    }
}
}

struct Args { const float* in[31]; float* out; unsigned char* ws; int ph_lo, ph_hi; };

__device__ __forceinline__ void transpose_item(const float* W, int ldw, int K, const float* g, bf16* WT, int mapkind, int nblk, int item, LAS float* scr, int lane) {
    const int kb = item / nblk, nb = item % nblk, k0 = 64 * kb, n0 = 32 * nb;
    const int kr = lane >> 3, n4 = (lane & 7) * 4;
    const int nd = n0 + n4;
    int src;
    if (mapkind == 1) { const int pn = nd >> 8, s = nd & 255; src = s < 128 ? 128 * pn + s : 2816 + 128 * pn + (s - 128); }
    else if (mapkind == 2) { const int pn = nd >> 8, sl = nd & 255; src = pn < 3 ? 256 * pn + 64 * ((sl >> 5) & 3) + 32 * (sl >> 7) + (sl & 31) : main2ref(nd); if (src >= ldw) src = -1; }
    else if (mapkind == 3) src = small2ref(nd);
    else src = nd < ldw ? nd : -1;
    typedef float f4t __attribute__((ext_vector_type(4)));
    f4t wv[8];
#pragma unroll
    for (int i = 0; i < 8; ++i) wv[i] = *(const f4t*)(W + (size_t)(k0 + kr + 8 * i) * ldw + (src >= 0 ? src : 0));
#pragma unroll
    for (int i = 0; i < 8; ++i) { const int kk = kr + 8 * i; const float gv = g ? g[k0 + kk] : 1.f;
#pragma unroll
        for (int e = 0; e < 4; ++e) scr[kk * 33 + n4 + e] = src >= 0 ? wv[i][e] * gv : 0.f; }
    LDS_WAIT();
    const int c = lane & 7;
#pragma unroll
    for (int j = 0; j < 4; ++j) { const int n = (lane >> 3) + 8 * j; const LAS float* s = scr + (8 * c) * 33 + n;
        v4u o; o.x = pk2(s[0 * 33], s[1 * 33]); o.y = pk2(s[2 * 33], s[3 * 33]); o.z = pk2(s[4 * 33], s[5 * 33]); o.w = pk2(s[6 * 33], s[7 * 33]);
        *(v4u*)(WT + (size_t)(n0 + n) * K + k0 + 8 * c) = o; }
    LDS_WAIT();
}

template <class T> __device__ __forceinline__ T* as_global(T* p) { return (T*)(__attribute__((address_space(1))) T*)p; }
__device__ __forceinline__ int tid_now(int wave_s) { int t; asm volatile("v_mbcnt_lo_u32_b32 %0, -1, 0\n\tv_mbcnt_hi_u32_b32 %0, -1, %0" : "=v"(t)); return t | (wave_s << 6); }
__global__ void __launch_bounds__(NWAVES * 64, 2) fwd(Args args) {
    extern __shared__ __attribute__((aligned(16))) unsigned char lds[];
    volatile LAS unsigned* MISC = (volatile LAS unsigned*)((LAS unsigned char*)lds + MISC_OFF);
    if (threadIdx.x < 32) MISC[threadIdx.x] = 0u;
    __syncthreads();
    XcdBarrier bar = xcd_barrier_post((unsigned*)(args.ws + WS_CTL) + CW_BAR, MISC + 8);
    volatile LAS unsigned long long* PT = (volatile LAS unsigned long long*)((LAS unsigned char*)lds + MISC_OFF + 256);
    if (threadIdx.x < 31) PT[threadIdx.x] = (unsigned long long)args.in[threadIdx.x];
    __syncthreads();
#define INP(i) ((const float*)(const GAS float*)PT[i])
    const int lo = args.ph_lo, hi = args.ph_hi;
    const int wave_s = __builtin_amdgcn_readfirstlane((int)threadIdx.x >> 6);
    int ph = 0;
#define BUF(name, off) float* name = (float*)(ws_ + (off))
#define BUFH(name, off) bf16* name = (bf16*)(ws_ + (off))
#define PHASE_BEGIN_R(R) if (lo <= ph && ph < hi) for (int rep_ = 0; rep_ < (R); ++rep_) { GAS unsigned char* wsg_ = (GAS unsigned char*)args.ws; GAS float* outg_ = (GAS float*)args.out; int tid = tid_now(wave_s); asm volatile("" : "+s"(wsg_), "+s"(outg_)); unsigned char* ws_ = (unsigned char*)wsg_;         \
        const int lane = tid & 63, wave = tid >> 6; const int gw = blockIdx.x * NWAVES + wave, NGW = gridDim.x * NWAVES; float* smem = (float*)lds; float* out = (float*)outg_; (void)lane; (void)wave; (void)gw; (void)NGW; (void)smem; (void)out; \
        BUF(X, WS_X); BUFH(XB, WS_XB); BUF(SSQP, WS_SSQ); BUFH(HB, WS_HB); BUFH(MIXB, WS_MIXB); BUF(MI, WS_MI); BUF(QN, WS_QN); BUF(KN, WS_KN); BUF(LF, WS_LF); BUF(FC, WS_FC); BUF(FCS, WS_FCS); \
        BUF(XBC, WS_XBC); BUF(DTB, WS_DT); BUF(GLOG, WS_GLOG); BUF(YS, WS_YS); BUF(GO, WS_GO); BUFH(QF, WS_QF); BUFH(KF, WS_KF); BUFH(VT, WS_VT); BUF(SSQH, WS_SSQH); BUFH(XC, WS_XC); BUFH(MIB, WS_MIB); (void)MIB; (void)QF; (void)KF; (void)VT; (void)SSQH; (void)XC; \
        (void)X; (void)XB; (void)SSQP; (void)HB; (void)MIXB; (void)MI; (void)QN; (void)KN; (void)LF; (void)FC; (void)FCS; (void)XBC; (void)DTB; (void)GLOG; (void)YS; (void)GO;
#define PHASE_END_R(R) if (ph + 1 < hi || rep_ + 1 < (R)) xcd_barrier(bar, tid_now(wave_s)); } ++ph;
#define PHASE_BEGIN PHASE_BEGIN_R(1)
#define PHASE_END PHASE_END_R(1)
#define WT_(l, off) ((bf16*)(ws_ + WS_WT + (size_t)(l) * WL_SIZE + (off)))

#define CONVERT_ITEM(it_, scr_, ln_) do { constexpr int I1 = 16 * 176, I2 = 44 * 32, I3 = 16 * 88, I4 = 16 * 32, I7 = 16, IL = 2 * I1 + 2 * I2 + I3 + I4 + I7; static_assert(IL == 10384, "item space"); \
        const int lw = (it_) / IL; int r = (it_) % IL; \
        if (r < I1) { transpose_item(INP(11) + (size_t)lw * 1024 * 5632, 5632, 1024, INP(10) + lw * 1024, WT_(lw, WL_W1), 1, 176, r, scr_, ln_); break; } r -= I1; \
        if (r < I2) { transpose_item(INP(12) + (size_t)lw * 2816 * 1024, 1024, 2816, nullptr, WT_(lw, WL_W2), 0, 32, r, scr_, ln_); break; } r -= I2; \
        if (r < I3) { transpose_item(INP(14) + (size_t)lw * 1024 * N_IN, N_IN, 1024, INP(13) + lw * 1024, WT_(lw, WL_W3), 2, 88, r, scr_, ln_); break; } r -= I3; \
        if (r < I4) { transpose_item(INP(27) + (size_t)lw * 1024 * 1024, 1024, 1024, nullptr, WT_(lw, WL_W4), 0, 32, r, scr_, ln_); break; } r -= I4; \
        if (r < I1) { transpose_item(INP(29) + (size_t)lw * 1024 * 5632, 5632, 1024, INP(28) + lw * 1024, WT_(lw, WL_W5), 1, 176, r, scr_, ln_); break; } r -= I1; \
        if (r < I2) { transpose_item(INP(30) + (size_t)lw * 2816 * 1024, 1024, 2816, nullptr, WT_(lw, WL_W6), 0, 32, r, scr_, ln_); break; } r -= I2; \
        transpose_item(INP(14) + (size_t)lw * 1024 * N_IN, N_IN, 1024, INP(13) + lw * 1024, WT_(lw, WL_W7), 3, 1, r, scr_, ln_); } while (0)
#define CONVERT_RANGE(lo_, hi_, gwv_, ngwv_) do { const int tn_ = tid_now(wave_s); const int lnr_ = tn_ & 63; LAS float* scrr_ = (LAS float*)((LAS unsigned char*)lds + wave_s * 16384); \
        for (int itr_ = (lo_) + (gwv_); itr_ < (hi_); itr_ += (ngwv_)) CONVERT_ITEM(itr_, scrr_, lnr_); } while (0)
    PHASE_BEGIN_R(R_P0)
        CONVERT_RANGE(0, 2816, gw, NGW);
        for (int i = blockIdx.x * 512 + tid; i < 2 * 12288; i += gridDim.x * 512) { const int j = i % 12288;
            if (i < 12288) { const int bh = j / 384, sl = (j % 384) >> 3, ch = j & 7; *(v4u*)(KF + ((size_t)bh * 2112 + 16 + sl) * 64 + ch * 8) = (v4u){0u, 0u, 0u, 0u}; }
            else { const int bh = j / 384, d = (j % 384) / 6, ch = j % 6; *(v4u*)(VT + ((size_t)bh * 64 + d) * 2112 + 16 + ch * 8) = (v4u){0u, 0u, 0u, 0u}; } }
        for (int r0 = gw * 2; r0 < M_PAD; r0 += NGW * 2) {
            float4 v[2][4];
#pragma unroll
            for (int q = 0; q < 2; ++q) { const int r = r0 + q;
                const float* src = r < MP ? INP(0) + (size_t)r * 1024 : r < R_META ? INP(1) + (size_t)(r - R_S) * 1024 : r < M_REAL ? INP(9) + (size_t)(r - R_META) * 1024 : nullptr;
#pragma unroll
                for (int j = 0; j < 4; ++j) v[q][j] = src ? ((const float4*)src)[lane + 64 * j] : make_float4(0.f, 0.f, 0.f, 0.f); }
#pragma unroll
            for (int q = 0; q < 2; ++q) { const int r = r0 + q;
                float4* o = (float4*)(X + (size_t)r * 1024) + lane; uint2* ob = (uint2*)(XB + (size_t)r * 1024) + lane; float s = 0.f;
#pragma unroll
                for (int j = 0; j < 4; ++j) { const float4 w = v[q][j]; if (r >= MP) o[64 * j] = w; ob[64 * j] = make_uint2(pk2(w.x, w.y), pk2(w.z, w.w)); s += (w.x * w.x + w.y * w.y) + (w.z * w.z + w.w * w.w); }
                s = wave_sum(s);
                if (lane < 16) SSQP[(size_t)r * 16 + lane] = lane == 0 ? s : 0.f;
                if (r >= M_REAL) { uint2* m = (uint2*)(MIXB + (size_t)r * 1024) + lane;
#pragma unroll
                    for (int j = 0; j < 4; ++j) m[64 * j] = make_uint2(0u, 0u); } }
        }
    PHASE_END_R(R_P0)

    for (int l = 0; l < DEPTH; ++l) {
#define mix_norm (INP(13) + l * 1024)
#define fox_q_norm (INP(15) + l * 64)
#define fox_k_norm (INP(16) + l * 64)
#define fox_f_bias (INP(17) + l * 4)
#define conv_w (INP(18) + l * 4 * 768)
#define conv_b (INP(19) + l * 768)
#define dt_bias (INP(20) + l * 8)
#define a_log (INP(21) + l * 8)
#define ssd_d (INP(22) + l * 8)
#define ssd_norm (INP(23) + l * 512)
#define w_gate (INP(24) + l * 16 * 128)
#define gate_bias (INP(25) + l * 128)
#define gla_norm (INP(26) + l * 64)
#define cache_k (INP(2))
#define cache_v (INP(3))
#define cache_lf (INP(4))
#define state_ssm (INP(5) + (size_t)l * DEC_BATCH * 8 * 4096)
#define state_conv (INP(6) + (size_t)l * DEC_BATCH * 3 * 768)
#define state_gla (INP(7) + (size_t)l * DEC_BATCH * 4 * 2048)
#define pt ((const int*)INP(8))
        for (int half = 0; half < 2; ++half) {
            PHASE_BEGIN_R(R_G1) { pg8::Gemm g{XB, WT_(l, half ? WL_W5 : WL_W1), M_PAD, 5632, 1024}; pg8::StaticOrder S; S.init(M_PAD, 5632, (int)gridDim.x, (int)blockIdx.x);
                pg8::EpiSwiglu E{HB, SSQP}; pg8::gemm_phase<pg8::EpiSwiglu, pg8::StaticOrder, true, true>((LAS unsigned char*)lds, g, S, E, tid);
                if (l == 0 && half == 0) {
                    if (gridDim.x == 256) { if (blockIdx.x >= 194) CONVERT_RANGE(2816, 4224, ((int)blockIdx.x - 194) * NWAVES + wave_s, 62 * NWAVES); }
                    else CONVERT_RANGE(2816, 4224, (int)blockIdx.x * NWAVES + wave_s, (int)gridDim.x * NWAVES); } } PHASE_END_R(R_G1)
            PHASE_BEGIN { pg8::Gemm g{HB, WT_(l, half ? WL_W6 : WL_W2), MP, 1024, 2816}; pg8::StaticOrder S; S.init(MP, 1024, (int)gridDim.x, (int)blockIdx.x);
                pg8::EpiResid E{(const GAS float*)nullptr, X, XB, SSQP, 0.5f, out, (l == DEPTH - 1 && half == 1) ? 1 : 0};     pg8::gemm_phase<pg8::EpiResid, pg8::StaticOrder, true, true>((LAS unsigned char*)lds, g, S, E, tid);
                eg::egemm_resid<2816, 8>(HB, WT_(l, half ? WL_W6 : WL_W2), X, XB, SSQP, 0.5f, out, (l == DEPTH - 1 && half == 1) ? 1 : 0, (LAS unsigned char*)lds, tid_now(wave_s));
                if (l == 0 && half == 0) {
                    if (gridDim.x == 256) { if (blockIdx.x >= 176) { CONVERT_RANGE(4224, 5632, ((int)blockIdx.x - 176) * NWAVES + wave_s, 80 * NWAVES); CONVERT_RANGE(10368, 10384, ((int)blockIdx.x - 176) * NWAVES + wave_s, 80 * NWAVES); } }
                    else { CONVERT_RANGE(4224, 5632, (int)blockIdx.x * NWAVES + wave_s, (int)gridDim.x * NWAVES); CONVERT_RANGE(10368, 10384, (int)blockIdx.x * NWAVES + wave_s, (int)gridDim.x * NWAVES); } }     } PHASE_END
            if (half == 1) break;

            PHASE_BEGIN_R(R_G3) { pg8::Gemm g{XB, WT_(l, WL_W3), M_PAD, N_MAIN, 1024}; pg8::StaticOrder S; S.init(M_PAD, N_MAIN, (int)gridDim.x, (int)blockIdx.x);
                pg8::EpiMix E{MI, MIB, SSQP, QF, KF, VT, fox_q_norm, fox_k_norm, fox_f_bias, LF, out, l}; pg8::gemm_phase<pg8::EpiMix, pg8::StaticOrder, true, true>((LAS unsigned char*)lds, g, S, E, tid);
                {
                    constexpr int NUS = (M_REAL + 31) / 32; int u0 = blockIdx.x, us = gridDim.x, ue = NUS;
                    if (gridDim.x == 256) { if (blockIdx.x >= 225) { u0 = (int)blockIdx.x - 225; us = 31; ue = 310; } else { u0 = 310 + (int)blockIdx.x; us = 1024; } }
                    sm::smalls_gemm(XB, WT_(l, WL_W7), SSQP, MI, LF, fox_f_bias, out, l, (LAS unsigned char*)lds, tid_now(wave_s), u0, us, ue); }
                if (l == 0) {
                    if (gridDim.x == 256) { if (blockIdx.x >= 225) CONVERT_RANGE(5632, 6144, ((int)blockIdx.x - 225) * NWAVES + wave_s, 31 * NWAVES); }
                    else CONVERT_RANGE(5632, 6144, (int)blockIdx.x * NWAVES + wave_s, (int)gridDim.x * NWAVES); } } PHASE_END_R(R_G3)
            PHASE_BEGIN
            {
                typedef float f4v __attribute__((ext_vector_type(4)));
                LAS float* lrs = (LAS float*)((LAS unsigned char*)lds + wave * 1024);
                for (int blk = gw; blk < (NGW == 2048 ? 2048 : 2048 + 2); blk += NGW) {
                    const bool isP = blk < 2048; const int bb = blk >> 8, i0 = isP ? 8 * (blk & 255) : 8 * (blk - 2048);
                    const int rowb = isP ? bb * 2048 + i0 : R_META + i0;
                    f4v u[3][11];
#pragma unroll
                    for (int j = 0; j < 11; ++j) { const int i = i0 + j - 3; int pr;
                        if (isP) pr = i >= 0 ? bb * 2048 + i : R_META + 16 + i; else pr = i >= 0 ? R_META + i : -1;
#pragma unroll
                        for (int k = 0; k < 3; ++k) { const uint2 w = *(const uint2*)(MIB + (size_t)(pr >= 0 ? pr : 0) * N_MAIN + CM_XBC + 4 * (lane + 64 * k));
                            const f4v v = (f4v){__uint_as_float(w.x << 16), __uint_as_float(w.x & 0xffff0000u), __uint_as_float(w.y << 16), __uint_as_float(w.y & 0xffff0000u)}; u[k][j] = pr >= 0 ? v : (f4v){0.f, 0.f, 0.f, 0.f}; } }
                    const f4v lrv = lane < 32 ? *(const f4v*)(MI + (size_t)(rowb + (lane >> 2)) * LDMI + C_LR + 4 * (lane & 3)) : (f4v){0.f, 0.f, 0.f, 0.f};
                    const float dtr = MI[(size_t)(rowb + (lane >> 3)) * LDMI + C_DT + (lane & 7)];
                    if (lane < 32) *(LAS f4v*)(lrs + (lane >> 2) * 16 + 4 * (lane & 3)) = lrv;
                    DTB[(size_t)(rowb + (lane >> 3)) * 8 + (lane & 7)] = softplusf(dtr + dt_bias[lane & 7]);
#pragma unroll
                    for (int k = 0; k < 3; ++k) { const int col = 4 * (lane + 64 * k);
                        const f4v w0 = *(const f4v*)(conv_w + col), w1 = *(const f4v*)(conv_w + 768 + col), w2 = *(const f4v*)(conv_w + 2 * 768 + col), w3 = *(const f4v*)(conv_w + 3 * 768 + col), bs = *(const f4v*)(conv_b + col);
#pragma unroll
                        for (int j = 0; j < 8; ++j) { const f4v o = w3 * u[k][j + 3] + w2 * u[k][j + 2] + w1 * u[k][j + 1] + w0 * u[k][j] + bs;
                            *(uint2*)(XC + (size_t)(rowb + j) * 768 + col) = make_uint2(fa::cvtpk(pg8::silu_fast(o[0]), pg8::silu_fast(o[1])), fa::cvtpk(pg8::silu_fast(o[2]), pg8::silu_fast(o[3]))); } }
                    LDS_WAIT();
                    float wc0[16], wc1[16];
#pragma unroll
                    for (int r = 0; r < 16; ++r) { wc0[r] = w_gate[r * 128 + lane]; wc1[r] = w_gate[r * 128 + 64 + lane]; }
                    const float gb0 = gate_bias[lane], gb1 = gate_bias[64 + lane];
#pragma unroll
                    for (int j = 0; j < 8; ++j) { float a0 = gb0, a1 = gb1;
#pragma unroll
                        for (int r4 = 0; r4 < 4; ++r4) { const f4v x = *(const LAS f4v*)(lrs + j * 16 + 4 * r4);
                            a0 += x[0] * wc0[4 * r4] + x[1] * wc0[4 * r4 + 1] + x[2] * wc0[4 * r4 + 2] + x[3] * wc0[4 * r4 + 3]; a1 += x[0] * wc1[4 * r4] + x[1] * wc1[4 * r4 + 1] + x[2] * wc1[4 * r4 + 2] + x[3] * wc1[4 * r4 + 3]; }
                        GLOG[(size_t)(rowb + j) * 128 + lane] = (fminf(a0, 0.f) - __logf(1.0f + __expf(-fabsf(a0)))) * (1.0f / 16.0f);
                        GLOG[(size_t)(rowb + j) * 128 + 64 + lane] = (fminf(a1, 0.f) - __logf(1.0f + __expf(-fabsf(a1)))) * (1.0f / 16.0f); }
                    LDS_WAIT();
                }
                if (NGW == 2048 && gw < 16) {
                    const int m = gw, row = R_META + m;
                    f4v um[3][4];
#pragma unroll
                    for (int j = 0; j < 4; ++j) { const int i = m + j - 3;
#pragma unroll
                        for (int k = 0; k < 3; ++k) { const uint2 w = *(const uint2*)(MIB + (size_t)(R_META + (i >= 0 ? i : 0)) * N_MAIN + CM_XBC + 4 * (lane + 64 * k));
                            const f4v v = (f4v){__uint_as_float(w.x << 16), __uint_as_float(w.x & 0xffff0000u), __uint_as_float(w.y << 16), __uint_as_float(w.y & 0xffff0000u)}; um[k][j] = i >= 0 ? v : (f4v){0.f, 0.f, 0.f, 0.f}; } }
                    if (lane < 8) DTB[(size_t)row * 8 + lane] = softplusf(MI[(size_t)row * LDMI + C_DT + lane] + dt_bias[lane]);
#pragma unroll
                    for (int k = 0; k < 3; ++k) { const int col = 4 * (lane + 64 * k);
                        const f4v w0 = *(const f4v*)(conv_w + col), w1 = *(const f4v*)(conv_w + 768 + col), w2 = *(const f4v*)(conv_w + 2 * 768 + col), w3 = *(const f4v*)(conv_w + 3 * 768 + col), bs = *(const f4v*)(conv_b + col);
                        const f4v o = w3 * um[k][3] + w2 * um[k][2] + w1 * um[k][1] + w0 * um[k][0] + bs;
                        *(uint2*)(XC + (size_t)row * 768 + col) = make_uint2(fa::cvtpk(pg8::silu_fast(o[0]), pg8::silu_fast(o[1])), fa::cvtpk(pg8::silu_fast(o[2]), pg8::silu_fast(o[3]))); }
                    float a0 = gate_bias[lane], a1 = gate_bias[64 + lane];
#pragma unroll
                    for (int r = 0; r < 16; ++r) { const float x = MI[(size_t)row * LDMI + C_LR + r]; a0 += x * w_gate[r * 128 + lane]; a1 += x * w_gate[r * 128 + 64 + lane]; }
                    GLOG[(size_t)row * 128 + lane] = (fminf(a0, 0.f) - __logf(1.0f + __expf(-fabsf(a0)))) * (1.0f / 16.0f);
                    GLOG[(size_t)row * 128 + 64 + lane] = (fminf(a1, 0.f) - __logf(1.0f + __expf(-fabsf(a1)))) * (1.0f / 16.0f);
                }
            }
            PHASE_END
            PHASE_BEGIN_R(R_MIX)
            {
                volatile LAS unsigned* qslot = (volatile LAS unsigned*)((LAS unsigned char*)lds + MISC_OFF + 64);
                unsigned* qhead = (unsigned*)(ws_ + WS_CTL) + CW_Q + 64 * l + 8 * rep_;
                constexpr int U_SSDP = 0, U_GLAP = 64, U_SAMP = 96, U_PATT = 224, U_META = 480, U_END = 481;
                for (;;) {
                    __syncthreads();
                    if (tid == 0) *qslot = atomicAdd(qhead, 1u);
                    __syncthreads();
                    const int u = (int)*qslot;
                    constexpr int N_CVU = (14608 + 15) / 16;
                    if (u >= U_END) {
                        if (l != 0 || u >= U_END + N_CVU) break;
                        const int j = 16 * (u - U_END) + 2 * wave_s; LAS float* scrq_ = (LAS float*)((LAS unsigned char*)lds + wave_s * 16384); const int lnq_ = tid_now(wave_s) & 63;
                        for (int e = 0; e < 2; ++e) { const int jj = j + e; if (jj < 14608) { const int itq_ = jj < 4224 ? 6144 + jj : 10384 + (jj - 4224); CONVERT_ITEM(itq_, scrq_, lnq_); } }
                        continue;
                    }
                    int tidu = tid; asm volatile("" : "+v"(tidu));
                    if (u < U_GLAP) {
                        const int b = u >> 3, h = u & 7;
                        la::ssd_prompt_unit(b, h, (const GAS bf16*)MIB, (const GAS bf16*)XC, (const GAS float*)DTB, -expf(a_log[h]), ssd_d[h], (GAS bf16*)MIXB, (GAS float*)SSQH, (GAS float*)(out + O_SSMP + ((size_t)(l * BATCH + b) * 8 + h) * 4096), (LAS unsigned char*)lds, tidu);
                    } else if (u < U_SAMP) {
                        const int b = (u - U_GLAP) >> 2, h = (u - U_GLAP) & 3;
                        la::gla_prompt_unit(b, h, (const GAS bf16*)MIB, (const GAS float*)GLOG, (const GAS float*)gla_norm, (GAS bf16*)MIXB, (GAS float*)(out + O_GLAP + ((size_t)(l * BATCH + b) * 4 + h) * 2048), (LAS unsigned char*)lds, tidu);
                    } else if (u < U_META) {
                        const int k = u - U_SAMP;
                        const int su = k < 64 ? k : ((k >= 160 && k < 224) ? k - 96 : -1);
                        if (su >= 0) {
                            eu::sample_unit(su, l, MI, cache_k, cache_v, cache_lf, pt, state_ssm, state_conv, state_gla, fox_q_norm, fox_k_norm, fox_f_bias, conv_w, conv_b, dt_bias, a_log, ssd_d, ssd_norm,
                                            w_gate, gate_bias, gla_norm, MIXB, out, (LAS unsigned char*)lds, tidu);
                        } else {
                            const int j = k < 160 ? k - 64 : k - 128; fa::fox_prompt_unit((j & 31) >> 2, j & 3, 7 - (j >> 5), QF, KF, VT, LF, MIXB, (LAS unsigned char*)lds, tidu);
                        }
                    } else {
                        eu::meta_unit(MI, fox_q_norm, fox_k_norm, fox_f_bias, MIXB, (LAS unsigned char*)lds, tidu);
                    }
                }
            }
            PHASE_END_R(R_MIX)
            PHASE_BEGIN
                { const float4 gn0 = *(const float4*)(ssd_norm + lane * 4), gn1 = *(const float4*)(ssd_norm + 256 + lane * 4);
                for (int i0 = gw * 4; i0 < MP + 16; i0 += NGW * 4) {
                    const int r0 = i0 < MP ? i0 : i0 + (R_META - MP);
                    uint2 w[4][2]; float4 q[4][2];
#pragma unroll
                    for (int j = 0; j < 4; ++j) { const size_t r = (size_t)(r0 + j);
                        q[j][0] = *(const float4*)(SSQH + r * 8); q[j][1] = *(const float4*)(SSQH + r * 8 + 4);
                        w[j][0] = *(const uint2*)(MIXB + r * 1024 + 256 + lane * 4); w[j][1] = *(const uint2*)(MIXB + r * 1024 + 512 + lane * 4); }
#pragma unroll
                    for (int j = 0; j < 4; ++j) { const size_t r = (size_t)(r0 + j);
#pragma unroll
                        for (int g = 0; g < 2; ++g) { const float4 qq = q[j][g]; const float rs = rsqrtf((qq.x + qq.y + qq.z + qq.w) * (1.f / 256.f) + EPS); const float4 gn = g ? gn1 : gn0; const uint2 ww = w[j][g];
                            const float y0 = __uint_as_float(ww.x << 16) * rs * gn.x, y1 = __uint_as_float(ww.x & 0xffff0000u) * rs * gn.y, y2 = __uint_as_float(ww.y << 16) * rs * gn.z, y3 = __uint_as_float(ww.y & 0xffff0000u) * rs * gn.w;
                            *(uint2*)(MIXB + r * 1024 + 256 + g * 256 + lane * 4) = make_uint2(pk2(y0, y1), pk2(y2, y3)); } }
                } }
            PHASE_END
            PHASE_BEGIN { pg8::Gemm g{MIXB, WT_(l, WL_W4), MP, 1024, 1024}; pg8::StaticOrder S; S.init(MP, 1024, (int)gridDim.x, (int)blockIdx.x);
                pg8::EpiResid E{(const GAS float*)nullptr, X, XB, SSQP, 1.0f, out, 0}; pg8::gemm_phase<pg8::EpiResid, pg8::StaticOrder, true, true>((LAS unsigned char*)lds, g, S, E, tid);
                eg::egemm_resid<1024, 8>(MIXB, WT_(l, WL_W4), X, XB, SSQP, 1.0f, out, 0, (LAS unsigned char*)lds, tid_now(wave_s)); } PHASE_END
        }
    }
}

extern "C" void kernel_launch(void* const* d_in, const int* in_sizes, int n_in, void* d_out, int out_size, void* d_ws, size_t ws_size, hipStream_t stream) {
    static int grid = 0;
    if (grid == 0) {
        if (n_in != 31 || out_size != (int)O_END || ws_size < WS_END) { fprintf(stderr, "kernel_launch: unexpected sizes n_in %d out %d ws %zu (need %zu)\n", n_in, out_size, ws_size, (size_t)WS_END); grid = -1; return; }
        int dev = 0, cus = 0;
        if (hipGetDevice(&dev) != hipSuccess || hipDeviceGetAttribute(&cus, hipDeviceAttributeMultiprocessorCount, dev) != hipSuccess) { grid = -1; return; }
        if (hipFuncSetAttribute((const void*)fwd, hipFuncAttributeMaxDynamicSharedMemorySize, LDS_BYTES) != hipSuccess) { fprintf(stderr, "kernel_launch: hipFuncSetAttribute failed\n"); grid = -1; return; }
        (void)hipGetLastError();
        grid = cus;
    }
    if (grid < 0) return;
    (void)hipMemsetAsync((char*)d_ws + WS_CTL, 0, CTL_ZERO_BYTES, stream);
    Args a{};
    for (int i = 0; i < 31; ++i) a.in[i] = (const float*)d_in[i];
    a.out = (float*)d_out; a.ws = (unsigned char*)d_ws; a.ph_lo = 0; a.ph_hi = 1000;
    hipLaunchKernelGGL(fwd, dim3(grid), dim3(NWAVES * 64), LDS_BYTES, stream, a);
}
```

```cpp
#include <hip/hip_runtime.h>
#include <cstdio>
#include <cstdint>

constexpr int D_MODEL = 1024, BATCH = 8, SEQ = 2048, DEPTH = 2, DEC_BATCH = 128, DEC_SEQ = 4, PAST = 2048, PAGE = 128, NPAGES = 16, NPOOL = 2560;
constexpr int N_META = 16, TP = N_META + SEQ;
constexpr int D_FF = 2816;
constexpr float EPS = 1e-6f;
constexpr int N_IN = 2844, LDMI = 2848;
constexpr int C_FQ = 0, C_FK = 256, C_FV = 512, C_FF = 768, C_SZ = 772, C_XBC = 1284, C_DT = 2052, C_GQ = 2060, C_GK = 2188, C_GV = 2316, C_LR = 2572, C_GG = 2588;
constexpr int N_MAIN = 2816, CM_SZ = 768, CM_XBC = 1280, CM_GQ = 2048, CM_GK = 2176, CM_GV = 2304, CM_GG = 2560;
__host__ __device__ constexpr int main2ref(int c) { return c < 768 ? c : (c < 2048 ? c + 4 : (c < 2560 ? c + 12 : c + 28)); }
__host__ __device__ constexpr int small2ref(int j) { return j < 4 ? C_FF + j : (j < 12 ? C_DT + (j - 4) : (j < 28 ? C_LR + (j - 12) : -1)); }
constexpr int MP = BATCH * SEQ, MS = DEC_BATCH * DEC_SEQ, R_S = MP, R_META = MP + MS, M_REAL = R_META + N_META, M_PAD = 17152;
constexpr size_t O_YP = 0;
constexpr size_t O_YS = O_YP + (size_t)BATCH * SEQ * D_MODEL;
constexpr size_t O_KP = O_YS + (size_t)MS * D_MODEL;
constexpr size_t O_VP = O_KP + (size_t)DEPTH * BATCH * TP * 256;
constexpr size_t O_LFP = O_VP + (size_t)DEPTH * BATCH * TP * 256;
constexpr size_t O_SSMP = O_LFP + (size_t)DEPTH * BATCH * TP * 4;
constexpr size_t O_CONVP = O_SSMP + (size_t)DEPTH * BATCH * 8 * 64 * 64;
constexpr size_t O_GLAP = O_CONVP + (size_t)DEPTH * BATCH * 3 * 768;
constexpr size_t O_KS = O_GLAP + (size_t)DEPTH * BATCH * 4 * 32 * 64;
constexpr size_t O_VS = O_KS + (size_t)DEPTH * MS * 256;
constexpr size_t O_LFS = O_VS + (size_t)DEPTH * MS * 256;
constexpr size_t O_SSMS = O_LFS + (size_t)DEPTH * MS * 4;
constexpr size_t O_CONVS = O_SSMS + (size_t)DEPTH * DEC_BATCH * 8 * 64 * 64;
constexpr size_t O_GLAS = O_CONVS + (size_t)DEPTH * DEC_BATCH * 3 * 768;
constexpr size_t O_END = O_GLAS + (size_t)DEPTH * DEC_BATCH * 4 * 32 * 64;
static_assert(O_END == 46638080, "output size");

constexpr size_t MiB = 1u << 20;
constexpr size_t WS_CTL = 0, CTL_ZERO_BYTES = 1 * MiB;
constexpr size_t SZ_W1 = (size_t)5632 * 1024 * 2, SZ_W2 = (size_t)1024 * 2816 * 2, SZ_W3 = (size_t)2816 * 1024 * 2, SZ_W7 = (size_t)32 * 1024 * 2, SZ_W4 = (size_t)1024 * 1024 * 2;
constexpr size_t WL_W1 = 0, WL_W2 = WL_W1 + SZ_W1, WL_W3 = WL_W2 + SZ_W2, WL_W4 = WL_W3 + SZ_W3, WL_W5 = WL_W4 + SZ_W4, WL_W6 = WL_W5 + SZ_W1, WL_W7 = WL_W6 + SZ_W2, WL_SIZE = WL_W7 + SZ_W7;
constexpr size_t WS_WT = 2 * MiB;
constexpr size_t WS_X = WS_WT + 2 * WL_SIZE;
constexpr size_t WS_XB = WS_X + (size_t)M_PAD * 1024 * 4;
constexpr size_t WS_SSQ = WS_XB + (size_t)M_PAD * 1024 * 2;
constexpr size_t WS_HB = WS_SSQ + (size_t)M_PAD * 16 * 4;
constexpr size_t WS_MIXB = WS_HB + (size_t)M_PAD * 2816 * 2;
constexpr size_t WS_MI = WS_MIXB + (size_t)M_PAD * 1024 * 2;
constexpr size_t WS_QN = WS_MI + (size_t)M_PAD * LDMI * 4;
constexpr size_t WS_KN = WS_QN + (size_t)M_PAD * 256 * 4;
constexpr size_t WS_LF = WS_KN + (size_t)M_PAD * 256 * 4;
constexpr size_t WS_FC = WS_LF + (size_t)M_PAD * 4 * 4;
constexpr size_t WS_FCS = WS_FC + (size_t)M_PAD * 4 * 4;
constexpr size_t WS_XBC = WS_FCS + (size_t)128 * 4 * 2052 * 4 + 4096;
constexpr size_t WS_DT = WS_XBC + (size_t)M_PAD * 768 * 4;
constexpr size_t WS_GLOG = WS_DT + (size_t)M_PAD * 8 * 4;
constexpr size_t WS_YS = WS_GLOG + (size_t)M_PAD * 128 * 4;
constexpr size_t WS_GO = WS_YS + (size_t)M_PAD * 512 * 4;
constexpr size_t WS_QF = WS_GO + (size_t)M_PAD * 256 * 4;
constexpr size_t WS_KF = WS_QF + (size_t)32 * 2048 * 64 * 2;
constexpr size_t WS_VT = WS_KF + (size_t)32 * 2112 * 64 * 2;
constexpr size_t WS_SSQH = WS_VT + (size_t)32 * 2112 * 64 * 2;
constexpr size_t WS_XC = WS_SSQH + (size_t)M_PAD * 8 * 4;
constexpr size_t WS_MIB = WS_XC + (size_t)M_PAD * 768 * 2;
constexpr size_t WS_END = WS_MIB + (size_t)M_PAD * LDMI * 2;
static_assert(WS_X % 256 == 0 && WS_XB % 256 == 0 && WS_SSQ % 256 == 0 && WS_HB % 256 == 0 && WS_MIXB % 256 == 0 && WS_MI % 256 == 0, "alignment");

#ifndef R_P0
#define R_P0 1
#endif
#ifndef R_G1
#define R_G1 1
#endif
#ifndef R_G3
#define R_G3 1
#endif
#ifndef R_PREP
#define R_PREP 1
#endif
#ifndef R_MIX
#define R_MIX 1
#endif
#ifndef R_BAR
#define R_BAR 0
#endif
constexpr int CW_BAR = 4096, CW_Q = 8192;
constexpr int NWAVES = 8;
constexpr int LDS_BYTES = 147456;
constexpr int MISC_OFF = 131072 + 320;

#define LAS __attribute__((address_space(3)))
#define GAS __attribute__((address_space(1)))
#define LDS_WAIT() asm volatile("s_waitcnt lgkmcnt(0)" ::: "memory")
typedef unsigned short bf16;
typedef unsigned v4u __attribute__((ext_vector_type(4)));
__device__ __forceinline__ unsigned f2bf(float f) { unsigned u = __builtin_bit_cast(unsigned, f); return (u + 0x7fffu + ((u >> 16) & 1u)) >> 16; }
__device__ __forceinline__ unsigned pk2(float lo, float hi) { return f2bf(lo) | (f2bf(hi) << 16); }

__device__ __forceinline__ float bperm(float x, int srclane);
namespace pg8 {
#define PG8_LAS __attribute__((address_space(3)))
typedef unsigned short bf16_t;
typedef short bf16x8 __attribute__((ext_vector_type(8)));
typedef float f32x4 __attribute__((ext_vector_type(4)));
typedef unsigned u32x4 __attribute__((ext_vector_type(4)));
constexpr int BM = 256, BK = 64, HALF = 128, HTB = HALF * BK * 2  , STAGE_BYTES = 8 * HTB, NXCD = 8, WGM = 8;

__host__ __device__ __forceinline__ int lds_byte(int r, int c) { const int st = (r >> 4) * 2 + (c >> 5), rr = r & 15, cc = c & 31, ob = rr * 64 + cc * 2; return st * 1024 + (ob ^ (((ob >> 9) & 1) << 5)); }
__host__ __device__ __forceinline__ void stage_rc(int b, int& R, int& C) { const int st = b / 1024, sb = b % 1024, swz = sb ^ (((sb >> 9) & 1) << 5); R = (st >> 1) * 16 + swz / 64; C = (st & 1) * 32 + (swz % 64) / 2; }
__host__ __device__ __forceinline__ int perm32(int rho) { const int n = rho >> 4, i = rho & 15; return 8 * (i >> 2) + 4 * n + (i & 3); }

struct Unit { int pm, pn; };
struct Gemm { const bf16_t* A; const bf16_t* Bt; int M, N, K; };

struct StaticOrder {
    int nM, nN, nwg, G, c;
    __host__ __device__ void init(int M, int N, int G_, int c_) { nM = M / BM; nN = N / BM; nwg = nM * nN; G = G_; c = c_; }
    __host__ __device__ bool next(int i, Unit& u) const {
        const long L = (long)i * G + c; if (L >= nwg) return false;
        int wgid = (int)L; { const int q = nwg / NXCD, r = nwg % NXCD, xcd = wgid % NXCD, off = wgid / NXCD; wgid = (xcd < r ? xcd * (q + 1) : r * (q + 1) + (xcd - r) * q) + off; }
        const int nig = WGM * nN, gid = wgid / nig, fm = gid * WGM, gsz = (nM - fm) < WGM ? (nM - fm) : WGM;
        u.pm = fm + ((wgid % nig) % gsz); u.pn = (wgid % nig) / gsz; return true;
    }
    __device__ __forceinline__ void a_ready(const Unit&) const {}
    __device__ __forceinline__ void done(const Unit&) const {}
};

__device__ __forceinline__ unsigned cvt_pk_bf16(float lo, float hi) { unsigned r; asm volatile("v_cvt_pk_bf16_f32 %0, %1, %2" : "=v"(r) : "v"(lo), "v"(hi)); return r; }
typedef float f32x2 __attribute__((ext_vector_type(2)));
__device__ __forceinline__ f32x2 gelu_pk(f32x2 v) {
    const f32x2 av = __builtin_elementwise_abs(v), d = av * 0.2316418882f + 1.0f;
    f32x2 t; t.x = __builtin_amdgcn_rcpf(d.x); t.y = __builtin_amdgcn_rcpf(d.y);
    f32x2 q = t * 0.5307027145f + (-0.7265760135f); q = q * t + 0.7107068705f; q = q * t + (-0.142248368f); q = q * t + 0.127414796f; q = q * t;
    const f32x2 s = (v * v) * (-0.72134752044f);
    f32x2 e; e.x = __builtin_amdgcn_exp2f(s.x); e.y = __builtin_amdgcn_exp2f(s.y);
    const f32x2 m = v * (q * e), r = v - m;
    f32x2 o; o.x = v.x < 0.f ? m.x : r.x; o.y = v.y < 0.f ? m.y : r.y; return o;
}


__device__ __forceinline__ float rstd_of(const float* SSQP, int row) {
    const f32x4* p = (const f32x4*)(SSQP + (size_t)row * 16);
    const f32x4 a = p[0], b = p[1], c = p[2], d = p[3];
    const float s = ((a[0] + a[1]) + (a[2] + a[3])) + ((b[0] + b[1]) + (b[2] + b[3])) + ((c[0] + c[1]) + (c[2] + c[3])) + ((d[0] + d[1]) + (d[2] + d[3]));
    return __builtin_amdgcn_rsqf(s * (1.0f / 1024.0f) + 1e-6f);
}
__device__ __forceinline__ float silu_fast(float x) { return x * __builtin_amdgcn_rcpf(1.0f + __expf(-x)); }
struct EpiSwiglu {
    static constexpr bool PERM = true, AFTER_DRAIN = false;
    bf16_t* H; const float* SSQP;
    __device__ __forceinline__ void operator()(const f32x4 (&acc)[2][2][4][2], const Unit& u, int wr, int wc, int fr, int fq) const {
        const int row0 = u.pm * BM + wr * 64 + fr, col0 = u.pn * 128 + wc * 32 + 8 * fq;
#pragma unroll
        for (int ai = 0; ai < 2; ++ai)
#pragma unroll
            for (int m = 0; m < 4; ++m) { const int row = row0 + ai * HALF + m * 16; const float rs = rstd_of(SSQP, row);
                const f32x4 g0 = acc[ai][0][m][0], g1 = acc[ai][0][m][1], u0 = acc[ai][1][m][0], u1 = acc[ai][1][m][1]; const float rs2 = rs * rs;
#define SWG(g, u) (silu_fast((g) * rs) * (u) * rs)
                u32x4 w; w.x = cvt_pk_bf16(SWG(g0[0], u0[0]), SWG(g0[1], u0[1])); w.y = cvt_pk_bf16(SWG(g0[2], u0[2]), SWG(g0[3], u0[3]));
                w.z = cvt_pk_bf16(SWG(g1[0], u1[0]), SWG(g1[1], u1[1])); w.w = cvt_pk_bf16(SWG(g1[2], u1[2]), SWG(g1[3], u1[3])); (void)rs2;
#undef SWG
                *(u32x4*)(H + (size_t)row * 2816 + col0) = w; }
    }
};
struct EpiResid {
    static constexpr bool PERM = true, AFTER_DRAIN = false;
    const GAS float* Xin; float* X; bf16_t* XB; float* SSQP; float scale; float* out; int final_;
    __device__ __forceinline__ void operator()(const f32x4 (&acc)[2][2][4][2], const Unit& u, int wr, int wc, int fr, int fq) const {
        const int row0 = u.pm * BM + wr * 64 + fr;
#pragma unroll
        for (int ai = 0; ai < 2; ++ai)
#pragma unroll
            for (int m = 0; m < 4; ++m) { const int row = row0 + ai * HALF + m * 16; float ss = 0.f;
#pragma unroll
                for (int bj = 0; bj < 2; ++bj) { const int col = u.pn * BM + bj * HALF + wc * 32 + 8 * fq;
                    const f32x4 a0 = acc[ai][bj][m][0], a1 = acc[ai][bj][m][1]; f32x4 x0, x1;
                    if (Xin) { const GAS f32x4* xi = (const GAS f32x4*)(Xin + (size_t)row * 1024 + col); x0 = xi[0]; x1 = xi[1]; }
                    else { const u32x4 wb = *(const u32x4*)(XB + (size_t)row * 1024 + col);
                        x0[0] = __uint_as_float(wb.x << 16); x0[1] = __uint_as_float(wb.x & 0xffff0000u); x0[2] = __uint_as_float(wb.y << 16); x0[3] = __uint_as_float(wb.y & 0xffff0000u);
                        x1[0] = __uint_as_float(wb.z << 16); x1[1] = __uint_as_float(wb.z & 0xffff0000u); x1[2] = __uint_as_float(wb.w << 16); x1[3] = __uint_as_float(wb.w & 0xffff0000u); }
                    x0[0] += a0[0] * scale; x0[1] += a0[1] * scale; x0[2] += a0[2] * scale; x0[3] += a0[3] * scale; x1[0] += a1[0] * scale; x1[1] += a1[1] * scale; x1[2] += a1[2] * scale; x1[3] += a1[3] * scale;
                    if (!final_) {
                    u32x4 w; w.x = cvt_pk_bf16(x0[0], x0[1]); w.y = cvt_pk_bf16(x0[2], x0[3]); w.z = cvt_pk_bf16(x1[0], x1[1]); w.w = cvt_pk_bf16(x1[2], x1[3]);
                    *(u32x4*)(XB + (size_t)row * 1024 + col) = w;
                    ss += (x0[0] * x0[0] + x0[1] * x0[1]) + (x0[2] * x0[2] + x0[3] * x0[3]) + (x1[0] * x1[0] + x1[1] * x1[1]) + (x1[2] * x1[2] + x1[3] * x1[3]); }
                    if (final_) { float* o = nullptr; if (row < MP) o = out + O_YP + (size_t)row * 1024 + col; else if (row < R_META) o = out + O_YS + (size_t)(row - R_S) * 1024 + col;
                        if (o) { ((f32x4*)o)[0] = x0; ((f32x4*)o)[1] = x1; } } }
                ss += bperm(ss, (fq * 16 + fr) ^ 16); ss += bperm(ss, (fq * 16 + fr) ^ 32);
                if (fq == 0 && !final_) SSQP[(size_t)row * 16 + u.pn * 4 + wc] = ss; }
    }
};
struct EpiMix {
    static constexpr bool PERM = true, AFTER_DRAIN = false;
    float* MI; bf16_t* MIB; const float* SSQP; bf16_t* QF; bf16_t* KF; bf16_t* VT; const float* qg; const float* kg; const float* fbias; float* LF; float* out; int l;
    __device__ __forceinline__ void operator()(const f32x4 (&acc)[2][2][4][2], const Unit& u, int wr, int wc, int fr_, int fq_) const {
        int ln_; asm volatile("v_mbcnt_lo_u32_b32 %0, -1, 0\n\tv_mbcnt_hi_u32_b32 %0, -1, %0" : "=v"(ln_)); const int fr = ln_ & 15, fq = ln_ >> 4; (void)fr_; (void)fq_;
        const int row0 = u.pm * BM + wr * 64 + fr;
        if (u.pn < 3) {
            f32x4 gn[2][2];
            const float* gp = u.pn == 0 ? qg : kg;
#pragma unroll
            for (int bj = 0; bj < 2; ++bj)
#pragma unroll
                for (int n = 0; n < 2; ++n) gn[bj][n] = u.pn < 2 ? *(const f32x4*)(gp + 32 * bj + 8 * fq + 4 * n) : (f32x4){1.f, 1.f, 1.f, 1.f};
            const float qs = u.pn == 0 ? 0.18033688011112042f : 1.0f;
#pragma unroll
            for (int ai = 0; ai < 2; ++ai)
#pragma unroll
                for (int m = 0; m < 4; ++m) { const int row = row0 + ai * HALF + m * 16; const float rs = rstd_of(SSQP, row);
                    float v[2][8]; float ss = 0.f;
#pragma unroll
                    for (int bj = 0; bj < 2; ++bj) { const f32x4 a0 = acc[ai][bj][m][0], a1 = acc[ai][bj][m][1];
                        v[bj][0] = a0[0] * rs; v[bj][1] = a0[1] * rs; v[bj][2] = a0[2] * rs; v[bj][3] = a0[3] * rs; v[bj][4] = a1[0] * rs; v[bj][5] = a1[1] * rs; v[bj][6] = a1[2] * rs; v[bj][7] = a1[3] * rs;
                        if (row >= MP) { f32x4* o = (f32x4*)(MI + (size_t)row * LDMI + u.pn * 256 + wc * 64 + bj * 32 + 8 * fq);
                            o[0] = (f32x4){v[bj][0], v[bj][1], v[bj][2], v[bj][3]}; o[1] = (f32x4){v[bj][4], v[bj][5], v[bj][6], v[bj][7]}; }
#pragma unroll
                        for (int e = 0; e < 8; ++e) ss += v[bj][e] * v[bj][e]; }
                    if (u.pn < 2) { ss += bperm(ss, (fq * 16 + fr) ^ 16); ss += bperm(ss, (fq * 16 + fr) ^ 32); const float hn = __builtin_amdgcn_rsqf(ss * (1.0f / 64.0f) + 1e-6f) * qs;
#pragma unroll
                        for (int bj = 0; bj < 2; ++bj)
#pragma unroll
                            for (int e = 0; e < 8; ++e) v[bj][e] *= hn * gn[bj][e >> 2][e & 3]; }
                    const bool isP = row < MP, isM = row >= R_META && row < M_REAL;
                    if (u.pn > 0 && row < M_REAL) {
                        float* ob; int nc = 1; size_t cs_ = 0;
                        if (isP) ob = out + (u.pn == 1 ? O_KP : O_VP) + ((size_t)(l * BATCH + (row >> 11)) * TP + 16 + (row & 2047)) * 256;
                        else if (isM) { ob = out + (u.pn == 1 ? O_KP : O_VP) + ((size_t)(l * BATCH) * TP + (row - R_META)) * 256; nc = BATCH; cs_ = (size_t)TP * 256; }
                        else ob = out + (u.pn == 1 ? O_KS : O_VS) + ((size_t)l * MS + (row - R_S)) * 256;
                        for (int c = 0; c < nc; ++c)
#pragma unroll
                            for (int bj = 0; bj < 2; ++bj) { f32x4* o = (f32x4*)(ob + c * cs_ + wc * 64 + bj * 32 + 8 * fq);
                                o[0] = (f32x4){v[bj][0], v[bj][1], v[bj][2], v[bj][3]}; o[1] = (f32x4){v[bj][4], v[bj][5], v[bj][6], v[bj][7]}; }
                    }
                    if (isP || (isM && u.pn > 0)) {
                        const int b0 = isP ? (row >> 11) : 0, nb = isP ? 1 : 8, slot = isP ? 64 + (row & 2047) : row - R_META;
                        for (int bb = b0; bb < b0 + nb; ++bb) { const int bh = bb * 4 + wc;
                            if (u.pn < 2) {
                                bf16_t* dst = u.pn == 0 ? QF + ((size_t)bh * 2048 + (row & 2047)) * 64 : KF + ((size_t)bh * 2112 + slot) * 64;
#pragma unroll
                                for (int bj = 0; bj < 2; ++bj) { u32x4 w; w.x = cvt_pk_bf16(v[bj][0], v[bj][1]); w.y = cvt_pk_bf16(v[bj][2], v[bj][3]); w.z = cvt_pk_bf16(v[bj][4], v[bj][5]); w.w = cvt_pk_bf16(v[bj][6], v[bj][7]);
                                    *(u32x4*)(dst + 32 * bj + 8 * fq) = w; }
                            } else {
#pragma unroll
                                for (int bj = 0; bj < 2; ++bj)
#pragma unroll
                                    for (int e = 0; e < 8; e += 2) { const unsigned w = cvt_pk_bf16(v[bj][e], v[bj][e + 1]); const int d = 32 * bj + 8 * fq + e;
                                        VT[((size_t)bh * 64 + d) * 2112 + slot] = (bf16_t)(w & 0xffffu); VT[((size_t)bh * 64 + d + 1) * 2112 + slot] = (bf16_t)(w >> 16); }
                            } } } }
        } else {
#pragma unroll
            for (int ai = 0; ai < 2; ++ai)
#pragma unroll
                for (int m = 0; m < 4; ++m) { const int row = row0 + ai * HALF + m * 16; const float rs = rstd_of(SSQP, row);
#pragma unroll
                    for (int bj = 0; bj < 2; ++bj) { const int colm = u.pn * BM + bj * HALF + wc * 32 + 8 * fq, col = main2ref(colm);
                        const f32x4 a0 = acc[ai][bj][m][0], a1 = acc[ai][bj][m][1];
                        f32x4 r0v = (f32x4){a0[0] * rs, a0[1] * rs, a0[2] * rs, a0[3] * rs}, r1v = (f32x4){a1[0] * rs, a1[1] * rs, a1[2] * rs, a1[3] * rs};
                        if ((colm >= CM_SZ && colm < CM_SZ + 512) || colm >= CM_GG) {
#pragma unroll
                            for (int e = 0; e < 4; ++e) { r0v[e] = silu_fast(r0v[e]); r1v[e] = silu_fast(r1v[e]); } }
                        { u32x4 w; w.x = cvt_pk_bf16(r0v[0], r0v[1]); w.y = cvt_pk_bf16(r0v[2], r0v[3]); w.z = cvt_pk_bf16(r1v[0], r1v[1]); w.w = cvt_pk_bf16(r1v[2], r1v[3]); *(u32x4*)(MIB + (size_t)row * N_MAIN + colm) = w; }
                        if (row >= MP) { f32x4* o = (f32x4*)(MI + (size_t)row * LDMI + col); o[0] = r0v; o[1] = r1v; }
                        if (colm >= CM_XBC && colm < CM_XBC + 768) {
                            float* cvo = nullptr;
                            if (row < MP) { if ((row & 2047) >= 2045) cvo = out + O_CONVP + ((size_t)(l * BATCH + (row >> 11)) * 3 + ((row & 2047) - 2045)) * 768; }
                            else if (row < R_META) { if (((row - R_S) & 3) >= 1) cvo = out + O_CONVS + ((size_t)(l * DEC_BATCH + ((row - R_S) >> 2)) * 3 + (((row - R_S) & 3) - 1)) * 768; }
                            if (cvo) { *(f32x4*)(cvo + colm - CM_XBC) = r0v; *(f32x4*)(cvo + colm - CM_XBC + 4) = r1v; } }
                    } }
        }
    }
};

template <class Epi, class Sched, bool ALIGN_EPI = false, bool SP2 = false>
__device__ __forceinline__ void gemm_phase(PG8_LAS unsigned char* lds, const Gemm g, const Sched& S, const Epi& E, const int tid) {
    const int wid = __builtin_amdgcn_readfirstlane(tid >> 6), lane = tid & 63, wr = wid >> 2, wc = wid & 3, fr = lane & 15, fq = lane >> 4;
    const int K = g.K, nt = K / BK;
    unsigned voffA[2], voffB[2];
#pragma unroll
    for (int i = 0; i < 2; ++i) { int R, C; stage_rc(tid * 16 + i * 8192, R, C); const int Rb = Epi::PERM ? ((R & ~31) + perm32(R & 31)) : R;
        voffA[i] = (unsigned)(R * K + C) * 2u; voffB[i] = (unsigned)(Rb * K + C) * 2u; }
    const size_t kstep = (size_t)(BK * 2);
    const size_t hstep = (size_t)HALF * K * 2;
    const size_t tstep = 2 * hstep;
    const unsigned ldsw = (unsigned)wid * 1024u;
    const int aoff = lds_byte(wr * 64 + fr, fq * 8), boff = lds_byte(wc * 32 + fr, fq * 8);
#define PG8_SA(b, h) (((b) * 2 + (h)) * HTB)
#define PG8_SB(b, h) ((4 + (b) * 2 + (h)) * HTB)
#define PG8_STAGE(bufoff, gbase, voff) do { _Pragma("unroll") for (int _i = 0; _i < 2; ++_i) \
        __builtin_amdgcn_global_load_lds((const unsigned*)((const char*)(gbase) + (voff)[_i]), (PG8_LAS unsigned*)(lds + (bufoff) + ldsw + _i * 8192), 16, 0, 0); } while (0)
#define PG8_LDA(dst, b, h) do { _Pragma("unroll") for (int m = 0; m < 4; ++m) _Pragma("unroll") for (int k = 0; k < 2; ++k) dst[m][k] = *(const PG8_LAS bf16x8*)(lds + PG8_SA(b, h) + aoff + m * 2048 + k * 1024); } while (0)
#define PG8_LDB(dst, b, h) do { _Pragma("unroll") for (int n = 0; n < 2; ++n) _Pragma("unroll") for (int k = 0; k < 2; ++k) dst[n][k] = *(const PG8_LAS bf16x8*)(lds + PG8_SB(b, h) + boff + n * 2048 + k * 1024); } while (0)
#define PG8_MMA(ai, bj, At, Bt) do { __builtin_amdgcn_s_setprio(1); _Pragma("unroll") for (int m = 0; m < 4; ++m) _Pragma("unroll") for (int n = 0; n < 2; ++n) _Pragma("unroll") for (int k = 0; k < 2; ++k) \
        acc[ai][bj][m][n] = __builtin_amdgcn_mfma_f32_16x16x32_bf16(Bt[n][k], At[m][k], acc[ai][bj][m][n], 0, 0, 0); __builtin_amdgcn_s_setprio(0); } while (0)
#define PG8_WAIT_V(n) asm volatile("s_waitcnt vmcnt(" #n ")" ::: "memory")
#define PG8_WAIT_L(n) asm volatile("s_waitcnt lgkmcnt(" #n ")" ::: "memory")
#define PG8_BAR __builtin_amdgcn_s_barrier()
#define PG8_SCHED __builtin_amdgcn_sched_barrier(0)
    Unit cur, nxt; int ui = 0;
    if (!S.next(0, cur)) return;
    f32x4 acc[2][2][4][2];
#pragma unroll
    for (int a = 0; a < 2; ++a)
#pragma unroll
        for (int b = 0; b < 2; ++b)
#pragma unroll
            for (int m = 0; m < 4; ++m)
#pragma unroll
                for (int n = 0; n < 2; ++n) acc[a][b][m][n] = (f32x4){0.f, 0.f, 0.f, 0.f};
    bf16x8 At[4][2], B0[2][2], B1[2][2];
    const char* cA = (const char*)g.A + (size_t)cur.pm * tstep; const char* cB = (const char*)g.Bt + (size_t)cur.pn * tstep;
    S.a_ready(cur);
    if constexpr (SP2) {
        PG8_STAGE(PG8_SB(0, 0), cB, voffB); PG8_STAGE(PG8_SB(0, 1), cB + hstep, voffB); PG8_STAGE(PG8_SA(0, 0), cA, voffA); PG8_STAGE(PG8_SA(0, 1), cA + hstep, voffA);
        if (wr == 1) PG8_BAR;
        PG8_WAIT_V(2); PG8_BAR;
        PG8_STAGE(PG8_SB(1, 0), cB + kstep, voffB); PG8_STAGE(PG8_SA(1, 0), cA + kstep, voffA); PG8_STAGE(PG8_SB(1, 1), cB + hstep + kstep, voffB);
        PG8_WAIT_V(6); PG8_BAR;
    } else {
        PG8_STAGE(PG8_SB(0, 0), cB, voffB); PG8_STAGE(PG8_SA(0, 0), cA, voffA); PG8_STAGE(PG8_SB(0, 1), cB + hstep, voffB); PG8_STAGE(PG8_SA(0, 1), cA + hstep, voffA);
        if (wr == 1) PG8_BAR;
        PG8_WAIT_V(4); PG8_BAR;
        PG8_STAGE(PG8_SB(1, 0), cB + kstep, voffB); PG8_STAGE(PG8_SA(1, 0), cA + kstep, voffA); PG8_STAGE(PG8_SB(1, 1), cB + hstep + kstep, voffB);
        PG8_WAIT_V(6); PG8_BAR;
    }
    for (;;) {
        const bool has_next = S.next(ui + 1, nxt);
        const char* nA = has_next ? (const char*)g.A + (size_t)nxt.pm * tstep : cA; const char* nB = has_next ? (const char*)g.Bt + (size_t)nxt.pn * tstep : cB;
        for (int t = 0; t < nt; t += 2) {
            const bool last = (t == nt - 2);
            const char* a1 = cA + (size_t)(t + 1) * kstep;
            const char* a2 = last ? nA : cA + (size_t)(t + 2) * kstep; const char* b2 = last ? nB : cB + (size_t)(t + 2) * kstep;
            const char* a3 = a2 + kstep; const char* b3 = b2 + kstep;
            if (last && has_next) S.a_ready(nxt);
            if constexpr (SP2) {
            PG8_LDB(B0, 0, 0); PG8_LDB(B1, 0, 1); PG8_SCHED; PG8_LDA(At, 0, 0); PG8_STAGE(PG8_SA(1, 1), a1 + hstep, voffA);
            PG8_WAIT_V(8); PG8_WAIT_L(0); PG8_BAR; PG8_MMA(0, 0, At, B0); PG8_MMA(0, 1, At, B1); PG8_BAR; PG8_SCHED;
            PG8_LDA(At, 0, 1); PG8_STAGE(PG8_SB(0, 0), b2, voffB); PG8_STAGE(PG8_SB(0, 1), b2 + hstep, voffB); PG8_STAGE(PG8_SA(0, 0), a2, voffA);
            PG8_WAIT_V(8); PG8_WAIT_L(0); PG8_BAR; PG8_MMA(1, 0, At, B0); PG8_MMA(1, 1, At, B1); PG8_BAR; PG8_SCHED;
            PG8_LDB(B0, 1, 0); PG8_LDB(B1, 1, 1); PG8_SCHED; PG8_LDA(At, 1, 0); PG8_STAGE(PG8_SA(0, 1), a2 + hstep, voffA);
            PG8_WAIT_V(8); PG8_WAIT_L(0); PG8_BAR; PG8_MMA(0, 0, At, B0); PG8_MMA(0, 1, At, B1); PG8_BAR; PG8_SCHED;
            PG8_LDA(At, 1, 1); PG8_STAGE(PG8_SB(1, 0), b3, voffB); PG8_STAGE(PG8_SB(1, 1), b3 + hstep, voffB); PG8_STAGE(PG8_SA(1, 0), a3, voffA);
            PG8_WAIT_V(8); PG8_WAIT_L(0); PG8_BAR; PG8_MMA(1, 0, At, B0); PG8_MMA(1, 1, At, B1); PG8_BAR; PG8_SCHED;
            } else {
            PG8_LDB(B0, 0, 0); PG8_SCHED; PG8_LDA(At, 0, 0); PG8_STAGE(PG8_SA(1, 1), a1 + hstep, voffA);
            PG8_WAIT_L(8); PG8_BAR; PG8_WAIT_L(0); PG8_MMA(0, 0, At, B0); PG8_BAR; PG8_SCHED;
            PG8_LDB(B1, 0, 1); PG8_STAGE(PG8_SB(0, 0), b2, voffB);
            PG8_BAR; PG8_WAIT_L(0); PG8_MMA(0, 1, At, B1); PG8_BAR;
            PG8_LDA(At, 0, 1); PG8_STAGE(PG8_SA(0, 0), a2, voffA);
            PG8_BAR; PG8_WAIT_L(0); PG8_MMA(1, 0, At, B0); PG8_BAR; PG8_SCHED;
            PG8_STAGE(PG8_SB(0, 1), b2 + hstep, voffB);
            PG8_WAIT_V(6); PG8_BAR; PG8_MMA(1, 1, At, B1); PG8_BAR;
            PG8_LDB(B0, 1, 0); PG8_SCHED; PG8_LDA(At, 1, 0); PG8_STAGE(PG8_SA(0, 1), a2 + hstep, voffA);
            PG8_WAIT_L(8); PG8_BAR; PG8_WAIT_L(0); PG8_MMA(0, 0, At, B0); PG8_BAR; PG8_SCHED;
            PG8_LDB(B1, 1, 1); PG8_STAGE(PG8_SB(1, 0), b3, voffB);
            PG8_BAR; PG8_WAIT_L(0); PG8_MMA(0, 1, At, B1); PG8_BAR;
            PG8_LDA(At, 1, 1); PG8_STAGE(PG8_SA(1, 0), a3, voffA);
            PG8_BAR; PG8_WAIT_L(0); PG8_MMA(1, 0, At, B0); PG8_BAR; PG8_SCHED;
            PG8_STAGE(PG8_SB(1, 1), b3 + hstep, voffB);
            PG8_WAIT_V(6); PG8_BAR; PG8_MMA(1, 1, At, B1); PG8_BAR;
            }
        }
        if constexpr (ALIGN_EPI) { if (wr == 0) PG8_BAR; }
        if constexpr (!Epi::AFTER_DRAIN) { E(acc, cur, wr, wc, fr, fq); S.done(cur); }
        if (!has_next) break;
#pragma unroll
        for (int a = 0; a < 2; ++a)
#pragma unroll
            for (int b = 0; b < 2; ++b)
#pragma unroll
                for (int m = 0; m < 4; ++m)
#pragma unroll
                    for (int n = 0; n < 2; ++n) acc[a][b][m][n] = (f32x4){0.f, 0.f, 0.f, 0.f};
        cur = nxt; cA = nA; cB = nB; ++ui;
        if constexpr (ALIGN_EPI) { if (wr == 1) PG8_BAR; }
    }
    PG8_WAIT_V(0);
    if constexpr (!ALIGN_EPI) { if (wr == 0) PG8_BAR; }
    PG8_BAR;
    if constexpr (Epi::AFTER_DRAIN) { E.fused(acc, cur, wr, wc, fr, fq, lds, wid, lane); S.done(cur); }
#undef PG8_SA
#undef PG8_SB
#undef PG8_STAGE
#undef PG8_LDA
#undef PG8_LDB
#undef PG8_MMA
#undef PG8_WAIT_V
#undef PG8_WAIT_L
#undef PG8_BAR
#undef PG8_SCHED
}
}

#define XB_TMO      128
#define XB_XCNT(j)  (256  + 64 * (j))
#define XB_XSUB(j)  (1280 + 64 * (j))
#define XB_XGEN(j)  (2304 + 64 * (j))
#define XB_TOP      3328
#define XB_TOPGEN   3392
#define XCD_BAR_WORDS 3456
#define XB_SPIN_CAP (1u << 23)
__device__ __forceinline__ unsigned xb_ld(unsigned* p)              { return __hip_atomic_load(p, __ATOMIC_RELAXED, __HIP_MEMORY_SCOPE_AGENT); }
__device__ __forceinline__ unsigned xb_add(unsigned* p, unsigned v) { return __hip_atomic_fetch_add(p, v, __ATOMIC_RELAXED, __HIP_MEMORY_SCOPE_AGENT); }
__device__ __forceinline__ unsigned xb_xcc_id() { return (unsigned)__builtin_amdgcn_s_getreg((3 << 11) | 20) & 0xFu; }
#define XB_SPIN(cond, bar) do { unsigned _sp = 0; while (cond) { __builtin_amdgcn_s_sleep(1); \
    if ((++_sp & 255u) == 0u) { if (xb_ld(&(bar)[XB_TMO])) break; if (_sp > XB_SPIN_CAP) { atomicAdd(&(bar)[XB_TMO], 1u); break; } } } } while (0)
struct XcdBarrier { unsigned* bar; unsigned x; volatile LAS unsigned* st; };
__device__ __forceinline__ XcdBarrier xcd_barrier_post(unsigned* bar, volatile LAS unsigned* st) {
    XcdBarrier b; b.bar = bar; b.x = xb_xcc_id(); b.st = st;
    if (threadIdx.x == 0) (void)xb_add(&bar[XB_XCNT(b.x)], 1u);
    return b;
}
__device__ __forceinline__ void xcd_barrier_complete(unsigned* bar, unsigned x, unsigned& nloc, unsigned& nx) {
    const unsigned G = gridDim.x * gridDim.y * gridDim.z;
    unsigned sum, cnt, mine, sp = 0u;
    for (;;) {
        sum = 0u; cnt = 0u; mine = 0u;
#pragma unroll
        for (unsigned j = 0; j < 16; ++j) { const unsigned c = xb_ld(&bar[XB_XCNT(j)]); sum += c; cnt += (c > 0u) ? 1u : 0u; mine = (j == x) ? c : mine; }
        if (sum == G) break;
        __builtin_amdgcn_s_sleep(1);
        if ((++sp & 255u) == 0u) { if (xb_ld(&bar[XB_TMO])) break; if (sp > XB_SPIN_CAP) { atomicAdd(&bar[XB_TMO], 1u); break; } }
    }
    nloc = mine > 0u ? mine : 1u; nx = cnt > 0u ? cnt : 1u;
}
__device__ __forceinline__ void xcd_barrier(const XcdBarrier& b, const int tid_) {
    asm volatile("s_waitcnt vmcnt(0)" ::: "memory");
    __syncthreads();
    if (tid_ == 0) {
        unsigned* bar = b.bar; asm volatile("" : "+s"(bar));
        __builtin_amdgcn_s_waitcnt(0);
        unsigned nloc = b.st[0], nx = b.st[1];
        if (nloc == 0u) { xcd_barrier_complete(bar, b.x, nloc, nx); b.st[0] = nloc; b.st[1] = nx; }
        const unsigned old = xb_add(&bar[XB_XSUB(b.x)], 1u);
        const unsigned gen = old / nloc;
        if (old + 1u == (gen + 1u) * nloc) {
            __builtin_amdgcn_fence(__ATOMIC_RELEASE, "agent");
            asm volatile("s_waitcnt vmcnt(0)" ::: "memory");
            const unsigned og = xb_add(&bar[XB_TOP], 1u);
            const unsigned tg = og / nx;
            if (og + 1u == (tg + 1u) * nx) xb_add(&bar[XB_TOPGEN], 1u);
            else XB_SPIN(xb_ld(&bar[XB_TOPGEN]) == tg, bar);
            __builtin_amdgcn_fence(__ATOMIC_ACQUIRE, "agent");
            xb_add(&bar[XB_XGEN(b.x)], 1u);
            asm volatile("s_waitcnt vmcnt(0)" ::: "memory");
        } else {
            XB_SPIN(xb_ld(&bar[XB_XGEN(b.x)]) == gen, bar);
            __builtin_amdgcn_fence(__ATOMIC_ACQUIRE, "agent");
            asm volatile("s_waitcnt vmcnt(0)" ::: "memory");
        }
    }
    __syncthreads();
}

__device__ __forceinline__ float wave_sum(float v) {
#pragma unroll
    for (int o = 1; o < 64; o <<= 1) v += __shfl_xor(v, o);
    return v;
}
__device__ __forceinline__ float wave_max(float v) {
#pragma unroll
    for (int o = 1; o < 64; o <<= 1) v = fmaxf(v, __shfl_xor(v, o));
    return v;
}
__device__ __forceinline__ float bperm(float x, int srclane) { return __builtin_bit_cast(float, __builtin_amdgcn_ds_bpermute(srclane << 2, __builtin_bit_cast(int, x))); }
__device__ __forceinline__ float wave_sum_l(float v, int lane) {
#pragma unroll
    for (int o = 1; o < 64; o <<= 1) v += bperm(v, lane ^ o);
    return v;
}
__device__ __forceinline__ float wave_max_l(float v, int lane) {
#pragma unroll
    for (int o = 1; o < 64; o <<= 1) v = fmaxf(v, bperm(v, lane ^ o));
    return v;
}
__device__ __forceinline__ float siluf(float x) { return x / (1.f + expf(-x)); }
__device__ __forceinline__ float log_sigmoidf(float x) { return fminf(x, 0.f) - log1pf(expf(-fabsf(x))); }
__device__ __forceinline__ float softplusf(float x) { return fmaxf(x, 0.f) + log1pf(expf(-fabsf(x))); }

__device__ __forceinline__ const float* conv_prev(const float* MI, const float* state_conv_l, int r, int j) {
    if (r < MP) { const int b = r >> 11, i = r & 2047; const int p = i - j; if (p >= 0) return MI + (size_t)(b * 2048 + p) * LDMI + C_XBC; return MI + (size_t)(R_META + 16 + p) * LDMI + C_XBC; }
    if (r < R_META) { const int s = r - R_S, b = s >> 2, i = s & 3; const int p = i - j; if (p >= 0) return MI + (size_t)(R_S + b * 4 + p) * LDMI + C_XBC; return state_conv_l + (size_t)(b * 3 + 3 + p) * 768; }
    const int i = r - R_META, p = i - j; if (p >= 0) return MI + (size_t)(R_META + p) * LDMI + C_XBC; return nullptr;
}

struct PromptKeys { const float* KN; const float* MI; const float* FC; int b, h;
    __device__ __forceinline__ void get(int j, const float*& kp, const float*& vp, float& Fk) const { const int row = j < 16 ? R_META + j : b * 2048 + (j - 16);
        kp = KN + (size_t)row * 256 + h * 64; vp = MI + (size_t)row * LDMI + C_FV + h * 64; Fk = FC[row * 4 + h]; } };
struct SampleKeys { const float* KN; const float* MI; const float* FCS; const float* ck; const float* cv; const int* pt; int b, h, l;
    __device__ __forceinline__ void get(int j, const float*& kp, const float*& vp, float& Fk) const {
        Fk = FCS[(size_t)(b * 4 + h) * 2052 + j];
        if (j < 2048) { const int page = pt[b * 16 + (j >> 7)]; const size_t off = (((size_t)l * NPOOL + page) * 128 + (j & 127)) * 256 + h * 64; kp = ck + off; vp = cv + off; }
        else { const int row = R_S + b * 4 + (j - 2048); kp = KN + (size_t)row * 256 + h * 64; vp = MI + (size_t)row * LDMI + C_FV + h * 64; } } };

template <class Keys>
__device__ __forceinline__ void attn_row(const float* qg, float Fq, int nk, const Keys& K, bf16* outp, float* sq, float* sc, int lane) {
    sq[lane] = qg[lane];
    LDS_WAIT();
    float mx = -INFINITY;
    for (int j = lane; j < nk; j += 64) {
        const float* kp; const float* vp; float Fk; K.get(j, kp, vp, Fk);
        float s = 0.f;
#pragma unroll
        for (int d4 = 0; d4 < 16; ++d4) { const float4 a = ((const float4*)sq)[d4]; const float4 b = ((const float4*)kp)[d4]; s += a.x * b.x + a.y * b.y + a.z * b.z + a.w * b.w; }
        s = s * 0.125f + (Fq - Fk);
        sc[j] = s; mx = fmaxf(mx, s);
    }
    mx = wave_max_l(mx, lane);
    float sum = 0.f;
    for (int j = lane; j < nk; j += 64) { const float p = expf(sc[j] - mx); sc[j] = p; sum += p; }
    sum = wave_sum_l(sum, lane);
    LDS_WAIT();
    float o = 0.f;
    for (int j = 0; j < nk; ++j) { const float* kp; const float* vp; float Fk; K.get(j, kp, vp, Fk); o += sc[j] * vp[lane]; }
    outp[lane] = (bf16)f2bf(o / sum);
    LDS_WAIT();
}

namespace fa {
typedef short bf16x8 __attribute__((ext_vector_type(8)));
typedef short s16x4 __attribute__((ext_vector_type(4)));
typedef float f4 __attribute__((ext_vector_type(4)));
typedef float f32x16 __attribute__((ext_vector_type(16)));
typedef float f32x2_t __attribute__((ext_vector_type(2)));
typedef __bf16 bf16x2_t __attribute__((ext_vector_type(2)));
__device__ __forceinline__ unsigned cvtpk(float lo, float hi) { f32x2_t v = {lo, hi}; bf16x2_t b = __builtin_convertvector(v, bf16x2_t); return __builtin_bit_cast(unsigned, b); }
__device__ __forceinline__ int crow(int r, int hi) { return (r & 3) + 8 * (r >> 2) + 4 * hi; }
template <int CTRL> __device__ __forceinline__ float dpp(float x) { return __builtin_bit_cast(float, __builtin_amdgcn_mov_dpp(__builtin_bit_cast(int, x), CTRL, 0xf, 0xf, true)); }
constexpr int XOR1 = 0xB1, XOR2 = 0x4E, XOR7 = 0x141, XOR8 = 0x128;
__device__ __forceinline__ float row16_sum(float s) { s += dpp<XOR1>(s); s += dpp<XOR2>(s); s += dpp<XOR7>(s); s += dpp<XOR8>(s); return s; }
#define MFMA32(a, b, c) __builtin_amdgcn_mfma_f32_32x32x16_bf16((a), (b), (c), 0, 0, 0)

constexpr int KSTR = 144;
constexpr int L_K0 = 0, L_V0 = 2 * 64 * KSTR, L_KB = 4 * 64 * KSTR, L_WS = L_KB + 2112 * 4, L_END = L_WS + 64;
constexpr float LOG2E = 1.4426950408889634f;

__device__ __forceinline__ void fox_prompt_unit(int b, int h, int qb, const bf16* QF, const bf16* KF, const bf16* VT, const float* LF, bf16* MIXB, LAS unsigned char* lds, int tid) {
    const int lane = tid & 63, wave = __builtin_amdgcn_readfirstlane(tid >> 6), r32 = lane & 31, hi = lane >> 5;
    const int ntile = 5 + 4 * qb, nslots = 64 * ntile;
    LAS float* kb = (LAS float*)(lds + L_KB); LAS float* wsum = (LAS float*)(lds + L_WS);
    {
        float v[5]; float run = 0.f;
#pragma unroll
        for (int e = 0; e < 5; ++e) { const int slot = 5 * tid + e; float lf = 0.f;
            if (slot < 16) lf = LF[(R_META + slot) * 4 + h]; else if (slot >= 64 && slot < nslots) lf = LF[(b * 2048 + slot - 64) * 4 + h];
            run += lf; v[e] = run; }
        float x = run;
#pragma unroll
        for (int o = 1; o < 64; o <<= 1) { const float y = bperm(x, lane - o); if (lane >= o) x += y; }
        if (lane == 63) wsum[wave] = x;
        __syncthreads();
        float off = x - run;
        for (int w = 0; w < wave; ++w) off += wsum[w];
#pragma unroll
        for (int e = 0; e < 5; ++e) { const int slot = 5 * tid + e; if (slot < 2112) kb[slot] = (slot >= 16 && slot < 64) ? -INFINITY : -(off + v[e]) * LOG2E; }
    }
    const bf16* Qw = QF + ((size_t)(b * 4 + h) * 2048 + 256 * qb + 32 * wave) * 64;
    bf16x8 qr[4];
#pragma unroll
    for (int d0 = 0; d0 < 4; ++d0) qr[d0] = *(const bf16x8*)(Qw + r32 * 64 + d0 * 16 + hi * 8);
    const bf16* Kg = KF + (size_t)(b * 4 + h) * 2112 * 64 + (size_t)(tid >> 3) * 64 + (tid & 7) * 8;
    const bf16* Vg = VT + (size_t)(b * 4 + h) * 64 * 2112 + (size_t)(tid >> 3) * 2112 + (tid & 7) * 8;
    const int soff = (tid >> 3) * KSTR + (tid & 7) * 16;
    v4u kreg = *(const v4u*)Kg, vreg = *(const v4u*)Vg;
    *(LAS v4u*)(lds + L_K0 + soff) = kreg; *(LAS v4u*)(lds + L_V0 + soff) = vreg;
    __syncthreads();
    asm volatile("" : "+v"(qr[0]), "+v"(qr[1]), "+v"(qr[2]), "+v"(qr[3]));
    float m = -INFINITY, l = 0.f; f32x16 o0, o1;
#pragma unroll
    for (int i = 0; i < 16; ++i) { o0[i] = 0.f; o1[i] = 0.f; }
    const int qrow = 256 * qb + 32 * wave + r32;
    const int wave_last = 1 + (256 * qb + 32 * wave + 31) / 64;
    for (int t = 0; t < ntile; ++t) {
        const int cur = t & 1;
        if (t + 1 < ntile) { kreg = *(const v4u*)(Kg + (size_t)(t + 1) * 64 * 64); vreg = *(const v4u*)(Vg + (t + 1) * 64); }
        if (t <= wave_last) {
            LAS unsigned char* Kc = lds + L_K0 + cur * 64 * KSTR; LAS unsigned char* Vc = lds + L_V0 + cur * 64 * KSTR;
            f32x16 p0, p1;
#pragma unroll
            for (int i = 0; i < 16; ++i) { p0[i] = 0.f; p1[i] = 0.f; }
#pragma unroll
            for (int d0 = 0; d0 < 4; ++d0) {
                const bf16x8 a0 = *(const LAS bf16x8*)(Kc + r32 * KSTR + (d0 * 16 + hi * 8) * 2);
                const bf16x8 a1 = *(const LAS bf16x8*)(Kc + (32 + r32) * KSTR + (d0 * 16 + hi * 8) * 2);
                p0 = MFMA32(a0, qr[d0], p0); p1 = MFMA32(a1, qr[d0], p1);
            }
#pragma unroll
            for (int g = 0; g < 4; ++g) { const f4 b0 = *(const LAS f4*)(kb + 64 * t + 8 * g + 4 * hi); const f4 b1 = *(const LAS f4*)(kb + 64 * t + 32 + 8 * g + 4 * hi);
                p0[4 * g + 0] += b0[0]; p0[4 * g + 1] += b0[1]; p0[4 * g + 2] += b0[2]; p0[4 * g + 3] += b0[3]; p1[4 * g + 0] += b1[0]; p1[4 * g + 1] += b1[1]; p1[4 * g + 2] += b1[2]; p1[4 * g + 3] += b1[3]; }
            if (t >= 4 * qb + 1) {
                const int kbase = 64 * (t - 1);
#pragma unroll
                for (int i = 0; i < 16; ++i) { const int pk = kbase + crow(i, hi); if (pk > qrow) p0[i] = -INFINITY; if (pk + 32 > qrow) p1[i] = -INFINITY; }
            }
            float rm = fmaxf(p0[0], p1[0]);
#pragma unroll
            for (int i = 1; i < 16; ++i) rm = fmaxf(rm, fmaxf(p0[i], p1[i]));
            rm = fmaxf(rm, bperm(rm, lane ^ 32));
            const float mn = fmaxf(m, rm); const float sc = __builtin_amdgcn_exp2f(m - mn); m = mn;
            float rsum = 0.f;
#pragma unroll
            for (int i = 0; i < 16; ++i) { p0[i] = __builtin_amdgcn_exp2f(p0[i] - mn); p1[i] = __builtin_amdgcn_exp2f(p1[i] - mn); rsum += p0[i] + p1[i]; }
            l = l * sc + rsum;
#pragma unroll
            for (int i = 0; i < 16; ++i) { o0[i] *= sc; o1[i] *= sc; }
#pragma unroll
            for (int blk = 0; blk < 2; ++blk)
#pragma unroll
                for (int s2 = 0; s2 < 2; ++s2) {
                    v4u pw;
                    if (blk == 0) { pw.x = cvtpk(p0[8 * s2 + 0], p0[8 * s2 + 1]); pw.y = cvtpk(p0[8 * s2 + 2], p0[8 * s2 + 3]); pw.z = cvtpk(p0[8 * s2 + 4], p0[8 * s2 + 5]); pw.w = cvtpk(p0[8 * s2 + 6], p0[8 * s2 + 7]); }
                    else          { pw.x = cvtpk(p1[8 * s2 + 0], p1[8 * s2 + 1]); pw.y = cvtpk(p1[8 * s2 + 2], p1[8 * s2 + 3]); pw.z = cvtpk(p1[8 * s2 + 4], p1[8 * s2 + 5]); pw.w = cvtpk(p1[8 * s2 + 6], p1[8 * s2 + 7]); }
                    const bf16x8 pb = __builtin_bit_cast(bf16x8, pw);
                    const int koff = (32 * blk + 16 * s2 + 4 * hi) * 2;
                    { const s16x4 lo = *(const LAS s16x4*)(Vc + r32 * KSTR + koff), hh = *(const LAS s16x4*)(Vc + r32 * KSTR + koff + 16);
                      const bf16x8 va = {lo[0], lo[1], lo[2], lo[3], hh[0], hh[1], hh[2], hh[3]}; o0 = MFMA32(va, pb, o0); }
                    { const s16x4 lo = *(const LAS s16x4*)(Vc + (32 + r32) * KSTR + koff), hh = *(const LAS s16x4*)(Vc + (32 + r32) * KSTR + koff + 16);
                      const bf16x8 va = {lo[0], lo[1], lo[2], lo[3], hh[0], hh[1], hh[2], hh[3]}; o1 = MFMA32(va, pb, o1); }
                }
        }
        if (t + 1 < ntile) { *(LAS v4u*)(lds + L_K0 + (cur ^ 1) * 64 * KSTR + soff) = kreg; *(LAS v4u*)(lds + L_V0 + (cur ^ 1) * 64 * KSTR + soff) = vreg; }
        __syncthreads();
    }
    l += bperm(l, lane ^ 32);
    const float inv = 1.0f / l;
    bf16* orow = MIXB + (size_t)(b * 2048 + qrow) * 1024 + h * 64;
#pragma unroll
    for (int g = 0; g < 4; ++g) {
        *(uint2*)(orow + 8 * g + 4 * hi) = make_uint2(cvtpk(o0[4 * g] * inv, o0[4 * g + 1] * inv), cvtpk(o0[4 * g + 2] * inv, o0[4 * g + 3] * inv));
        *(uint2*)(orow + 32 + 8 * g + 4 * hi) = make_uint2(cvtpk(o1[4 * g] * inv, o1[4 * g + 1] * inv), cvtpk(o1[4 * g + 2] * inv, o1[4 * g + 3] * inv));
    }
}

constexpr int S_D = 0, S_WS = 32768, S_PART = 33024, S_PSTR = 68;
__device__ __forceinline__ void fox_sample_unit(int b, int l, const float* QN, const float* KN, const float* MI, const float* LF, const float* ck, const float* cv, const float* clf, const int* pt,
                                                bf16* MIXB, LAS unsigned char* lds, int tid) {
    const int lane = tid & 63, wave = __builtin_amdgcn_readfirstlane(tid >> 6), h = lane >> 4, d4 = lane & 15;
    LAS f4* Dl = (LAS f4*)(lds + S_D); LAS f4* wsum = (LAS f4*)(lds + S_WS);
    {
        const int page = pt[b * 16 + (tid >> 5)];
        const f4* src = (const f4*)(clf + (((size_t)l * NPOOL + page) * 128 + 4 * (tid & 31)) * 4);
        const f4 v0 = src[0], v1 = src[1], v2 = src[2], v3 = src[3];
        const f4 s2 = v3, s1 = v3 + v2, s0 = s1 + v1, tot = s0 + v0;
        f4 x = tot;
#pragma unroll
        for (int o = 1; o < 64; o <<= 1) { f4 y; y[0] = bperm(x[0], lane + o); y[1] = bperm(x[1], lane + o); y[2] = bperm(x[2], lane + o); y[3] = bperm(x[3], lane + o); if (lane + o < 64) x += y; }
        if (lane == 0) wsum[wave] = x;
        __syncthreads();
        f4 off = x - tot;
        for (int w = wave + 1; w < 8; ++w) off += wsum[w];
        Dl[4 * tid + 0] = s0 + off; Dl[4 * tid + 1] = s1 + off; Dl[4 * tid + 2] = s2 + off; Dl[4 * tid + 3] = off;
        __syncthreads();
    }
    float4 q[4];
#pragma unroll
    for (int i = 0; i < 4; ++i) { const float4 t = *(const float4*)(QN + (size_t)(R_S + b * 4 + i) * 256 + h * 64 + 4 * d4); q[i] = make_float4(t.x * 0.125f, t.y * 0.125f, t.z * 0.125f, t.w * 0.125f); }
    float m[4], ls[4]; float4 o[4];
#pragma unroll
    for (int i = 0; i < 4; ++i) { m[i] = -INFINITY; ls[i] = 0.f; o[i] = make_float4(0.f, 0.f, 0.f, 0.f); }
    const LAS float* Df = (const LAS float*)Dl;
    for (int p = 0; p < 16; ++p) {
        const int page = pt[b * 16 + p];
        const size_t base = (((size_t)l * NPOOL + page) * 128 + 16 * wave) * 256 + lane * 4;
#pragma unroll
        for (int hf = 0; hf < 2; ++hf) {
            pg8::f32x4 kk[8], vv[8];
#pragma unroll
            for (int j = 0; j < 8; ++j) { kk[j] = __builtin_nontemporal_load((const pg8::f32x4*)(ck + base + (size_t)(hf * 8 + j) * 256)); vv[j] = __builtin_nontemporal_load((const pg8::f32x4*)(cv + base + (size_t)(hf * 8 + j) * 256)); }
            float s[4][8];
#pragma unroll
            for (int j = 0; j < 8; ++j) { const float dk = Df[(p * 128 + 16 * wave + hf * 8 + j) * 4 + h];
#pragma unroll
                for (int i = 0; i < 4; ++i) s[i][j] = row16_sum(q[i].x * kk[j][0] + q[i].y * kk[j][1] + q[i].z * kk[j][2] + q[i].w * kk[j][3]) + dk; }
#pragma unroll
            for (int i = 0; i < 4; ++i) {
                float mx = s[i][0];
#pragma unroll
                for (int j = 1; j < 8; ++j) mx = fmaxf(mx, s[i][j]);
                const float mn = fmaxf(m[i], mx); const float sc = __expf(m[i] - mn); m[i] = mn;
                ls[i] *= sc; o[i].x *= sc; o[i].y *= sc; o[i].z *= sc; o[i].w *= sc;
#pragma unroll
                for (int j = 0; j < 8; ++j) { const float pj = __expf(s[i][j] - mn); ls[i] += pj; o[i].x += pj * vv[j][0]; o[i].y += pj * vv[j][1]; o[i].z += pj * vv[j][2]; o[i].w += pj * vv[j][3]; }
            }
        }
    }
    LAS float* part = (LAS float*)(lds + S_PART);
#pragma unroll
    for (int i = 0; i < 4; ++i) { LAS float* pp = part + ((wave * 16) + h * 4 + i) * S_PSTR; *(LAS f4*)(pp + 4 + 4 * d4) = (f4){o[i].x, o[i].y, o[i].z, o[i].w}; if (d4 == 0) { pp[0] = m[i]; pp[1] = ls[i]; } }
    __syncthreads();
    for (int u = tid; u < 1024; u += 512) {
        const int hh = u >> 8, i = (u >> 6) & 3, d = u & 63;
        const int rowq = R_S + b * 4 + i;
        float sn[4]; float G = 0.f;
#pragma unroll
        for (int j = 0; j < 4; ++j) { const int rowk = R_S + b * 4 + j; G -= LF[rowk * 4 + hh]; float dot = 0.f;
            const float* qp = QN + (size_t)rowq * 256 + hh * 64; const float* kp = KN + (size_t)rowk * 256 + hh * 64;
            for (int c = 0; c < 64; ++c) dot += qp[c] * kp[c];
            sn[j] = j <= i ? dot * 0.125f + G : -INFINITY; }
        float mt = fmaxf(fmaxf(sn[0], sn[1]), fmaxf(sn[2], sn[3]));
        for (int w = 0; w < 8; ++w) mt = fmaxf(mt, part[(w * 16 + hh * 4 + i) * S_PSTR]);
        float lt = 0.f, ot = 0.f;
        for (int w = 0; w < 8; ++w) { const LAS float* pp = part + (w * 16 + hh * 4 + i) * S_PSTR; const float e = __expf(pp[0] - mt); lt += e * pp[1]; ot += e * pp[4 + d]; }
#pragma unroll
        for (int j = 0; j < 4; ++j) { const float e = __expf(sn[j] - mt); lt += e; ot += e * MI[(size_t)(R_S + b * 4 + j) * LDMI + C_FV + hh * 64 + d]; }
        MIXB[(size_t)rowq * 1024 + hh * 64 + d] = (bf16)f2bf(ot / lt);
    }
    __syncthreads();
}
#undef MFMA32
}

namespace la {
using fa::bf16x8; using fa::s16x4; using fa::f32x16; using fa::f4; using fa::cvtpk; using fa::crow;
#define MFMA32(a, b, c) __builtin_amdgcn_mfma_f32_32x32x16_bf16((a), (b), (c), 0, 0, 0)
#define LDS_BARRIER() asm volatile("s_waitcnt lgkmcnt(0)\n\ts_barrier" ::: "memory")
__device__ __forceinline__ int seq_row(int b, int c, int t) { const int sg = 128 * c - 112 + t; return sg < 0 ? -1 : (sg < 16 ? R_META + sg : b * 2048 + sg - 16); }
__device__ __forceinline__ bf16x8 pack8(const f32x16& x, int s) { v4u p; p.x = cvtpk(x[8 * s], x[8 * s + 1]); p.y = cvtpk(x[8 * s + 2], x[8 * s + 3]); p.z = cvtpk(x[8 * s + 4], x[8 * s + 5]); p.w = cvtpk(x[8 * s + 6], x[8 * s + 7]); return __builtin_bit_cast(bf16x8, p); }
__device__ __forceinline__ bf16x8 ld16(const LAS unsigned char* p) { return *(const LAS bf16x8*)p; }
__device__ __forceinline__ bf16x8 ld8x2(const LAS unsigned char* p) { const s16x4 lo = *(const LAS s16x4*)p, hh = *(const LAS s16x4*)(p + 16); return (bf16x8){lo[0], lo[1], lo[2], lo[3], hh[0], hh[1], hh[2], hh[3]}; }
__device__ __forceinline__ float silu_f(float x) { return x * __builtin_amdgcn_rcpf(1.0f + __expf(-x)); }
__device__ __forceinline__ float bf2f(unsigned short v) { return __uint_as_float((unsigned)v << 16); }
typedef unsigned u2v __attribute__((ext_vector_type(2)));
constexpr int TPITCH = 272;
constexpr int OPITCH = 68;

constexpr int G_QL = 0, G_KL = 10240, G_KT = 20480, G_VT = 29184, G_OUT = 46592, G_BC = 81408, G_SEG = 98304, G_BL = 100352, G_BLR = 100480;
__device__ __forceinline__ void gla_prompt_unit(int b, int h, const GAS bf16* MIB, const GAS float* GLOG, const GAS float* gnorm, GAS bf16* MIXB, GAS float* state_out, LAS unsigned char* lds, int tid0) {
    int tid = tid0;
    int lane = tid & 63, wave = __builtin_amdgcn_readfirstlane(tid >> 6), r32 = lane & 31, hi = lane >> 5, vt = wave & 1, tt = wave < 4 ? (wave >> 1) : 3 - ((wave - 4) >> 1);
    LAS unsigned char* QL = lds + G_QL; LAS unsigned char* KL = lds + G_KL; LAS unsigned char* KT = lds + G_KT; LAS unsigned char* VT = lds + G_VT;
    LAS float* OUT = (LAS float*)(lds + G_OUT); LAS float* BC = (LAS float*)(lds + G_BC); LAS float* SEG = (LAS float*)(lds + G_SEG); LAS float* BL = (LAS float*)(lds + G_BL); LAS float* BLR = (LAS float*)(lds + G_BLR);
    f32x16 SK;
#pragma unroll
    for (int i = 0; i < 16; ++i) SK[i] = 0.f;
    int kk = tid & 31, seg = tid >> 5;
    f4 q0, q1, k0, k1, v4[4]; float gl[8];
#define BF4(w_) ((f4){__uint_as_float((w_)[0] << 16), __uint_as_float((w_)[0] & 0xffff0000u), __uint_as_float((w_)[1] << 16), __uint_as_float((w_)[1] & 0xffff0000u)})
#define GLA_LOAD(cc) do { const int row = seq_row(b, (cc), tid >> 2); const GAS bf16* mr = MIB + (size_t)(row >= 0 ? row : 0) * N_MAIN; const int qd_ = tid & 3; \
        const u2v a0_ = *(const GAS u2v*)(mr + CM_GQ + h * 32 + 8 * qd_), a1_ = *(const GAS u2v*)(mr + CM_GQ + h * 32 + 8 * qd_ + 4), b0_ = *(const GAS u2v*)(mr + CM_GK + h * 32 + 8 * qd_), b1_ = *(const GAS u2v*)(mr + CM_GK + h * 32 + 8 * qd_ + 4); \
        u2v c_[4]; _Pragma("unroll") for (int j4 = 0; j4 < 4; ++j4) c_[j4] = *(const GAS u2v*)(mr + CM_GV + h * 64 + 16 * qd_ + 4 * j4); \
        _Pragma("unroll") for (int e_ = 0; e_ < 8; ++e_) { const int rg_ = seq_row(b, (cc), 8 * (tid >> 5) + e_); gl[e_] = GLOG[(size_t)(rg_ >= 0 ? rg_ : 0) * 128 + h * 32 + (tid & 31)]; } \
        q0 = BF4(a0_); q1 = BF4(a1_); k0 = BF4(b0_); k1 = BF4(b1_); _Pragma("unroll") for (int j4 = 0; j4 < 4; ++j4) v4[j4] = BF4(c_[j4]); } while (0)
    GLA_LOAD(0);
    for (int c = 0; c < 17; ++c) {
        tid = tid0; asm volatile("" : "+v"(tid)); lane = tid & 63; wave = __builtin_amdgcn_readfirstlane(tid >> 6); r32 = lane & 31; hi = lane >> 5; vt = wave & 1; tt = wave < 4 ? (wave >> 1) : 3 - ((wave - 4) >> 1); kk = tid & 31; seg = tid >> 5;
        if (c == 0 && (tid >> 2) < 112) { const f4 z = (f4){0.f, 0.f, 0.f, 0.f}; q0 = z; q1 = z; k0 = z; k1 = z; v4[0] = z; v4[1] = z; v4[2] = z; v4[3] = z; }
        {
            float bcl[8]; float run = 0.f;
#pragma unroll
            for (int e = 0; e < 8; ++e) { const float gv = (c == 0 && 8 * seg + e < 112) ? 0.f : gl[e]; run += gv; bcl[e] = run; }
            SEG[seg * 32 + kk] = run;
            LDS_BARRIER();
            float off = 0.f, tot = 0.f;
#pragma unroll
            for (int s = 0; s < 16; ++s) { const float v = SEG[s * 32 + kk]; tot += v; if (s < seg) off += v; }
#pragma unroll
            for (int e = 0; e < 8; ++e) BC[(8 * seg + e) * 33 + kk] = bcl[e] + off;
            if (seg == 0) { BL[kk] = __expf(tot); BLR[kk] = tot; }
            LDS_BARRIER();
        }
        {
            const int t = tid >> 2, qd = tid & 3;
            const float q[8] = {q0[0], q0[1], q0[2], q0[3], q1[0], q1[1], q1[2], q1[3]}, k[8] = {k0[0], k0[1], k0[2], k0[3], k1[0], k1[1], k1[2], k1[3]};
            float qv[8], kv[8];
#pragma unroll
            for (int j = 0; j < 8; ++j) { const float bcv = BC[t * 33 + 8 * qd + j]; qv[j] = q[j] * 0.17677669529663687f * __expf(bcv); kv[j] = k[j] * __expf(-bcv);
                *(LAS bf16*)(KT + (8 * qd + j) * TPITCH + 2 * t) = (bf16)(cvtpk(k[j] * __expf(BLR[8 * qd + j] - bcv), 0.f) & 0xffffu); }
            *(LAS v4u*)(QL + t * 80 + qd * 16) = (v4u){cvtpk(qv[0], qv[1]), cvtpk(qv[2], qv[3]), cvtpk(qv[4], qv[5]), cvtpk(qv[6], qv[7])};
            *(LAS v4u*)(KL + t * 80 + qd * 16) = (v4u){cvtpk(kv[0], kv[1]), cvtpk(kv[2], kv[3]), cvtpk(kv[4], kv[5]), cvtpk(kv[6], kv[7])};
#pragma unroll
            for (int j4 = 0; j4 < 4; ++j4)
#pragma unroll
                for (int e = 0; e < 4; e += 2) { const unsigned w_ = cvtpk(v4[j4][e], v4[j4][e + 1]); *(LAS bf16*)(VT + (16 * qd + 4 * j4 + e) * TPITCH + 2 * t) = (bf16)(w_ & 0xffffu); *(LAS bf16*)(VT + (16 * qd + 4 * j4 + e + 1) * TPITCH + 2 * t) = (bf16)(w_ >> 16); }
        }
        float zz[16];
#pragma unroll
        for (int i = 0; i < 16; ++i) { const int row = seq_row(b, c, 16 * wave + i); zz[i] = bf2f(MIB[(size_t)(row >= 0 ? row : 0) * N_MAIN + CM_GG + h * 64 + lane]); }
        if (c + 1 < 17) GLA_LOAD(c + 1);
        LDS_BARRIER();
        {
            f32x16 y;
#pragma unroll
            for (int i = 0; i < 16; ++i) y[i] = 0.f;
            const LAS unsigned char* qrow = QL + (32 * tt + r32) * 80;
#pragma unroll
            for (int s2 = 0; s2 < 2; ++s2) y = MFMA32(pack8(SK, s2), ld8x2(qrow + (16 * s2 + 4 * hi) * 2), y);
            for (int i = 0; i <= tt; ++i) {
                f32x16 gt;
#pragma unroll
                for (int r = 0; r < 16; ++r) gt[r] = 0.f;
#pragma unroll
                for (int ks = 0; ks < 2; ++ks) gt = MFMA32(ld16(KL + (32 * i + r32) * 80 + (16 * ks + 8 * hi) * 2), ld16(qrow + (16 * ks + 8 * hi) * 2), gt);
                if (i == tt) {
#pragma unroll
                    for (int r = 0; r < 16; ++r) if (crow(r, hi) > r32) gt[r] = 0.f; }
#pragma unroll
                for (int s2 = 0; s2 < 2; ++s2) y = MFMA32(ld8x2(VT + (32 * vt + r32) * TPITCH + (32 * i + 16 * s2 + 4 * hi) * 2), pack8(gt, s2), y);
            }
#pragma unroll
            for (int r = 0; r < 16; ++r) SK[r] *= BL[crow(r, hi)];
#pragma unroll
            for (int ks = 0; ks < 8; ++ks) SK = MFMA32(ld16(KT + r32 * TPITCH + (16 * ks + 8 * hi) * 2), ld16(VT + (32 * vt + r32) * TPITCH + (16 * ks + 8 * hi) * 2), SK);
#pragma unroll
            for (int g4 = 0; g4 < 4; ++g4) *(LAS f4*)(OUT + (32 * tt + r32) * OPITCH + 32 * vt + 8 * g4 + 4 * hi) = (f4){y[4 * g4], y[4 * g4 + 1], y[4 * g4 + 2], y[4 * g4 + 3]};
        }
        LDS_BARRIER();
        {
            const float gnl = gnorm[lane];
            float ov[16], ss[16];
#pragma unroll
            for (int i = 0; i < 16; ++i) { ov[i] = OUT[(16 * wave + i) * OPITCH + lane]; ss[i] = fa::row16_sum(ov[i] * ov[i]); }
#pragma unroll
            for (int i = 0; i < 16; ++i) ss[i] += bperm(ss[i], lane ^ 16);
#pragma unroll
            for (int i = 0; i < 16; ++i) ss[i] += bperm(ss[i], lane ^ 32);
#pragma unroll
            for (int i = 0; i < 16; ++i) { const int row = seq_row(b, c, 16 * wave + i);
                if (row >= 0 && (row < MP || b == 0)) MIXB[(size_t)row * 1024 + 768 + h * 64 + lane] = (bf16)(cvtpk(ov[i] * rsqrtf(ss[i] * (1.0f / 64.0f) + EPS) * gnl * zz[i], 0.f) & 0xffffu); }
        }
        LDS_BARRIER();
    }
#undef GLA_LOAD
    if (tt == 0) {
#pragma unroll
        for (int r = 0; r < 16; ++r) state_out[crow(r, hi) * 64 + 32 * vt + r32] = SK[r]; }
}

constexpr int S_QL = 0, S_KL = 18432, S_KT = 36864, S_VT = 54272, S_OUT = 71680, S_CS = 106496, S_DT = 107008, S_TOT = 107520, S_FS = 107776;
__device__ __forceinline__ void ssd_prompt_unit(int b, int h, const GAS bf16* MIB, const GAS bf16* XC, const GAS float* DTS, float A, float Dh, GAS bf16* MIXB, GAS float* SSQH, GAS float* state_out, LAS unsigned char* lds, int tid0) {
    int tid = tid0; const int g = h >> 2;
    int lane = tid & 63, wave = __builtin_amdgcn_readfirstlane(tid >> 6), r32 = lane & 31, hi = lane >> 5, vt = wave & 1, tt = wave < 4 ? (wave >> 1) : 3 - ((wave - 4) >> 1);
    LAS unsigned char* QL = lds + S_QL; LAS unsigned char* KL = lds + S_KL; LAS unsigned char* KT = lds + S_KT; LAS unsigned char* VT = lds + S_VT;
    LAS float* OUT = (LAS float*)(lds + S_OUT); LAS float* CS = (LAS float*)(lds + S_CS); LAS float* DT = (LAS float*)(lds + S_DT); LAS float* TOT = (LAS float*)(lds + S_TOT);
    f32x16 SK0, SK1;
#pragma unroll
    for (int i = 0; i < 16; ++i) { SK0[i] = 0.f; SK1[i] = 0.f; }
    v4u pb0, pb1, pc0, pc1, px0, px1; float dr0, dr1;
#define SSD_LOAD(cc) do { const int row_ = seq_row(b, (cc), tid >> 2); const GAS bf16* xr_ = XC + (size_t)(row_ >= 0 ? row_ : 0) * 768; const int q_ = tid & 3; \
        pb0 = *(const GAS v4u*)(xr_ + 512 + 64 * g + 8 * q_); pb1 = *(const GAS v4u*)(xr_ + 512 + 64 * g + 32 + 8 * q_); pc0 = *(const GAS v4u*)(xr_ + 640 + 64 * g + 8 * q_); pc1 = *(const GAS v4u*)(xr_ + 640 + 64 * g + 32 + 8 * q_); \
        px0 = *(const GAS v4u*)(xr_ + 64 * h + 8 * q_); px1 = *(const GAS v4u*)(xr_ + 64 * h + 32 + 8 * q_); \
        const int ra_ = seq_row(b, (cc), 2 * lane), rb_ = seq_row(b, (cc), 2 * lane + 1); dr0 = DTS[(size_t)(ra_ >= 0 ? ra_ : 0) * 8 + h]; dr1 = DTS[(size_t)(rb_ >= 0 ? rb_ : 0) * 8 + h]; } while (0)
    SSD_LOAD(0);
    for (int c = 0; c < 17; ++c) {
        tid = tid0; asm volatile("" : "+v"(tid)); lane = tid & 63; wave = __builtin_amdgcn_readfirstlane(tid >> 6); r32 = lane & 31; hi = lane >> 5; vt = wave & 1; tt = wave < 4 ? (wave >> 1) : 3 - ((wave - 4) >> 1);
        {
            const int t = tid >> 2, q = tid & 3;
            const bool pad0 = c == 0 && 2 * lane < 112, pad1 = c == 0 && 2 * lane + 1 < 112;
            const float d0 = pad0 ? 0.f : dr0, d1 = pad1 ? 0.f : dr1;
            const float a0 = d0 * A, a1 = d1 * A; float x = a0 + a1;
#pragma unroll
            for (int o = 1; o < 64; o <<= 1) { const float y = bperm(x, lane - o); if (lane >= o) x += y; }
            const float csl = bperm(x, 63);
            const float cs1 = x, cs0 = x - a1;
            if (tt > 0) {
                const float R = bperm(cs1, 16 * tt - 1);
                LAS float* FSw = (LAS float*)(lds + S_FS) + wave * 128;
                *(LAS u2v*)(FSw + 2 * lane) = (u2v){__float_as_uint(__expf(fminf(R - cs0, 0.f)) * d0), __float_as_uint(__expf(fminf(R - cs1, 0.f)) * d1)}; }
            if (wave == 0) { *(LAS u2v*)(CS + 2 * lane) = (u2v){__float_as_uint(cs0), __float_as_uint(cs1)}; *(LAS u2v*)(DT + 2 * lane) = (u2v){__float_as_uint(d0), __float_as_uint(d1)}; if (lane == 0) TOT[0] = csl; }
            const int src = t >> 1; const float csa = bperm(cs0, src), csb = bperm(cs1, src), dta = bperm(d0, src), dtb_ = bperm(d1, src);
            const float cst = (t & 1) ? csb : csa, dtt = (t & 1) ? dtb_ : dta;
            const float wgt = dtt * __expf(csl - cst);
            const bool padt = c == 0 && t < 112;
            if (padt) { const v4u z = (v4u){0u, 0u, 0u, 0u}; pb0 = z; pb1 = z; pc0 = z; pc1 = z; px0 = z; px1 = z; }
            *(LAS v4u*)(KL + t * 144 + q * 16) = pb0; *(LAS v4u*)(KL + t * 144 + 64 + q * 16) = pb1;
            *(LAS v4u*)(QL + t * 144 + q * 16) = pc0; *(LAS v4u*)(QL + t * 144 + 64 + q * 16) = pc1;
            const unsigned xw[8] = {px0.x, px0.y, px0.z, px0.w, px1.x, px1.y, px1.z, px1.w};
            const unsigned bw[8] = {pb0.x, pb0.y, pb0.z, pb0.w, pb1.x, pb1.y, pb1.z, pb1.w};
#pragma unroll
            for (int j = 0; j < 8; ++j) { const int p = (j < 4 ? 8 * q : 32 + 8 * q) + 2 * (j & 3);
                *(LAS bf16*)(VT + p * TPITCH + 2 * t) = (bf16)(xw[j] & 0xffffu); *(LAS bf16*)(VT + (p + 1) * TPITCH + 2 * t) = (bf16)(xw[j] >> 16);
                const unsigned wb = cvtpk(__uint_as_float(bw[j] << 16) * wgt, __uint_as_float(bw[j] & 0xffff0000u) * wgt);
                *(LAS bf16*)(KT + p * TPITCH + 2 * t) = (bf16)(wb & 0xffffu); *(LAS bf16*)(KT + (p + 1) * TPITCH + 2 * t) = (bf16)(wb >> 16); }
        }
        LDS_BARRIER();
        float zz[16];
#pragma unroll
        for (int i = 0; i < 16; ++i) { const int row = seq_row(b, c, 16 * wave + i); zz[i] = bf2f(MIB[(size_t)(row >= 0 ? row : 0) * N_MAIN + CM_SZ + h * 64 + lane]); }
        if (c + 1 < 17) SSD_LOAD(c + 1);
        {
            f32x16 y;
#pragma unroll
            for (int i = 0; i < 16; ++i) y[i] = 0.f;
            const LAS unsigned char* qrow = QL + (32 * tt + r32) * 144;
#pragma unroll
            for (int s2 = 0; s2 < 2; ++s2) { y = MFMA32(pack8(SK0, s2), ld8x2(qrow + (16 * s2 + 4 * hi) * 2), y); y = MFMA32(pack8(SK1, s2), ld8x2(qrow + (32 + 16 * s2 + 4 * hi) * 2), y); }
            const float cst = CS[32 * tt + r32]; const float ect = __expf(cst);
#pragma unroll
            for (int i = 0; i < 16; ++i) y[i] *= ect;
            if (tt > 0) {
                const LAS float* FSw = (const LAS float*)(lds + S_FS) + wave * 128;
                f32x16 y2;
#pragma unroll
                for (int r = 0; r < 16; ++r) y2[r] = 0.f;
                for (int i = 0; i < tt; ++i) {
                    f32x16 gt;
#pragma unroll
                    for (int r = 0; r < 16; ++r) gt[r] = 0.f;
#pragma unroll
                    for (int ks = 0; ks < 4; ++ks) gt = MFMA32(ld16(KL + (32 * i + r32) * 144 + (16 * ks + 8 * hi) * 2), ld16(qrow + (16 * ks + 8 * hi) * 2), gt);
#pragma unroll
                    for (int g4 = 0; g4 < 4; ++g4) { const f4 fs4 = *(const LAS f4*)(FSw + 32 * i + 8 * g4 + 4 * hi); gt[4 * g4] *= fs4[0]; gt[4 * g4 + 1] *= fs4[1]; gt[4 * g4 + 2] *= fs4[2]; gt[4 * g4 + 3] *= fs4[3]; }
#pragma unroll
                    for (int s2 = 0; s2 < 2; ++s2) y2 = MFMA32(ld8x2(VT + (32 * vt + r32) * TPITCH + (32 * i + 16 * s2 + 4 * hi) * 2), pack8(gt, s2), y2);
                }
                const float et = __expf(fminf(cst - CS[32 * tt - 1], 0.f));
#pragma unroll
                for (int r = 0; r < 16; ++r) y[r] += et * y2[r];
            }
            {
                const int i = tt;
                f32x16 gt;
#pragma unroll
                for (int r = 0; r < 16; ++r) gt[r] = 0.f;
#pragma unroll
                for (int ks = 0; ks < 4; ++ks) gt = MFMA32(ld16(KL + (32 * i + r32) * 144 + (16 * ks + 8 * hi) * 2), ld16(qrow + (16 * ks + 8 * hi) * 2), gt);
#pragma unroll
                for (int g4 = 0; g4 < 4; ++g4) { const f4 cs4 = *(const LAS f4*)(CS + 32 * i + 8 * g4 + 4 * hi), dt4 = *(const LAS f4*)(DT + 32 * i + 8 * g4 + 4 * hi);
#pragma unroll
                    for (int e = 0; e < 4; ++e) { const bool vis = 8 * g4 + 4 * hi + e <= r32; const float wv = vis ? __expf(fminf(cst - cs4[e], 0.f)) * dt4[e] : 0.f; gt[4 * g4 + e] *= wv; } }
#pragma unroll
                for (int s2 = 0; s2 < 2; ++s2) y = MFMA32(ld8x2(VT + (32 * vt + r32) * TPITCH + (32 * i + 16 * s2 + 4 * hi) * 2), pack8(gt, s2), y);
            }
            const float ecl = __expf(TOT[0]);
#pragma unroll
            for (int r = 0; r < 16; ++r) { SK0[r] *= ecl; SK1[r] *= ecl; }
#pragma unroll 2
            for (int ks = 0; ks < 8; ++ks) { const bf16x8 xb = ld16(VT + (32 * vt + r32) * TPITCH + (16 * ks + 8 * hi) * 2);
                SK0 = MFMA32(ld16(KT + r32 * TPITCH + (16 * ks + 8 * hi) * 2), xb, SK0); SK1 = MFMA32(ld16(KT + (32 + r32) * TPITCH + (16 * ks + 8 * hi) * 2), xb, SK1); }
#pragma unroll
            for (int g4 = 0; g4 < 4; ++g4) { f4 o;
#pragma unroll
                for (int e = 0; e < 4; ++e) o[e] = y[4 * g4 + e] + Dh * bf2f(*(const LAS bf16*)(VT + (32 * vt + 8 * g4 + 4 * hi + e) * TPITCH + 2 * (32 * tt + r32)));
                *(LAS f4*)(OUT + (32 * tt + r32) * OPITCH + 32 * vt + 8 * g4 + 4 * hi) = o; }
        }
        LDS_BARRIER();
        {
            float yv[16], ss[16];
#pragma unroll
            for (int i = 0; i < 16; ++i) { yv[i] = OUT[(16 * wave + i) * OPITCH + lane] * zz[i]; ss[i] = fa::row16_sum(yv[i] * yv[i]); }
#pragma unroll
            for (int i = 0; i < 16; ++i) ss[i] += bperm(ss[i], lane ^ 16);
#pragma unroll
            for (int i = 0; i < 16; ++i) ss[i] += bperm(ss[i], lane ^ 32);
            if (c > 0) {
                const size_t row0 = (size_t)b * 2048 + 128 * (c - 1) + 16 * wave;
#pragma unroll
                for (int i = 0; i < 16; ++i) { if (lane == 0) SSQH[(row0 + i) * 8 + h] = ss[i]; MIXB[(row0 + i) * 1024 + 256 + h * 64 + lane] = (bf16)(cvtpk(yv[i], 0.f) & 0xffffu); }
            } else if (b == 0 && wave == 7) {
#pragma unroll
                for (int i = 0; i < 16; ++i) { if (lane == 0) SSQH[(size_t)(R_META + i) * 8 + h] = ss[i]; MIXB[(size_t)(R_META + i) * 1024 + 256 + h * 64 + lane] = (bf16)(cvtpk(yv[i], 0.f) & 0xffffu); }
            }
        }
        LDS_BARRIER();
    }
#undef SSD_LOAD
    if (tt == 0) {
#pragma unroll
        for (int g4 = 0; g4 < 4; ++g4) { *(GAS f4*)(state_out + (32 * vt + r32) * 64 + 8 * g4 + 4 * hi) = (f4){SK0[4 * g4], SK0[4 * g4 + 1], SK0[4 * g4 + 2], SK0[4 * g4 + 3]};
            *(GAS f4*)(state_out + (32 * vt + r32) * 64 + 32 + 8 * g4 + 4 * hi) = (f4){SK1[4 * g4], SK1[4 * g4 + 1], SK1[4 * g4 + 2], SK1[4 * g4 + 3]}; } }
}
#undef MFMA32
}

namespace eu {
using fa::f4;
constexpr int E_Q = 67840, E_K = 71936, E_V = 76032, E_LF = 80128, E_XBC = 80256, E_DT = 92544, E_GLOG = 92672, E_YS = 94720, E_GO = 102912, E_END = 107008;

__device__ __forceinline__ void sample_unit(int b, int l, const float* MI, const float* ck, const float* cv, const float* clf, const int* pt, const float* st_ssm, const float* st_conv, const float* st_gla,
        const float* qg, const float* kg, const float* fbias, const float* cw, const float* cb, const float* dtb, const float* alog, const float* dsk, const float* snorm,
        const float* wg, const float* gbias, const float* gnorm, bf16* MIXB, float* out, LAS unsigned char* lds, int tid) {
    const int lane = tid & 63, wave = __builtin_amdgcn_readfirstlane(tid >> 6);
    LAS float* EQ = (LAS float*)(lds + E_Q); LAS float* EK = (LAS float*)(lds + E_K); LAS float* EV = (LAS float*)(lds + E_V); LAS float* ELF = (LAS float*)(lds + E_LF);
    LAS float* EX = (LAS float*)(lds + E_XBC); LAS float* EDT = (LAS float*)(lds + E_DT); LAS float* EG = (LAS float*)(lds + E_GLOG); LAS float* EYS = (LAS float*)(lds + E_YS); LAS float* EGO = (LAS float*)(lds + E_GO);
    const int r0 = R_S + 4 * b;
    if (wave < 4) { const float* mi = MI + (size_t)(r0 + wave) * LDMI;
#pragma unroll
        for (int h = 0; h < 4; ++h) { const float q = mi[C_FQ + h * 64 + lane], k = mi[C_FK + h * 64 + lane], v = mi[C_FV + h * 64 + lane];
            const float qs = rsqrtf(wave_sum_l(q * q, lane) * (1.f / 64.f) + EPS), ks = rsqrtf(wave_sum_l(k * k, lane) * (1.f / 64.f) + EPS);
            EQ[wave * 256 + h * 64 + lane] = q * qs * qg[lane]; EK[wave * 256 + h * 64 + lane] = k * ks * kg[lane]; EV[wave * 256 + h * 64 + lane] = v; }
        if (lane < 4) ELF[wave * 4 + lane] = log_sigmoidf(mi[C_FF + lane] + fbias[lane]);
    }
    for (int idx = tid; idx < 3072; idx += 512) { const int i = idx / 768, c = idx - i * 768; float u[4];
#pragma unroll
        for (int j = 0; j < 4; ++j) { const int p = i - j; u[j] = p >= 0 ? MI[(size_t)(r0 + p) * LDMI + C_XBC + c] : st_conv[(size_t)(b * 3 + 3 + p) * 768 + c]; }
        const float o = cw[3 * 768 + c] * u[0] + cw[2 * 768 + c] * u[1] + cw[768 + c] * u[2] + cw[c] * u[3] + cb[c];
        EX[i * 768 + c] = siluf(o); }
    if (tid < 32) EDT[tid] = softplusf(MI[(size_t)(r0 + (tid >> 3)) * LDMI + C_DT + (tid & 7)] + dtb[tid & 7]);
    { const int i = tid >> 7, c = tid & 127; const float* lr = MI + (size_t)(r0 + i) * LDMI + C_LR; float a = gbias[c];
#pragma unroll
        for (int r = 0; r < 16; ++r) a += lr[r] * wg[r * 128 + c];
        EG[i * 128 + c] = log_sigmoidf(a) * (1.0f / 16.0f); }
    {
        const int h = lane >> 4, d4 = lane & 15;
        LAS f4* Dl = (LAS f4*)(lds + fa::S_D); LAS f4* wsum = (LAS f4*)(lds + fa::S_WS);
        {
            const int page = pt[b * 16 + (tid >> 5)];
            const f4* src = (const f4*)(clf + (((size_t)l * NPOOL + page) * 128 + 4 * (tid & 31)) * 4);
            const f4 v0 = src[0], v1 = src[1], v2 = src[2], v3 = src[3];
            const f4 s2 = v3, s1 = v3 + v2, s0 = s1 + v1, tot = s0 + v0;
            f4 x = tot;
#pragma unroll
            for (int o = 1; o < 64; o <<= 1) { f4 y; y[0] = bperm(x[0], lane + o); y[1] = bperm(x[1], lane + o); y[2] = bperm(x[2], lane + o); y[3] = bperm(x[3], lane + o); if (lane + o < 64) x += y; }
            if (lane == 0) wsum[wave] = x;
            __syncthreads();
            f4 off = x - tot;
            for (int w = wave + 1; w < 8; ++w) off += wsum[w];
            Dl[4 * tid + 0] = s0 + off; Dl[4 * tid + 1] = s1 + off; Dl[4 * tid + 2] = s2 + off; Dl[4 * tid + 3] = off;
            __syncthreads();
        }
        const int r16 = lane & 15, q4 = lane >> 4, hp = r16 >> 2, iq = lane & 3;
        f4 q[4];
#pragma unroll
        for (int i = 0; i < 4; ++i) q[i] = *(const LAS f4*)(EQ + i * 256 + h * 64 + 4 * d4) * 0.125f;
        float m = -INFINITY, ls = 0.f; f4 oc[4];
#pragma unroll
        for (int c = 0; c < 4; ++c) oc[c] = (f4){0.f, 0.f, 0.f, 0.f};
        const LAS float* Df = (const LAS float*)Dl;
        const bool b0 = lane & 1, b1 = lane & 2, mine = hp == q4;
        for (int p = 0; p < 16; ++p) {
            const int page = pt[b * 16 + p];
            const size_t base = (((size_t)l * NPOOL + page) * 128 + 16 * wave) * 256 + lane * 4;
            f4 kk[16], vv[16];
#pragma unroll
            for (int j = 0; j < 16; ++j) { kk[j] = __builtin_nontemporal_load((const f4*)(ck + base + (size_t)j * 256)); vv[j] = __builtin_nontemporal_load((const f4*)(cv + base + (size_t)j * 256)); }
            float sj[16];
#pragma unroll
            for (int j = 0; j < 16; ++j) {
                float pq[4];
#pragma unroll
                for (int i = 0; i < 4; ++i) pq[i] = q[i][0] * kk[j][0] + q[i][1] * kk[j][1] + q[i][2] * kk[j][2] + q[i][3] * kk[j][3];
                const float k0 = b0 ? pq[1] : pq[0], g0 = b0 ? pq[0] : pq[1], k1 = b0 ? pq[3] : pq[2], g1 = b0 ? pq[2] : pq[3];
                const float r0 = k0 + fa::dpp<fa::XOR1>(g0), r1 = k1 + fa::dpp<fa::XOR1>(g1);
                float t = (b1 ? r1 : r0) + fa::dpp<fa::XOR2>(b1 ? r0 : r1);
                t += fa::dpp<0x124>(t); t += fa::dpp<0x128>(t);
                sj[j] = t + Df[(p * 128 + 16 * wave + j) * 4 + h];
            }
            float mx = sj[0];
#pragma unroll
            for (int j = 1; j < 16; ++j) mx = fmaxf(mx, sj[j]);
            const float mn = fmaxf(m, mx); const float sc = __expf(m - mn); m = mn;
            float rs = 0.f;
#pragma unroll
            for (int j = 0; j < 16; ++j) { sj[j] = __expf(sj[j] - mn); rs += sj[j]; }
            ls = ls * sc + rs;
            const float scc = bperm(sc, 16 * hp + iq);
#pragma unroll
            for (int c = 0; c < 4; ++c) { oc[c][0] *= scc; oc[c][1] *= scc; oc[c][2] *= scc; oc[c][3] *= scc; }
#pragma unroll
            for (int g = 0; g < 2; ++g) {
                v4u w = (v4u){fa::cvtpk(sj[8 * g], sj[8 * g + 1]), fa::cvtpk(sj[8 * g + 2], sj[8 * g + 3]), fa::cvtpk(sj[8 * g + 4], sj[8 * g + 5]), fa::cvtpk(sj[8 * g + 6], sj[8 * g + 7])};
                if (!mine) w = (v4u){0u, 0u, 0u, 0u};
                const fa::bf16x8 pbv = __builtin_bit_cast(fa::bf16x8, w);
#pragma unroll
                for (int c = 0; c < 4; ++c) {
                    const v4u a = (v4u){fa::cvtpk(vv[8 * g][c], vv[8 * g + 1][c]), fa::cvtpk(vv[8 * g + 2][c], vv[8 * g + 3][c]), fa::cvtpk(vv[8 * g + 4][c], vv[8 * g + 5][c]), fa::cvtpk(vv[8 * g + 6][c], vv[8 * g + 7][c])};
                    oc[c] = __builtin_amdgcn_mfma_f32_16x16x32_bf16(__builtin_bit_cast(fa::bf16x8, a), pbv, oc[c], 0, 0, 0); }
            }
        }
        m = bperm(m, 16 * hp + iq); ls = bperm(ls, 16 * hp + iq);
        LAS float* part = (LAS float*)(lds + fa::S_PART);
        { LAS float* pp = part + (wave * 16 + r16) * fa::S_PSTR;
#pragma unroll
            for (int e = 0; e < 4; ++e) *(LAS f4*)(pp + 4 + 16 * q4 + 4 * e) = (f4){oc[0][e], oc[1][e], oc[2][e], oc[3][e]};
            if (q4 == 0) { pp[0] = m; pp[1] = ls; } }
        __syncthreads();
        for (int u = tid; u < 1024; u += 512) {
            const int hh = u >> 8, i = (u >> 6) & 3, d = u & 63;
            float sn[4]; float G = 0.f;
#pragma unroll
            for (int j = 0; j < 4; ++j) { G -= ELF[j * 4 + hh]; float dot = 0.f;
                for (int c = 0; c < 64; ++c) dot += EQ[i * 256 + hh * 64 + c] * EK[j * 256 + hh * 64 + c];
                sn[j] = j <= i ? dot * 0.125f + G : -INFINITY; }
            float mt = fmaxf(fmaxf(sn[0], sn[1]), fmaxf(sn[2], sn[3]));
            for (int w = 0; w < 8; ++w) mt = fmaxf(mt, part[(w * 16 + hh * 4 + i) * fa::S_PSTR]);
            float lt = 0.f, ot = 0.f;
            for (int w = 0; w < 8; ++w) { const LAS float* pp = part + (w * 16 + hh * 4 + i) * fa::S_PSTR; const float e = __expf(pp[0] - mt); lt += e * pp[1]; ot += e * pp[4 + d]; }
#pragma unroll
            for (int j = 0; j < 4; ++j) { const float e = __expf(sn[j] - mt); lt += e; ot += e * EV[j * 256 + hh * 64 + d]; }
            MIXB[(size_t)(r0 + i) * 1024 + hh * 64 + d] = (bf16)f2bf(ot / lt);
        }
    }
    {
        const int h = wave, g = h >> 2, p = lane;
        const f4* h0 = (const f4*)(st_ssm + (((size_t)b * 8 + h) * 64 + p) * 64);
        f4 hs[16];
#pragma unroll
        for (int n4 = 0; n4 < 16; ++n4) hs[n4] = h0[n4];
        const float A = -expf(alog[h]);
        for (int i = 0; i < 4; ++i) {
            const float dt = EDT[i * 8 + h]; const float dec = expf(dt * A); const float xdt = EX[i * 768 + h * 64 + p] * dt;
            float y = 0.f;
#pragma unroll
            for (int n4 = 0; n4 < 16; ++n4) { const f4 Bv = *(const LAS f4*)(EX + i * 768 + 512 + g * 64 + 4 * n4), Cv = *(const LAS f4*)(EX + i * 768 + 640 + g * 64 + 4 * n4);
                hs[n4] = hs[n4] * dec + Bv * xdt; y += Cv[0] * hs[n4][0] + Cv[1] * hs[n4][1] + Cv[2] * hs[n4][2] + Cv[3] * hs[n4][3]; }
            EYS[i * 512 + h * 64 + p] = y;
        }
        f4* ho = (f4*)(out + O_SSMS + (((size_t)(l * DEC_BATCH + b) * 8 + h) * 64 + p) * 64);
#pragma unroll
        for (int n4 = 0; n4 < 16; ++n4) ho[n4] = hs[n4];
    }
    if (wave < 4) {
        const int h = wave, v = lane;
        const float* s0 = st_gla + ((size_t)b * 4 + h) * 2048;
        float S[32];
#pragma unroll
        for (int k = 0; k < 32; ++k) S[k] = s0[k * 64 + v];
        for (int i = 0; i < 4; ++i) {
            const float* mi = MI + (size_t)(r0 + i) * LDMI;
            const float vv = mi[C_GV + h * 64 + v];
            float o = 0.f;
#pragma unroll
            for (int k4 = 0; k4 < 8; ++k4) { const f4 q4 = *(const f4*)(mi + C_GQ + h * 32 + 4 * k4), k4v = *(const f4*)(mi + C_GK + h * 32 + 4 * k4), g4 = *(const LAS f4*)(EG + i * 128 + h * 32 + 4 * k4);
#pragma unroll
                for (int e = 0; e < 4; ++e) { S[4 * k4 + e] = S[4 * k4 + e] * __expf(g4[e]) + k4v[e] * vv; o += q4[e] * 0.17677669529663687f * S[4 * k4 + e]; } }
            EGO[i * 256 + h * 64 + v] = o;
        }
        float* so = out + O_GLAS + ((size_t)(l * DEC_BATCH + b) * 4 + h) * 2048;
#pragma unroll
        for (int k = 0; k < 32; ++k) so[k * 64 + v] = S[k];
    }
    __syncthreads();
    if (wave < 4) { const int i = wave; const float* mi = MI + (size_t)(r0 + i) * LDMI;
#pragma unroll
        for (int g = 0; g < 2; ++g) { float y[4]; float s = 0.f;
#pragma unroll
            for (int e = 0; e < 4; ++e) { const int c = g * 256 + lane * 4 + e; y[e] = (EYS[i * 512 + c] + EX[i * 768 + c] * dsk[c >> 6]) * mi[C_SZ + c]; s += y[e] * y[e]; }
            const float rs = rsqrtf(wave_sum_l(s, lane) * (1.f / 256.f) + EPS);
            *(uint2*)(MIXB + (size_t)(r0 + i) * 1024 + 256 + g * 256 + lane * 4) = make_uint2(pk2(y[0] * rs * snorm[g * 256 + lane * 4], y[1] * rs * snorm[g * 256 + lane * 4 + 1]), pk2(y[2] * rs * snorm[g * 256 + lane * 4 + 2], y[3] * rs * snorm[g * 256 + lane * 4 + 3])); }
#pragma unroll
        for (int hh = 0; hh < 4; ++hh) { const float o = EGO[i * 256 + hh * 64 + lane]; const float rs = rsqrtf(wave_sum_l(o * o, lane) * (1.f / 64.f) + EPS);
            MIXB[(size_t)(r0 + i) * 1024 + 768 + hh * 64 + lane] = (bf16)f2bf(o * rs * gnorm[lane] * mi[C_GG + hh * 64 + lane]); }
    }
    __syncthreads();
}

constexpr int M_Q = 0, M_K = 16384, M_LF = 32768, M_F = 33024;
__device__ __forceinline__ void meta_unit(const float* MI, const float* qg, const float* kg, const float* fbias, bf16* MIXB, LAS unsigned char* lds, int tid) {
    const int lane = tid & 63, wave = __builtin_amdgcn_readfirstlane(tid >> 6);
    LAS float* MQ = (LAS float*)(lds + M_Q); LAS float* MK = (LAS float*)(lds + M_K); LAS float* MLF = (LAS float*)(lds + M_LF); LAS float* MF = (LAS float*)(lds + M_F);
    for (int j = wave; j < 16; j += 8) { const float* mi = MI + (size_t)(R_META + j) * LDMI;
#pragma unroll
        for (int h = 0; h < 4; ++h) { const float q = mi[C_FQ + h * 64 + lane], k = mi[C_FK + h * 64 + lane];
            const float qs = rsqrtf(wave_sum_l(q * q, lane) * (1.f / 64.f) + EPS), ks = rsqrtf(wave_sum_l(k * k, lane) * (1.f / 64.f) + EPS);
            MQ[j * 256 + h * 64 + lane] = q * qs * qg[lane]; MK[j * 256 + h * 64 + lane] = k * ks * kg[lane]; }
        if (lane < 4) MLF[j * 4 + lane] = log_sigmoidf(mi[C_FF + lane] + fbias[lane]); }
    __syncthreads();
    if (tid < 4) { float F = 0.f; for (int j = 0; j < 16; ++j) { F += MLF[j * 4 + tid]; MF[j * 4 + tid] = F; } }
    __syncthreads();
    for (int pr = wave; pr < 64; pr += 8) { const int h = pr >> 4, j = pr & 15;
        const float qv = MQ[j * 256 + h * 64 + lane];
        float sc[16]; float mx = -INFINITY;
#pragma unroll
        for (int k = 0; k < 16; ++k) { const float s = wave_sum_l(qv * MK[k * 256 + h * 64 + lane], lane) * 0.125f + (MF[j * 4 + h] - MF[k * 4 + h]); sc[k] = k <= j ? s : -INFINITY; mx = fmaxf(mx, sc[k]); }
        float sum = 0.f, o = 0.f;
#pragma unroll
        for (int k = 0; k < 16; ++k) { const float p = __expf(sc[k] - mx); sum += p; o += p * MI[(size_t)(R_META + k) * LDMI + C_FV + h * 64 + lane]; }
        MIXB[(size_t)(R_META + j) * 1024 + h * 64 + lane] = (bf16)f2bf(o / sum); }
    __syncthreads();
}
}

namespace eg {
using fa::bf16x8; using fa::f32x16; using fa::f4; using fa::crow;
template <int K, int NB>
__device__ __forceinline__ f4 egemm_tile(const bf16* A, const bf16* Bt, int row0, int col0, LAS unsigned char* lds, int tid) {
    const int lane = tid & 63, wave = __builtin_amdgcn_readfirstlane(tid >> 6), r32 = lane & 31, hi = lane >> 5;
    constexpr int KW = K / 8, NS = KW / 16, NBAT = (NS + NB - 1) / NB;
    const GAS bf16* ap = (const GAS bf16*)A + (size_t)(row0 + r32) * K + wave * KW + 8 * hi;
    const GAS bf16* bp0 = (const GAS bf16*)Bt + (size_t)(col0 + r32) * K + wave * KW + 8 * hi; const GAS bf16* bp1 = bp0 + (size_t)32 * K;
    f32x16 c0, c1;
#pragma unroll
    for (int i = 0; i < 16; ++i) { c0[i] = 0.f; c1[i] = 0.f; }
    bf16x8 fa_[2][NB], fb0[2][NB], fb1[2][NB];
#define EG_LOAD(buf, bat) do { _Pragma("unroll") for (int j = 0; j < NB; ++j) if ((bat) * NB + j < NS) { fa_[buf][j] = *(const GAS bf16x8*)(ap + ((bat) * NB + j) * 16); fb0[buf][j] = *(const GAS bf16x8*)(bp0 + ((bat) * NB + j) * 16); fb1[buf][j] = *(const GAS bf16x8*)(bp1 + ((bat) * NB + j) * 16); } } while (0)
#define EG_MMA(buf, bat) do { _Pragma("unroll") for (int j = 0; j < NB; ++j) if ((bat) * NB + j < NS) { c0 = __builtin_amdgcn_mfma_f32_32x32x16_bf16(fa_[buf][j], fb0[buf][j], c0, 0, 0, 0); c1 = __builtin_amdgcn_mfma_f32_32x32x16_bf16(fa_[buf][j], fb1[buf][j], c1, 0, 0, 0); } } while (0)
    EG_LOAD(0, 0);
#pragma unroll
    for (int bat = 0; bat < NBAT; ++bat) { if (bat + 1 < NBAT) { if ((bat + 1) & 1) EG_LOAD(1, bat + 1); else EG_LOAD(0, bat + 1); } if (bat & 1) EG_MMA(1, bat); else EG_MMA(0, bat); }
#undef EG_LOAD
#undef EG_MMA
    LAS float* red = (LAS float*)lds + wave * 2048;
#pragma unroll
    for (int i = 0; i < 16; ++i) { red[crow(i, hi) * 64 + r32] = c0[i]; red[crow(i, hi) * 64 + 32 + r32] = c1[i]; }
    __syncthreads();
    const LAS float* rp = (const LAS float*)lds + (tid >> 4) * 64 + (tid & 15) * 4;
    f4 s = *(const LAS f4*)rp;
#pragma unroll
    for (int w = 1; w < 8; ++w) s += *(const LAS f4*)(rp + w * 2048);
    __syncthreads();
    return s;
}
template <int K, int NB>
__device__ __forceinline__ void egemm_resid(const bf16* A, const bf16* Bt, float* X, bf16* XB, float* SSQP, float scale, float* out, int final_, LAS unsigned char* lds, int tid) {
    const int lane = tid & 63, wave = __builtin_amdgcn_readfirstlane(tid >> 6), r32 = lane & 31, hi = lane >> 5;
    constexpr int KW = K / 8, NS = KW / 16, NBAT = (NS + NB - 1) / NB;
    for (int u = blockIdx.x; u < 11 * 16; u += gridDim.x) {
        const int rt = u >> 4, ct = u & 15, row0 = MP + 48 * rt, col0 = 64 * ct;
        const int ra = row0 + (tid >> 4), col = col0 + (tid & 15) * 4; const bool hasb = (tid >> 4) < 16;
        GAS f4* xpa = (GAS f4*)(X + (size_t)ra * 1024 + col); GAS f4* xpb = (GAS f4*)(X + (size_t)(ra + 32) * 1024 + col);
        f4 xa = *xpa, xb = *xpb;
        const GAS bf16* ap0 = (const GAS bf16*)A + (size_t)(row0 + r32) * K + wave * KW + 8 * hi; const GAS bf16* ap1 = ap0 + (size_t)32 * K;
        const GAS bf16* bp0 = (const GAS bf16*)Bt + (size_t)(col0 + r32) * K + wave * KW + 8 * hi; const GAS bf16* bp1 = bp0 + (size_t)32 * K;
        f32x16 c00, c01, c10, c11;
#pragma unroll
        for (int i = 0; i < 16; ++i) { c00[i] = 0.f; c01[i] = 0.f; c10[i] = 0.f; c11[i] = 0.f; }
        constexpr int QB = 4, NQ = (NS + QB - 1) / QB;
        bf16x8 fa0[2][QB], fa1[2][QB], fb0[2][QB], fb1[2][QB];
#define EGR_LOAD(buf, bat) do { \
            _Pragma("unroll") for (int j = 0; j < QB; ++j) if ((bat) * QB + j < NS) fa0[buf][j] = *(const GAS bf16x8*)(ap0 + ((bat) * QB + j) * 16); \
            _Pragma("unroll") for (int j = 0; j < QB; ++j) if ((bat) * QB + j < NS) fb0[buf][j] = *(const GAS bf16x8*)(bp0 + ((bat) * QB + j) * 16); \
            _Pragma("unroll") for (int j = 0; j < QB; ++j) if ((bat) * QB + j < NS) fa1[buf][j] = *(const GAS bf16x8*)(ap1 + ((bat) * QB + j) * 16); \
            _Pragma("unroll") for (int j = 0; j < QB; ++j) if ((bat) * QB + j < NS) fb1[buf][j] = *(const GAS bf16x8*)(bp1 + ((bat) * QB + j) * 16); } while (0)
#define EGR_MMA(buf, bat) do { _Pragma("unroll") for (int j = 0; j < QB; ++j) if ((bat) * QB + j < NS) { \
            c00 = __builtin_amdgcn_mfma_f32_32x32x16_bf16(fa0[buf][j], fb0[buf][j], c00, 0, 0, 0); c01 = __builtin_amdgcn_mfma_f32_32x32x16_bf16(fa0[buf][j], fb1[buf][j], c01, 0, 0, 0); \
            c10 = __builtin_amdgcn_mfma_f32_32x32x16_bf16(fa1[buf][j], fb0[buf][j], c10, 0, 0, 0); c11 = __builtin_amdgcn_mfma_f32_32x32x16_bf16(fa1[buf][j], fb1[buf][j], c11, 0, 0, 0); } } while (0)
        EGR_LOAD(0, 0);
#pragma unroll
        for (int bat = 0; bat < NQ; ++bat) {
            if (bat + 1 < NQ) { if ((bat + 1) & 1) EGR_LOAD(1, bat + 1); else EGR_LOAD(0, bat + 1); }
            if (bat & 1) EGR_MMA(1, bat); else EGR_MMA(0, bat);
        }
#undef EGR_LOAD
#undef EGR_MMA
        LAS float* red = (LAS float*)lds + wave * 4096;
#pragma unroll
        for (int i = 0; i < 16; ++i) { red[crow(i, hi) * 64 + r32] = c00[i]; red[crow(i, hi) * 64 + 32 + r32] = c01[i]; red[(32 + crow(i, hi)) * 64 + r32] = c10[i]; red[(32 + crow(i, hi)) * 64 + 32 + r32] = c11[i]; }
        __syncthreads();
        const LAS float* rp = (const LAS float*)lds + (tid >> 4) * 64 + (tid & 15) * 4;
        f4 sa = *(const LAS f4*)rp, sb = *(const LAS f4*)(rp + 32 * 64);
#pragma unroll
        for (int w = 1; w < 8; ++w) { sa += *(const LAS f4*)(rp + w * 4096); sb += *(const LAS f4*)(rp + w * 4096 + 32 * 64); }
        __syncthreads();
#pragma unroll
        for (int hb = 0; hb < 2; ++hb) {
            if (hb == 1 && !hasb) break;
            const int row = hb ? ra + 32 : ra; f4 x = hb ? xb : xa; const f4 acc = hb ? sb : sa;
            x[0] += acc[0] * scale; x[1] += acc[1] * scale; x[2] += acc[2] * scale; x[3] += acc[3] * scale;
            *(hb ? xpb : xpa) = x;
            *(GAS la::u2v*)(XB + (size_t)row * 1024 + col) = (la::u2v){fa::cvtpk(x[0], x[1]), fa::cvtpk(x[2], x[3])};
            const float ss = fa::row16_sum((x[0] * x[0] + x[1] * x[1]) + (x[2] * x[2] + x[3] * x[3]));
            if ((tid & 15) == 0) SSQP[(size_t)row * 16 + ct] = ss;
            if (final_ && row < R_META) *(GAS f4*)(out + O_YS + (size_t)(row - R_S) * 1024 + col) = x;
        }
    }
}
}

namespace sm {
using fa::bf16x8; using fa::f32x16; using fa::crow;
__device__ __forceinline__ void smalls_gemm(const bf16* XB, const bf16* Wt, const float* SSQP, float* MI, float* LF, const float* fbias, float* out, int l, LAS unsigned char* lds, int tid, int u0, int ustep, int uend) {
    const int lane = tid & 63, wave = __builtin_amdgcn_readfirstlane(tid >> 6), r32 = lane & 31, hi = lane >> 5;
    constexpr int NU = (M_REAL + 31) / 32;
    const GAS bf16* bp = (const GAS bf16*)Wt + (size_t)r32 * 1024 + wave * 128 + 8 * hi;
    const GAS bf16* ap = (const GAS bf16*)XB + (size_t)r32 * 1024 + wave * 128 + 8 * hi;
    bf16x8 fa_[8], fb_[8];
    if (u0 < uend) {
#pragma unroll
        for (int j = 0; j < 8; ++j) fa_[j] = *(const GAS bf16x8*)(ap + (size_t)u0 * 32 * 1024 + 16 * j);
#pragma unroll
        for (int j = 0; j < 8; ++j) fb_[j] = *(const GAS bf16x8*)(bp + 16 * j); }
    for (int u = u0; u < uend; u += ustep) {
        const int row0 = 32 * u;
        f32x16 c;
#pragma unroll
        for (int i = 0; i < 16; ++i) c[i] = 0.f;
#pragma unroll
        for (int j = 0; j < 8; ++j) c = __builtin_amdgcn_mfma_f32_32x32x16_bf16(fa_[j], fb_[j], c, 0, 0, 0);
        if (u + ustep < uend) {
#pragma unroll
            for (int j = 0; j < 8; ++j) fa_[j] = *(const GAS bf16x8*)(ap + (size_t)(u + ustep) * 32 * 1024 + 16 * j); }
        const float rs = pg8::rstd_of(SSQP, row0 + (tid >> 4));
        LAS float* red = (LAS float*)lds + wave * 1024;
#pragma unroll
        for (int i = 0; i < 16; ++i) red[crow(i, hi) * 32 + r32] = c[i];
        __syncthreads();
        const int rr = tid >> 4, c0 = (tid & 15) * 2; const int row = row0 + rr;
        float v0 = 0.f, v1 = 0.f;
#pragma unroll
        for (int w = 0; w < 8; ++w) { v0 += ((const LAS float*)lds)[w * 1024 + rr * 32 + c0]; v1 += ((const LAS float*)lds)[w * 1024 + rr * 32 + c0 + 1]; }
        __syncthreads();
        v0 *= rs; v1 *= rs;
        if (c0 < 28) { MI[(size_t)row * LDMI + small2ref(c0)] = v0; MI[(size_t)row * LDMI + small2ref(c0 + 1)] = v1; }
        if (c0 < 4 && row < M_REAL) {
            const float x0 = v0 + fbias[c0], x1 = v1 + fbias[c0 + 1];
            const float l0 = fminf(x0, 0.f) - log1pf(__expf(-fabsf(x0))), l1 = fminf(x1, 0.f) - log1pf(__expf(-fabsf(x1)));
            LF[(size_t)row * 4 + c0] = l0; LF[(size_t)row * 4 + c0 + 1] = l1;
            if (row < MP) { float* o = out + O_LFP + ((size_t)(l * BATCH + (row >> 11)) * TP + 16 + (row & 2047)) * 4 + c0; o[0] = l0; o[1] = l1; }
            else if (row < R_META) { float* o = out + O_LFS + ((size_t)l * MS + (row - R_S)) * 4 + c0; o[0] = l0; o[1] = l1; }
            else for (int cc = 0; cc < BATCH; ++cc) { float* o = out + O_LFP + ((size_t)(l * BATCH + cc) * TP + (row - R_META)) * 4 + c0; o[0] = l0; o[1] = l1; }
        }
    }
}
}

struct Args { const float* in[31]; float* out; unsigned char* ws; int ph_lo, ph_hi; };

__device__ __forceinline__ void transpose_item(const float* W, int ldw, int K, const float* g, bf16* WT, int mapkind, int nblk, int item, LAS float* scr, int lane) {
    const int kb = item / nblk, nb = item % nblk, k0 = 64 * kb, n0 = 32 * nb;
    const int kr = lane >> 3, n4 = (lane & 7) * 4;
    const int nd = n0 + n4;
    int src;
    if (mapkind == 1) { const int pn = nd >> 8, s = nd & 255; src = s < 128 ? 128 * pn + s : 2816 + 128 * pn + (s - 128); }
    else if (mapkind == 2) { const int pn = nd >> 8, sl = nd & 255; src = pn < 3 ? 256 * pn + 64 * ((sl >> 5) & 3) + 32 * (sl >> 7) + (sl & 31) : main2ref(nd); if (src >= ldw) src = -1; }
    else if (mapkind == 3) src = small2ref(nd);
    else src = nd < ldw ? nd : -1;
    typedef float f4t __attribute__((ext_vector_type(4)));
    f4t wv[8];
#pragma unroll
    for (int i = 0; i < 8; ++i) wv[i] = *(const f4t*)(W + (size_t)(k0 + kr + 8 * i) * ldw + (src >= 0 ? src : 0));
#pragma unroll
    for (int i = 0; i < 8; ++i) { const int kk = kr + 8 * i; const float gv = g ? g[k0 + kk] : 1.f;
#pragma unroll
        for (int e = 0; e < 4; ++e) scr[kk * 33 + n4 + e] = src >= 0 ? wv[i][e] * gv : 0.f; }
    LDS_WAIT();
    const int c = lane & 7;
#pragma unroll
    for (int j = 0; j < 4; ++j) { const int n = (lane >> 3) + 8 * j; const LAS float* s = scr + (8 * c) * 33 + n;
        v4u o; o.x = pk2(s[0 * 33], s[1 * 33]); o.y = pk2(s[2 * 33], s[3 * 33]); o.z = pk2(s[4 * 33], s[5 * 33]); o.w = pk2(s[6 * 33], s[7 * 33]);
        *(v4u*)(WT + (size_t)(n0 + n) * K + k0 + 8 * c) = o; }
    LDS_WAIT();
}

template <class T> __device__ __forceinline__ T* as_global(T* p) { return (T*)(__attribute__((address_space(1))) T*)p; }
__device__ __forceinline__ int tid_now(int wave_s) { int t; asm volatile("v_mbcnt_lo_u32_b32 %0, -1, 0\n\tv_mbcnt_hi_u32_b32 %0, -1, %0" : "=v"(t)); return t | (wave_s << 6); }
__global__ void __launch_bounds__(NWAVES * 64, 2) fwd(Args args) {
    extern __shared__ __attribute__((aligned(16))) unsigned char lds[];
    volatile LAS unsigned* MISC = (volatile LAS unsigned*)((LAS unsigned char*)lds + MISC_OFF);
    if (threadIdx.x < 32) MISC[threadIdx.x] = 0u;
    __syncthreads();
    XcdBarrier bar = xcd_barrier_post((unsigned*)(args.ws + WS_CTL) + CW_BAR, MISC + 8);
    volatile LAS unsigned long long* PT = (volatile LAS unsigned long long*)((LAS unsigned char*)lds + MISC_OFF + 256);
    if (threadIdx.x < 31) PT[threadIdx.x] = (unsigned long long)args.in[threadIdx.x];
    __syncthreads();
#define INP(i) ((const float*)(const GAS float*)PT[i])
    const int lo = args.ph_lo, hi = args.ph_hi;
    const int wave_s = __builtin_amdgcn_readfirstlane((int)threadIdx.x >> 6);
    int ph = 0;
#define BUF(name, off) float* name = (float*)(ws_ + (off))
#define BUFH(name, off) bf16* name = (bf16*)(ws_ + (off))
#define PHASE_BEGIN_R(R) if (lo <= ph && ph < hi) for (int rep_ = 0; rep_ < (R); ++rep_) { GAS unsigned char* wsg_ = (GAS unsigned char*)args.ws; GAS float* outg_ = (GAS float*)args.out; int tid = tid_now(wave_s); asm volatile("" : "+s"(wsg_), "+s"(outg_)); unsigned char* ws_ = (unsigned char*)wsg_;         \
        const int lane = tid & 63, wave = tid >> 6; const int gw = blockIdx.x * NWAVES + wave, NGW = gridDim.x * NWAVES; float* smem = (float*)lds; float* out = (float*)outg_; (void)lane; (void)wave; (void)gw; (void)NGW; (void)smem; (void)out; \
        BUF(X, WS_X); BUFH(XB, WS_XB); BUF(SSQP, WS_SSQ); BUFH(HB, WS_HB); BUFH(MIXB, WS_MIXB); BUF(MI, WS_MI); BUF(QN, WS_QN); BUF(KN, WS_KN); BUF(LF, WS_LF); BUF(FC, WS_FC); BUF(FCS, WS_FCS); \
        BUF(XBC, WS_XBC); BUF(DTB, WS_DT); BUF(GLOG, WS_GLOG); BUF(YS, WS_YS); BUF(GO, WS_GO); BUFH(QF, WS_QF); BUFH(KF, WS_KF); BUFH(VT, WS_VT); BUF(SSQH, WS_SSQH); BUFH(XC, WS_XC); BUFH(MIB, WS_MIB); (void)MIB; (void)QF; (void)KF; (void)VT; (void)SSQH; (void)XC; \
        (void)X; (void)XB; (void)SSQP; (void)HB; (void)MIXB; (void)MI; (void)QN; (void)KN; (void)LF; (void)FC; (void)FCS; (void)XBC; (void)DTB; (void)GLOG; (void)YS; (void)GO;
#define PHASE_END_R(R) if (ph + 1 < hi || rep_ + 1 < (R)) xcd_barrier(bar, tid_now(wave_s)); } ++ph;
#define PHASE_BEGIN PHASE_BEGIN_R(1)
#define PHASE_END PHASE_END_R(1)
#define WT_(l, off) ((bf16*)(ws_ + WS_WT + (size_t)(l) * WL_SIZE + (off)))

#define CONVERT_ITEM(it_, scr_, ln_) do { constexpr int I1 = 16 * 176, I2 = 44 * 32, I3 = 16 * 88, I4 = 16 * 32, I7 = 16, IL = 2 * I1 + 2 * I2 + I3 + I4 + I7; static_assert(IL == 10384, "item space"); \
        const int lw = (it_) / IL; int r = (it_) % IL; \
        if (r < I1) { transpose_item(INP(11) + (size_t)lw * 1024 * 5632, 5632, 1024, INP(10) + lw * 1024, WT_(lw, WL_W1), 1, 176, r, scr_, ln_); break; } r -= I1; \
        if (r < I2) { transpose_item(INP(12) + (size_t)lw * 2816 * 1024, 1024, 2816, nullptr, WT_(lw, WL_W2), 0, 32, r, scr_, ln_); break; } r -= I2; \
        if (r < I3) { transpose_item(INP(14) + (size_t)lw * 1024 * N_IN, N_IN, 1024, INP(13) + lw * 1024, WT_(lw, WL_W3), 2, 88, r, scr_, ln_); break; } r -= I3; \
        if (r < I4) { transpose_item(INP(27) + (size_t)lw * 1024 * 1024, 1024, 1024, nullptr, WT_(lw, WL_W4), 0, 32, r, scr_, ln_); break; } r -= I4; \
        if (r < I1) { transpose_item(INP(29) + (size_t)lw * 1024 * 5632, 5632, 1024, INP(28) + lw * 1024, WT_(lw, WL_W5), 1, 176, r, scr_, ln_); break; } r -= I1; \
        if (r < I2) { transpose_item(INP(30) + (size_t)lw * 2816 * 1024, 1024, 2816, nullptr, WT_(lw, WL_W6), 0, 32, r, scr_, ln_); break; } r -= I2; \
        transpose_item(INP(14) + (size_t)lw * 1024 * N_IN, N_IN, 1024, INP(13) + lw * 1024, WT_(lw, WL_W7), 3, 1, r, scr_, ln_); } while (0)
#define CONVERT_RANGE(lo_, hi_, gwv_, ngwv_) do { const int tn_ = tid_now(wave_s); const int lnr_ = tn_ & 63; LAS float* scrr_ = (LAS float*)((LAS unsigned char*)lds + wave_s * 16384); \
        for (int itr_ = (lo_) + (gwv_); itr_ < (hi_); itr_ += (ngwv_)) CONVERT_ITEM(itr_, scrr_, lnr_); } while (0)
#define CONVERT_TAIL(lo_, hi_, first_) do { if (gridDim.x == 256) { if ((int)blockIdx.x >= (first_)) CONVERT_RANGE(lo_, hi_, ((int)blockIdx.x - (first_)) * NWAVES + wave_s, (256 - (first_)) * NWAVES); } \
        else CONVERT_RANGE(lo_, hi_, (int)blockIdx.x * NWAVES + wave_s, (int)gridDim.x * NWAVES); } while (0)
    PHASE_BEGIN_R(R_P0)
        CONVERT_RANGE(0, 2816, gw, NGW);
        for (int i = blockIdx.x * 512 + tid; i < 2 * 12288; i += gridDim.x * 512) { const int j = i % 12288;
            if (i < 12288) { const int bh = j / 384, sl = (j % 384) >> 3, ch = j & 7; *(v4u*)(KF + ((size_t)bh * 2112 + 16 + sl) * 64 + ch * 8) = (v4u){0u, 0u, 0u, 0u}; }
            else { const int bh = j / 384, d = (j % 384) / 6, ch = j % 6; *(v4u*)(VT + ((size_t)bh * 64 + d) * 2112 + 16 + ch * 8) = (v4u){0u, 0u, 0u, 0u}; } }
        for (int r0 = gw * 2; r0 < M_PAD; r0 += NGW * 2) {
            float4 v[2][4];
#pragma unroll
            for (int q = 0; q < 2; ++q) { const int r = r0 + q;
                const float* src = r < MP ? INP(0) + (size_t)r * 1024 : r < R_META ? INP(1) + (size_t)(r - R_S) * 1024 : r < M_REAL ? INP(9) + (size_t)(r - R_META) * 1024 : nullptr;
#pragma unroll
                for (int j = 0; j < 4; ++j) v[q][j] = src ? ((const float4*)src)[lane + 64 * j] : make_float4(0.f, 0.f, 0.f, 0.f); }
#pragma unroll
            for (int q = 0; q < 2; ++q) { const int r = r0 + q;
                float4* o = (float4*)(X + (size_t)r * 1024) + lane; uint2* ob = (uint2*)(XB + (size_t)r * 1024) + lane; float s = 0.f;
#pragma unroll
                for (int j = 0; j < 4; ++j) { const float4 w = v[q][j]; if (r >= MP) o[64 * j] = w; ob[64 * j] = make_uint2(pk2(w.x, w.y), pk2(w.z, w.w)); s += (w.x * w.x + w.y * w.y) + (w.z * w.z + w.w * w.w); }
                s = wave_sum(s);
                if (lane < 16) SSQP[(size_t)r * 16 + lane] = lane == 0 ? s : 0.f;
                if (r >= M_REAL) { uint2* m = (uint2*)(MIXB + (size_t)r * 1024) + lane;
#pragma unroll
                    for (int j = 0; j < 4; ++j) m[64 * j] = make_uint2(0u, 0u); } }
        }
    PHASE_END_R(R_P0)

    for (int l = 0; l < DEPTH; ++l) {
#define mix_norm (INP(13) + l * 1024)
#define fox_q_norm (INP(15) + l * 64)
#define fox_k_norm (INP(16) + l * 64)
#define fox_f_bias (INP(17) + l * 4)
#define conv_w (INP(18) + l * 4 * 768)
#define conv_b (INP(19) + l * 768)
#define dt_bias (INP(20) + l * 8)
#define a_log (INP(21) + l * 8)
#define ssd_d (INP(22) + l * 8)
#define ssd_norm (INP(23) + l * 512)
#define w_gate (INP(24) + l * 16 * 128)
#define gate_bias (INP(25) + l * 128)
#define gla_norm (INP(26) + l * 64)
#define cache_k (INP(2))
#define cache_v (INP(3))
#define cache_lf (INP(4))
#define state_ssm (INP(5) + (size_t)l * DEC_BATCH * 8 * 4096)
#define state_conv (INP(6) + (size_t)l * DEC_BATCH * 3 * 768)
#define state_gla (INP(7) + (size_t)l * DEC_BATCH * 4 * 2048)
#define pt ((const int*)INP(8))
        for (int half = 0; half < 2; ++half) {
            PHASE_BEGIN_R(R_G1) { pg8::Gemm g{XB, WT_(l, half ? WL_W5 : WL_W1), M_PAD, 5632, 1024}; pg8::StaticOrder S; S.init(M_PAD, 5632, (int)gridDim.x, (int)blockIdx.x);
                pg8::EpiSwiglu E{HB, SSQP}; pg8::gemm_phase<pg8::EpiSwiglu, pg8::StaticOrder, true, true>((LAS unsigned char*)lds, g, S, E, tid);
                if (l == 0 && half == 0) {
                    if (gridDim.x == 256) { if (blockIdx.x >= 194) CONVERT_RANGE(2816, 4224, ((int)blockIdx.x - 194) * NWAVES + wave_s, 62 * NWAVES); }
                    else CONVERT_RANGE(2816, 4224, (int)blockIdx.x * NWAVES + wave_s, (int)gridDim.x * NWAVES); }
                if (l == 0 && half == 1) CONVERT_TAIL(8960, 10368, 194);
                if (l == 1 && half == 0) CONVERT_TAIL(10384 + 2816, 10384 + 4224, 194);
                if (l == 1 && half == 1) CONVERT_TAIL(10384 + 8960, 10384 + 10368, 194);
                } PHASE_END_R(R_G1)
            PHASE_BEGIN { pg8::Gemm g{HB, WT_(l, half ? WL_W6 : WL_W2), MP, 1024, 2816}; pg8::StaticOrder S; S.init(MP, 1024, (int)gridDim.x, (int)blockIdx.x);
                pg8::EpiResid E{(const GAS float*)nullptr, X, XB, SSQP, 0.5f, out, (l == DEPTH - 1 && half == 1) ? 1 : 0};     pg8::gemm_phase<pg8::EpiResid, pg8::StaticOrder, true, true>((LAS unsigned char*)lds, g, S, E, tid);
                eg::egemm_resid<2816, 8>(HB, WT_(l, half ? WL_W6 : WL_W2), X, XB, SSQP, 0.5f, out, (l == DEPTH - 1 && half == 1) ? 1 : 0, (LAS unsigned char*)lds, tid_now(wave_s));
                if (l == 0 && half == 0) {
                    if (gridDim.x == 256) { if (blockIdx.x >= 176) { CONVERT_RANGE(4224, 5632, ((int)blockIdx.x - 176) * NWAVES + wave_s, 80 * NWAVES); CONVERT_RANGE(10368, 10384, ((int)blockIdx.x - 176) * NWAVES + wave_s, 80 * NWAVES); } }
                    else { CONVERT_RANGE(4224, 5632, (int)blockIdx.x * NWAVES + wave_s, (int)gridDim.x * NWAVES); CONVERT_RANGE(10368, 10384, (int)blockIdx.x * NWAVES + wave_s, (int)gridDim.x * NWAVES); } }     } PHASE_END
            if (half == 1) break;

            PHASE_BEGIN_R(R_G3) { pg8::Gemm g{XB, WT_(l, WL_W3), M_PAD, N_MAIN, 1024}; pg8::StaticOrder S; S.init(M_PAD, N_MAIN, (int)gridDim.x, (int)blockIdx.x);
                pg8::EpiMix E{MI, MIB, SSQP, QF, KF, VT, fox_q_norm, fox_k_norm, fox_f_bias, LF, out, l}; pg8::gemm_phase<pg8::EpiMix, pg8::StaticOrder, true, true>((LAS unsigned char*)lds, g, S, E, tid);
                {
                    constexpr int NUS = (M_REAL + 31) / 32; int u0 = blockIdx.x, us = gridDim.x, ue = NUS;
                    if (gridDim.x == 256) { if (blockIdx.x >= 225) { u0 = (int)blockIdx.x - 225; us = 31; ue = 310; } else { u0 = 310 + (int)blockIdx.x; us = 1024; } }
                    sm::smalls_gemm(XB, WT_(l, WL_W7), SSQP, MI, LF, fox_f_bias, out, l, (LAS unsigned char*)lds, tid_now(wave_s), u0, us, ue); }
                if (l == 0) {
                    if (gridDim.x == 256) { if (blockIdx.x >= 225) CONVERT_RANGE(5632, 6144, ((int)blockIdx.x - 225) * NWAVES + wave_s, 31 * NWAVES); }
                    else CONVERT_RANGE(5632, 6144, (int)blockIdx.x * NWAVES + wave_s, (int)gridDim.x * NWAVES); } } PHASE_END_R(R_G3)
            PHASE_BEGIN
            {
                typedef float f4v __attribute__((ext_vector_type(4)));
                LAS float* lrs = (LAS float*)((LAS unsigned char*)lds + wave * 1024);
                for (int blk = gw; blk < (NGW == 2048 ? 2048 : 2048 + 2); blk += NGW) {
                    const bool isP = blk < 2048; const int bb = blk >> 8, i0 = isP ? 8 * (blk & 255) : 8 * (blk - 2048);
                    const int rowb = isP ? bb * 2048 + i0 : R_META + i0;
                    f4v u[3][11];
#pragma unroll
                    for (int j = 0; j < 11; ++j) { const int i = i0 + j - 3; int pr;
                        if (isP) pr = i >= 0 ? bb * 2048 + i : R_META + 16 + i; else pr = i >= 0 ? R_META + i : -1;
#pragma unroll
                        for (int k = 0; k < 3; ++k) { const uint2 w = *(const uint2*)(MIB + (size_t)(pr >= 0 ? pr : 0) * N_MAIN + CM_XBC + 4 * (lane + 64 * k));
                            const f4v v = (f4v){__uint_as_float(w.x << 16), __uint_as_float(w.x & 0xffff0000u), __uint_as_float(w.y << 16), __uint_as_float(w.y & 0xffff0000u)}; u[k][j] = pr >= 0 ? v : (f4v){0.f, 0.f, 0.f, 0.f}; } }
                    const f4v lrv = lane < 32 ? *(const f4v*)(MI + (size_t)(rowb + (lane >> 2)) * LDMI + C_LR + 4 * (lane & 3)) : (f4v){0.f, 0.f, 0.f, 0.f};
                    const float dtr = MI[(size_t)(rowb + (lane >> 3)) * LDMI + C_DT + (lane & 7)];
                    if (lane < 32) *(LAS f4v*)(lrs + (lane >> 2) * 16 + 4 * (lane & 3)) = lrv;
                    DTB[(size_t)(rowb + (lane >> 3)) * 8 + (lane & 7)] = softplusf(dtr + dt_bias[lane & 7]);
#pragma unroll
                    for (int k = 0; k < 3; ++k) { const int col = 4 * (lane + 64 * k);
                        const f4v w0 = *(const f4v*)(conv_w + col), w1 = *(const f4v*)(conv_w + 768 + col), w2 = *(const f4v*)(conv_w + 2 * 768 + col), w3 = *(const f4v*)(conv_w + 3 * 768 + col), bs = *(const f4v*)(conv_b + col);
#pragma unroll
                        for (int j = 0; j < 8; ++j) { const f4v o = w3 * u[k][j + 3] + w2 * u[k][j + 2] + w1 * u[k][j + 1] + w0 * u[k][j] + bs;
                            *(uint2*)(XC + (size_t)(rowb + j) * 768 + col) = make_uint2(fa::cvtpk(pg8::silu_fast(o[0]), pg8::silu_fast(o[1])), fa::cvtpk(pg8::silu_fast(o[2]), pg8::silu_fast(o[3]))); } }
                    LDS_WAIT();
                    float wc0[16], wc1[16];
#pragma unroll
                    for (int r = 0; r < 16; ++r) { wc0[r] = w_gate[r * 128 + lane]; wc1[r] = w_gate[r * 128 + 64 + lane]; }
                    const float gb0 = gate_bias[lane], gb1 = gate_bias[64 + lane];
#pragma unroll
                    for (int j = 0; j < 8; ++j) { float a0 = gb0, a1 = gb1;
#pragma unroll
                        for (int r4 = 0; r4 < 4; ++r4) { const f4v x = *(const LAS f4v*)(lrs + j * 16 + 4 * r4);
                            a0 += x[0] * wc0[4 * r4] + x[1] * wc0[4 * r4 + 1] + x[2] * wc0[4 * r4 + 2] + x[3] * wc0[4 * r4 + 3]; a1 += x[0] * wc1[4 * r4] + x[1] * wc1[4 * r4 + 1] + x[2] * wc1[4 * r4 + 2] + x[3] * wc1[4 * r4 + 3]; }
                        GLOG[(size_t)(rowb + j) * 128 + lane] = (fminf(a0, 0.f) - __logf(1.0f + __expf(-fabsf(a0)))) * (1.0f / 16.0f);
                        GLOG[(size_t)(rowb + j) * 128 + 64 + lane] = (fminf(a1, 0.f) - __logf(1.0f + __expf(-fabsf(a1)))) * (1.0f / 16.0f); }
                    LDS_WAIT();
                }
                if (NGW == 2048 && gw < 16) {
                    const int m = gw, row = R_META + m;
                    f4v um[3][4];
#pragma unroll
                    for (int j = 0; j < 4; ++j) { const int i = m + j - 3;
#pragma unroll
                        for (int k = 0; k < 3; ++k) { const uint2 w = *(const uint2*)(MIB + (size_t)(R_META + (i >= 0 ? i : 0)) * N_MAIN + CM_XBC + 4 * (lane + 64 * k));
                            const f4v v = (f4v){__uint_as_float(w.x << 16), __uint_as_float(w.x & 0xffff0000u), __uint_as_float(w.y << 16), __uint_as_float(w.y & 0xffff0000u)}; um[k][j] = i >= 0 ? v : (f4v){0.f, 0.f, 0.f, 0.f}; } }
                    if (lane < 8) DTB[(size_t)row * 8 + lane] = softplusf(MI[(size_t)row * LDMI + C_DT + lane] + dt_bias[lane]);
#pragma unroll
                    for (int k = 0; k < 3; ++k) { const int col = 4 * (lane + 64 * k);
                        const f4v w0 = *(const f4v*)(conv_w + col), w1 = *(const f4v*)(conv_w + 768 + col), w2 = *(const f4v*)(conv_w + 2 * 768 + col), w3 = *(const f4v*)(conv_w + 3 * 768 + col), bs = *(const f4v*)(conv_b + col);
                        const f4v o = w3 * um[k][3] + w2 * um[k][2] + w1 * um[k][1] + w0 * um[k][0] + bs;
                        *(uint2*)(XC + (size_t)row * 768 + col) = make_uint2(fa::cvtpk(pg8::silu_fast(o[0]), pg8::silu_fast(o[1])), fa::cvtpk(pg8::silu_fast(o[2]), pg8::silu_fast(o[3]))); }
                    float a0 = gate_bias[lane], a1 = gate_bias[64 + lane];
#pragma unroll
                    for (int r = 0; r < 16; ++r) { const float x = MI[(size_t)row * LDMI + C_LR + r]; a0 += x * w_gate[r * 128 + lane]; a1 += x * w_gate[r * 128 + 64 + lane]; }
                    GLOG[(size_t)row * 128 + lane] = (fminf(a0, 0.f) - __logf(1.0f + __expf(-fabsf(a0)))) * (1.0f / 16.0f);
                    GLOG[(size_t)row * 128 + 64 + lane] = (fminf(a1, 0.f) - __logf(1.0f + __expf(-fabsf(a1)))) * (1.0f / 16.0f);
                }
            }
            PHASE_END
            PHASE_BEGIN_R(R_MIX)
            {
                volatile LAS unsigned* qslot = (volatile LAS unsigned*)((LAS unsigned char*)lds + MISC_OFF + 64);
                unsigned* qhead = (unsigned*)(ws_ + WS_CTL) + CW_Q + 64 * l + 8 * rep_;
                constexpr int U_SSDP = 0, U_GLAP = 64, U_SAMP = 96, U_PATT = 224, U_META = 480, U_END = 481;
                for (;;) {
                    __syncthreads();
                    if (tid == 0) *qslot = atomicAdd(qhead, 1u);
                    __syncthreads();
                    const int u = (int)*qslot;
                    constexpr int N_CVU = (10384 + 15) / 16;
                    if (u >= U_END) {
                        if (l != 0 || u >= U_END + N_CVU) break;
                        const int j = 16 * (u - U_END) + 2 * wave_s; LAS float* scrq_ = (LAS float*)((LAS unsigned char*)lds + wave_s * 16384); const int lnq_ = tid_now(wave_s) & 63;
                        for (int e = 0; e < 2; ++e) { const int jj = j + e; if (jj < 10384) { const int itq_ = jj < 2816 ? 6144 + jj : jj < 5632 ? 10384 + (jj - 2816) : jj < 10368 ? 14608 + (jj - 5632) : 20752 + (jj - 10368); CONVERT_ITEM(itq_, scrq_, lnq_); } }
                        continue;
                    }
                    int tidu = tid; asm volatile("" : "+v"(tidu));
                    if (u < U_GLAP) {
                        const int b = u >> 3, h = u & 7;
                        la::ssd_prompt_unit(b, h, (const GAS bf16*)MIB, (const GAS bf16*)XC, (const GAS float*)DTB, -expf(a_log[h]), ssd_d[h], (GAS bf16*)MIXB, (GAS float*)SSQH, (GAS float*)(out + O_SSMP + ((size_t)(l * BATCH + b) * 8 + h) * 4096), (LAS unsigned char*)lds, tidu);
                    } else if (u < U_SAMP) {
                        const int b = (u - U_GLAP) >> 2, h = (u - U_GLAP) & 3;
                        la::gla_prompt_unit(b, h, (const GAS bf16*)MIB, (const GAS float*)GLOG, (const GAS float*)gla_norm, (GAS bf16*)MIXB, (GAS float*)(out + O_GLAP + ((size_t)(l * BATCH + b) * 4 + h) * 2048), (LAS unsigned char*)lds, tidu);
                    } else if (u < U_META) {
                        const int k = u - U_SAMP;
                        const int su = k < 64 ? k : ((k >= 160 && k < 224) ? k - 96 : -1);
                        if (su >= 0) {
                            eu::sample_unit(su, l, MI, cache_k, cache_v, cache_lf, pt, state_ssm, state_conv, state_gla, fox_q_norm, fox_k_norm, fox_f_bias, conv_w, conv_b, dt_bias, a_log, ssd_d, ssd_norm,
                                            w_gate, gate_bias, gla_norm, MIXB, out, (LAS unsigned char*)lds, tidu);
                        } else {
                            const int j = k < 160 ? k - 64 : k - 128; fa::fox_prompt_unit((j & 31) >> 2, j & 3, 7 - (j >> 5), QF, KF, VT, LF, MIXB, (LAS unsigned char*)lds, tidu);
                        }
                    } else {
                        eu::meta_unit(MI, fox_q_norm, fox_k_norm, fox_f_bias, MIXB, (LAS unsigned char*)lds, tidu);
                    }
                }
            }
            PHASE_END_R(R_MIX)
            PHASE_BEGIN
                { const float4 gn0 = *(const float4*)(ssd_norm + lane * 4), gn1 = *(const float4*)(ssd_norm + 256 + lane * 4);
                for (int i0 = gw * 4; i0 < MP + 16; i0 += NGW * 4) {
                    const int r0 = i0 < MP ? i0 : i0 + (R_META - MP);
                    uint2 w[4][2]; float4 q[4][2];
#pragma unroll
                    for (int j = 0; j < 4; ++j) { const size_t r = (size_t)(r0 + j);
                        q[j][0] = *(const float4*)(SSQH + r * 8); q[j][1] = *(const float4*)(SSQH + r * 8 + 4);
                        w[j][0] = *(const uint2*)(MIXB + r * 1024 + 256 + lane * 4); w[j][1] = *(const uint2*)(MIXB + r * 1024 + 512 + lane * 4); }
#pragma unroll
                    for (int j = 0; j < 4; ++j) { const size_t r = (size_t)(r0 + j);
#pragma unroll
                        for (int g = 0; g < 2; ++g) { const float4 qq = q[j][g]; const float rs = rsqrtf((qq.x + qq.y + qq.z + qq.w) * (1.f / 256.f) + EPS); const float4 gn = g ? gn1 : gn0; const uint2 ww = w[j][g];
                            const float y0 = __uint_as_float(ww.x << 16) * rs * gn.x, y1 = __uint_as_float(ww.x & 0xffff0000u) * rs * gn.y, y2 = __uint_as_float(ww.y << 16) * rs * gn.z, y3 = __uint_as_float(ww.y & 0xffff0000u) * rs * gn.w;
                            *(uint2*)(MIXB + r * 1024 + 256 + g * 256 + lane * 4) = make_uint2(pk2(y0, y1), pk2(y2, y3)); } }
                } }
            PHASE_END
            PHASE_BEGIN { pg8::Gemm g{MIXB, WT_(l, WL_W4), MP, 1024, 1024}; pg8::StaticOrder S; S.init(MP, 1024, (int)gridDim.x, (int)blockIdx.x);
                pg8::EpiResid E{(const GAS float*)nullptr, X, XB, SSQP, 1.0f, out, 0}; pg8::gemm_phase<pg8::EpiResid, pg8::StaticOrder, true, true>((LAS unsigned char*)lds, g, S, E, tid);
                eg::egemm_resid<1024, 8>(MIXB, WT_(l, WL_W4), X, XB, SSQP, 1.0f, out, 0, (LAS unsigned char*)lds, tid_now(wave_s)); } PHASE_END
        }
    }
}

extern "C" void kernel_launch(void* const* d_in, const int* in_sizes, int n_in, void* d_out, int out_size, void* d_ws, size_t ws_size, hipStream_t stream) {
    static int grid = 0;
    if (grid == 0) {
        if (n_in != 31 || out_size != (int)O_END || ws_size < WS_END) { fprintf(stderr, "kernel_launch: unexpected sizes n_in %d out %d ws %zu (need %zu)\n", n_in, out_size, ws_size, (size_t)WS_END); grid = -1; return; }
        int dev = 0, cus = 0;
        if (hipGetDevice(&dev) != hipSuccess || hipDeviceGetAttribute(&cus, hipDeviceAttributeMultiprocessorCount, dev) != hipSuccess) { grid = -1; return; }
        if (hipFuncSetAttribute((const void*)fwd, hipFuncAttributeMaxDynamicSharedMemorySize, LDS_BYTES) != hipSuccess) { fprintf(stderr, "kernel_launch: hipFuncSetAttribute failed\n"); grid = -1; return; }
        (void)hipGetLastError();
        grid = cus;
    }
    if (grid < 0) return;
    (void)hipMemsetAsync((char*)d_ws + WS_CTL, 0, CTL_ZERO_BYTES, stream);
    Args a{};
    for (int i = 0; i < 31; ++i) a.in[i] = (const float*)d_in[i];
    a.out = (float*)d_out; a.ws = (unsigned char*)d_ws; a.ph_lo = 0; a.ph_hi = 1000;
    hipLaunchKernelGGL(fwd, dim3(grid), dim3(NWAVES * 64), LDS_BYTES, stream, a);
}
```

```cpp
#include <hip/hip_runtime.h>
#include <cstdio>
#include <cstdint>

constexpr int D_MODEL = 1024, BATCH = 8, SEQ = 2048, DEPTH = 2, DEC_BATCH = 128, DEC_SEQ = 4, PAST = 2048, PAGE = 128, NPAGES = 16, NPOOL = 2560;
constexpr int N_META = 16, TP = N_META + SEQ;
constexpr int D_FF = 2816;
constexpr float EPS = 1e-6f;
constexpr int N_IN = 2844, LDMI = 2848;
constexpr int C_FQ = 0, C_FK = 256, C_FV = 512, C_FF = 768, C_SZ = 772, C_XBC = 1284, C_DT = 2052, C_GQ = 2060, C_GK = 2188, C_GV = 2316, C_LR = 2572, C_GG = 2588;
constexpr int N_MAIN = 2816, CM_SZ = 768, CM_XBC = 1280, CM_GQ = 2048, CM_GK = 2176, CM_GV = 2304, CM_GG = 2560;
__host__ __device__ constexpr int main2ref(int c) { return c < 768 ? c : (c < 2048 ? c + 4 : (c < 2560 ? c + 12 : c + 28)); }
__host__ __device__ constexpr int small2ref(int j) { return j < 4 ? C_FF + j : (j < 12 ? C_DT + (j - 4) : (j < 28 ? C_LR + (j - 12) : -1)); }
constexpr int MP = BATCH * SEQ, MS = DEC_BATCH * DEC_SEQ, R_S = MP, R_META = MP + MS, M_REAL = R_META + N_META, M_PAD = 17152;
constexpr size_t O_YP = 0;
constexpr size_t O_YS = O_YP + (size_t)BATCH * SEQ * D_MODEL;
constexpr size_t O_KP = O_YS + (size_t)MS * D_MODEL;
constexpr size_t O_VP = O_KP + (size_t)DEPTH * BATCH * TP * 256;
constexpr size_t O_LFP = O_VP + (size_t)DEPTH * BATCH * TP * 256;
constexpr size_t O_SSMP = O_LFP + (size_t)DEPTH * BATCH * TP * 4;
constexpr size_t O_CONVP = O_SSMP + (size_t)DEPTH * BATCH * 8 * 64 * 64;
constexpr size_t O_GLAP = O_CONVP + (size_t)DEPTH * BATCH * 3 * 768;
constexpr size_t O_KS = O_GLAP + (size_t)DEPTH * BATCH * 4 * 32 * 64;
constexpr size_t O_VS = O_KS + (size_t)DEPTH * MS * 256;
constexpr size_t O_LFS = O_VS + (size_t)DEPTH * MS * 256;
constexpr size_t O_SSMS = O_LFS + (size_t)DEPTH * MS * 4;
constexpr size_t O_CONVS = O_SSMS + (size_t)DEPTH * DEC_BATCH * 8 * 64 * 64;
constexpr size_t O_GLAS = O_CONVS + (size_t)DEPTH * DEC_BATCH * 3 * 768;
constexpr size_t O_END = O_GLAS + (size_t)DEPTH * DEC_BATCH * 4 * 32 * 64;
static_assert(O_END == 46638080, "output size");

constexpr size_t MiB = 1u << 20;
constexpr size_t WS_CTL = 0, CTL_ZERO_BYTES = 1 * MiB;
constexpr size_t SZ_W1 = (size_t)5632 * 1024 * 2, SZ_W2 = (size_t)1024 * 2816 * 2, SZ_W3 = (size_t)2816 * 1024 * 2, SZ_W7 = (size_t)32 * 1024 * 2, SZ_W4 = (size_t)1024 * 1024 * 2;
constexpr size_t WL_W1 = 0, WL_W2 = WL_W1 + SZ_W1, WL_W3 = WL_W2 + SZ_W2, WL_W4 = WL_W3 + SZ_W3, WL_W5 = WL_W4 + SZ_W4, WL_W6 = WL_W5 + SZ_W1, WL_W7 = WL_W6 + SZ_W2, WL_SIZE = WL_W7 + SZ_W7;
constexpr size_t WS_WT = 2 * MiB;
constexpr size_t WS_X = WS_WT + 2 * WL_SIZE;
constexpr size_t WS_XB = WS_X + (size_t)M_PAD * 1024 * 4;
constexpr size_t WS_SSQ = WS_XB + (size_t)M_PAD * 1024 * 2;
constexpr size_t WS_HB = WS_SSQ + (size_t)M_PAD * 16 * 4;
constexpr size_t WS_MIXB = WS_HB + (size_t)M_PAD * 2816 * 2;
constexpr size_t WS_MI = WS_MIXB + (size_t)M_PAD * 1024 * 2;
constexpr size_t WS_QN = WS_MI + (size_t)M_PAD * LDMI * 4;
constexpr size_t WS_KN = WS_QN + (size_t)M_PAD * 256 * 4;
constexpr size_t WS_LF = WS_KN + (size_t)M_PAD * 256 * 4;
constexpr size_t WS_FC = WS_LF + (size_t)M_PAD * 4 * 4;
constexpr size_t WS_FCS = WS_FC + (size_t)M_PAD * 4 * 4;
constexpr size_t WS_XBC = WS_FCS + (size_t)128 * 4 * 2052 * 4 + 4096;
constexpr size_t WS_DT = WS_XBC + (size_t)M_PAD * 768 * 4;
constexpr size_t WS_GLOG = WS_DT + (size_t)M_PAD * 8 * 4;
constexpr size_t WS_YS = WS_GLOG + (size_t)M_PAD * 128 * 4;
constexpr size_t WS_GO = WS_YS + (size_t)M_PAD * 512 * 4;
constexpr size_t WS_QF = WS_GO + (size_t)M_PAD * 256 * 4;
constexpr size_t WS_KF = WS_QF + (size_t)32 * 2048 * 64 * 2;
constexpr size_t WS_VT = WS_KF + (size_t)32 * 2112 * 64 * 2;
constexpr size_t WS_SSQH = WS_VT + (size_t)32 * 2112 * 64 * 2;
constexpr size_t WS_XC = WS_SSQH + (size_t)M_PAD * 8 * 4;
constexpr size_t WS_MIB = WS_XC + (size_t)M_PAD * 768 * 2;
constexpr size_t WS_END = WS_MIB + (size_t)M_PAD * LDMI * 2;
static_assert(WS_X % 256 == 0 && WS_XB % 256 == 0 && WS_SSQ % 256 == 0 && WS_HB % 256 == 0 && WS_MIXB % 256 == 0 && WS_MI % 256 == 0, "alignment");

#ifndef R_P0
#define R_P0 1
#endif
#ifndef R_G1
#define R_G1 1
#endif
#ifndef R_G3
#define R_G3 1
#endif
#ifndef R_PREP
#define R_PREP 1
#endif
#ifndef R_MIX
#define R_MIX 1
#endif
#ifndef R_BAR
#define R_BAR 0
#endif
constexpr int CW_BAR = 4096, CW_Q = 8192;
constexpr int NWAVES = 8;
constexpr int LDS_BYTES = 147456;
constexpr int MISC_OFF = 131072 + 320;

#define LAS __attribute__((address_space(3)))
#define GAS __attribute__((address_space(1)))
#define LDS_WAIT() asm volatile("s_waitcnt lgkmcnt(0)" ::: "memory")
typedef unsigned short bf16;
typedef unsigned v4u __attribute__((ext_vector_type(4)));
__device__ __forceinline__ unsigned f2bf(float f) { unsigned u = __builtin_bit_cast(unsigned, f); return (u + 0x7fffu + ((u >> 16) & 1u)) >> 16; }
__device__ __forceinline__ unsigned pk2(float lo, float hi) { return f2bf(lo) | (f2bf(hi) << 16); }

__device__ __forceinline__ float bperm(float x, int srclane);
namespace pg8 {
#define PG8_LAS __attribute__((address_space(3)))
typedef unsigned short bf16_t;
typedef short bf16x8 __attribute__((ext_vector_type(8)));
typedef float f32x4 __attribute__((ext_vector_type(4)));
typedef unsigned u32x4 __attribute__((ext_vector_type(4)));
constexpr int BM = 256, BK = 64, HALF = 128, HTB = HALF * BK * 2  , STAGE_BYTES = 8 * HTB, NXCD = 8, WGM = 8;

__host__ __device__ __forceinline__ int lds_byte(int r, int c) { const int st = (r >> 4) * 2 + (c >> 5), rr = r & 15, cc = c & 31, ob = rr * 64 + cc * 2; return st * 1024 + (ob ^ (((ob >> 9) & 1) << 5)); }
__host__ __device__ __forceinline__ void stage_rc(int b, int& R, int& C) { const int st = b / 1024, sb = b % 1024, swz = sb ^ (((sb >> 9) & 1) << 5); R = (st >> 1) * 16 + swz / 64; C = (st & 1) * 32 + (swz % 64) / 2; }
__host__ __device__ __forceinline__ int perm32(int rho) { const int n = rho >> 4, i = rho & 15; return 8 * (i >> 2) + 4 * n + (i & 3); }

struct Unit { int pm, pn; };
struct Gemm { const bf16_t* A; const bf16_t* Bt; int M, N, K; };

struct StaticOrder {
    int nM, nN, nwg, G, c;
    __host__ __device__ void init(int M, int N, int G_, int c_) { nM = M / BM; nN = N / BM; nwg = nM * nN; G = G_; c = c_; }
    __host__ __device__ bool next(int i, Unit& u) const {
        const long L = (long)i * G + c; if (L >= nwg) return false;
        int wgid = (int)L; { const int q = nwg / NXCD, r = nwg % NXCD, xcd = wgid % NXCD, off = wgid / NXCD; wgid = (xcd < r ? xcd * (q + 1) : r * (q + 1) + (xcd - r) * q) + off; }
        const int nig = WGM * nN, gid = wgid / nig, fm = gid * WGM, gsz = (nM - fm) < WGM ? (nM - fm) : WGM;
        u.pm = fm + ((wgid % nig) % gsz); u.pn = (wgid % nig) / gsz; return true;
    }
    __device__ __forceinline__ void a_ready(const Unit&) const {}
    __device__ __forceinline__ void done(const Unit&) const {}
};

__device__ __forceinline__ unsigned cvt_pk_bf16(float lo, float hi) { unsigned r; asm volatile("v_cvt_pk_bf16_f32 %0, %1, %2" : "=v"(r) : "v"(lo), "v"(hi)); return r; }
typedef float f32x2 __attribute__((ext_vector_type(2)));
__device__ __forceinline__ f32x2 gelu_pk(f32x2 v) {
    const f32x2 av = __builtin_elementwise_abs(v), d = av * 0.2316418882f + 1.0f;
    f32x2 t; t.x = __builtin_amdgcn_rcpf(d.x); t.y = __builtin_amdgcn_rcpf(d.y);
    f32x2 q = t * 0.5307027145f + (-0.7265760135f); q = q * t + 0.7107068705f; q = q * t + (-0.142248368f); q = q * t + 0.127414796f; q = q * t;
    const f32x2 s = (v * v) * (-0.72134752044f);
    f32x2 e; e.x = __builtin_amdgcn_exp2f(s.x); e.y = __builtin_amdgcn_exp2f(s.y);
    const f32x2 m = v * (q * e), r = v - m;
    f32x2 o; o.x = v.x < 0.f ? m.x : r.x; o.y = v.y < 0.f ? m.y : r.y; return o;
}


__device__ __forceinline__ float rstd_of(const float* SSQP, int row) {
    const f32x4* p = (const f32x4*)(SSQP + (size_t)row * 16);
    const f32x4 a = p[0], b = p[1], c = p[2], d = p[3];
    const float s = ((a[0] + a[1]) + (a[2] + a[3])) + ((b[0] + b[1]) + (b[2] + b[3])) + ((c[0] + c[1]) + (c[2] + c[3])) + ((d[0] + d[1]) + (d[2] + d[3]));
    return __builtin_amdgcn_rsqf(s * (1.0f / 1024.0f) + 1e-6f);
}
__device__ __forceinline__ float silu_fast(float x) { return x * __builtin_amdgcn_rcpf(1.0f + __expf(-x)); }
struct EpiSwiglu {
    static constexpr bool PERM = true, AFTER_DRAIN = false;
    bf16_t* H; const float* SSQP;
    __device__ __forceinline__ void operator()(const f32x4 (&acc)[2][2][4][2], const Unit& u, int wr, int wc, int fr, int fq) const {
        const int row0 = u.pm * BM + wr * 64 + fr, col0 = u.pn * 128 + wc * 32 + 8 * fq;
#pragma unroll
        for (int ai = 0; ai < 2; ++ai)
#pragma unroll
            for (int m = 0; m < 4; ++m) { const int row = row0 + ai * HALF + m * 16; const float rs = rstd_of(SSQP, row);
                const f32x4 g0 = acc[ai][0][m][0], g1 = acc[ai][0][m][1], u0 = acc[ai][1][m][0], u1 = acc[ai][1][m][1]; const float rs2 = rs * rs;
#define SWG(g, u) (silu_fast((g) * rs) * (u) * rs)
                u32x4 w; w.x = cvt_pk_bf16(SWG(g0[0], u0[0]), SWG(g0[1], u0[1])); w.y = cvt_pk_bf16(SWG(g0[2], u0[2]), SWG(g0[3], u0[3]));
                w.z = cvt_pk_bf16(SWG(g1[0], u1[0]), SWG(g1[1], u1[1])); w.w = cvt_pk_bf16(SWG(g1[2], u1[2]), SWG(g1[3], u1[3])); (void)rs2;
#undef SWG
                *(u32x4*)(H + (size_t)row * 2816 + col0) = w; }
    }
};
struct EpiResid {
    static constexpr bool PERM = true, AFTER_DRAIN = false;
    const GAS float* Xin; float* X; bf16_t* XB; float* SSQP; float scale; float* out; int final_;
    __device__ __forceinline__ void operator()(const f32x4 (&acc)[2][2][4][2], const Unit& u, int wr, int wc, int fr, int fq) const {
        const int row0 = u.pm * BM + wr * 64 + fr;
#pragma unroll
        for (int ai = 0; ai < 2; ++ai)
#pragma unroll
            for (int m = 0; m < 4; ++m) { const int row = row0 + ai * HALF + m * 16; float ss = 0.f;
#pragma unroll
                for (int bj = 0; bj < 2; ++bj) { const int col = u.pn * BM + bj * HALF + wc * 32 + 8 * fq;
                    const f32x4 a0 = acc[ai][bj][m][0], a1 = acc[ai][bj][m][1]; f32x4 x0, x1;
                    if (Xin) { const GAS f32x4* xi = (const GAS f32x4*)(Xin + (size_t)row * 1024 + col); x0 = xi[0]; x1 = xi[1]; }
                    else { const u32x4 wb = *(const u32x4*)(XB + (size_t)row * 1024 + col);
                        x0[0] = __uint_as_float(wb.x << 16); x0[1] = __uint_as_float(wb.x & 0xffff0000u); x0[2] = __uint_as_float(wb.y << 16); x0[3] = __uint_as_float(wb.y & 0xffff0000u);
                        x1[0] = __uint_as_float(wb.z << 16); x1[1] = __uint_as_float(wb.z & 0xffff0000u); x1[2] = __uint_as_float(wb.w << 16); x1[3] = __uint_as_float(wb.w & 0xffff0000u); }
                    x0[0] += a0[0] * scale; x0[1] += a0[1] * scale; x0[2] += a0[2] * scale; x0[3] += a0[3] * scale; x1[0] += a1[0] * scale; x1[1] += a1[1] * scale; x1[2] += a1[2] * scale; x1[3] += a1[3] * scale;
                    if (!final_) {
                    u32x4 w; w.x = cvt_pk_bf16(x0[0], x0[1]); w.y = cvt_pk_bf16(x0[2], x0[3]); w.z = cvt_pk_bf16(x1[0], x1[1]); w.w = cvt_pk_bf16(x1[2], x1[3]);
                    *(u32x4*)(XB + (size_t)row * 1024 + col) = w;
                    ss += (x0[0] * x0[0] + x0[1] * x0[1]) + (x0[2] * x0[2] + x0[3] * x0[3]) + (x1[0] * x1[0] + x1[1] * x1[1]) + (x1[2] * x1[2] + x1[3] * x1[3]); }
                    if (final_) { float* o = nullptr; if (row < MP) o = out + O_YP + (size_t)row * 1024 + col; else if (row < R_META) o = out + O_YS + (size_t)(row - R_S) * 1024 + col;
                        if (o) { ((f32x4*)o)[0] = x0; ((f32x4*)o)[1] = x1; } } }
                ss += bperm(ss, (fq * 16 + fr) ^ 16); ss += bperm(ss, (fq * 16 + fr) ^ 32);
                if (fq == 0 && !final_) SSQP[(size_t)row * 16 + u.pn * 4 + wc] = ss; }
    }
};
struct EpiMix {
    static constexpr bool PERM = true, AFTER_DRAIN = false;
    float* MI; bf16_t* MIB; const float* SSQP; bf16_t* QF; bf16_t* KF; bf16_t* VT; const float* qg; const float* kg; const float* fbias; float* LF; float* out; int l;
    __device__ __forceinline__ void operator()(const f32x4 (&acc)[2][2][4][2], const Unit& u, int wr, int wc, int fr_, int fq_) const {
        int ln_; asm volatile("v_mbcnt_lo_u32_b32 %0, -1, 0\n\tv_mbcnt_hi_u32_b32 %0, -1, %0" : "=v"(ln_)); const int fr = ln_ & 15, fq = ln_ >> 4; (void)fr_; (void)fq_;
        const int row0 = u.pm * BM + wr * 64 + fr;
        if (u.pn < 3) {
            f32x4 gn[2][2];
            const float* gp = u.pn == 0 ? qg : kg;
#pragma unroll
            for (int bj = 0; bj < 2; ++bj)
#pragma unroll
                for (int n = 0; n < 2; ++n) gn[bj][n] = u.pn < 2 ? *(const f32x4*)(gp + 32 * bj + 8 * fq + 4 * n) : (f32x4){1.f, 1.f, 1.f, 1.f};
            const float qs = u.pn == 0 ? 0.18033688011112042f : 1.0f;
#pragma unroll
            for (int ai = 0; ai < 2; ++ai)
#pragma unroll
                for (int m = 0; m < 4; ++m) { const int row = row0 + ai * HALF + m * 16; const float rs = rstd_of(SSQP, row);
                    float v[2][8]; float ss = 0.f;
#pragma unroll
                    for (int bj = 0; bj < 2; ++bj) { const f32x4 a0 = acc[ai][bj][m][0], a1 = acc[ai][bj][m][1];
                        v[bj][0] = a0[0] * rs; v[bj][1] = a0[1] * rs; v[bj][2] = a0[2] * rs; v[bj][3] = a0[3] * rs; v[bj][4] = a1[0] * rs; v[bj][5] = a1[1] * rs; v[bj][6] = a1[2] * rs; v[bj][7] = a1[3] * rs;
                        if (row >= MP) { f32x4* o = (f32x4*)(MI + (size_t)row * LDMI + u.pn * 256 + wc * 64 + bj * 32 + 8 * fq);
                            o[0] = (f32x4){v[bj][0], v[bj][1], v[bj][2], v[bj][3]}; o[1] = (f32x4){v[bj][4], v[bj][5], v[bj][6], v[bj][7]}; }
#pragma unroll
                        for (int e = 0; e < 8; ++e) ss += v[bj][e] * v[bj][e]; }
                    if (u.pn < 2) { ss += bperm(ss, (fq * 16 + fr) ^ 16); ss += bperm(ss, (fq * 16 + fr) ^ 32); const float hn = __builtin_amdgcn_rsqf(ss * (1.0f / 64.0f) + 1e-6f) * qs;
#pragma unroll
                        for (int bj = 0; bj < 2; ++bj)
#pragma unroll
                            for (int e = 0; e < 8; ++e) v[bj][e] *= hn * gn[bj][e >> 2][e & 3]; }
                    const bool isP = row < MP, isM = row >= R_META && row < M_REAL;
                    if (u.pn > 0 && row < M_REAL) {
                        float* ob; int nc = 1; size_t cs_ = 0;
                        if (isP) ob = out + (u.pn == 1 ? O_KP : O_VP) + ((size_t)(l * BATCH + (row >> 11)) * TP + 16 + (row & 2047)) * 256;
                        else if (isM) { ob = out + (u.pn == 1 ? O_KP : O_VP) + ((size_t)(l * BATCH) * TP + (row - R_META)) * 256; nc = BATCH; cs_ = (size_t)TP * 256; }
                        else ob = out + (u.pn == 1 ? O_KS : O_VS) + ((size_t)l * MS + (row - R_S)) * 256;
                        for (int c = 0; c < nc; ++c)
#pragma unroll
                            for (int bj = 0; bj < 2; ++bj) { f32x4* o = (f32x4*)(ob + c * cs_ + wc * 64 + bj * 32 + 8 * fq);
                                o[0] = (f32x4){v[bj][0], v[bj][1], v[bj][2], v[bj][3]}; o[1] = (f32x4){v[bj][4], v[bj][5], v[bj][6], v[bj][7]}; }
                    }
                    if (isP || (isM && u.pn > 0)) {
                        const int b0 = isP ? (row >> 11) : 0, nb = isP ? 1 : 8, slot = isP ? 64 + (row & 2047) : row - R_META;
                        for (int bb = b0; bb < b0 + nb; ++bb) { const int bh = bb * 4 + wc;
                            if (u.pn < 2) {
                                bf16_t* dst = u.pn == 0 ? QF + ((size_t)bh * 2048 + (row & 2047)) * 64 : KF + ((size_t)bh * 2112 + slot) * 64;
#pragma unroll
                                for (int bj = 0; bj < 2; ++bj) { u32x4 w; w.x = cvt_pk_bf16(v[bj][0], v[bj][1]); w.y = cvt_pk_bf16(v[bj][2], v[bj][3]); w.z = cvt_pk_bf16(v[bj][4], v[bj][5]); w.w = cvt_pk_bf16(v[bj][6], v[bj][7]);
                                    *(u32x4*)(dst + 32 * bj + 8 * fq) = w; }
                            } else {
#pragma unroll
                                for (int bj = 0; bj < 2; ++bj)
#pragma unroll
                                    for (int e = 0; e < 8; e += 2) { const unsigned w = cvt_pk_bf16(v[bj][e], v[bj][e + 1]); const int d = 32 * bj + 8 * fq + e;
                                        VT[((size_t)bh * 64 + d) * 2112 + slot] = (bf16_t)(w & 0xffffu); VT[((size_t)bh * 64 + d + 1) * 2112 + slot] = (bf16_t)(w >> 16); }
                            } } } }
        } else {
#pragma unroll
            for (int ai = 0; ai < 2; ++ai)
#pragma unroll
                for (int m = 0; m < 4; ++m) { const int row = row0 + ai * HALF + m * 16; const float rs = rstd_of(SSQP, row);
#pragma unroll
                    for (int bj = 0; bj < 2; ++bj) { const int colm = u.pn * BM + bj * HALF + wc * 32 + 8 * fq, col = main2ref(colm);
                        const f32x4 a0 = acc[ai][bj][m][0], a1 = acc[ai][bj][m][1];
                        f32x4 r0v = (f32x4){a0[0] * rs, a0[1] * rs, a0[2] * rs, a0[3] * rs}, r1v = (f32x4){a1[0] * rs, a1[1] * rs, a1[2] * rs, a1[3] * rs};
                        if ((colm >= CM_SZ && colm < CM_SZ + 512) || colm >= CM_GG) {
#pragma unroll
                            for (int e = 0; e < 4; ++e) { r0v[e] = silu_fast(r0v[e]); r1v[e] = silu_fast(r1v[e]); } }
                        { u32x4 w; w.x = cvt_pk_bf16(r0v[0], r0v[1]); w.y = cvt_pk_bf16(r0v[2], r0v[3]); w.z = cvt_pk_bf16(r1v[0], r1v[1]); w.w = cvt_pk_bf16(r1v[2], r1v[3]); *(u32x4*)(MIB + (size_t)row * N_MAIN + colm) = w; }
                        if (row >= MP) { f32x4* o = (f32x4*)(MI + (size_t)row * LDMI + col); o[0] = r0v; o[1] = r1v; }
                        if (colm >= CM_XBC && colm < CM_XBC + 768) {
                            float* cvo = nullptr;
                            if (row < MP) { if ((row & 2047) >= 2045) cvo = out + O_CONVP + ((size_t)(l * BATCH + (row >> 11)) * 3 + ((row & 2047) - 2045)) * 768; }
                            else if (row < R_META) { if (((row - R_S) & 3) >= 1) cvo = out + O_CONVS + ((size_t)(l * DEC_BATCH + ((row - R_S) >> 2)) * 3 + (((row - R_S) & 3) - 1)) * 768; }
                            if (cvo) { *(f32x4*)(cvo + colm - CM_XBC) = r0v; *(f32x4*)(cvo + colm - CM_XBC + 4) = r1v; } }
                    } }
        }
    }
};

template <class Epi, class Sched, bool ALIGN_EPI = false, bool SP2 = false>
__device__ __forceinline__ void gemm_phase(PG8_LAS unsigned char* lds, const Gemm g, const Sched& S, const Epi& E, const int tid) {
    const int wid = __builtin_amdgcn_readfirstlane(tid >> 6), lane = tid & 63, wr = wid >> 2, wc = wid & 3, fr = lane & 15, fq = lane >> 4;
    const int K = g.K, nt = K / BK;
    unsigned voffA[2], voffB[2];
#pragma unroll
    for (int i = 0; i < 2; ++i) { int R, C; stage_rc(tid * 16 + i * 8192, R, C); const int Rb = Epi::PERM ? ((R & ~31) + perm32(R & 31)) : R;
        voffA[i] = (unsigned)(R * K + C) * 2u; voffB[i] = (unsigned)(Rb * K + C) * 2u; }
    const size_t kstep = (size_t)(BK * 2);
    const size_t hstep = (size_t)HALF * K * 2;
    const size_t tstep = 2 * hstep;
    const unsigned ldsw = (unsigned)wid * 1024u;
    const int aoff = lds_byte(wr * 64 + fr, fq * 8), boff = lds_byte(wc * 32 + fr, fq * 8);
#define PG8_SA(b, h) (((b) * 2 + (h)) * HTB)
#define PG8_SB(b, h) ((4 + (b) * 2 + (h)) * HTB)
#define PG8_STAGE(bufoff, gbase, voff) do { _Pragma("unroll") for (int _i = 0; _i < 2; ++_i) \
        __builtin_amdgcn_global_load_lds((const unsigned*)((const char*)(gbase) + (voff)[_i]), (PG8_LAS unsigned*)(lds + (bufoff) + ldsw + _i * 8192), 16, 0, 0); } while (0)
#define PG8_LDA(dst, b, h) do { _Pragma("unroll") for (int m = 0; m < 4; ++m) _Pragma("unroll") for (int k = 0; k < 2; ++k) dst[m][k] = *(const PG8_LAS bf16x8*)(lds + PG8_SA(b, h) + aoff + m * 2048 + k * 1024); } while (0)
#define PG8_LDB(dst, b, h) do { _Pragma("unroll") for (int n = 0; n < 2; ++n) _Pragma("unroll") for (int k = 0; k < 2; ++k) dst[n][k] = *(const PG8_LAS bf16x8*)(lds + PG8_SB(b, h) + boff + n * 2048 + k * 1024); } while (0)
#define PG8_MMA(ai, bj, At, Bt) do { __builtin_amdgcn_s_setprio(1); _Pragma("unroll") for (int m = 0; m < 4; ++m) _Pragma("unroll") for (int n = 0; n < 2; ++n) _Pragma("unroll") for (int k = 0; k < 2; ++k) \
        acc[ai][bj][m][n] = __builtin_amdgcn_mfma_f32_16x16x32_bf16(Bt[n][k], At[m][k], acc[ai][bj][m][n], 0, 0, 0); __builtin_amdgcn_s_setprio(0); } while (0)
#define PG8_WAIT_V(n) asm volatile("s_waitcnt vmcnt(" #n ")" ::: "memory")
#define PG8_WAIT_L(n) asm volatile("s_waitcnt lgkmcnt(" #n ")" ::: "memory")
#define PG8_BAR __builtin_amdgcn_s_barrier()
#define PG8_SCHED __builtin_amdgcn_sched_barrier(0)
    Unit cur, nxt; int ui = 0;
    if (!S.next(0, cur)) return;
    f32x4 acc[2][2][4][2];
#pragma unroll
    for (int a = 0; a < 2; ++a)
#pragma unroll
        for (int b = 0; b < 2; ++b)
#pragma unroll
            for (int m = 0; m < 4; ++m)
#pragma unroll
                for (int n = 0; n < 2; ++n) acc[a][b][m][n] = (f32x4){0.f, 0.f, 0.f, 0.f};
    bf16x8 At[4][2], B0[2][2], B1[2][2];
    const char* cA = (const char*)g.A + (size_t)cur.pm * tstep; const char* cB = (const char*)g.Bt + (size_t)cur.pn * tstep;
    S.a_ready(cur);
    if constexpr (SP2) {
        PG8_STAGE(PG8_SB(0, 0), cB, voffB); PG8_STAGE(PG8_SB(0, 1), cB + hstep, voffB); PG8_STAGE(PG8_SA(0, 0), cA, voffA); PG8_STAGE(PG8_SA(0, 1), cA + hstep, voffA);
        if (wr == 1) PG8_BAR;
        PG8_WAIT_V(2); PG8_BAR;
        PG8_STAGE(PG8_SB(1, 0), cB + kstep, voffB); PG8_STAGE(PG8_SA(1, 0), cA + kstep, voffA); PG8_STAGE(PG8_SB(1, 1), cB + hstep + kstep, voffB);
        PG8_WAIT_V(6); PG8_BAR;
    } else {
        PG8_STAGE(PG8_SB(0, 0), cB, voffB); PG8_STAGE(PG8_SA(0, 0), cA, voffA); PG8_STAGE(PG8_SB(0, 1), cB + hstep, voffB); PG8_STAGE(PG8_SA(0, 1), cA + hstep, voffA);
        if (wr == 1) PG8_BAR;
        PG8_WAIT_V(4); PG8_BAR;
        PG8_STAGE(PG8_SB(1, 0), cB + kstep, voffB); PG8_STAGE(PG8_SA(1, 0), cA + kstep, voffA); PG8_STAGE(PG8_SB(1, 1), cB + hstep + kstep, voffB);
        PG8_WAIT_V(6); PG8_BAR;
    }
    for (;;) {
        const bool has_next = S.next(ui + 1, nxt);
        const char* nA = has_next ? (const char*)g.A + (size_t)nxt.pm * tstep : cA; const char* nB = has_next ? (const char*)g.Bt + (size_t)nxt.pn * tstep : cB;
        for (int t = 0; t < nt; t += 2) {
            const bool last = (t == nt - 2);
            const char* a1 = cA + (size_t)(t + 1) * kstep;
            const char* a2 = last ? nA : cA + (size_t)(t + 2) * kstep; const char* b2 = last ? nB : cB + (size_t)(t + 2) * kstep;
            const char* a3 = a2 + kstep; const char* b3 = b2 + kstep;
            if (last && has_next) S.a_ready(nxt);
            if constexpr (SP2) {
            PG8_LDB(B0, 0, 0); PG8_LDB(B1, 0, 1); PG8_SCHED; PG8_LDA(At, 0, 0); PG8_STAGE(PG8_SA(1, 1), a1 + hstep, voffA);
            PG8_WAIT_V(8); PG8_WAIT_L(0); PG8_BAR; PG8_MMA(0, 0, At, B0); PG8_MMA(0, 1, At, B1); PG8_BAR; PG8_SCHED;
            PG8_LDA(At, 0, 1); PG8_STAGE(PG8_SB(0, 0), b2, voffB); PG8_STAGE(PG8_SB(0, 1), b2 + hstep, voffB); PG8_STAGE(PG8_SA(0, 0), a2, voffA);
            PG8_WAIT_V(8); PG8_WAIT_L(0); PG8_BAR; PG8_MMA(1, 0, At, B0); PG8_MMA(1, 1, At, B1); PG8_BAR; PG8_SCHED;
            PG8_LDB(B0, 1, 0); PG8_LDB(B1, 1, 1); PG8_SCHED; PG8_LDA(At, 1, 0); PG8_STAGE(PG8_SA(0, 1), a2 + hstep, voffA);
            PG8_WAIT_V(8); PG8_WAIT_L(0); PG8_BAR; PG8_MMA(0, 0, At, B0); PG8_MMA(0, 1, At, B1); PG8_BAR; PG8_SCHED;
            PG8_LDA(At, 1, 1); PG8_STAGE(PG8_SB(1, 0), b3, voffB); PG8_STAGE(PG8_SB(1, 1), b3 + hstep, voffB); PG8_STAGE(PG8_SA(1, 0), a3, voffA);
            PG8_WAIT_V(8); PG8_WAIT_L(0); PG8_BAR; PG8_MMA(1, 0, At, B0); PG8_MMA(1, 1, At, B1); PG8_BAR; PG8_SCHED;
            } else {
            PG8_LDB(B0, 0, 0); PG8_SCHED; PG8_LDA(At, 0, 0); PG8_STAGE(PG8_SA(1, 1), a1 + hstep, voffA);
            PG8_WAIT_L(8); PG8_BAR; PG8_WAIT_L(0); PG8_MMA(0, 0, At, B0); PG8_BAR; PG8_SCHED;
            PG8_LDB(B1, 0, 1); PG8_STAGE(PG8_SB(0, 0), b2, voffB);
            PG8_BAR; PG8_WAIT_L(0); PG8_MMA(0, 1, At, B1); PG8_BAR;
            PG8_LDA(At, 0, 1); PG8_STAGE(PG8_SA(0, 0), a2, voffA);
            PG8_BAR; PG8_WAIT_L(0); PG8_MMA(1, 0, At, B0); PG8_BAR; PG8_SCHED;
            PG8_STAGE(PG8_SB(0, 1), b2 + hstep, voffB);
            PG8_WAIT_V(6); PG8_BAR; PG8_MMA(1, 1, At, B1); PG8_BAR;
            PG8_LDB(B0, 1, 0); PG8_SCHED; PG8_LDA(At, 1, 0); PG8_STAGE(PG8_SA(0, 1), a2 + hstep, voffA);
            PG8_WAIT_L(8); PG8_BAR; PG8_WAIT_L(0); PG8_MMA(0, 0, At, B0); PG8_BAR; PG8_SCHED;
            PG8_LDB(B1, 1, 1); PG8_STAGE(PG8_SB(1, 0), b3, voffB);
            PG8_BAR; PG8_WAIT_L(0); PG8_MMA(0, 1, At, B1); PG8_BAR;
            PG8_LDA(At, 1, 1); PG8_STAGE(PG8_SA(1, 0), a3, voffA);
            PG8_BAR; PG8_WAIT_L(0); PG8_MMA(1, 0, At, B0); PG8_BAR; PG8_SCHED;
            PG8_STAGE(PG8_SB(1, 1), b3 + hstep, voffB);
            PG8_WAIT_V(6); PG8_BAR; PG8_MMA(1, 1, At, B1); PG8_BAR;
            }
        }
        if constexpr (ALIGN_EPI) { if (wr == 0) PG8_BAR; }
        if constexpr (!Epi::AFTER_DRAIN) { E(acc, cur, wr, wc, fr, fq); S.done(cur); }
        if (!has_next) break;
#pragma unroll
        for (int a = 0; a < 2; ++a)
#pragma unroll
            for (int b = 0; b < 2; ++b)
#pragma unroll
                for (int m = 0; m < 4; ++m)
#pragma unroll
                    for (int n = 0; n < 2; ++n) acc[a][b][m][n] = (f32x4){0.f, 0.f, 0.f, 0.f};
        cur = nxt; cA = nA; cB = nB; ++ui;
        if constexpr (ALIGN_EPI) { if (wr == 1) PG8_BAR; }
    }
    PG8_WAIT_V(0);
    if constexpr (!ALIGN_EPI) { if (wr == 0) PG8_BAR; }
    PG8_BAR;
    if constexpr (Epi::AFTER_DRAIN) { E.fused(acc, cur, wr, wc, fr, fq, lds, wid, lane); S.done(cur); }
#undef PG8_SA
#undef PG8_SB
#undef PG8_STAGE
#undef PG8_LDA
#undef PG8_LDB
#undef PG8_MMA
#undef PG8_WAIT_V
#undef PG8_WAIT_L
#undef PG8_BAR
#undef PG8_SCHED
}
}

#define XB_TMO      128
#define XB_XCNT(j)  (256  + 64 * (j))
#define XB_XSUB(j)  (1280 + 64 * (j))
#define XB_XGEN(j)  (2304 + 64 * (j))
#define XB_TOP      3328
#define XB_TOPGEN   3392
#define XCD_BAR_WORDS 3456
#define XB_SPIN_CAP (1u << 23)
__device__ __forceinline__ unsigned xb_ld(unsigned* p)              { return __hip_atomic_load(p, __ATOMIC_RELAXED, __HIP_MEMORY_SCOPE_AGENT); }
__device__ __forceinline__ unsigned xb_add(unsigned* p, unsigned v) { return __hip_atomic_fetch_add(p, v, __ATOMIC_RELAXED, __HIP_MEMORY_SCOPE_AGENT); }
__device__ __forceinline__ unsigned xb_xcc_id() { return (unsigned)__builtin_amdgcn_s_getreg((3 << 11) | 20) & 0xFu; }
#define XB_SPIN(cond, bar) do { unsigned _sp = 0; while (cond) { __builtin_amdgcn_s_sleep(1); \
    if ((++_sp & 255u) == 0u) { if (xb_ld(&(bar)[XB_TMO])) break; if (_sp > XB_SPIN_CAP) { atomicAdd(&(bar)[XB_TMO], 1u); break; } } } } while (0)
struct XcdBarrier { unsigned* bar; unsigned x; volatile LAS unsigned* st; };
__device__ __forceinline__ XcdBarrier xcd_barrier_post(unsigned* bar, volatile LAS unsigned* st) {
    XcdBarrier b; b.bar = bar; b.x = xb_xcc_id(); b.st = st;
    if (threadIdx.x == 0) (void)xb_add(&bar[XB_XCNT(b.x)], 1u);
    return b;
}
__device__ __forceinline__ void xcd_barrier_complete(unsigned* bar, unsigned x, unsigned& nloc, unsigned& nx) {
    const unsigned G = gridDim.x * gridDim.y * gridDim.z;
    unsigned sum, cnt, mine, sp = 0u;
    for (;;) {
        sum = 0u; cnt = 0u; mine = 0u;
#pragma unroll
        for (unsigned j = 0; j < 16; ++j) { const unsigned c = xb_ld(&bar[XB_XCNT(j)]); sum += c; cnt += (c > 0u) ? 1u : 0u; mine = (j == x) ? c : mine; }
        if (sum == G) break;
        __builtin_amdgcn_s_sleep(1);
        if ((++sp & 255u) == 0u) { if (xb_ld(&bar[XB_TMO])) break; if (sp > XB_SPIN_CAP) { atomicAdd(&bar[XB_TMO], 1u); break; } }
    }
    nloc = mine > 0u ? mine : 1u; nx = cnt > 0u ? cnt : 1u;
}
__device__ __forceinline__ void xcd_barrier(const XcdBarrier& b, const int tid_) {
    asm volatile("s_waitcnt vmcnt(0)" ::: "memory");
    __syncthreads();
    if (tid_ == 0) {
        unsigned* bar = b.bar; asm volatile("" : "+s"(bar));
        __builtin_amdgcn_s_waitcnt(0);
        unsigned nloc = b.st[0], nx = b.st[1];
        if (nloc == 0u) { xcd_barrier_complete(bar, b.x, nloc, nx); b.st[0] = nloc; b.st[1] = nx; }
        const unsigned old = xb_add(&bar[XB_XSUB(b.x)], 1u);
        const unsigned gen = old / nloc;
        if (old + 1u == (gen + 1u) * nloc) {
            __builtin_amdgcn_fence(__ATOMIC_RELEASE, "agent");
            asm volatile("s_waitcnt vmcnt(0)" ::: "memory");
            const unsigned og = xb_add(&bar[XB_TOP], 1u);
            const unsigned tg = og / nx;
            if (og + 1u == (tg + 1u) * nx) xb_add(&bar[XB_TOPGEN], 1u);
            else XB_SPIN(xb_ld(&bar[XB_TOPGEN]) == tg, bar);
            __builtin_amdgcn_fence(__ATOMIC_ACQUIRE, "agent");
            xb_add(&bar[XB_XGEN(b.x)], 1u);
            asm volatile("s_waitcnt vmcnt(0)" ::: "memory");
        } else {
            XB_SPIN(xb_ld(&bar[XB_XGEN(b.x)]) == gen, bar);
            __builtin_amdgcn_fence(__ATOMIC_ACQUIRE, "agent");
            asm volatile("s_waitcnt vmcnt(0)" ::: "memory");
        }
    }
    __syncthreads();
}

__device__ __forceinline__ float wave_sum(float v) {
#pragma unroll
    for (int o = 1; o < 64; o <<= 1) v += __shfl_xor(v, o);
    return v;
}
__device__ __forceinline__ float wave_max(float v) {
#pragma unroll
    for (int o = 1; o < 64; o <<= 1) v = fmaxf(v, __shfl_xor(v, o));
    return v;
}
__device__ __forceinline__ float bperm(float x, int srclane) { return __builtin_bit_cast(float, __builtin_amdgcn_ds_bpermute(srclane << 2, __builtin_bit_cast(int, x))); }
__device__ __forceinline__ float wave_sum_l(float v, int lane) {
#pragma unroll
    for (int o = 1; o < 64; o <<= 1) v += bperm(v, lane ^ o);
    return v;
}
__device__ __forceinline__ float wave_max_l(float v, int lane) {
#pragma unroll
    for (int o = 1; o < 64; o <<= 1) v = fmaxf(v, bperm(v, lane ^ o));
    return v;
}
__device__ __forceinline__ float siluf(float x) { return x / (1.f + expf(-x)); }
__device__ __forceinline__ float log_sigmoidf(float x) { return fminf(x, 0.f) - log1pf(expf(-fabsf(x))); }
__device__ __forceinline__ float softplusf(float x) { return fmaxf(x, 0.f) + log1pf(expf(-fabsf(x))); }

__device__ __forceinline__ const float* conv_prev(const float* MI, const float* state_conv_l, int r, int j) {
    if (r < MP) { const int b = r >> 11, i = r & 2047; const int p = i - j; if (p >= 0) return MI + (size_t)(b * 2048 + p) * LDMI + C_XBC; return MI + (size_t)(R_META + 16 + p) * LDMI + C_XBC; }
    if (r < R_META) { const int s = r - R_S, b = s >> 2, i = s & 3; const int p = i - j; if (p >= 0) return MI + (size_t)(R_S + b * 4 + p) * LDMI + C_XBC; return state_conv_l + (size_t)(b * 3 + 3 + p) * 768; }
    const int i = r - R_META, p = i - j; if (p >= 0) return MI + (size_t)(R_META + p) * LDMI + C_XBC; return nullptr;
}

struct PromptKeys { const float* KN; const float* MI; const float* FC; int b, h;
    __device__ __forceinline__ void get(int j, const float*& kp, const float*& vp, float& Fk) const { const int row = j < 16 ? R_META + j : b * 2048 + (j - 16);
        kp = KN + (size_t)row * 256 + h * 64; vp = MI + (size_t)row * LDMI + C_FV + h * 64; Fk = FC[row * 4 + h]; } };
struct SampleKeys { const float* KN; const float* MI; const float* FCS; const float* ck; const float* cv; const int* pt; int b, h, l;
    __device__ __forceinline__ void get(int j, const float*& kp, const float*& vp, float& Fk) const {
        Fk = FCS[(size_t)(b * 4 + h) * 2052 + j];
        if (j < 2048) { const int page = pt[b * 16 + (j >> 7)]; const size_t off = (((size_t)l * NPOOL + page) * 128 + (j & 127)) * 256 + h * 64; kp = ck + off; vp = cv + off; }
        else { const int row = R_S + b * 4 + (j - 2048); kp = KN + (size_t)row * 256 + h * 64; vp = MI + (size_t)row * LDMI + C_FV + h * 64; } } };

template <class Keys>
__device__ __forceinline__ void attn_row(const float* qg, float Fq, int nk, const Keys& K, bf16* outp, float* sq, float* sc, int lane) {
    sq[lane] = qg[lane];
    LDS_WAIT();
    float mx = -INFINITY;
    for (int j = lane; j < nk; j += 64) {
        const float* kp; const float* vp; float Fk; K.get(j, kp, vp, Fk);
        float s = 0.f;
#pragma unroll
        for (int d4 = 0; d4 < 16; ++d4) { const float4 a = ((const float4*)sq)[d4]; const float4 b = ((const float4*)kp)[d4]; s += a.x * b.x + a.y * b.y + a.z * b.z + a.w * b.w; }
        s = s * 0.125f + (Fq - Fk);
        sc[j] = s; mx = fmaxf(mx, s);
    }
    mx = wave_max_l(mx, lane);
    float sum = 0.f;
    for (int j = lane; j < nk; j += 64) { const float p = expf(sc[j] - mx); sc[j] = p; sum += p; }
    sum = wave_sum_l(sum, lane);
    LDS_WAIT();
    float o = 0.f;
    for (int j = 0; j < nk; ++j) { const float* kp; const float* vp; float Fk; K.get(j, kp, vp, Fk); o += sc[j] * vp[lane]; }
    outp[lane] = (bf16)f2bf(o / sum);
    LDS_WAIT();
}

namespace fa {
typedef short bf16x8 __attribute__((ext_vector_type(8)));
typedef short s16x4 __attribute__((ext_vector_type(4)));
typedef float f4 __attribute__((ext_vector_type(4)));
typedef float f32x16 __attribute__((ext_vector_type(16)));
typedef float f32x2_t __attribute__((ext_vector_type(2)));
typedef __bf16 bf16x2_t __attribute__((ext_vector_type(2)));
__device__ __forceinline__ unsigned cvtpk(float lo, float hi) { f32x2_t v = {lo, hi}; bf16x2_t b = __builtin_convertvector(v, bf16x2_t); return __builtin_bit_cast(unsigned, b); }
__device__ __forceinline__ int crow(int r, int hi) { return (r & 3) + 8 * (r >> 2) + 4 * hi; }
template <int CTRL> __device__ __forceinline__ float dpp(float x) { return __builtin_bit_cast(float, __builtin_amdgcn_mov_dpp(__builtin_bit_cast(int, x), CTRL, 0xf, 0xf, true)); }
constexpr int XOR1 = 0xB1, XOR2 = 0x4E, XOR7 = 0x141, XOR8 = 0x128;
__device__ __forceinline__ float row16_sum(float s) { s += dpp<XOR1>(s); s += dpp<XOR2>(s); s += dpp<XOR7>(s); s += dpp<XOR8>(s); return s; }
#define MFMA32(a, b, c) __builtin_amdgcn_mfma_f32_32x32x16_bf16((a), (b), (c), 0, 0, 0)

constexpr int KSTR = 144;
constexpr int L_K0 = 0, L_V0 = 2 * 64 * KSTR, L_KB = 4 * 64 * KSTR, L_WS = L_KB + 2112 * 4, L_END = L_WS + 64;
constexpr float LOG2E = 1.4426950408889634f;

__device__ __forceinline__ void fox_prompt_unit(int b, int h, int qb, const bf16* QF, const bf16* KF, const bf16* VT, const float* LF, bf16* MIXB, LAS unsigned char* lds, int tid) {
    const int lane = tid & 63, wave = __builtin_amdgcn_readfirstlane(tid >> 6), r32 = lane & 31, hi = lane >> 5;
    const int ntile = 5 + 4 * qb, nslots = 64 * ntile;
    LAS float* kb = (LAS float*)(lds + L_KB); LAS float* wsum = (LAS float*)(lds + L_WS);
    {
        float v[5]; float run = 0.f;
#pragma unroll
        for (int e = 0; e < 5; ++e) { const int slot = 5 * tid + e; float lf = 0.f;
            if (slot < 16) lf = LF[(R_META + slot) * 4 + h]; else if (slot >= 64 && slot < nslots) lf = LF[(b * 2048 + slot - 64) * 4 + h];
            run += lf; v[e] = run; }
        float x = run;
#pragma unroll
        for (int o = 1; o < 64; o <<= 1) { const float y = bperm(x, lane - o); if (lane >= o) x += y; }
        if (lane == 63) wsum[wave] = x;
        __syncthreads();
        float off = x - run;
        for (int w = 0; w < wave; ++w) off += wsum[w];
#pragma unroll
        for (int e = 0; e < 5; ++e) { const int slot = 5 * tid + e; if (slot < 2112) kb[slot] = (slot >= 16 && slot < 64) ? -INFINITY : -(off + v[e]) * LOG2E; }
    }
    const bf16* Qw = QF + ((size_t)(b * 4 + h) * 2048 + 256 * qb + 32 * wave) * 64;
    bf16x8 qr[4];
#pragma unroll
    for (int d0 = 0; d0 < 4; ++d0) qr[d0] = *(const bf16x8*)(Qw + r32 * 64 + d0 * 16 + hi * 8);
    const bf16* Kg = KF + (size_t)(b * 4 + h) * 2112 * 64 + (size_t)(tid >> 3) * 64 + (tid & 7) * 8;
    const bf16* Vg = VT + (size_t)(b * 4 + h) * 64 * 2112 + (size_t)(tid >> 3) * 2112 + (tid & 7) * 8;
    const int soff = (tid >> 3) * KSTR + (tid & 7) * 16;
    v4u kreg = *(const v4u*)Kg, vreg = *(const v4u*)Vg;
    *(LAS v4u*)(lds + L_K0 + soff) = kreg; *(LAS v4u*)(lds + L_V0 + soff) = vreg;
    __syncthreads();
    asm volatile("" : "+v"(qr[0]), "+v"(qr[1]), "+v"(qr[2]), "+v"(qr[3]));
    float m = -INFINITY, l = 0.f; f32x16 o0, o1;
#pragma unroll
    for (int i = 0; i < 16; ++i) { o0[i] = 0.f; o1[i] = 0.f; }
    const int qrow = 256 * qb + 32 * wave + r32;
    const int wave_last = 1 + (256 * qb + 32 * wave + 31) / 64;
    for (int t = 0; t < ntile; ++t) {
        const int cur = t & 1;
        if (t + 1 < ntile) { kreg = *(const v4u*)(Kg + (size_t)(t + 1) * 64 * 64); vreg = *(const v4u*)(Vg + (t + 1) * 64); }
        if (t <= wave_last) {
            LAS unsigned char* Kc = lds + L_K0 + cur * 64 * KSTR; LAS unsigned char* Vc = lds + L_V0 + cur * 64 * KSTR;
            f32x16 p0, p1;
#pragma unroll
            for (int i = 0; i < 16; ++i) { p0[i] = 0.f; p1[i] = 0.f; }
#pragma unroll
            for (int d0 = 0; d0 < 4; ++d0) {
                const bf16x8 a0 = *(const LAS bf16x8*)(Kc + r32 * KSTR + (d0 * 16 + hi * 8) * 2);
                const bf16x8 a1 = *(const LAS bf16x8*)(Kc + (32 + r32) * KSTR + (d0 * 16 + hi * 8) * 2);
                p0 = MFMA32(a0, qr[d0], p0); p1 = MFMA32(a1, qr[d0], p1);
            }
#pragma unroll
            for (int g = 0; g < 4; ++g) { const f4 b0 = *(const LAS f4*)(kb + 64 * t + 8 * g + 4 * hi); const f4 b1 = *(const LAS f4*)(kb + 64 * t + 32 + 8 * g + 4 * hi);
                p0[4 * g + 0] += b0[0]; p0[4 * g + 1] += b0[1]; p0[4 * g + 2] += b0[2]; p0[4 * g + 3] += b0[3]; p1[4 * g + 0] += b1[0]; p1[4 * g + 1] += b1[1]; p1[4 * g + 2] += b1[2]; p1[4 * g + 3] += b1[3]; }
            if (t >= 4 * qb + 1) {
                const int kbase = 64 * (t - 1);
#pragma unroll
                for (int i = 0; i < 16; ++i) { const int pk = kbase + crow(i, hi); if (pk > qrow) p0[i] = -INFINITY; if (pk + 32 > qrow) p1[i] = -INFINITY; }
            }
            float rm = fmaxf(p0[0], p1[0]);
#pragma unroll
            for (int i = 1; i < 16; ++i) rm = fmaxf(rm, fmaxf(p0[i], p1[i]));
            rm = fmaxf(rm, bperm(rm, lane ^ 32));
            const float mn = fmaxf(m, rm); const float sc = __builtin_amdgcn_exp2f(m - mn); m = mn;
            float rsum = 0.f;
#pragma unroll
            for (int i = 0; i < 16; ++i) { p0[i] = __builtin_amdgcn_exp2f(p0[i] - mn); p1[i] = __builtin_amdgcn_exp2f(p1[i] - mn); rsum += p0[i] + p1[i]; }
            l = l * sc + rsum;
#pragma unroll
            for (int i = 0; i < 16; ++i) { o0[i] *= sc; o1[i] *= sc; }
#pragma unroll
            for (int blk = 0; blk < 2; ++blk)
#pragma unroll
                for (int s2 = 0; s2 < 2; ++s2) {
                    v4u pw;
                    if (blk == 0) { pw.x = cvtpk(p0[8 * s2 + 0], p0[8 * s2 + 1]); pw.y = cvtpk(p0[8 * s2 + 2], p0[8 * s2 + 3]); pw.z = cvtpk(p0[8 * s2 + 4], p0[8 * s2 + 5]); pw.w = cvtpk(p0[8 * s2 + 6], p0[8 * s2 + 7]); }
                    else          { pw.x = cvtpk(p1[8 * s2 + 0], p1[8 * s2 + 1]); pw.y = cvtpk(p1[8 * s2 + 2], p1[8 * s2 + 3]); pw.z = cvtpk(p1[8 * s2 + 4], p1[8 * s2 + 5]); pw.w = cvtpk(p1[8 * s2 + 6], p1[8 * s2 + 7]); }
                    const bf16x8 pb = __builtin_bit_cast(bf16x8, pw);
                    const int koff = (32 * blk + 16 * s2 + 4 * hi) * 2;
                    { const s16x4 lo = *(const LAS s16x4*)(Vc + r32 * KSTR + koff), hh = *(const LAS s16x4*)(Vc + r32 * KSTR + koff + 16);
                      const bf16x8 va = {lo[0], lo[1], lo[2], lo[3], hh[0], hh[1], hh[2], hh[3]}; o0 = MFMA32(va, pb, o0); }
                    { const s16x4 lo = *(const LAS s16x4*)(Vc + (32 + r32) * KSTR + koff), hh = *(const LAS s16x4*)(Vc + (32 + r32) * KSTR + koff + 16);
                      const bf16x8 va = {lo[0], lo[1], lo[2], lo[3], hh[0], hh[1], hh[2], hh[3]}; o1 = MFMA32(va, pb, o1); }
                }
        }
        if (t + 1 < ntile) { *(LAS v4u*)(lds + L_K0 + (cur ^ 1) * 64 * KSTR + soff) = kreg; *(LAS v4u*)(lds + L_V0 + (cur ^ 1) * 64 * KSTR + soff) = vreg; }
        __syncthreads();
    }
    l += bperm(l, lane ^ 32);
    const float inv = 1.0f / l;
    bf16* orow = MIXB + (size_t)(b * 2048 + qrow) * 1024 + h * 64;
#pragma unroll
    for (int g = 0; g < 4; ++g) {
        *(uint2*)(orow + 8 * g + 4 * hi) = make_uint2(cvtpk(o0[4 * g] * inv, o0[4 * g + 1] * inv), cvtpk(o0[4 * g + 2] * inv, o0[4 * g + 3] * inv));
        *(uint2*)(orow + 32 + 8 * g + 4 * hi) = make_uint2(cvtpk(o1[4 * g] * inv, o1[4 * g + 1] * inv), cvtpk(o1[4 * g + 2] * inv, o1[4 * g + 3] * inv));
    }
}

constexpr int S_D = 0, S_WS = 32768, S_PART = 33024, S_PSTR = 68;
__device__ __forceinline__ void fox_sample_unit(int b, int l, const float* QN, const float* KN, const float* MI, const float* LF, const float* ck, const float* cv, const float* clf, const int* pt,
                                                bf16* MIXB, LAS unsigned char* lds, int tid) {
    const int lane = tid & 63, wave = __builtin_amdgcn_readfirstlane(tid >> 6), h = lane >> 4, d4 = lane & 15;
    LAS f4* Dl = (LAS f4*)(lds + S_D); LAS f4* wsum = (LAS f4*)(lds + S_WS);
    {
        const int page = pt[b * 16 + (tid >> 5)];
        const f4* src = (const f4*)(clf + (((size_t)l * NPOOL + page) * 128 + 4 * (tid & 31)) * 4);
        const f4 v0 = src[0], v1 = src[1], v2 = src[2], v3 = src[3];
        const f4 s2 = v3, s1 = v3 + v2, s0 = s1 + v1, tot = s0 + v0;
        f4 x = tot;
#pragma unroll
        for (int o = 1; o < 64; o <<= 1) { f4 y; y[0] = bperm(x[0], lane + o); y[1] = bperm(x[1], lane + o); y[2] = bperm(x[2], lane + o); y[3] = bperm(x[3], lane + o); if (lane + o < 64) x += y; }
        if (lane == 0) wsum[wave] = x;
        __syncthreads();
        f4 off = x - tot;
        for (int w = wave + 1; w < 8; ++w) off += wsum[w];
        Dl[4 * tid + 0] = s0 + off; Dl[4 * tid + 1] = s1 + off; Dl[4 * tid + 2] = s2 + off; Dl[4 * tid + 3] = off;
        __syncthreads();
    }
    float4 q[4];
#pragma unroll
    for (int i = 0; i < 4; ++i) { const float4 t = *(const float4*)(QN + (size_t)(R_S + b * 4 + i) * 256 + h * 64 + 4 * d4); q[i] = make_float4(t.x * 0.125f, t.y * 0.125f, t.z * 0.125f, t.w * 0.125f); }
    float m[4], ls[4]; float4 o[4];
#pragma unroll
    for (int i = 0; i < 4; ++i) { m[i] = -INFINITY; ls[i] = 0.f; o[i] = make_float4(0.f, 0.f, 0.f, 0.f); }
    const LAS float* Df = (const LAS float*)Dl;
    for (int p = 0; p < 16; ++p) {
        const int page = pt[b * 16 + p];
        const size_t base = (((size_t)l * NPOOL + page) * 128 + 16 * wave) * 256 + lane * 4;
#pragma unroll
        for (int hf = 0; hf < 2; ++hf) {
            pg8::f32x4 kk[8], vv[8];
#pragma unroll
            for (int j = 0; j < 8; ++j) { kk[j] = __builtin_nontemporal_load((const pg8::f32x4*)(ck + base + (size_t)(hf * 8 + j) * 256)); vv[j] = __builtin_nontemporal_load((const pg8::f32x4*)(cv + base + (size_t)(hf * 8 + j) * 256)); }
            float s[4][8];
#pragma unroll
            for (int j = 0; j < 8; ++j) { const float dk = Df[(p * 128 + 16 * wave + hf * 8 + j) * 4 + h];
#pragma unroll
                for (int i = 0; i < 4; ++i) s[i][j] = row16_sum(q[i].x * kk[j][0] + q[i].y * kk[j][1] + q[i].z * kk[j][2] + q[i].w * kk[j][3]) + dk; }
#pragma unroll
            for (int i = 0; i < 4; ++i) {
                float mx = s[i][0];
#pragma unroll
                for (int j = 1; j < 8; ++j) mx = fmaxf(mx, s[i][j]);
                const float mn = fmaxf(m[i], mx); const float sc = __expf(m[i] - mn); m[i] = mn;
                ls[i] *= sc; o[i].x *= sc; o[i].y *= sc; o[i].z *= sc; o[i].w *= sc;
#pragma unroll
                for (int j = 0; j < 8; ++j) { const float pj = __expf(s[i][j] - mn); ls[i] += pj; o[i].x += pj * vv[j][0]; o[i].y += pj * vv[j][1]; o[i].z += pj * vv[j][2]; o[i].w += pj * vv[j][3]; }
            }
        }
    }
    LAS float* part = (LAS float*)(lds + S_PART);
#pragma unroll
    for (int i = 0; i < 4; ++i) { LAS float* pp = part + ((wave * 16) + h * 4 + i) * S_PSTR; *(LAS f4*)(pp + 4 + 4 * d4) = (f4){o[i].x, o[i].y, o[i].z, o[i].w}; if (d4 == 0) { pp[0] = m[i]; pp[1] = ls[i]; } }
    __syncthreads();
    for (int u = tid; u < 1024; u += 512) {
        const int hh = u >> 8, i = (u >> 6) & 3, d = u & 63;
        const int rowq = R_S + b * 4 + i;
        float sn[4]; float G = 0.f;
#pragma unroll
        for (int j = 0; j < 4; ++j) { const int rowk = R_S + b * 4 + j; G -= LF[rowk * 4 + hh]; float dot = 0.f;
            const float* qp = QN + (size_t)rowq * 256 + hh * 64; const float* kp = KN + (size_t)rowk * 256 + hh * 64;
            for (int c = 0; c < 64; ++c) dot += qp[c] * kp[c];
            sn[j] = j <= i ? dot * 0.125f + G : -INFINITY; }
        float mt = fmaxf(fmaxf(sn[0], sn[1]), fmaxf(sn[2], sn[3]));
        for (int w = 0; w < 8; ++w) mt = fmaxf(mt, part[(w * 16 + hh * 4 + i) * S_PSTR]);
        float lt = 0.f, ot = 0.f;
        for (int w = 0; w < 8; ++w) { const LAS float* pp = part + (w * 16 + hh * 4 + i) * S_PSTR; const float e = __expf(pp[0] - mt); lt += e * pp[1]; ot += e * pp[4 + d]; }
#pragma unroll
        for (int j = 0; j < 4; ++j) { const float e = __expf(sn[j] - mt); lt += e; ot += e * MI[(size_t)(R_S + b * 4 + j) * LDMI + C_FV + hh * 64 + d]; }
        MIXB[(size_t)rowq * 1024 + hh * 64 + d] = (bf16)f2bf(ot / lt);
    }
    __syncthreads();
}
#undef MFMA32
}

namespace la {
using fa::bf16x8; using fa::s16x4; using fa::f32x16; using fa::f4; using fa::cvtpk; using fa::crow;
#define MFMA32(a, b, c) __builtin_amdgcn_mfma_f32_32x32x16_bf16((a), (b), (c), 0, 0, 0)
#define LDS_BARRIER() asm volatile("s_waitcnt lgkmcnt(0)\n\ts_barrier" ::: "memory")
__device__ __forceinline__ int seq_row(int b, int c, int t) { const int sg = 128 * c - 112 + t; return sg < 0 ? -1 : (sg < 16 ? R_META + sg : b * 2048 + sg - 16); }
__device__ __forceinline__ bf16x8 pack8(const f32x16& x, int s) { v4u p; p.x = cvtpk(x[8 * s], x[8 * s + 1]); p.y = cvtpk(x[8 * s + 2], x[8 * s + 3]); p.z = cvtpk(x[8 * s + 4], x[8 * s + 5]); p.w = cvtpk(x[8 * s + 6], x[8 * s + 7]); return __builtin_bit_cast(bf16x8, p); }
__device__ __forceinline__ bf16x8 ld16(const LAS unsigned char* p) { return *(const LAS bf16x8*)p; }
__device__ __forceinline__ bf16x8 ld8x2(const LAS unsigned char* p) { const s16x4 lo = *(const LAS s16x4*)p, hh = *(const LAS s16x4*)(p + 16); return (bf16x8){lo[0], lo[1], lo[2], lo[3], hh[0], hh[1], hh[2], hh[3]}; }
__device__ __forceinline__ float silu_f(float x) { return x * __builtin_amdgcn_rcpf(1.0f + __expf(-x)); }
__device__ __forceinline__ float bf2f(unsigned short v) { return __uint_as_float((unsigned)v << 16); }
typedef unsigned u2v __attribute__((ext_vector_type(2)));
constexpr int TPITCH = 272;
constexpr int OPITCH = 68;

constexpr int G_QL = 0, G_KL = 10240, G_KT = 20480, G_VT = 29184, G_OUT = 46592, G_BC = 81408, G_SEG = 98304, G_BL = 100352, G_BLR = 100480;
__device__ __forceinline__ void gla_prompt_unit(int b, int h, const GAS bf16* MIB, const GAS float* GLOG, const GAS float* gnorm, GAS bf16* MIXB, GAS float* state_out, LAS unsigned char* lds, int tid0) {
    int tid = tid0;
    int lane = tid & 63, wave = __builtin_amdgcn_readfirstlane(tid >> 6), r32 = lane & 31, hi = lane >> 5, vt = wave & 1, tt = wave < 4 ? (wave >> 1) : 3 - ((wave - 4) >> 1);
    LAS unsigned char* QL = lds + G_QL; LAS unsigned char* KL = lds + G_KL; LAS unsigned char* KT = lds + G_KT; LAS unsigned char* VT = lds + G_VT;
    LAS float* OUT = (LAS float*)(lds + G_OUT); LAS float* BC = (LAS float*)(lds + G_BC); LAS float* SEG = (LAS float*)(lds + G_SEG); LAS float* BL = (LAS float*)(lds + G_BL); LAS float* BLR = (LAS float*)(lds + G_BLR);
    f32x16 SK;
#pragma unroll
    for (int i = 0; i < 16; ++i) SK[i] = 0.f;
    int kk = tid & 31, seg = tid >> 5;
    f4 q0, q1, k0, k1, v4[4]; float gl[8];
#define BF4(w_) ((f4){__uint_as_float((w_)[0] << 16), __uint_as_float((w_)[0] & 0xffff0000u), __uint_as_float((w_)[1] << 16), __uint_as_float((w_)[1] & 0xffff0000u)})
#define GLA_LOAD(cc) do { const int row = seq_row(b, (cc), tid >> 2); const GAS bf16* mr = MIB + (size_t)(row >= 0 ? row : 0) * N_MAIN; const int qd_ = tid & 3; \
        const u2v a0_ = *(const GAS u2v*)(mr + CM_GQ + h * 32 + 8 * qd_), a1_ = *(const GAS u2v*)(mr + CM_GQ + h * 32 + 8 * qd_ + 4), b0_ = *(const GAS u2v*)(mr + CM_GK + h * 32 + 8 * qd_), b1_ = *(const GAS u2v*)(mr + CM_GK + h * 32 + 8 * qd_ + 4); \
        u2v c_[4]; _Pragma("unroll") for (int j4 = 0; j4 < 4; ++j4) c_[j4] = *(const GAS u2v*)(mr + CM_GV + h * 64 + 16 * qd_ + 4 * j4); \
        _Pragma("unroll") for (int e_ = 0; e_ < 8; ++e_) { const int rg_ = seq_row(b, (cc), 8 * (tid >> 5) + e_); gl[e_] = GLOG[(size_t)(rg_ >= 0 ? rg_ : 0) * 128 + h * 32 + (tid & 31)]; } \
        q0 = BF4(a0_); q1 = BF4(a1_); k0 = BF4(b0_); k1 = BF4(b1_); _Pragma("unroll") for (int j4 = 0; j4 < 4; ++j4) v4[j4] = BF4(c_[j4]); } while (0)
    GLA_LOAD(0);
    for (int c = 0; c < 17; ++c) {
        tid = tid0; asm volatile("" : "+v"(tid)); lane = tid & 63; wave = __builtin_amdgcn_readfirstlane(tid >> 6); r32 = lane & 31; hi = lane >> 5; vt = wave & 1; tt = wave < 4 ? (wave >> 1) : 3 - ((wave - 4) >> 1); kk = tid & 31; seg = tid >> 5;
        if (c == 0 && (tid >> 2) < 112) { const f4 z = (f4){0.f, 0.f, 0.f, 0.f}; q0 = z; q1 = z; k0 = z; k1 = z; v4[0] = z; v4[1] = z; v4[2] = z; v4[3] = z; }
        {
            float bcl[8]; float run = 0.f;
#pragma unroll
            for (int e = 0; e < 8; ++e) { const float gv = (c == 0 && 8 * seg + e < 112) ? 0.f : gl[e]; run += gv; bcl[e] = run; }
            SEG[seg * 32 + kk] = run;
            LDS_BARRIER();
            float off = 0.f, tot = 0.f;
#pragma unroll
            for (int s = 0; s < 16; ++s) { const float v = SEG[s * 32 + kk]; tot += v; if (s < seg) off += v; }
#pragma unroll
            for (int e = 0; e < 8; ++e) BC[(8 * seg + e) * 33 + kk] = bcl[e] + off;
            if (seg == 0) { BL[kk] = __expf(tot); BLR[kk] = tot; }
            LDS_BARRIER();
        }
        {
            const int t = tid >> 2, qd = tid & 3;
            const float q[8] = {q0[0], q0[1], q0[2], q0[3], q1[0], q1[1], q1[2], q1[3]}, k[8] = {k0[0], k0[1], k0[2], k0[3], k1[0], k1[1], k1[2], k1[3]};
            float qv[8], kv[8];
#pragma unroll
            for (int j = 0; j < 8; ++j) { const float bcv = BC[t * 33 + 8 * qd + j]; qv[j] = q[j] * 0.17677669529663687f * __expf(bcv); kv[j] = k[j] * __expf(-bcv);
                *(LAS bf16*)(KT + (8 * qd + j) * TPITCH + 2 * t) = (bf16)(cvtpk(k[j] * __expf(BLR[8 * qd + j] - bcv), 0.f) & 0xffffu); }
            *(LAS v4u*)(QL + t * 80 + qd * 16) = (v4u){cvtpk(qv[0], qv[1]), cvtpk(qv[2], qv[3]), cvtpk(qv[4], qv[5]), cvtpk(qv[6], qv[7])};
            *(LAS v4u*)(KL + t * 80 + qd * 16) = (v4u){cvtpk(kv[0], kv[1]), cvtpk(kv[2], kv[3]), cvtpk(kv[4], kv[5]), cvtpk(kv[6], kv[7])};
#pragma unroll
            for (int j4 = 0; j4 < 4; ++j4)
#pragma unroll
                for (int e = 0; e < 4; e += 2) { const unsigned w_ = cvtpk(v4[j4][e], v4[j4][e + 1]); *(LAS bf16*)(VT + (16 * qd + 4 * j4 + e) * TPITCH + 2 * t) = (bf16)(w_ & 0xffffu); *(LAS bf16*)(VT + (16 * qd + 4 * j4 + e + 1) * TPITCH + 2 * t) = (bf16)(w_ >> 16); }
        }
        float zz[16];
#pragma unroll
        for (int i = 0; i < 16; ++i) { const int row = seq_row(b, c, 16 * wave + i); zz[i] = bf2f(MIB[(size_t)(row >= 0 ? row : 0) * N_MAIN + CM_GG + h * 64 + lane]); }
        if (c + 1 < 17) GLA_LOAD(c + 1);
        LDS_BARRIER();
        {
            f32x16 y;
#pragma unroll
            for (int i = 0; i < 16; ++i) y[i] = 0.f;
            const LAS unsigned char* qrow = QL + (32 * tt + r32) * 80;
#pragma unroll
            for (int s2 = 0; s2 < 2; ++s2) y = MFMA32(pack8(SK, s2), ld8x2(qrow + (16 * s2 + 4 * hi) * 2), y);
            for (int i = 0; i <= tt; ++i) {
                f32x16 gt;
#pragma unroll
                for (int r = 0; r < 16; ++r) gt[r] = 0.f;
#pragma unroll
                for (int ks = 0; ks < 2; ++ks) gt = MFMA32(ld16(KL + (32 * i + r32) * 80 + (16 * ks + 8 * hi) * 2), ld16(qrow + (16 * ks + 8 * hi) * 2), gt);
                if (i == tt) {
#pragma unroll
                    for (int r = 0; r < 16; ++r) if (crow(r, hi) > r32) gt[r] = 0.f; }
#pragma unroll
                for (int s2 = 0; s2 < 2; ++s2) y = MFMA32(ld8x2(VT + (32 * vt + r32) * TPITCH + (32 * i + 16 * s2 + 4 * hi) * 2), pack8(gt, s2), y);
            }
#pragma unroll
            for (int r = 0; r < 16; ++r) SK[r] *= BL[crow(r, hi)];
#pragma unroll
            for (int ks = 0; ks < 8; ++ks) SK = MFMA32(ld16(KT + r32 * TPITCH + (16 * ks + 8 * hi) * 2), ld16(VT + (32 * vt + r32) * TPITCH + (16 * ks + 8 * hi) * 2), SK);
#pragma unroll
            for (int g4 = 0; g4 < 4; ++g4) *(LAS f4*)(OUT + (32 * tt + r32) * OPITCH + 32 * vt + 8 * g4 + 4 * hi) = (f4){y[4 * g4], y[4 * g4 + 1], y[4 * g4 + 2], y[4 * g4 + 3]};
        }
        LDS_BARRIER();
        {
            const float gnl = gnorm[lane];
            float ov[16], ss[16];
#pragma unroll
            for (int i = 0; i < 16; ++i) { ov[i] = OUT[(16 * wave + i) * OPITCH + lane]; ss[i] = fa::row16_sum(ov[i] * ov[i]); }
#pragma unroll
            for (int i = 0; i < 16; ++i) ss[i] += bperm(ss[i], lane ^ 16);
#pragma unroll
            for (int i = 0; i < 16; ++i) ss[i] += bperm(ss[i], lane ^ 32);
#pragma unroll
            for (int i = 0; i < 16; ++i) { const int row = seq_row(b, c, 16 * wave + i);
                if (row >= 0 && (row < MP || b == 0)) MIXB[(size_t)row * 1024 + 768 + h * 64 + lane] = (bf16)(cvtpk(ov[i] * rsqrtf(ss[i] * (1.0f / 64.0f) + EPS) * gnl * zz[i], 0.f) & 0xffffu); }
        }
        LDS_BARRIER();
    }
#undef GLA_LOAD
    if (tt == 0) {
#pragma unroll
        for (int r = 0; r < 16; ++r) state_out[crow(r, hi) * 64 + 32 * vt + r32] = SK[r]; }
}

constexpr int S_QL = 0, S_KL = 18432, S_KT = 36864, S_VT = 54272, S_OUT = 71680, S_CS = 106496, S_DT = 107008, S_TOT = 107520, S_FS = 107776;
__device__ __forceinline__ void ssd_prompt_unit(int b, int h, const GAS bf16* MIB, const GAS bf16* XC, const GAS float* DTS, float A, float Dh, GAS bf16* MIXB, GAS float* SSQH, GAS float* state_out, LAS unsigned char* lds, int tid0) {
    int tid = tid0; const int g = h >> 2;
    int lane = tid & 63, wave = __builtin_amdgcn_readfirstlane(tid >> 6), r32 = lane & 31, hi = lane >> 5, vt = wave & 1, tt = wave < 4 ? (wave >> 1) : 3 - ((wave - 4) >> 1);
    LAS unsigned char* QL = lds + S_QL; LAS unsigned char* KL = lds + S_KL; LAS unsigned char* KT = lds + S_KT; LAS unsigned char* VT = lds + S_VT;
    LAS float* OUT = (LAS float*)(lds + S_OUT); LAS float* CS = (LAS float*)(lds + S_CS); LAS float* DT = (LAS float*)(lds + S_DT); LAS float* TOT = (LAS float*)(lds + S_TOT);
    f32x16 SK0, SK1;
#pragma unroll
    for (int i = 0; i < 16; ++i) { SK0[i] = 0.f; SK1[i] = 0.f; }
    v4u pb0, pb1, pc0, pc1, px0, px1; float dr0, dr1;
#define SSD_LOAD(cc) do { const int row_ = seq_row(b, (cc), tid >> 2); const GAS bf16* xr_ = XC + (size_t)(row_ >= 0 ? row_ : 0) * 768; const int q_ = tid & 3; \
        pb0 = *(const GAS v4u*)(xr_ + 512 + 64 * g + 8 * q_); pb1 = *(const GAS v4u*)(xr_ + 512 + 64 * g + 32 + 8 * q_); pc0 = *(const GAS v4u*)(xr_ + 640 + 64 * g + 8 * q_); pc1 = *(const GAS v4u*)(xr_ + 640 + 64 * g + 32 + 8 * q_); \
        px0 = *(const GAS v4u*)(xr_ + 64 * h + 8 * q_); px1 = *(const GAS v4u*)(xr_ + 64 * h + 32 + 8 * q_); \
        const int ra_ = seq_row(b, (cc), 2 * lane), rb_ = seq_row(b, (cc), 2 * lane + 1); dr0 = DTS[(size_t)(ra_ >= 0 ? ra_ : 0) * 8 + h]; dr1 = DTS[(size_t)(rb_ >= 0 ? rb_ : 0) * 8 + h]; } while (0)
    SSD_LOAD(0);
    for (int c = 0; c < 17; ++c) {
        tid = tid0; asm volatile("" : "+v"(tid)); lane = tid & 63; wave = __builtin_amdgcn_readfirstlane(tid >> 6); r32 = lane & 31; hi = lane >> 5; vt = wave & 1; tt = wave < 4 ? (wave >> 1) : 3 - ((wave - 4) >> 1);
        {
            const int t = tid >> 2, q = tid & 3;
            const bool pad0 = c == 0 && 2 * lane < 112, pad1 = c == 0 && 2 * lane + 1 < 112;
            const float d0 = pad0 ? 0.f : dr0, d1 = pad1 ? 0.f : dr1;
            const float a0 = d0 * A, a1 = d1 * A; float x = a0 + a1;
#pragma unroll
            for (int o = 1; o < 64; o <<= 1) { const float y = bperm(x, lane - o); if (lane >= o) x += y; }
            const float csl = bperm(x, 63);
            const float cs1 = x, cs0 = x - a1;
            if (tt > 0) {
                const float R = bperm(cs1, 16 * tt - 1);
                LAS float* FSw = (LAS float*)(lds + S_FS) + wave * 128;
                *(LAS u2v*)(FSw + 2 * lane) = (u2v){__float_as_uint(__expf(fminf(R - cs0, 0.f)) * d0), __float_as_uint(__expf(fminf(R - cs1, 0.f)) * d1)}; }
            if (wave == 0) { *(LAS u2v*)(CS + 2 * lane) = (u2v){__float_as_uint(cs0), __float_as_uint(cs1)}; *(LAS u2v*)(DT + 2 * lane) = (u2v){__float_as_uint(d0), __float_as_uint(d1)}; if (lane == 0) TOT[0] = csl; }
            const int src = t >> 1; const float csa = bperm(cs0, src), csb = bperm(cs1, src), dta = bperm(d0, src), dtb_ = bperm(d1, src);
            const float cst = (t & 1) ? csb : csa, dtt = (t & 1) ? dtb_ : dta;
            const float wgt = dtt * __expf(csl - cst);
            const bool padt = c == 0 && t < 112;
            if (padt) { const v4u z = (v4u){0u, 0u, 0u, 0u}; pb0 = z; pb1 = z; pc0 = z; pc1 = z; px0 = z; px1 = z; }
            *(LAS v4u*)(KL + t * 144 + q * 16) = pb0; *(LAS v4u*)(KL + t * 144 + 64 + q * 16) = pb1;
            *(LAS v4u*)(QL + t * 144 + q * 16) = pc0; *(LAS v4u*)(QL + t * 144 + 64 + q * 16) = pc1;
            const unsigned xw[8] = {px0.x, px0.y, px0.z, px0.w, px1.x, px1.y, px1.z, px1.w};
            const unsigned bw[8] = {pb0.x, pb0.y, pb0.z, pb0.w, pb1.x, pb1.y, pb1.z, pb1.w};
#pragma unroll
            for (int j = 0; j < 8; ++j) { const int p = (j < 4 ? 8 * q : 32 + 8 * q) + 2 * (j & 3);
                *(LAS bf16*)(VT + p * TPITCH + 2 * t) = (bf16)(xw[j] & 0xffffu); *(LAS bf16*)(VT + (p + 1) * TPITCH + 2 * t) = (bf16)(xw[j] >> 16);
                const unsigned wb = cvtpk(__uint_as_float(bw[j] << 16) * wgt, __uint_as_float(bw[j] & 0xffff0000u) * wgt);
                *(LAS bf16*)(KT + p * TPITCH + 2 * t) = (bf16)(wb & 0xffffu); *(LAS bf16*)(KT + (p + 1) * TPITCH + 2 * t) = (bf16)(wb >> 16); }
        }
        LDS_BARRIER();
        float zz[16];
#pragma unroll
        for (int i = 0; i < 16; ++i) { const int row = seq_row(b, c, 16 * wave + i); zz[i] = bf2f(MIB[(size_t)(row >= 0 ? row : 0) * N_MAIN + CM_SZ + h * 64 + lane]); }
        if (c + 1 < 17) SSD_LOAD(c + 1);
        {
            f32x16 y;
#pragma unroll
            for (int i = 0; i < 16; ++i) y[i] = 0.f;
            const LAS unsigned char* qrow = QL + (32 * tt + r32) * 144;
#pragma unroll
            for (int s2 = 0; s2 < 2; ++s2) { y = MFMA32(pack8(SK0, s2), ld8x2(qrow + (16 * s2 + 4 * hi) * 2), y); y = MFMA32(pack8(SK1, s2), ld8x2(qrow + (32 + 16 * s2 + 4 * hi) * 2), y); }
            const float cst = CS[32 * tt + r32]; const float ect = __expf(cst);
#pragma unroll
            for (int i = 0; i < 16; ++i) y[i] *= ect;
            if (tt > 0) {
                const LAS float* FSw = (const LAS float*)(lds + S_FS) + wave * 128;
                f32x16 y2;
#pragma unroll
                for (int r = 0; r < 16; ++r) y2[r] = 0.f;
                for (int i = 0; i < tt; ++i) {
                    f32x16 gt;
#pragma unroll
                    for (int r = 0; r < 16; ++r) gt[r] = 0.f;
#pragma unroll
                    for (int ks = 0; ks < 4; ++ks) gt = MFMA32(ld16(KL + (32 * i + r32) * 144 + (16 * ks + 8 * hi) * 2), ld16(qrow + (16 * ks + 8 * hi) * 2), gt);
#pragma unroll
                    for (int g4 = 0; g4 < 4; ++g4) { const f4 fs4 = *(const LAS f4*)(FSw + 32 * i + 8 * g4 + 4 * hi); gt[4 * g4] *= fs4[0]; gt[4 * g4 + 1] *= fs4[1]; gt[4 * g4 + 2] *= fs4[2]; gt[4 * g4 + 3] *= fs4[3]; }
#pragma unroll
                    for (int s2 = 0; s2 < 2; ++s2) y2 = MFMA32(ld8x2(VT + (32 * vt + r32) * TPITCH + (32 * i + 16 * s2 + 4 * hi) * 2), pack8(gt, s2), y2);
                }
                const float et = __expf(fminf(cst - CS[32 * tt - 1], 0.f));
#pragma unroll
                for (int r = 0; r < 16; ++r) y[r] += et * y2[r];
            }
            {
                const int i = tt;
                f32x16 gt;
#pragma unroll
                for (int r = 0; r < 16; ++r) gt[r] = 0.f;
#pragma unroll
                for (int ks = 0; ks < 4; ++ks) gt = MFMA32(ld16(KL + (32 * i + r32) * 144 + (16 * ks + 8 * hi) * 2), ld16(qrow + (16 * ks + 8 * hi) * 2), gt);
#pragma unroll
                for (int g4 = 0; g4 < 4; ++g4) { const f4 cs4 = *(const LAS f4*)(CS + 32 * i + 8 * g4 + 4 * hi), dt4 = *(const LAS f4*)(DT + 32 * i + 8 * g4 + 4 * hi);
#pragma unroll
                    for (int e = 0; e < 4; ++e) { const bool vis = 8 * g4 + 4 * hi + e <= r32; const float wv = vis ? __expf(fminf(cst - cs4[e], 0.f)) * dt4[e] : 0.f; gt[4 * g4 + e] *= wv; } }
#pragma unroll
                for (int s2 = 0; s2 < 2; ++s2) y = MFMA32(ld8x2(VT + (32 * vt + r32) * TPITCH + (32 * i + 16 * s2 + 4 * hi) * 2), pack8(gt, s2), y);
            }
            const float ecl = __expf(TOT[0]);
#pragma unroll
            for (int r = 0; r < 16; ++r) { SK0[r] *= ecl; SK1[r] *= ecl; }
#pragma unroll 2
            for (int ks = 0; ks < 8; ++ks) { const bf16x8 xb = ld16(VT + (32 * vt + r32) * TPITCH + (16 * ks + 8 * hi) * 2);
                SK0 = MFMA32(ld16(KT + r32 * TPITCH + (16 * ks + 8 * hi) * 2), xb, SK0); SK1 = MFMA32(ld16(KT + (32 + r32) * TPITCH + (16 * ks + 8 * hi) * 2), xb, SK1); }
#pragma unroll
            for (int g4 = 0; g4 < 4; ++g4) { f4 o;
#pragma unroll
                for (int e = 0; e < 4; ++e) o[e] = y[4 * g4 + e] + Dh * bf2f(*(const LAS bf16*)(VT + (32 * vt + 8 * g4 + 4 * hi + e) * TPITCH + 2 * (32 * tt + r32)));
                *(LAS f4*)(OUT + (32 * tt + r32) * OPITCH + 32 * vt + 8 * g4 + 4 * hi) = o; }
        }
        LDS_BARRIER();
        {
            float yv[16], ss[16];
#pragma unroll
            for (int i = 0; i < 16; ++i) { yv[i] = OUT[(16 * wave + i) * OPITCH + lane] * zz[i]; ss[i] = fa::row16_sum(yv[i] * yv[i]); }
#pragma unroll
            for (int i = 0; i < 16; ++i) ss[i] += bperm(ss[i], lane ^ 16);
#pragma unroll
            for (int i = 0; i < 16; ++i) ss[i] += bperm(ss[i], lane ^ 32);
            if (c > 0) {
                const size_t row0 = (size_t)b * 2048 + 128 * (c - 1) + 16 * wave;
#pragma unroll
                for (int i = 0; i < 16; ++i) { if (lane == 0) SSQH[(row0 + i) * 8 + h] = ss[i]; MIXB[(row0 + i) * 1024 + 256 + h * 64 + lane] = (bf16)(cvtpk(yv[i], 0.f) & 0xffffu); }
            } else if (b == 0 && wave == 7) {
#pragma unroll
                for (int i = 0; i < 16; ++i) { if (lane == 0) SSQH[(size_t)(R_META + i) * 8 + h] = ss[i]; MIXB[(size_t)(R_META + i) * 1024 + 256 + h * 64 + lane] = (bf16)(cvtpk(yv[i], 0.f) & 0xffffu); }
            }
        }
        LDS_BARRIER();
    }
#undef SSD_LOAD
    if (tt == 0) {
#pragma unroll
        for (int g4 = 0; g4 < 4; ++g4) { *(GAS f4*)(state_out + (32 * vt + r32) * 64 + 8 * g4 + 4 * hi) = (f4){SK0[4 * g4], SK0[4 * g4 + 1], SK0[4 * g4 + 2], SK0[4 * g4 + 3]};
            *(GAS f4*)(state_out + (32 * vt + r32) * 64 + 32 + 8 * g4 + 4 * hi) = (f4){SK1[4 * g4], SK1[4 * g4 + 1], SK1[4 * g4 + 2], SK1[4 * g4 + 3]}; } }
}
#undef MFMA32
}

namespace eu {
using fa::f4;
constexpr int E_Q = 67840, E_K = 71936, E_V = 76032, E_LF = 80128, E_XBC = 80256, E_DT = 92544, E_GLOG = 92672, E_YS = 94720, E_GO = 102912, E_END = 107008;

__device__ __forceinline__ void sample_unit(int b, int l, const float* MI, const float* ck, const float* cv, const float* clf, const int* pt, const float* st_ssm, const float* st_conv, const float* st_gla,
        const float* qg, const float* kg, const float* fbias, const float* cw, const float* cb, const float* dtb, const float* alog, const float* dsk, const float* snorm,
        const float* wg, const float* gbias, const float* gnorm, bf16* MIXB, float* out, LAS unsigned char* lds, int tid) {
    const int lane = tid & 63, wave = __builtin_amdgcn_readfirstlane(tid >> 6);
    LAS float* EQ = (LAS float*)(lds + E_Q); LAS float* EK = (LAS float*)(lds + E_K); LAS float* EV = (LAS float*)(lds + E_V); LAS float* ELF = (LAS float*)(lds + E_LF);
    LAS float* EX = (LAS float*)(lds + E_XBC); LAS float* EDT = (LAS float*)(lds + E_DT); LAS float* EG = (LAS float*)(lds + E_GLOG); LAS float* EYS = (LAS float*)(lds + E_YS); LAS float* EGO = (LAS float*)(lds + E_GO);
    const int r0 = R_S + 4 * b;
    if (wave < 4) { const float* mi = MI + (size_t)(r0 + wave) * LDMI;
#pragma unroll
        for (int h = 0; h < 4; ++h) { const float q = mi[C_FQ + h * 64 + lane], k = mi[C_FK + h * 64 + lane], v = mi[C_FV + h * 64 + lane];
            const float qs = rsqrtf(wave_sum_l(q * q, lane) * (1.f / 64.f) + EPS), ks = rsqrtf(wave_sum_l(k * k, lane) * (1.f / 64.f) + EPS);
            EQ[wave * 256 + h * 64 + lane] = q * qs * qg[lane]; EK[wave * 256 + h * 64 + lane] = k * ks * kg[lane]; EV[wave * 256 + h * 64 + lane] = v; }
        if (lane < 4) ELF[wave * 4 + lane] = log_sigmoidf(mi[C_FF + lane] + fbias[lane]);
    }
    for (int idx = tid; idx < 3072; idx += 512) { const int i = idx / 768, c = idx - i * 768; float u[4];
#pragma unroll
        for (int j = 0; j < 4; ++j) { const int p = i - j; u[j] = p >= 0 ? MI[(size_t)(r0 + p) * LDMI + C_XBC + c] : st_conv[(size_t)(b * 3 + 3 + p) * 768 + c]; }
        const float o = cw[3 * 768 + c] * u[0] + cw[2 * 768 + c] * u[1] + cw[768 + c] * u[2] + cw[c] * u[3] + cb[c];
        EX[i * 768 + c] = siluf(o); }
    if (tid < 32) EDT[tid] = softplusf(MI[(size_t)(r0 + (tid >> 3)) * LDMI + C_DT + (tid & 7)] + dtb[tid & 7]);
    { const int i = tid >> 7, c = tid & 127; const float* lr = MI + (size_t)(r0 + i) * LDMI + C_LR; float a = gbias[c];
#pragma unroll
        for (int r = 0; r < 16; ++r) a += lr[r] * wg[r * 128 + c];
        EG[i * 128 + c] = log_sigmoidf(a) * (1.0f / 16.0f); }
    {
        const int h = lane >> 4, d4 = lane & 15;
        LAS f4* Dl = (LAS f4*)(lds + fa::S_D); LAS f4* wsum = (LAS f4*)(lds + fa::S_WS);
        {
            const int page = pt[b * 16 + (tid >> 5)];
            const f4* src = (const f4*)(clf + (((size_t)l * NPOOL + page) * 128 + 4 * (tid & 31)) * 4);
            const f4 v0 = src[0], v1 = src[1], v2 = src[2], v3 = src[3];
            const f4 s2 = v3, s1 = v3 + v2, s0 = s1 + v1, tot = s0 + v0;
            f4 x = tot;
#pragma unroll
            for (int o = 1; o < 64; o <<= 1) { f4 y; y[0] = bperm(x[0], lane + o); y[1] = bperm(x[1], lane + o); y[2] = bperm(x[2], lane + o); y[3] = bperm(x[3], lane + o); if (lane + o < 64) x += y; }
            if (lane == 0) wsum[wave] = x;
            __syncthreads();
            f4 off = x - tot;
            for (int w = wave + 1; w < 8; ++w) off += wsum[w];
            Dl[4 * tid + 0] = s0 + off; Dl[4 * tid + 1] = s1 + off; Dl[4 * tid + 2] = s2 + off; Dl[4 * tid + 3] = off;
            __syncthreads();
        }
        const int r16 = lane & 15, q4 = lane >> 4, hp = r16 >> 2, iq = lane & 3;
        f4 q[4];
#pragma unroll
        for (int i = 0; i < 4; ++i) q[i] = *(const LAS f4*)(EQ + i * 256 + h * 64 + 4 * d4) * 0.125f;
        float m = -INFINITY, ls = 0.f; f4 oc[4];
#pragma unroll
        for (int c = 0; c < 4; ++c) oc[c] = (f4){0.f, 0.f, 0.f, 0.f};
        const LAS float* Df = (const LAS float*)Dl;
        const bool b0 = lane & 1, b1 = lane & 2, mine = hp == q4;
        for (int p = 0; p < 16; ++p) {
            const int page = pt[b * 16 + p];
            const size_t base = (((size_t)l * NPOOL + page) * 128 + 16 * wave) * 256 + lane * 4;
            f4 kk[16], vv[16];
#pragma unroll
            for (int j = 0; j < 16; ++j) { kk[j] = __builtin_nontemporal_load((const f4*)(ck + base + (size_t)j * 256)); vv[j] = __builtin_nontemporal_load((const f4*)(cv + base + (size_t)j * 256)); }
            float sj[16];
#pragma unroll
            for (int j = 0; j < 16; ++j) {
                float pq[4];
#pragma unroll
                for (int i = 0; i < 4; ++i) pq[i] = q[i][0] * kk[j][0] + q[i][1] * kk[j][1] + q[i][2] * kk[j][2] + q[i][3] * kk[j][3];
                const float k0 = b0 ? pq[1] : pq[0], g0 = b0 ? pq[0] : pq[1], k1 = b0 ? pq[3] : pq[2], g1 = b0 ? pq[2] : pq[3];
                const float r0 = k0 + fa::dpp<fa::XOR1>(g0), r1 = k1 + fa::dpp<fa::XOR1>(g1);
                float t = (b1 ? r1 : r0) + fa::dpp<fa::XOR2>(b1 ? r0 : r1);
                t += fa::dpp<0x124>(t); t += fa::dpp<0x128>(t);
                sj[j] = t + Df[(p * 128 + 16 * wave + j) * 4 + h];
            }
            float mx = sj[0];
#pragma unroll
            for (int j = 1; j < 16; ++j) mx = fmaxf(mx, sj[j]);
            const float mn = fmaxf(m, mx); const float sc = __expf(m - mn); m = mn;
            float rs = 0.f;
#pragma unroll
            for (int j = 0; j < 16; ++j) { sj[j] = __expf(sj[j] - mn); rs += sj[j]; }
            ls = ls * sc + rs;
            const float scc = bperm(sc, 16 * hp + iq);
#pragma unroll
            for (int c = 0; c < 4; ++c) { oc[c][0] *= scc; oc[c][1] *= scc; oc[c][2] *= scc; oc[c][3] *= scc; }
#pragma unroll
            for (int g = 0; g < 2; ++g) {
                v4u w = (v4u){fa::cvtpk(sj[8 * g], sj[8 * g + 1]), fa::cvtpk(sj[8 * g + 2], sj[8 * g + 3]), fa::cvtpk(sj[8 * g + 4], sj[8 * g + 5]), fa::cvtpk(sj[8 * g + 6], sj[8 * g + 7])};
                if (!mine) w = (v4u){0u, 0u, 0u, 0u};
                const fa::bf16x8 pbv = __builtin_bit_cast(fa::bf16x8, w);
#pragma unroll
                for (int c = 0; c < 4; ++c) {
                    const v4u a = (v4u){fa::cvtpk(vv[8 * g][c], vv[8 * g + 1][c]), fa::cvtpk(vv[8 * g + 2][c], vv[8 * g + 3][c]), fa::cvtpk(vv[8 * g + 4][c], vv[8 * g + 5][c]), fa::cvtpk(vv[8 * g + 6][c], vv[8 * g + 7][c])};
                    oc[c] = __builtin_amdgcn_mfma_f32_16x16x32_bf16(__builtin_bit_cast(fa::bf16x8, a), pbv, oc[c], 0, 0, 0); }
            }
        }
        m = bperm(m, 16 * hp + iq); ls = bperm(ls, 16 * hp + iq);
        LAS float* part = (LAS float*)(lds + fa::S_PART);
        { LAS float* pp = part + (wave * 16 + r16) * fa::S_PSTR;
#pragma unroll
            for (int e = 0; e < 4; ++e) *(LAS f4*)(pp + 4 + 16 * q4 + 4 * e) = (f4){oc[0][e], oc[1][e], oc[2][e], oc[3][e]};
            if (q4 == 0) { pp[0] = m; pp[1] = ls; } }
        __syncthreads();
        for (int u = tid; u < 1024; u += 512) {
            const int hh = u >> 8, i = (u >> 6) & 3, d = u & 63;
            float sn[4]; float G = 0.f;
#pragma unroll
            for (int j = 0; j < 4; ++j) { G -= ELF[j * 4 + hh]; float dot = 0.f;
                for (int c = 0; c < 64; ++c) dot += EQ[i * 256 + hh * 64 + c] * EK[j * 256 + hh * 64 + c];
                sn[j] = j <= i ? dot * 0.125f + G : -INFINITY; }
            float mt = fmaxf(fmaxf(sn[0], sn[1]), fmaxf(sn[2], sn[3]));
            for (int w = 0; w < 8; ++w) mt = fmaxf(mt, part[(w * 16 + hh * 4 + i) * fa::S_PSTR]);
            float lt = 0.f, ot = 0.f;
            for (int w = 0; w < 8; ++w) { const LAS float* pp = part + (w * 16 + hh * 4 + i) * fa::S_PSTR; const float e = __expf(pp[0] - mt); lt += e * pp[1]; ot += e * pp[4 + d]; }
#pragma unroll
            for (int j = 0; j < 4; ++j) { const float e = __expf(sn[j] - mt); lt += e; ot += e * EV[j * 256 + hh * 64 + d]; }
            MIXB[(size_t)(r0 + i) * 1024 + hh * 64 + d] = (bf16)f2bf(ot / lt);
        }
    }
    {
        const int h = wave, g = h >> 2, p = lane;
        const f4* h0 = (const f4*)(st_ssm + (((size_t)b * 8 + h) * 64 + p) * 64);
        f4 hs[16];
#pragma unroll
        for (int n4 = 0; n4 < 16; ++n4) hs[n4] = h0[n4];
        const float A = -expf(alog[h]);
        for (int i = 0; i < 4; ++i) {
            const float dt = EDT[i * 8 + h]; const float dec = expf(dt * A); const float xdt = EX[i * 768 + h * 64 + p] * dt;
            float y = 0.f;
#pragma unroll
            for (int n4 = 0; n4 < 16; ++n4) { const f4 Bv = *(const LAS f4*)(EX + i * 768 + 512 + g * 64 + 4 * n4), Cv = *(const LAS f4*)(EX + i * 768 + 640 + g * 64 + 4 * n4);
                hs[n4] = hs[n4] * dec + Bv * xdt; y += Cv[0] * hs[n4][0] + Cv[1] * hs[n4][1] + Cv[2] * hs[n4][2] + Cv[3] * hs[n4][3]; }
            EYS[i * 512 + h * 64 + p] = y;
        }
        f4* ho = (f4*)(out + O_SSMS + (((size_t)(l * DEC_BATCH + b) * 8 + h) * 64 + p) * 64);
#pragma unroll
        for (int n4 = 0; n4 < 16; ++n4) ho[n4] = hs[n4];
    }
    if (wave < 4) {
        const int h = wave, v = lane;
        const float* s0 = st_gla + ((size_t)b * 4 + h) * 2048;
        float S[32];
#pragma unroll
        for (int k = 0; k < 32; ++k) S[k] = s0[k * 64 + v];
        for (int i = 0; i < 4; ++i) {
            const float* mi = MI + (size_t)(r0 + i) * LDMI;
            const float vv = mi[C_GV + h * 64 + v];
            float o = 0.f;
#pragma unroll
            for (int k4 = 0; k4 < 8; ++k4) { const f4 q4 = *(const f4*)(mi + C_GQ + h * 32 + 4 * k4), k4v = *(const f4*)(mi + C_GK + h * 32 + 4 * k4), g4 = *(const LAS f4*)(EG + i * 128 + h * 32 + 4 * k4);
#pragma unroll
                for (int e = 0; e < 4; ++e) { S[4 * k4 + e] = S[4 * k4 + e] * __expf(g4[e]) + k4v[e] * vv; o += q4[e] * 0.17677669529663687f * S[4 * k4 + e]; } }
            EGO[i * 256 + h * 64 + v] = o;
        }
        float* so = out + O_GLAS + ((size_t)(l * DEC_BATCH + b) * 4 + h) * 2048;
#pragma unroll
        for (int k = 0; k < 32; ++k) so[k * 64 + v] = S[k];
    }
    __syncthreads();
    if (wave < 4) { const int i = wave; const float* mi = MI + (size_t)(r0 + i) * LDMI;
#pragma unroll
        for (int g = 0; g < 2; ++g) { float y[4]; float s = 0.f;
#pragma unroll
            for (int e = 0; e < 4; ++e) { const int c = g * 256 + lane * 4 + e; y[e] = (EYS[i * 512 + c] + EX[i * 768 + c] * dsk[c >> 6]) * mi[C_SZ + c]; s += y[e] * y[e]; }
            const float rs = rsqrtf(wave_sum_l(s, lane) * (1.f / 256.f) + EPS);
            *(uint2*)(MIXB + (size_t)(r0 + i) * 1024 + 256 + g * 256 + lane * 4) = make_uint2(pk2(y[0] * rs * snorm[g * 256 + lane * 4], y[1] * rs * snorm[g * 256 + lane * 4 + 1]), pk2(y[2] * rs * snorm[g * 256 + lane * 4 + 2], y[3] * rs * snorm[g * 256 + lane * 4 + 3])); }
#pragma unroll
        for (int hh = 0; hh < 4; ++hh) { const float o = EGO[i * 256 + hh * 64 + lane]; const float rs = rsqrtf(wave_sum_l(o * o, lane) * (1.f / 64.f) + EPS);
            MIXB[(size_t)(r0 + i) * 1024 + 768 + hh * 64 + lane] = (bf16)f2bf(o * rs * gnorm[lane] * mi[C_GG + hh * 64 + lane]); }
    }
    __syncthreads();
}

constexpr int M_Q = 0, M_K = 16384, M_LF = 32768, M_F = 33024;
__device__ __forceinline__ void meta_unit(const float* MI, const float* qg, const float* kg, const float* fbias, bf16* MIXB, LAS unsigned char* lds, int tid) {
    const int lane = tid & 63, wave = __builtin_amdgcn_readfirstlane(tid >> 6);
    LAS float* MQ = (LAS float*)(lds + M_Q); LAS float* MK = (LAS float*)(lds + M_K); LAS float* MLF = (LAS float*)(lds + M_LF); LAS float* MF = (LAS float*)(lds + M_F);
    for (int j = wave; j < 16; j += 8) { const float* mi = MI + (size_t)(R_META + j) * LDMI;
#pragma unroll
        for (int h = 0; h < 4; ++h) { const float q = mi[C_FQ + h * 64 + lane], k = mi[C_FK + h * 64 + lane];
            const float qs = rsqrtf(wave_sum_l(q * q, lane) * (1.f / 64.f) + EPS), ks = rsqrtf(wave_sum_l(k * k, lane) * (1.f / 64.f) + EPS);
            MQ[j * 256 + h * 64 + lane] = q * qs * qg[lane]; MK[j * 256 + h * 64 + lane] = k * ks * kg[lane]; }
        if (lane < 4) MLF[j * 4 + lane] = log_sigmoidf(mi[C_FF + lane] + fbias[lane]); }
    __syncthreads();
    if (tid < 4) { float F = 0.f; for (int j = 0; j < 16; ++j) { F += MLF[j * 4 + tid]; MF[j * 4 + tid] = F; } }
    __syncthreads();
    for (int pr = wave; pr < 64; pr += 8) { const int h = pr >> 4, j = pr & 15;
        const float qv = MQ[j * 256 + h * 64 + lane];
        float sc[16]; float mx = -INFINITY;
#pragma unroll
        for (int k = 0; k < 16; ++k) { const float s = wave_sum_l(qv * MK[k * 256 + h * 64 + lane], lane) * 0.125f + (MF[j * 4 + h] - MF[k * 4 + h]); sc[k] = k <= j ? s : -INFINITY; mx = fmaxf(mx, sc[k]); }
        float sum = 0.f, o = 0.f;
#pragma unroll
        for (int k = 0; k < 16; ++k) { const float p = __expf(sc[k] - mx); sum += p; o += p * MI[(size_t)(R_META + k) * LDMI + C_FV + h * 64 + lane]; }
        MIXB[(size_t)(R_META + j) * 1024 + h * 64 + lane] = (bf16)f2bf(o / sum); }
    __syncthreads();
}
}

namespace eg {
using fa::bf16x8; using fa::f32x16; using fa::f4; using fa::crow;
template <int K, int NB>
__device__ __forceinline__ f4 egemm_tile(const bf16* A, const bf16* Bt, int row0, int col0, LAS unsigned char* lds, int tid) {
    const int lane = tid & 63, wave = __builtin_amdgcn_readfirstlane(tid >> 6), r32 = lane & 31, hi = lane >> 5;
    constexpr int KW = K / 8, NS = KW / 16, NBAT = (NS + NB - 1) / NB;
    const GAS bf16* ap = (const GAS bf16*)A + (size_t)(row0 + r32) * K + wave * KW + 8 * hi;
    const GAS bf16* bp0 = (const GAS bf16*)Bt + (size_t)(col0 + r32) * K + wave * KW + 8 * hi; const GAS bf16* bp1 = bp0 + (size_t)32 * K;
    f32x16 c0, c1;
#pragma unroll
    for (int i = 0; i < 16; ++i) { c0[i] = 0.f; c1[i] = 0.f; }
    bf16x8 fa_[2][NB], fb0[2][NB], fb1[2][NB];
#define EG_LOAD(buf, bat) do { _Pragma("unroll") for (int j = 0; j < NB; ++j) if ((bat) * NB + j < NS) { fa_[buf][j] = *(const GAS bf16x8*)(ap + ((bat) * NB + j) * 16); fb0[buf][j] = *(const GAS bf16x8*)(bp0 + ((bat) * NB + j) * 16); fb1[buf][j] = *(const GAS bf16x8*)(bp1 + ((bat) * NB + j) * 16); } } while (0)
#define EG_MMA(buf, bat) do { _Pragma("unroll") for (int j = 0; j < NB; ++j) if ((bat) * NB + j < NS) { c0 = __builtin_amdgcn_mfma_f32_32x32x16_bf16(fa_[buf][j], fb0[buf][j], c0, 0, 0, 0); c1 = __builtin_amdgcn_mfma_f32_32x32x16_bf16(fa_[buf][j], fb1[buf][j], c1, 0, 0, 0); } } while (0)
    EG_LOAD(0, 0);
#pragma unroll
    for (int bat = 0; bat < NBAT; ++bat) { if (bat + 1 < NBAT) { if ((bat + 1) & 1) EG_LOAD(1, bat + 1); else EG_LOAD(0, bat + 1); } if (bat & 1) EG_MMA(1, bat); else EG_MMA(0, bat); }
#undef EG_LOAD
#undef EG_MMA
    LAS float* red = (LAS float*)lds + wave * 2048;
#pragma unroll
    for (int i = 0; i < 16; ++i) { red[crow(i, hi) * 64 + r32] = c0[i]; red[crow(i, hi) * 64 + 32 + r32] = c1[i]; }
    __syncthreads();
    const LAS float* rp = (const LAS float*)lds + (tid >> 4) * 64 + (tid & 15) * 4;
    f4 s = *(const LAS f4*)rp;
#pragma unroll
    for (int w = 1; w < 8; ++w) s += *(const LAS f4*)(rp + w * 2048);
    __syncthreads();
    return s;
}
template <int K, int NB>
__device__ __forceinline__ void egemm_resid(const bf16* A, const bf16* Bt, float* X, bf16* XB, float* SSQP, float scale, float* out, int final_, LAS unsigned char* lds, int tid) {
    const int lane = tid & 63, wave = __builtin_amdgcn_readfirstlane(tid >> 6), r32 = lane & 31, hi = lane >> 5;
    constexpr int KW = K / 8, NS = KW / 16, NBAT = (NS + NB - 1) / NB;
    for (int u = blockIdx.x; u < 11 * 16; u += gridDim.x) {
        const int rt = u >> 4, ct = u & 15, row0 = MP + 48 * rt, col0 = 64 * ct;
        const int ra = row0 + (tid >> 4), col = col0 + (tid & 15) * 4; const bool hasb = (tid >> 4) < 16;
        GAS f4* xpa = (GAS f4*)(X + (size_t)ra * 1024 + col); GAS f4* xpb = (GAS f4*)(X + (size_t)(ra + 32) * 1024 + col);
        f4 xa = *xpa, xb = *xpb;
        const GAS bf16* ap0 = (const GAS bf16*)A + (size_t)(row0 + r32) * K + wave * KW + 8 * hi; const GAS bf16* ap1 = ap0 + (size_t)32 * K;
        const GAS bf16* bp0 = (const GAS bf16*)Bt + (size_t)(col0 + r32) * K + wave * KW + 8 * hi; const GAS bf16* bp1 = bp0 + (size_t)32 * K;
        f32x16 c00, c01, c10, c11;
#pragma unroll
        for (int i = 0; i < 16; ++i) { c00[i] = 0.f; c01[i] = 0.f; c10[i] = 0.f; c11[i] = 0.f; }
        constexpr int QB = 4, NQ = (NS + QB - 1) / QB;
        bf16x8 fa0[2][QB], fa1[2][QB], fb0[2][QB], fb1[2][QB];
#define EGR_LOAD(buf, bat) do { \
            _Pragma("unroll") for (int j = 0; j < QB; ++j) if ((bat) * QB + j < NS) fa0[buf][j] = *(const GAS bf16x8*)(ap0 + ((bat) * QB + j) * 16); \
            _Pragma("unroll") for (int j = 0; j < QB; ++j) if ((bat) * QB + j < NS) fb0[buf][j] = *(const GAS bf16x8*)(bp0 + ((bat) * QB + j) * 16); \
            _Pragma("unroll") for (int j = 0; j < QB; ++j) if ((bat) * QB + j < NS) fa1[buf][j] = *(const GAS bf16x8*)(ap1 + ((bat) * QB + j) * 16); \
            _Pragma("unroll") for (int j = 0; j < QB; ++j) if ((bat) * QB + j < NS) fb1[buf][j] = *(const GAS bf16x8*)(bp1 + ((bat) * QB + j) * 16); } while (0)
#define EGR_MMA(buf, bat) do { _Pragma("unroll") for (int j = 0; j < QB; ++j) if ((bat) * QB + j < NS) { \
            c00 = __builtin_amdgcn_mfma_f32_32x32x16_bf16(fa0[buf][j], fb0[buf][j], c00, 0, 0, 0); c01 = __builtin_amdgcn_mfma_f32_32x32x16_bf16(fa0[buf][j], fb1[buf][j], c01, 0, 0, 0); \
            c10 = __builtin_amdgcn_mfma_f32_32x32x16_bf16(fa1[buf][j], fb0[buf][j], c10, 0, 0, 0); c11 = __builtin_amdgcn_mfma_f32_32x32x16_bf16(fa1[buf][j], fb1[buf][j], c11, 0, 0, 0); } } while (0)
        EGR_LOAD(0, 0);
#pragma unroll
        for (int bat = 0; bat < NQ; ++bat) {
            if (bat + 1 < NQ) { if ((bat + 1) & 1) EGR_LOAD(1, bat + 1); else EGR_LOAD(0, bat + 1); }
            if (bat & 1) EGR_MMA(1, bat); else EGR_MMA(0, bat);
        }
#undef EGR_LOAD
#undef EGR_MMA
        LAS float* red = (LAS float*)lds + wave * 4096;
#pragma unroll
        for (int i = 0; i < 16; ++i) { red[crow(i, hi) * 64 + r32] = c00[i]; red[crow(i, hi) * 64 + 32 + r32] = c01[i]; red[(32 + crow(i, hi)) * 64 + r32] = c10[i]; red[(32 + crow(i, hi)) * 64 + 32 + r32] = c11[i]; }
        __syncthreads();
        const LAS float* rp = (const LAS float*)lds + (tid >> 4) * 64 + (tid & 15) * 4;
        f4 sa = *(const LAS f4*)rp, sb = *(const LAS f4*)(rp + 32 * 64);
#pragma unroll
        for (int w = 1; w < 8; ++w) { sa += *(const LAS f4*)(rp + w * 4096); sb += *(const LAS f4*)(rp + w * 4096 + 32 * 64); }
        __syncthreads();
#pragma unroll
        for (int hb = 0; hb < 2; ++hb) {
            if (hb == 1 && !hasb) break;
            const int row = hb ? ra + 32 : ra; f4 x = hb ? xb : xa; const f4 acc = hb ? sb : sa;
            x[0] += acc[0] * scale; x[1] += acc[1] * scale; x[2] += acc[2] * scale; x[3] += acc[3] * scale;
            *(hb ? xpb : xpa) = x;
            *(GAS la::u2v*)(XB + (size_t)row * 1024 + col) = (la::u2v){fa::cvtpk(x[0], x[1]), fa::cvtpk(x[2], x[3])};
            const float ss = fa::row16_sum((x[0] * x[0] + x[1] * x[1]) + (x[2] * x[2] + x[3] * x[3]));
            if ((tid & 15) == 0) SSQP[(size_t)row * 16 + ct] = ss;
            if (final_ && row < R_META) *(GAS f4*)(out + O_YS + (size_t)(row - R_S) * 1024 + col) = x;
        }
    }
}
}

namespace sm {
using fa::bf16x8; using fa::f32x16; using fa::crow;
__device__ __forceinline__ void smalls_gemm(const bf16* XB, const bf16* Wt, const float* SSQP, float* MI, float* LF, const float* fbias, float* out, int l, LAS unsigned char* lds, int tid, int u0, int ustep, int uend) {
    const int lane = tid & 63, wave = __builtin_amdgcn_readfirstlane(tid >> 6), r32 = lane & 31, hi = lane >> 5;
    constexpr int NU = (M_REAL + 31) / 32;
    const GAS bf16* bp = (const GAS bf16*)Wt + (size_t)r32 * 1024 + wave * 128 + 8 * hi;
    const GAS bf16* ap = (const GAS bf16*)XB + (size_t)r32 * 1024 + wave * 128 + 8 * hi;
    bf16x8 fa_[8], fb_[8];
    if (u0 < uend) {
#pragma unroll
        for (int j = 0; j < 8; ++j) fa_[j] = *(const GAS bf16x8*)(ap + (size_t)u0 * 32 * 1024 + 16 * j);
#pragma unroll
        for (int j = 0; j < 8; ++j) fb_[j] = *(const GAS bf16x8*)(bp + 16 * j); }
    for (int u = u0; u < uend; u += ustep) {
        const int row0 = 32 * u;
        f32x16 c;
#pragma unroll
        for (int i = 0; i < 16; ++i) c[i] = 0.f;
#pragma unroll
        for (int j = 0; j < 8; ++j) c = __builtin_amdgcn_mfma_f32_32x32x16_bf16(fa_[j], fb_[j], c, 0, 0, 0);
        if (u + ustep < uend) {
#pragma unroll
            for (int j = 0; j < 8; ++j) fa_[j] = *(const GAS bf16x8*)(ap + (size_t)(u + ustep) * 32 * 1024 + 16 * j); }
        const float rs = pg8::rstd_of(SSQP, row0 + (tid >> 4));
        LAS float* red = (LAS float*)lds + wave * 1024;
#pragma unroll
        for (int i = 0; i < 16; ++i) red[crow(i, hi) * 32 + r32] = c[i];
        __syncthreads();
        const int rr = tid >> 4, c0 = (tid & 15) * 2; const int row = row0 + rr;
        float v0 = 0.f, v1 = 0.f;
#pragma unroll
        for (int w = 0; w < 8; ++w) { v0 += ((const LAS float*)lds)[w * 1024 + rr * 32 + c0]; v1 += ((const LAS float*)lds)[w * 1024 + rr * 32 + c0 + 1]; }
        __syncthreads();
        v0 *= rs; v1 *= rs;
        if (c0 < 28) { MI[(size_t)row * LDMI + small2ref(c0)] = v0; MI[(size_t)row * LDMI + small2ref(c0 + 1)] = v1; }
        if (c0 < 4 && row < M_REAL) {
            const float x0 = v0 + fbias[c0], x1 = v1 + fbias[c0 + 1];
            const float l0 = fminf(x0, 0.f) - log1pf(__expf(-fabsf(x0))), l1 = fminf(x1, 0.f) - log1pf(__expf(-fabsf(x1)));
            LF[(size_t)row * 4 + c0] = l0; LF[(size_t)row * 4 + c0 + 1] = l1;
            if (row < MP) { float* o = out + O_LFP + ((size_t)(l * BATCH + (row >> 11)) * TP + 16 + (row & 2047)) * 4 + c0; o[0] = l0; o[1] = l1; }
            else if (row < R_META) { float* o = out + O_LFS + ((size_t)l * MS + (row - R_S)) * 4 + c0; o[0] = l0; o[1] = l1; }
            else for (int cc = 0; cc < BATCH; ++cc) { float* o = out + O_LFP + ((size_t)(l * BATCH + cc) * TP + (row - R_META)) * 4 + c0; o[0] = l0; o[1] = l1; }
        }
    }
}
}

struct Args { const float* in[31]; float* out; unsigned char* ws; int ph_lo, ph_hi; };

__device__ __forceinline__ void transpose_item(const float* W, int ldw, int K, const float* g, bf16* WT, int mapkind, int nblk, int item, LAS float* scr, int lane) {
    const int kb = item / nblk, nb = item % nblk, k0 = 64 * kb, n0 = 32 * nb;
    const int kr = lane >> 3, n4 = (lane & 7) * 4;
    const int nd = n0 + n4;
    int src;
    if (mapkind == 1) { const int pn = nd >> 8, s = nd & 255; src = s < 128 ? 128 * pn + s : 2816 + 128 * pn + (s - 128); }
    else if (mapkind == 2) { const int pn = nd >> 8, sl = nd & 255; src = pn < 3 ? 256 * pn + 64 * ((sl >> 5) & 3) + 32 * (sl >> 7) + (sl & 31) : main2ref(nd); if (src >= ldw) src = -1; }
    else if (mapkind == 3) src = small2ref(nd);
    else src = nd < ldw ? nd : -1;
    typedef float f4t __attribute__((ext_vector_type(4)));
    f4t wv[8];
#pragma unroll
    for (int i = 0; i < 8; ++i) wv[i] = __builtin_nontemporal_load((const f4t*)(W + (size_t)(k0 + kr + 8 * i) * ldw + (src >= 0 ? src : 0)));
#pragma unroll
    for (int i = 0; i < 8; ++i) { const int kk = kr + 8 * i; const float gv = g ? g[k0 + kk] : 1.f;
#pragma unroll
        for (int e = 0; e < 4; ++e) scr[kk * 33 + n4 + e] = src >= 0 ? wv[i][e] * gv : 0.f; }
    LDS_WAIT();
    const int c = lane & 7;
#pragma unroll
    for (int j = 0; j < 4; ++j) { const int n = (lane >> 3) + 8 * j; const LAS float* s = scr + (8 * c) * 33 + n;
        v4u o; o.x = pk2(s[0 * 33], s[1 * 33]); o.y = pk2(s[2 * 33], s[3 * 33]); o.z = pk2(s[4 * 33], s[5 * 33]); o.w = pk2(s[6 * 33], s[7 * 33]);
        *(v4u*)(WT + (size_t)(n0 + n) * K + k0 + 8 * c) = o; }
    LDS_WAIT();
}

template <class T> __device__ __forceinline__ T* as_global(T* p) { return (T*)(__attribute__((address_space(1))) T*)p; }
__device__ __forceinline__ int tid_now(int wave_s) { int t; asm volatile("v_mbcnt_lo_u32_b32 %0, -1, 0\n\tv_mbcnt_hi_u32_b32 %0, -1, %0" : "=v"(t)); return t | (wave_s << 6); }
__global__ void __launch_bounds__(NWAVES * 64, 2) fwd(Args args) {
    extern __shared__ __attribute__((aligned(16))) unsigned char lds[];
    volatile LAS unsigned* MISC = (volatile LAS unsigned*)((LAS unsigned char*)lds + MISC_OFF);
    if (threadIdx.x < 32) MISC[threadIdx.x] = 0u;
    __syncthreads();
    XcdBarrier bar = xcd_barrier_post((unsigned*)(args.ws + WS_CTL) + CW_BAR, MISC + 8);
    volatile LAS unsigned long long* PT = (volatile LAS unsigned long long*)((LAS unsigned char*)lds + MISC_OFF + 256);
    if (threadIdx.x < 31) PT[threadIdx.x] = (unsigned long long)args.in[threadIdx.x];
    __syncthreads();
#define INP(i) ((const float*)(const GAS float*)PT[i])
    const int lo = args.ph_lo, hi = args.ph_hi;
    const int wave_s = __builtin_amdgcn_readfirstlane((int)threadIdx.x >> 6);
    int ph = 0;
#define BUF(name, off) float* name = (float*)(ws_ + (off))
#define BUFH(name, off) bf16* name = (bf16*)(ws_ + (off))
#define PHASE_BEGIN_R(R) if (lo <= ph && ph < hi) for (int rep_ = 0; rep_ < (R); ++rep_) { GAS unsigned char* wsg_ = (GAS unsigned char*)args.ws; GAS float* outg_ = (GAS float*)args.out; int tid = tid_now(wave_s); asm volatile("" : "+s"(wsg_), "+s"(outg_)); unsigned char* ws_ = (unsigned char*)wsg_;         \
        const int lane = tid & 63, wave = tid >> 6; const int gw = blockIdx.x * NWAVES + wave, NGW = gridDim.x * NWAVES; float* smem = (float*)lds; float* out = (float*)outg_; (void)lane; (void)wave; (void)gw; (void)NGW; (void)smem; (void)out; \
        BUF(X, WS_X); BUFH(XB, WS_XB); BUF(SSQP, WS_SSQ); BUFH(HB, WS_HB); BUFH(MIXB, WS_MIXB); BUF(MI, WS_MI); BUF(QN, WS_QN); BUF(KN, WS_KN); BUF(LF, WS_LF); BUF(FC, WS_FC); BUF(FCS, WS_FCS); \
        BUF(XBC, WS_XBC); BUF(DTB, WS_DT); BUF(GLOG, WS_GLOG); BUF(YS, WS_YS); BUF(GO, WS_GO); BUFH(QF, WS_QF); BUFH(KF, WS_KF); BUFH(VT, WS_VT); BUF(SSQH, WS_SSQH); BUFH(XC, WS_XC); BUFH(MIB, WS_MIB); (void)MIB; (void)QF; (void)KF; (void)VT; (void)SSQH; (void)XC; \
        (void)X; (void)XB; (void)SSQP; (void)HB; (void)MIXB; (void)MI; (void)QN; (void)KN; (void)LF; (void)FC; (void)FCS; (void)XBC; (void)DTB; (void)GLOG; (void)YS; (void)GO;
#define PHASE_END_R(R) if (ph + 1 < hi || rep_ + 1 < (R)) xcd_barrier(bar, tid_now(wave_s)); } ++ph;
#define PHASE_BEGIN PHASE_BEGIN_R(1)
#define PHASE_END PHASE_END_R(1)
#define WT_(l, off) ((bf16*)(ws_ + WS_WT + (size_t)(l) * WL_SIZE + (off)))

#define CONVERT_ITEM(it_, scr_, ln_) do { constexpr int I1 = 16 * 176, I2 = 44 * 32, I3 = 16 * 88, I4 = 16 * 32, I7 = 16, IL = 2 * I1 + 2 * I2 + I3 + I4 + I7; static_assert(IL == 10384, "item space"); \
        const int lw = (it_) / IL; int r = (it_) % IL; \
        if (r < I1) { transpose_item(INP(11) + (size_t)lw * 1024 * 5632, 5632, 1024, INP(10) + lw * 1024, WT_(lw, WL_W1), 1, 176, r, scr_, ln_); break; } r -= I1; \
        if (r < I2) { transpose_item(INP(12) + (size_t)lw * 2816 * 1024, 1024, 2816, nullptr, WT_(lw, WL_W2), 0, 32, r, scr_, ln_); break; } r -= I2; \
        if (r < I3) { transpose_item(INP(14) + (size_t)lw * 1024 * N_IN, N_IN, 1024, INP(13) + lw * 1024, WT_(lw, WL_W3), 2, 88, r, scr_, ln_); break; } r -= I3; \
        if (r < I4) { transpose_item(INP(27) + (size_t)lw * 1024 * 1024, 1024, 1024, nullptr, WT_(lw, WL_W4), 0, 32, r, scr_, ln_); break; } r -= I4; \
        if (r < I1) { transpose_item(INP(29) + (size_t)lw * 1024 * 5632, 5632, 1024, INP(28) + lw * 1024, WT_(lw, WL_W5), 1, 176, r, scr_, ln_); break; } r -= I1; \
        if (r < I2) { transpose_item(INP(30) + (size_t)lw * 2816 * 1024, 1024, 2816, nullptr, WT_(lw, WL_W6), 0, 32, r, scr_, ln_); break; } r -= I2; \
        transpose_item(INP(14) + (size_t)lw * 1024 * N_IN, N_IN, 1024, INP(13) + lw * 1024, WT_(lw, WL_W7), 3, 1, r, scr_, ln_); } while (0)
#define CONVERT_RANGE(lo_, hi_, gwv_, ngwv_) do { const int tn_ = tid_now(wave_s); const int lnr_ = tn_ & 63; LAS float* scrr_ = (LAS float*)((LAS unsigned char*)lds + wave_s * 16384); \
        for (int itr_ = (lo_) + (gwv_); itr_ < (hi_); itr_ += (ngwv_)) CONVERT_ITEM(itr_, scrr_, lnr_); } while (0)
#define CONVERT_TAIL(lo_, hi_, first_) do { if (gridDim.x == 256) { if ((int)blockIdx.x >= (first_)) CONVERT_RANGE(lo_, hi_, ((int)blockIdx.x - (first_)) * NWAVES + wave_s, (256 - (first_)) * NWAVES); } \
        else CONVERT_RANGE(lo_, hi_, (int)blockIdx.x * NWAVES + wave_s, (int)gridDim.x * NWAVES); } while (0)
    PHASE_BEGIN_R(R_P0)
        CONVERT_RANGE(0, 2816, gw, NGW);
        for (int i = blockIdx.x * 512 + tid; i < 2 * 12288; i += gridDim.x * 512) { const int j = i % 12288;
            if (i < 12288) { const int bh = j / 384, sl = (j % 384) >> 3, ch = j & 7; *(v4u*)(KF + ((size_t)bh * 2112 + 16 + sl) * 64 + ch * 8) = (v4u){0u, 0u, 0u, 0u}; }
            else { const int bh = j / 384, d = (j % 384) / 6, ch = j % 6; *(v4u*)(VT + ((size_t)bh * 64 + d) * 2112 + 16 + ch * 8) = (v4u){0u, 0u, 0u, 0u}; } }
        for (int r0 = gw * 2; r0 < M_PAD; r0 += NGW * 2) {
            float4 v[2][4];
#pragma unroll
            for (int q = 0; q < 2; ++q) { const int r = r0 + q;
                const float* src = r < MP ? INP(0) + (size_t)r * 1024 : r < R_META ? INP(1) + (size_t)(r - R_S) * 1024 : r < M_REAL ? INP(9) + (size_t)(r - R_META) * 1024 : nullptr;
#pragma unroll
                for (int j = 0; j < 4; ++j) v[q][j] = src ? ((const float4*)src)[lane + 64 * j] : make_float4(0.f, 0.f, 0.f, 0.f); }
#pragma unroll
            for (int q = 0; q < 2; ++q) { const int r = r0 + q;
                float4* o = (float4*)(X + (size_t)r * 1024) + lane; uint2* ob = (uint2*)(XB + (size_t)r * 1024) + lane; float s = 0.f;
#pragma unroll
                for (int j = 0; j < 4; ++j) { const float4 w = v[q][j]; if (r >= MP) o[64 * j] = w; ob[64 * j] = make_uint2(pk2(w.x, w.y), pk2(w.z, w.w)); s += (w.x * w.x + w.y * w.y) + (w.z * w.z + w.w * w.w); }
                s = wave_sum(s);
                if (lane < 16) SSQP[(size_t)r * 16 + lane] = lane == 0 ? s : 0.f;
                if (r >= M_REAL) { uint2* m = (uint2*)(MIXB + (size_t)r * 1024) + lane;
#pragma unroll
                    for (int j = 0; j < 4; ++j) m[64 * j] = make_uint2(0u, 0u); } }
        }
    PHASE_END_R(R_P0)

    for (int l = 0; l < DEPTH; ++l) {
#define mix_norm (INP(13) + l * 1024)
#define fox_q_norm (INP(15) + l * 64)
#define fox_k_norm (INP(16) + l * 64)
#define fox_f_bias (INP(17) + l * 4)
#define conv_w (INP(18) + l * 4 * 768)
#define conv_b (INP(19) + l * 768)
#define dt_bias (INP(20) + l * 8)
#define a_log (INP(21) + l * 8)
#define ssd_d (INP(22) + l * 8)
#define ssd_norm (INP(23) + l * 512)
#define w_gate (INP(24) + l * 16 * 128)
#define gate_bias (INP(25) + l * 128)
#define gla_norm (INP(26) + l * 64)
#define cache_k (INP(2))
#define cache_v (INP(3))
#define cache_lf (INP(4))
#define state_ssm (INP(5) + (size_t)l * DEC_BATCH * 8 * 4096)
#define state_conv (INP(6) + (size_t)l * DEC_BATCH * 3 * 768)
#define state_gla (INP(7) + (size_t)l * DEC_BATCH * 4 * 2048)
#define pt ((const int*)INP(8))
        for (int half = 0; half < 2; ++half) {
            PHASE_BEGIN_R(R_G1) { pg8::Gemm g{XB, WT_(l, half ? WL_W5 : WL_W1), M_PAD, 5632, 1024}; pg8::StaticOrder S; S.init(M_PAD, 5632, (int)gridDim.x, (int)blockIdx.x);
                pg8::EpiSwiglu E{HB, SSQP}; pg8::gemm_phase<pg8::EpiSwiglu, pg8::StaticOrder, true, true>((LAS unsigned char*)lds, g, S, E, tid);
                if (l == 0 && half == 0) {
                    if (gridDim.x == 256) { if (blockIdx.x >= 194) CONVERT_RANGE(2816, 4224, ((int)blockIdx.x - 194) * NWAVES + wave_s, 62 * NWAVES); }
                    else CONVERT_RANGE(2816, 4224, (int)blockIdx.x * NWAVES + wave_s, (int)gridDim.x * NWAVES); }
                if (l == 0 && half == 1) CONVERT_TAIL(8960, 10368, 194);
                if (l == 1 && half == 0) CONVERT_TAIL(10384 + 2816, 10384 + 4224, 194);
                if (l == 1 && half == 1) CONVERT_TAIL(10384 + 8960, 10384 + 10368, 194);
                } PHASE_END_R(R_G1)
            PHASE_BEGIN { pg8::Gemm g{HB, WT_(l, half ? WL_W6 : WL_W2), MP, 1024, 2816}; pg8::StaticOrder S; S.init(MP, 1024, (int)gridDim.x, (int)blockIdx.x);
                pg8::EpiResid E{(const GAS float*)nullptr, X, XB, SSQP, 0.5f, out, (l == DEPTH - 1 && half == 1) ? 1 : 0};     pg8::gemm_phase<pg8::EpiResid, pg8::StaticOrder, true, true>((LAS unsigned char*)lds, g, S, E, tid);
                eg::egemm_resid<2816, 8>(HB, WT_(l, half ? WL_W6 : WL_W2), X, XB, SSQP, 0.5f, out, (l == DEPTH - 1 && half == 1) ? 1 : 0, (LAS unsigned char*)lds, tid_now(wave_s));
                if (l == 0 && half == 0) {
                    if (gridDim.x == 256) { if (blockIdx.x >= 176) { CONVERT_RANGE(4224, 5632, ((int)blockIdx.x - 176) * NWAVES + wave_s, 80 * NWAVES); CONVERT_RANGE(10368, 10384, ((int)blockIdx.x - 176) * NWAVES + wave_s, 80 * NWAVES); } }
                    else { CONVERT_RANGE(4224, 5632, (int)blockIdx.x * NWAVES + wave_s, (int)gridDim.x * NWAVES); CONVERT_RANGE(10368, 10384, (int)blockIdx.x * NWAVES + wave_s, (int)gridDim.x * NWAVES); } }     } PHASE_END
            if (half == 1) break;

            PHASE_BEGIN_R(R_G3) { pg8::Gemm g{XB, WT_(l, WL_W3), M_PAD, N_MAIN, 1024}; pg8::StaticOrder S; S.init(M_PAD, N_MAIN, (int)gridDim.x, (int)blockIdx.x);
                pg8::EpiMix E{MI, MIB, SSQP, QF, KF, VT, fox_q_norm, fox_k_norm, fox_f_bias, LF, out, l}; pg8::gemm_phase<pg8::EpiMix, pg8::StaticOrder, true, true>((LAS unsigned char*)lds, g, S, E, tid);
                {
                    constexpr int NUS = (M_REAL + 31) / 32; int u0 = blockIdx.x, us = gridDim.x, ue = NUS;
                    if (gridDim.x == 256) { if (blockIdx.x >= 225) { u0 = (int)blockIdx.x - 225; us = 31; ue = 310; } else { u0 = 310 + (int)blockIdx.x; us = 1024; } }
                    sm::smalls_gemm(XB, WT_(l, WL_W7), SSQP, MI, LF, fox_f_bias, out, l, (LAS unsigned char*)lds, tid_now(wave_s), u0, us, ue); }
                if (l == 0) {
                    if (gridDim.x == 256) { if (blockIdx.x >= 225) CONVERT_RANGE(5632, 6144, ((int)blockIdx.x - 225) * NWAVES + wave_s, 31 * NWAVES); }
                    else CONVERT_RANGE(5632, 6144, (int)blockIdx.x * NWAVES + wave_s, (int)gridDim.x * NWAVES); } } PHASE_END_R(R_G3)
            PHASE_BEGIN
            {
                typedef float f4v __attribute__((ext_vector_type(4)));
                LAS float* lrs = (LAS float*)((LAS unsigned char*)lds + wave * 1024);
                for (int blk = gw; blk < (NGW == 2048 ? 2048 : 2048 + 2); blk += NGW) {
                    const bool isP = blk < 2048; const int bb = blk >> 8, i0 = isP ? 8 * (blk & 255) : 8 * (blk - 2048);
                    const int rowb = isP ? bb * 2048 + i0 : R_META + i0;
                    f4v u[3][11];
#pragma unroll
                    for (int j = 0; j < 11; ++j) { const int i = i0 + j - 3; int pr;
                        if (isP) pr = i >= 0 ? bb * 2048 + i : R_META + 16 + i; else pr = i >= 0 ? R_META + i : -1;
#pragma unroll
                        for (int k = 0; k < 3; ++k) { const uint2 w = *(const uint2*)(MIB + (size_t)(pr >= 0 ? pr : 0) * N_MAIN + CM_XBC + 4 * (lane + 64 * k));
                            const f4v v = (f4v){__uint_as_float(w.x << 16), __uint_as_float(w.x & 0xffff0000u), __uint_as_float(w.y << 16), __uint_as_float(w.y & 0xffff0000u)}; u[k][j] = pr >= 0 ? v : (f4v){0.f, 0.f, 0.f, 0.f}; } }
                    const f4v lrv = lane < 32 ? *(const f4v*)(MI + (size_t)(rowb + (lane >> 2)) * LDMI + C_LR + 4 * (lane & 3)) : (f4v){0.f, 0.f, 0.f, 0.f};
                    const float dtr = MI[(size_t)(rowb + (lane >> 3)) * LDMI + C_DT + (lane & 7)];
                    if (lane < 32) *(LAS f4v*)(lrs + (lane >> 2) * 16 + 4 * (lane & 3)) = lrv;
                    DTB[(size_t)(rowb + (lane >> 3)) * 8 + (lane & 7)] = softplusf(dtr + dt_bias[lane & 7]);
#pragma unroll
                    for (int k = 0; k < 3; ++k) { const int col = 4 * (lane + 64 * k);
                        const f4v w0 = *(const f4v*)(conv_w + col), w1 = *(const f4v*)(conv_w + 768 + col), w2 = *(const f4v*)(conv_w + 2 * 768 + col), w3 = *(const f4v*)(conv_w + 3 * 768 + col), bs = *(const f4v*)(conv_b + col);
#pragma unroll
                        for (int j = 0; j < 8; ++j) { const f4v o = w3 * u[k][j + 3] + w2 * u[k][j + 2] + w1 * u[k][j + 1] + w0 * u[k][j] + bs;
                            *(uint2*)(XC + (size_t)(rowb + j) * 768 + col) = make_uint2(fa::cvtpk(pg8::silu_fast(o[0]), pg8::silu_fast(o[1])), fa::cvtpk(pg8::silu_fast(o[2]), pg8::silu_fast(o[3]))); } }
                    LDS_WAIT();
                    float wc0[16], wc1[16];
#pragma unroll
                    for (int r = 0; r < 16; ++r) { wc0[r] = w_gate[r * 128 + lane]; wc1[r] = w_gate[r * 128 + 64 + lane]; }
                    const float gb0 = gate_bias[lane], gb1 = gate_bias[64 + lane];
#pragma unroll
                    for (int j = 0; j < 8; ++j) { float a0 = gb0, a1 = gb1;
#pragma unroll
                        for (int r4 = 0; r4 < 4; ++r4) { const f4v x = *(const LAS f4v*)(lrs + j * 16 + 4 * r4);
                            a0 += x[0] * wc0[4 * r4] + x[1] * wc0[4 * r4 + 1] + x[2] * wc0[4 * r4 + 2] + x[3] * wc0[4 * r4 + 3]; a1 += x[0] * wc1[4 * r4] + x[1] * wc1[4 * r4 + 1] + x[2] * wc1[4 * r4 + 2] + x[3] * wc1[4 * r4 + 3]; }
                        GLOG[(size_t)(rowb + j) * 128 + lane] = (fminf(a0, 0.f) - __logf(1.0f + __expf(-fabsf(a0)))) * (1.0f / 16.0f);
                        GLOG[(size_t)(rowb + j) * 128 + 64 + lane] = (fminf(a1, 0.f) - __logf(1.0f + __expf(-fabsf(a1)))) * (1.0f / 16.0f); }
                    LDS_WAIT();
                }
                if (NGW == 2048 && gw < 16) {
                    const int m = gw, row = R_META + m;
                    f4v um[3][4];
#pragma unroll
                    for (int j = 0; j < 4; ++j) { const int i = m + j - 3;
#pragma unroll
                        for (int k = 0; k < 3; ++k) { const uint2 w = *(const uint2*)(MIB + (size_t)(R_META + (i >= 0 ? i : 0)) * N_MAIN + CM_XBC + 4 * (lane + 64 * k));
                            const f4v v = (f4v){__uint_as_float(w.x << 16), __uint_as_float(w.x & 0xffff0000u), __uint_as_float(w.y << 16), __uint_as_float(w.y & 0xffff0000u)}; um[k][j] = i >= 0 ? v : (f4v){0.f, 0.f, 0.f, 0.f}; } }
                    if (lane < 8) DTB[(size_t)row * 8 + lane] = softplusf(MI[(size_t)row * LDMI + C_DT + lane] + dt_bias[lane]);
#pragma unroll
                    for (int k = 0; k < 3; ++k) { const int col = 4 * (lane + 64 * k);
                        const f4v w0 = *(const f4v*)(conv_w + col), w1 = *(const f4v*)(conv_w + 768 + col), w2 = *(const f4v*)(conv_w + 2 * 768 + col), w3 = *(const f4v*)(conv_w + 3 * 768 + col), bs = *(const f4v*)(conv_b + col);
                        const f4v o = w3 * um[k][3] + w2 * um[k][2] + w1 * um[k][1] + w0 * um[k][0] + bs;
                        *(uint2*)(XC + (size_t)row * 768 + col) = make_uint2(fa::cvtpk(pg8::silu_fast(o[0]), pg8::silu_fast(o[1])), fa::cvtpk(pg8::silu_fast(o[2]), pg8::silu_fast(o[3]))); }
                    float a0 = gate_bias[lane], a1 = gate_bias[64 + lane];
#pragma unroll
                    for (int r = 0; r < 16; ++r) { const float x = MI[(size_t)row * LDMI + C_LR + r]; a0 += x * w_gate[r * 128 + lane]; a1 += x * w_gate[r * 128 + 64 + lane]; }
                    GLOG[(size_t)row * 128 + lane] = (fminf(a0, 0.f) - __logf(1.0f + __expf(-fabsf(a0)))) * (1.0f / 16.0f);
                    GLOG[(size_t)row * 128 + 64 + lane] = (fminf(a1, 0.f) - __logf(1.0f + __expf(-fabsf(a1)))) * (1.0f / 16.0f);
                }
            }
            PHASE_END
            PHASE_BEGIN_R(R_MIX)
            {
                volatile LAS unsigned* qslot = (volatile LAS unsigned*)((LAS unsigned char*)lds + MISC_OFF + 64);
                unsigned* qhead = (unsigned*)(ws_ + WS_CTL) + CW_Q + 64 * l + 8 * rep_;
                constexpr int U_SSDP = 0, U_GLAP = 64, U_SAMP = 96, U_PATT = 224, U_META = 480, U_END = 481;
                for (;;) {
                    __syncthreads();
                    if (tid == 0) *qslot = atomicAdd(qhead, 1u);
                    __syncthreads();
                    const int u = (int)*qslot;
                    constexpr int N_CVU = (10384 + 15) / 16;
                    if (u >= U_END) {
                        if (l != 0 || u >= U_END + N_CVU) break;
                        const int j = 16 * (u - U_END) + 2 * wave_s; LAS float* scrq_ = (LAS float*)((LAS unsigned char*)lds + wave_s * 16384); const int lnq_ = tid_now(wave_s) & 63;
                        for (int e = 0; e < 2; ++e) { const int jj = j + e; if (jj < 10384) { const int itq_ = jj < 2816 ? 6144 + jj : jj < 5632 ? 10384 + (jj - 2816) : jj < 10368 ? 14608 + (jj - 5632) : 20752 + (jj - 10368); CONVERT_ITEM(itq_, scrq_, lnq_); } }
                        continue;
                    }
                    int tidu = tid; asm volatile("" : "+v"(tidu));
                    if (u < U_GLAP) {
                        const int b = u >> 3, h = u & 7;
                        la::ssd_prompt_unit(b, h, (const GAS bf16*)MIB, (const GAS bf16*)XC, (const GAS float*)DTB, -expf(a_log[h]), ssd_d[h], (GAS bf16*)MIXB, (GAS float*)SSQH, (GAS float*)(out + O_SSMP + ((size_t)(l * BATCH + b) * 8 + h) * 4096), (LAS unsigned char*)lds, tidu);
                    } else if (u < U_SAMP) {
                        const int b = (u - U_GLAP) >> 2, h = (u - U_GLAP) & 3;
                        la::gla_prompt_unit(b, h, (const GAS bf16*)MIB, (const GAS float*)GLOG, (const GAS float*)gla_norm, (GAS bf16*)MIXB, (GAS float*)(out + O_GLAP + ((size_t)(l * BATCH + b) * 4 + h) * 2048), (LAS unsigned char*)lds, tidu);
                    } else if (u < U_META) {
                        const int k = u - U_SAMP;
                        const int su = k < 64 ? k : ((k >= 160 && k < 224) ? k - 96 : -1);
                        if (su >= 0) {
                            eu::sample_unit(su, l, MI, cache_k, cache_v, cache_lf, pt, state_ssm, state_conv, state_gla, fox_q_norm, fox_k_norm, fox_f_bias, conv_w, conv_b, dt_bias, a_log, ssd_d, ssd_norm,
                                            w_gate, gate_bias, gla_norm, MIXB, out, (LAS unsigned char*)lds, tidu);
                        } else {
                            const int j = k < 160 ? k - 64 : k - 128; fa::fox_prompt_unit((j & 31) >> 2, j & 3, 7 - (j >> 5), QF, KF, VT, LF, MIXB, (LAS unsigned char*)lds, tidu);
                        }
                    } else {
                        eu::meta_unit(MI, fox_q_norm, fox_k_norm, fox_f_bias, MIXB, (LAS unsigned char*)lds, tidu);
                    }
                }
            }
            PHASE_END_R(R_MIX)
            PHASE_BEGIN
                { const float4 gn0 = *(const float4*)(ssd_norm + lane * 4), gn1 = *(const float4*)(ssd_norm + 256 + lane * 4);
                for (int i0 = gw * 4; i0 < MP + 16; i0 += NGW * 4) {
                    const int r0 = i0 < MP ? i0 : i0 + (R_META - MP);
                    uint2 w[4][2]; float4 q[4][2];
#pragma unroll
                    for (int j = 0; j < 4; ++j) { const size_t r = (size_t)(r0 + j);
                        q[j][0] = *(const float4*)(SSQH + r * 8); q[j][1] = *(const float4*)(SSQH + r * 8 + 4);
                        w[j][0] = *(const uint2*)(MIXB + r * 1024 + 256 + lane * 4); w[j][1] = *(const uint2*)(MIXB + r * 1024 + 512 + lane * 4); }
#pragma unroll
                    for (int j = 0; j < 4; ++j) { const size_t r = (size_t)(r0 + j);
#pragma unroll
                        for (int g = 0; g < 2; ++g) { const float4 qq = q[j][g]; const float rs = rsqrtf((qq.x + qq.y + qq.z + qq.w) * (1.f / 256.f) + EPS); const float4 gn = g ? gn1 : gn0; const uint2 ww = w[j][g];
                            const float y0 = __uint_as_float(ww.x << 16) * rs * gn.x, y1 = __uint_as_float(ww.x & 0xffff0000u) * rs * gn.y, y2 = __uint_as_float(ww.y << 16) * rs * gn.z, y3 = __uint_as_float(ww.y & 0xffff0000u) * rs * gn.w;
                            *(uint2*)(MIXB + r * 1024 + 256 + g * 256 + lane * 4) = make_uint2(pk2(y0, y1), pk2(y2, y3)); } }
                } }
            PHASE_END
            PHASE_BEGIN { pg8::Gemm g{MIXB, WT_(l, WL_W4), MP, 1024, 1024}; pg8::StaticOrder S; S.init(MP, 1024, (int)gridDim.x, (int)blockIdx.x);
                pg8::EpiResid E{(const GAS float*)nullptr, X, XB, SSQP, 1.0f, out, 0}; pg8::gemm_phase<pg8::EpiResid, pg8::StaticOrder, true, true>((LAS unsigned char*)lds, g, S, E, tid);
                eg::egemm_resid<1024, 8>(MIXB, WT_(l, WL_W4), X, XB, SSQP, 1.0f, out, 0, (LAS unsigned char*)lds, tid_now(wave_s)); } PHASE_END
        }
    }
}

extern "C" void kernel_launch(void* const* d_in, const int* in_sizes, int n_in, void* d_out, int out_size, void* d_ws, size_t ws_size, hipStream_t stream) {
    static int grid = 0;
    if (grid == 0) {
        if (n_in != 31 || out_size != (int)O_END || ws_size < WS_END) { fprintf(stderr, "kernel_launch: unexpected sizes n_in %d out %d ws %zu (need %zu)\n", n_in, out_size, ws_size, (size_t)WS_END); grid = -1; return; }
        int dev = 0, cus = 0;
        if (hipGetDevice(&dev) != hipSuccess || hipDeviceGetAttribute(&cus, hipDeviceAttributeMultiprocessorCount, dev) != hipSuccess) { grid = -1; return; }
        if (hipFuncSetAttribute((const void*)fwd, hipFuncAttributeMaxDynamicSharedMemorySize, LDS_BYTES) != hipSuccess) { fprintf(stderr, "kernel_launch: hipFuncSetAttribute failed\n"); grid = -1; return; }
        (void)hipGetLastError();
        grid = cus;
    }
    if (grid < 0) return;
    (void)hipMemsetAsync((char*)d_ws + WS_CTL, 0, CTL_ZERO_BYTES, stream);
    Args a{};
    for (int i = 0; i < 31; ++i) a.in[i] = (const float*)d_in[i];
    a.out = (float*)d_out; a.ws = (unsigned char*)d_ws; a.ph_lo = 0; a.ph_hi = 1000;
    hipLaunchKernelGGL(fwd, dim3(grid), dim3(NWAVES * 64), LDS_BYTES, stream, a);
}
```

```cpp
#include <hip/hip_runtime.h>
#include <cstdio>
#include <cstdint>

constexpr int D_MODEL = 1024, BATCH = 8, SEQ = 2048, DEPTH = 2, DEC_BATCH = 128, DEC_SEQ = 4, PAST = 2048, PAGE = 128, NPAGES = 16, NPOOL = 2560;
constexpr int N_META = 16, TP = N_META + SEQ;
constexpr int D_FF = 2816;
constexpr float EPS = 1e-6f;
constexpr int N_IN = 2844, LDMI = 2848;
constexpr int C_FQ = 0, C_FK = 256, C_FV = 512, C_FF = 768, C_SZ = 772, C_XBC = 1284, C_DT = 2052, C_GQ = 2060, C_GK = 2188, C_GV = 2316, C_LR = 2572, C_GG = 2588;
constexpr int N_MAIN = 2816, CM_SZ = 768, CM_XBC = 1280, CM_GQ = 2048, CM_GK = 2176, CM_GV = 2304, CM_GG = 2560;
__host__ __device__ constexpr int main2ref(int c) { return c < 768 ? c : (c < 2048 ? c + 4 : (c < 2560 ? c + 12 : c + 28)); }
__host__ __device__ constexpr int small2ref(int j) { return j < 4 ? C_FF + j : (j < 12 ? C_DT + (j - 4) : (j < 28 ? C_LR + (j - 12) : -1)); }
constexpr int MP = BATCH * SEQ, MS = DEC_BATCH * DEC_SEQ, R_S = MP, R_META = MP + MS, M_REAL = R_META + N_META, M_PAD = 17152;
constexpr size_t O_YP = 0;
constexpr size_t O_YS = O_YP + (size_t)BATCH * SEQ * D_MODEL;
constexpr size_t O_KP = O_YS + (size_t)MS * D_MODEL;
constexpr size_t O_VP = O_KP + (size_t)DEPTH * BATCH * TP * 256;
constexpr size_t O_LFP = O_VP + (size_t)DEPTH * BATCH * TP * 256;
constexpr size_t O_SSMP = O_LFP + (size_t)DEPTH * BATCH * TP * 4;
constexpr size_t O_CONVP = O_SSMP + (size_t)DEPTH * BATCH * 8 * 64 * 64;
constexpr size_t O_GLAP = O_CONVP + (size_t)DEPTH * BATCH * 3 * 768;
constexpr size_t O_KS = O_GLAP + (size_t)DEPTH * BATCH * 4 * 32 * 64;
constexpr size_t O_VS = O_KS + (size_t)DEPTH * MS * 256;
constexpr size_t O_LFS = O_VS + (size_t)DEPTH * MS * 256;
constexpr size_t O_SSMS = O_LFS + (size_t)DEPTH * MS * 4;
constexpr size_t O_CONVS = O_SSMS + (size_t)DEPTH * DEC_BATCH * 8 * 64 * 64;
constexpr size_t O_GLAS = O_CONVS + (size_t)DEPTH * DEC_BATCH * 3 * 768;
constexpr size_t O_END = O_GLAS + (size_t)DEPTH * DEC_BATCH * 4 * 32 * 64;
static_assert(O_END == 46638080, "output size");

constexpr size_t MiB = 1u << 20;
constexpr size_t WS_CTL = 0, CTL_ZERO_BYTES = 1 * MiB;
constexpr size_t SZ_W1 = (size_t)5632 * 1024 * 2, SZ_W2 = (size_t)1024 * 2816 * 2, SZ_W3 = (size_t)2816 * 1024 * 2, SZ_W7 = (size_t)32 * 1024 * 2, SZ_W4 = (size_t)1024 * 1024 * 2;
constexpr size_t WL_W1 = 0, WL_W2 = WL_W1 + SZ_W1, WL_W3 = WL_W2 + SZ_W2, WL_W4 = WL_W3 + SZ_W3, WL_W5 = WL_W4 + SZ_W4, WL_W6 = WL_W5 + SZ_W1, WL_W7 = WL_W6 + SZ_W2, WL_SIZE = WL_W7 + SZ_W7;
constexpr size_t WS_WT = 2 * MiB;
constexpr size_t WS_X = WS_WT + 2 * WL_SIZE;
constexpr size_t WS_XB = WS_X + (size_t)M_PAD * 1024 * 4;
constexpr size_t WS_SSQ = WS_XB + (size_t)M_PAD * 1024 * 2;
constexpr size_t WS_HB = WS_SSQ + (size_t)M_PAD * 16 * 4;
constexpr size_t WS_MIXB = WS_HB + (size_t)M_PAD * 2816 * 2;
constexpr size_t WS_MI = WS_MIXB + (size_t)M_PAD * 1024 * 2;
constexpr size_t WS_QN = WS_MI + (size_t)M_PAD * LDMI * 4;
constexpr size_t WS_KN = WS_QN + (size_t)M_PAD * 256 * 4;
constexpr size_t WS_LF = WS_KN + (size_t)M_PAD * 256 * 4;
constexpr size_t WS_FC = WS_LF + (size_t)M_PAD * 4 * 4;
constexpr size_t WS_FCS = WS_FC + (size_t)M_PAD * 4 * 4;
constexpr size_t WS_XBC = WS_FCS + (size_t)128 * 4 * 2052 * 4 + 4096;
constexpr size_t WS_DT = WS_XBC + (size_t)M_PAD * 768 * 4;
constexpr size_t WS_GLOG = WS_DT + (size_t)M_PAD * 8 * 4;
constexpr size_t WS_YS = WS_GLOG + (size_t)M_PAD * 128 * 4;
constexpr size_t WS_GO = WS_YS + (size_t)M_PAD * 512 * 4;
constexpr size_t WS_QF = WS_GO + (size_t)M_PAD * 256 * 4;
constexpr size_t WS_KF = WS_QF + (size_t)32 * 2048 * 64 * 2;
constexpr size_t WS_VT = WS_KF + (size_t)32 * 2112 * 64 * 2;
constexpr size_t WS_SSQH = WS_VT + (size_t)32 * 2112 * 64 * 2;
constexpr size_t WS_XC = WS_SSQH + (size_t)M_PAD * 8 * 4;
constexpr size_t WS_MIB = WS_XC + (size_t)M_PAD * 768 * 2;
constexpr size_t WS_END = WS_MIB + (size_t)M_PAD * LDMI * 2;
static_assert(WS_X % 256 == 0 && WS_XB % 256 == 0 && WS_SSQ % 256 == 0 && WS_HB % 256 == 0 && WS_MIXB % 256 == 0 && WS_MI % 256 == 0, "alignment");

#ifndef R_P0
#define R_P0 1
#endif
#ifndef R_G1
#define R_G1 1
#endif
#ifndef R_G3
#define R_G3 1
#endif
#ifndef R_PREP
#define R_PREP 1
#endif
#ifndef R_MIX
#define R_MIX 1
#endif
#ifndef R_BAR
#define R_BAR 0
#endif
constexpr int CW_BAR = 4096, CW_Q = 8192;
constexpr int NWAVES = 8;
constexpr int LDS_BYTES = 147456;
constexpr int MISC_OFF = 131072 + 320;

#define LAS __attribute__((address_space(3)))
#define GAS __attribute__((address_space(1)))
#define LDS_WAIT() asm volatile("s_waitcnt lgkmcnt(0)" ::: "memory")
typedef unsigned short bf16;
typedef unsigned v4u __attribute__((ext_vector_type(4)));
__device__ __forceinline__ unsigned f2bf(float f) { unsigned u = __builtin_bit_cast(unsigned, f); return (u + 0x7fffu + ((u >> 16) & 1u)) >> 16; }
__device__ __forceinline__ unsigned pk2(float lo, float hi) { return f2bf(lo) | (f2bf(hi) << 16); }

__device__ __forceinline__ float bperm(float x, int srclane);
namespace pg8 {
#define PG8_LAS __attribute__((address_space(3)))
typedef unsigned short bf16_t;
typedef short bf16x8 __attribute__((ext_vector_type(8)));
typedef float f32x4 __attribute__((ext_vector_type(4)));
typedef unsigned u32x4 __attribute__((ext_vector_type(4)));
constexpr int BM = 256, BK = 64, HALF = 128, HTB = HALF * BK * 2  , STAGE_BYTES = 8 * HTB, NXCD = 8, WGM = 8;

__host__ __device__ __forceinline__ int lds_byte(int r, int c) { const int st = (r >> 4) * 2 + (c >> 5), rr = r & 15, cc = c & 31, ob = rr * 64 + cc * 2; return st * 1024 + (ob ^ (((ob >> 9) & 1) << 5)); }
__host__ __device__ __forceinline__ void stage_rc(int b, int& R, int& C) { const int st = b / 1024, sb = b % 1024, swz = sb ^ (((sb >> 9) & 1) << 5); R = (st >> 1) * 16 + swz / 64; C = (st & 1) * 32 + (swz % 64) / 2; }
__host__ __device__ __forceinline__ int perm32(int rho) { const int n = rho >> 4, i = rho & 15; return 8 * (i >> 2) + 4 * n + (i & 3); }

struct Unit { int pm, pn; };
struct Gemm { const bf16_t* A; const bf16_t* Bt; int M, N, K; };

struct StaticOrder {
    int nM, nN, nwg, G, c;
    __host__ __device__ void init(int M, int N, int G_, int c_) { nM = M / BM; nN = N / BM; nwg = nM * nN; G = G_; c = c_; }
    __host__ __device__ bool next(int i, Unit& u) const {
        const long L = (long)i * G + c; if (L >= nwg) return false;
        int wgid = (int)L; { const int q = nwg / NXCD, r = nwg % NXCD, xcd = wgid % NXCD, off = wgid / NXCD; wgid = (xcd < r ? xcd * (q + 1) : r * (q + 1) + (xcd - r) * q) + off; }
        const int nig = WGM * nN, gid = wgid / nig, fm = gid * WGM, gsz = (nM - fm) < WGM ? (nM - fm) : WGM;
        u.pm = fm + ((wgid % nig) % gsz); u.pn = (wgid % nig) / gsz; return true;
    }
    __device__ __forceinline__ void a_ready(const Unit&) const {}
    __device__ __forceinline__ void done(const Unit&) const {}
};

__device__ __forceinline__ unsigned cvt_pk_bf16(float lo, float hi) { unsigned r; asm volatile("v_cvt_pk_bf16_f32 %0, %1, %2" : "=v"(r) : "v"(lo), "v"(hi)); return r; }
typedef float f32x2 __attribute__((ext_vector_type(2)));
__device__ __forceinline__ f32x2 gelu_pk(f32x2 v) {
    const f32x2 av = __builtin_elementwise_abs(v), d = av * 0.2316418882f + 1.0f;
    f32x2 t; t.x = __builtin_amdgcn_rcpf(d.x); t.y = __builtin_amdgcn_rcpf(d.y);
    f32x2 q = t * 0.5307027145f + (-0.7265760135f); q = q * t + 0.7107068705f; q = q * t + (-0.142248368f); q = q * t + 0.127414796f; q = q * t;
    const f32x2 s = (v * v) * (-0.72134752044f);
    f32x2 e; e.x = __builtin_amdgcn_exp2f(s.x); e.y = __builtin_amdgcn_exp2f(s.y);
    const f32x2 m = v * (q * e), r = v - m;
    f32x2 o; o.x = v.x < 0.f ? m.x : r.x; o.y = v.y < 0.f ? m.y : r.y; return o;
}


__device__ __forceinline__ float rstd_of(const float* SSQP, int row) {
    const f32x4* p = (const f32x4*)(SSQP + (size_t)row * 16);
    const f32x4 a = p[0], b = p[1], c = p[2], d = p[3];
    const float s = ((a[0] + a[1]) + (a[2] + a[3])) + ((b[0] + b[1]) + (b[2] + b[3])) + ((c[0] + c[1]) + (c[2] + c[3])) + ((d[0] + d[1]) + (d[2] + d[3]));
    return __builtin_amdgcn_rsqf(s * (1.0f / 1024.0f) + 1e-6f);
}
__device__ __forceinline__ float silu_fast(float x) { return x * __builtin_amdgcn_rcpf(1.0f + __expf(-x)); }
struct EpiSwiglu {
    static constexpr bool PERM = true, AFTER_DRAIN = false;
    bf16_t* H; const float* SSQP;
    __device__ __forceinline__ void operator()(const f32x4 (&acc)[2][2][4][2], const Unit& u, int wr, int wc, int fr, int fq) const {
        const int row0 = u.pm * BM + wr * 64 + fr, col0 = u.pn * 128 + wc * 32 + 8 * fq;
#pragma unroll
        for (int ai = 0; ai < 2; ++ai)
#pragma unroll
            for (int m = 0; m < 4; ++m) { const int row = row0 + ai * HALF + m * 16; const float rs = rstd_of(SSQP, row);
                const f32x4 g0 = acc[ai][0][m][0], g1 = acc[ai][0][m][1], u0 = acc[ai][1][m][0], u1 = acc[ai][1][m][1]; const float rs2 = rs * rs;
#define SWG(g, u) (silu_fast((g) * rs) * (u) * rs)
                u32x4 w; w.x = cvt_pk_bf16(SWG(g0[0], u0[0]), SWG(g0[1], u0[1])); w.y = cvt_pk_bf16(SWG(g0[2], u0[2]), SWG(g0[3], u0[3]));
                w.z = cvt_pk_bf16(SWG(g1[0], u1[0]), SWG(g1[1], u1[1])); w.w = cvt_pk_bf16(SWG(g1[2], u1[2]), SWG(g1[3], u1[3])); (void)rs2;
#undef SWG
                *(u32x4*)(H + (size_t)row * 2816 + col0) = w; }
    }
};
struct EpiResid {
    static constexpr bool PERM = true, AFTER_DRAIN = false;
    const GAS float* Xin; float* X; bf16_t* XB; float* SSQP; float scale; float* out; int final_;
    __device__ __forceinline__ void operator()(const f32x4 (&acc)[2][2][4][2], const Unit& u, int wr, int wc, int fr, int fq) const {
        const int row0 = u.pm * BM + wr * 64 + fr;
#pragma unroll
        for (int ai = 0; ai < 2; ++ai)
#pragma unroll
            for (int m = 0; m < 4; ++m) { const int row = row0 + ai * HALF + m * 16; float ss = 0.f;
#pragma unroll
                for (int bj = 0; bj < 2; ++bj) { const int col = u.pn * BM + bj * HALF + wc * 32 + 8 * fq;
                    const f32x4 a0 = acc[ai][bj][m][0], a1 = acc[ai][bj][m][1]; f32x4 x0, x1;
                    if (Xin) { const GAS f32x4* xi = (const GAS f32x4*)(Xin + (size_t)row * 1024 + col); x0 = xi[0]; x1 = xi[1]; }
                    else { const u32x4 wb = *(const u32x4*)(XB + (size_t)row * 1024 + col);
                        x0[0] = __uint_as_float(wb.x << 16); x0[1] = __uint_as_float(wb.x & 0xffff0000u); x0[2] = __uint_as_float(wb.y << 16); x0[3] = __uint_as_float(wb.y & 0xffff0000u);
                        x1[0] = __uint_as_float(wb.z << 16); x1[1] = __uint_as_float(wb.z & 0xffff0000u); x1[2] = __uint_as_float(wb.w << 16); x1[3] = __uint_as_float(wb.w & 0xffff0000u); }
                    x0[0] += a0[0] * scale; x0[1] += a0[1] * scale; x0[2] += a0[2] * scale; x0[3] += a0[3] * scale; x1[0] += a1[0] * scale; x1[1] += a1[1] * scale; x1[2] += a1[2] * scale; x1[3] += a1[3] * scale;
                    if (!final_) {
                    u32x4 w; w.x = cvt_pk_bf16(x0[0], x0[1]); w.y = cvt_pk_bf16(x0[2], x0[3]); w.z = cvt_pk_bf16(x1[0], x1[1]); w.w = cvt_pk_bf16(x1[2], x1[3]);
                    *(u32x4*)(XB + (size_t)row * 1024 + col) = w;
                    ss += (x0[0] * x0[0] + x0[1] * x0[1]) + (x0[2] * x0[2] + x0[3] * x0[3]) + (x1[0] * x1[0] + x1[1] * x1[1]) + (x1[2] * x1[2] + x1[3] * x1[3]); }
                    if (final_) { float* o = nullptr; if (row < MP) o = out + O_YP + (size_t)row * 1024 + col; else if (row < R_META) o = out + O_YS + (size_t)(row - R_S) * 1024 + col;
                        if (o) { ((f32x4*)o)[0] = x0; ((f32x4*)o)[1] = x1; } } }
                ss += bperm(ss, (fq * 16 + fr) ^ 16); ss += bperm(ss, (fq * 16 + fr) ^ 32);
                if (fq == 0 && !final_) SSQP[(size_t)row * 16 + u.pn * 4 + wc] = ss; }
    }
};
struct EpiMix {
    static constexpr bool PERM = true, AFTER_DRAIN = false;
    float* MI; bf16_t* MIB; const float* SSQP; bf16_t* QF; bf16_t* KF; bf16_t* VT; const float* qg; const float* kg; const float* fbias; float* LF; float* out; int l;
    __device__ __forceinline__ void operator()(const f32x4 (&acc)[2][2][4][2], const Unit& u, int wr, int wc, int fr_, int fq_) const {
        int ln_; asm volatile("v_mbcnt_lo_u32_b32 %0, -1, 0\n\tv_mbcnt_hi_u32_b32 %0, -1, %0" : "=v"(ln_)); const int fr = ln_ & 15, fq = ln_ >> 4; (void)fr_; (void)fq_;
        const int row0 = u.pm * BM + wr * 64 + fr;
        if (u.pn < 3) {
            f32x4 gn[2][2];
            const float* gp = u.pn == 0 ? qg : kg;
#pragma unroll
            for (int bj = 0; bj < 2; ++bj)
#pragma unroll
                for (int n = 0; n < 2; ++n) gn[bj][n] = u.pn < 2 ? *(const f32x4*)(gp + 32 * bj + 8 * fq + 4 * n) : (f32x4){1.f, 1.f, 1.f, 1.f};
            const float qs = u.pn == 0 ? 0.18033688011112042f : 1.0f;
#pragma unroll
            for (int ai = 0; ai < 2; ++ai)
#pragma unroll
                for (int m = 0; m < 4; ++m) { const int row = row0 + ai * HALF + m * 16; const float rs = rstd_of(SSQP, row);
                    float v[2][8]; float ss = 0.f;
#pragma unroll
                    for (int bj = 0; bj < 2; ++bj) { const f32x4 a0 = acc[ai][bj][m][0], a1 = acc[ai][bj][m][1];
                        v[bj][0] = a0[0] * rs; v[bj][1] = a0[1] * rs; v[bj][2] = a0[2] * rs; v[bj][3] = a0[3] * rs; v[bj][4] = a1[0] * rs; v[bj][5] = a1[1] * rs; v[bj][6] = a1[2] * rs; v[bj][7] = a1[3] * rs;
                        if (row >= MP) { f32x4* o = (f32x4*)(MI + (size_t)row * LDMI + u.pn * 256 + wc * 64 + bj * 32 + 8 * fq);
                            o[0] = (f32x4){v[bj][0], v[bj][1], v[bj][2], v[bj][3]}; o[1] = (f32x4){v[bj][4], v[bj][5], v[bj][6], v[bj][7]}; }
#pragma unroll
                        for (int e = 0; e < 8; ++e) ss += v[bj][e] * v[bj][e]; }
                    if (u.pn < 2) { ss += bperm(ss, (fq * 16 + fr) ^ 16); ss += bperm(ss, (fq * 16 + fr) ^ 32); const float hn = __builtin_amdgcn_rsqf(ss * (1.0f / 64.0f) + 1e-6f) * qs;
#pragma unroll
                        for (int bj = 0; bj < 2; ++bj)
#pragma unroll
                            for (int e = 0; e < 8; ++e) v[bj][e] *= hn * gn[bj][e >> 2][e & 3]; }
                    const bool isP = row < MP, isM = row >= R_META && row < M_REAL;
                    if (u.pn > 0 && row < M_REAL) {
                        float* ob; int nc = 1; size_t cs_ = 0;
                        if (isP) ob = out + (u.pn == 1 ? O_KP : O_VP) + ((size_t)(l * BATCH + (row >> 11)) * TP + 16 + (row & 2047)) * 256;
                        else if (isM) { ob = out + (u.pn == 1 ? O_KP : O_VP) + ((size_t)(l * BATCH) * TP + (row - R_META)) * 256; nc = BATCH; cs_ = (size_t)TP * 256; }
                        else ob = out + (u.pn == 1 ? O_KS : O_VS) + ((size_t)l * MS + (row - R_S)) * 256;
                        for (int c = 0; c < nc; ++c)
#pragma unroll
                            for (int bj = 0; bj < 2; ++bj) { f32x4* o = (f32x4*)(ob + c * cs_ + wc * 64 + bj * 32 + 8 * fq);
                                o[0] = (f32x4){v[bj][0], v[bj][1], v[bj][2], v[bj][3]}; o[1] = (f32x4){v[bj][4], v[bj][5], v[bj][6], v[bj][7]}; }
                    }
                    if (isP || (isM && u.pn > 0)) {
                        const int b0 = isP ? (row >> 11) : 0, nb = isP ? 1 : 8, slot = isP ? 64 + (row & 2047) : row - R_META;
                        for (int bb = b0; bb < b0 + nb; ++bb) { const int bh = bb * 4 + wc;
                            if (u.pn < 2) {
                                bf16_t* dst = u.pn == 0 ? QF + ((size_t)bh * 2048 + (row & 2047)) * 64 : KF + ((size_t)bh * 2112 + slot) * 64;
#pragma unroll
                                for (int bj = 0; bj < 2; ++bj) { u32x4 w; w.x = cvt_pk_bf16(v[bj][0], v[bj][1]); w.y = cvt_pk_bf16(v[bj][2], v[bj][3]); w.z = cvt_pk_bf16(v[bj][4], v[bj][5]); w.w = cvt_pk_bf16(v[bj][6], v[bj][7]);
                                    *(u32x4*)(dst + 32 * bj + 8 * fq) = w; }
                            } else {
#pragma unroll
                                for (int bj = 0; bj < 2; ++bj)
#pragma unroll
                                    for (int e = 0; e < 8; e += 2) { const unsigned w = cvt_pk_bf16(v[bj][e], v[bj][e + 1]); const int d = 32 * bj + 8 * fq + e;
                                        VT[((size_t)bh * 64 + d) * 2112 + slot] = (bf16_t)(w & 0xffffu); VT[((size_t)bh * 64 + d + 1) * 2112 + slot] = (bf16_t)(w >> 16); }
                            } } } }
        } else {
#pragma unroll
            for (int ai = 0; ai < 2; ++ai)
#pragma unroll
                for (int m = 0; m < 4; ++m) { const int row = row0 + ai * HALF + m * 16; const float rs = rstd_of(SSQP, row);
#pragma unroll
                    for (int bj = 0; bj < 2; ++bj) { const int colm = u.pn * BM + bj * HALF + wc * 32 + 8 * fq, col = main2ref(colm);
                        const f32x4 a0 = acc[ai][bj][m][0], a1 = acc[ai][bj][m][1];
                        f32x4 r0v = (f32x4){a0[0] * rs, a0[1] * rs, a0[2] * rs, a0[3] * rs}, r1v = (f32x4){a1[0] * rs, a1[1] * rs, a1[2] * rs, a1[3] * rs};
                        if ((colm >= CM_SZ && colm < CM_SZ + 512) || colm >= CM_GG) {
#pragma unroll
                            for (int e = 0; e < 4; ++e) { r0v[e] = silu_fast(r0v[e]); r1v[e] = silu_fast(r1v[e]); } }
                        { u32x4 w; w.x = cvt_pk_bf16(r0v[0], r0v[1]); w.y = cvt_pk_bf16(r0v[2], r0v[3]); w.z = cvt_pk_bf16(r1v[0], r1v[1]); w.w = cvt_pk_bf16(r1v[2], r1v[3]); *(u32x4*)(MIB + (size_t)row * N_MAIN + colm) = w; }
                        if (row >= MP) { f32x4* o = (f32x4*)(MI + (size_t)row * LDMI + col); o[0] = r0v; o[1] = r1v; }
                        if (colm >= CM_XBC && colm < CM_XBC + 768) {
                            float* cvo = nullptr;
                            if (row < MP) { if ((row & 2047) >= 2045) cvo = out + O_CONVP + ((size_t)(l * BATCH + (row >> 11)) * 3 + ((row & 2047) - 2045)) * 768; }
                            else if (row < R_META) { if (((row - R_S) & 3) >= 1) cvo = out + O_CONVS + ((size_t)(l * DEC_BATCH + ((row - R_S) >> 2)) * 3 + (((row - R_S) & 3) - 1)) * 768; }
                            if (cvo) { *(f32x4*)(cvo + colm - CM_XBC) = r0v; *(f32x4*)(cvo + colm - CM_XBC + 4) = r1v; } }
                    } }
        }
    }
};

template <class Epi, class Sched, bool ALIGN_EPI = false, bool SP2 = false>
__device__ __forceinline__ void gemm_phase(PG8_LAS unsigned char* lds, const Gemm g, const Sched& S, const Epi& E, const int tid) {
    const int wid = __builtin_amdgcn_readfirstlane(tid >> 6), lane = tid & 63, wr = wid >> 2, wc = wid & 3, fr = lane & 15, fq = lane >> 4;
    const int K = g.K, nt = K / BK;
    unsigned voffA[2], voffB[2];
#pragma unroll
    for (int i = 0; i < 2; ++i) { int R, C; stage_rc(tid * 16 + i * 8192, R, C); const int Rb = Epi::PERM ? ((R & ~31) + perm32(R & 31)) : R;
        voffA[i] = (unsigned)(R * K + C) * 2u; voffB[i] = (unsigned)(Rb * K + C) * 2u; }
    const size_t kstep = (size_t)(BK * 2);
    const size_t hstep = (size_t)HALF * K * 2;
    const size_t tstep = 2 * hstep;
    const unsigned ldsw = (unsigned)wid * 1024u;
    const int aoff = lds_byte(wr * 64 + fr, fq * 8), boff = lds_byte(wc * 32 + fr, fq * 8);
#define PG8_SA(b, h) (((b) * 2 + (h)) * HTB)
#define PG8_SB(b, h) ((4 + (b) * 2 + (h)) * HTB)
#define PG8_STAGE(bufoff, gbase, voff) do { _Pragma("unroll") for (int _i = 0; _i < 2; ++_i) \
        __builtin_amdgcn_global_load_lds((const unsigned*)((const char*)(gbase) + (voff)[_i]), (PG8_LAS unsigned*)(lds + (bufoff) + ldsw + _i * 8192), 16, 0, 0); } while (0)
#define PG8_LDA(dst, b, h) do { _Pragma("unroll") for (int m = 0; m < 4; ++m) _Pragma("unroll") for (int k = 0; k < 2; ++k) dst[m][k] = *(const PG8_LAS bf16x8*)(lds + PG8_SA(b, h) + aoff + m * 2048 + k * 1024); } while (0)
#define PG8_LDB(dst, b, h) do { _Pragma("unroll") for (int n = 0; n < 2; ++n) _Pragma("unroll") for (int k = 0; k < 2; ++k) dst[n][k] = *(const PG8_LAS bf16x8*)(lds + PG8_SB(b, h) + boff + n * 2048 + k * 1024); } while (0)
#define PG8_MMA(ai, bj, At, Bt) do { __builtin_amdgcn_s_setprio(1); _Pragma("unroll") for (int m = 0; m < 4; ++m) _Pragma("unroll") for (int n = 0; n < 2; ++n) _Pragma("unroll") for (int k = 0; k < 2; ++k) \
        acc[ai][bj][m][n] = __builtin_amdgcn_mfma_f32_16x16x32_bf16(Bt[n][k], At[m][k], acc[ai][bj][m][n], 0, 0, 0); __builtin_amdgcn_s_setprio(0); } while (0)
#define PG8_WAIT_V(n) asm volatile("s_waitcnt vmcnt(" #n ")" ::: "memory")
#define PG8_WAIT_L(n) asm volatile("s_waitcnt lgkmcnt(" #n ")" ::: "memory")
#define PG8_BAR __builtin_amdgcn_s_barrier()
#define PG8_SCHED __builtin_amdgcn_sched_barrier(0)
    Unit cur, nxt; int ui = 0;
    if (!S.next(0, cur)) return;
    f32x4 acc[2][2][4][2];
#pragma unroll
    for (int a = 0; a < 2; ++a)
#pragma unroll
        for (int b = 0; b < 2; ++b)
#pragma unroll
            for (int m = 0; m < 4; ++m)
#pragma unroll
                for (int n = 0; n < 2; ++n) acc[a][b][m][n] = (f32x4){0.f, 0.f, 0.f, 0.f};
    bf16x8 At[4][2], B0[2][2], B1[2][2];
    const char* cA = (const char*)g.A + (size_t)cur.pm * tstep; const char* cB = (const char*)g.Bt + (size_t)cur.pn * tstep;
    S.a_ready(cur);
    if constexpr (SP2) {
        PG8_STAGE(PG8_SB(0, 0), cB, voffB); PG8_STAGE(PG8_SB(0, 1), cB + hstep, voffB); PG8_STAGE(PG8_SA(0, 0), cA, voffA); PG8_STAGE(PG8_SA(0, 1), cA + hstep, voffA);
        if (wr == 1) PG8_BAR;
        PG8_WAIT_V(2); PG8_BAR;
        PG8_STAGE(PG8_SB(1, 0), cB + kstep, voffB); PG8_STAGE(PG8_SA(1, 0), cA + kstep, voffA); PG8_STAGE(PG8_SB(1, 1), cB + hstep + kstep, voffB);
        PG8_WAIT_V(6); PG8_BAR;
    } else {
        PG8_STAGE(PG8_SB(0, 0), cB, voffB); PG8_STAGE(PG8_SA(0, 0), cA, voffA); PG8_STAGE(PG8_SB(0, 1), cB + hstep, voffB); PG8_STAGE(PG8_SA(0, 1), cA + hstep, voffA);
        if (wr == 1) PG8_BAR;
        PG8_WAIT_V(4); PG8_BAR;
        PG8_STAGE(PG8_SB(1, 0), cB + kstep, voffB); PG8_STAGE(PG8_SA(1, 0), cA + kstep, voffA); PG8_STAGE(PG8_SB(1, 1), cB + hstep + kstep, voffB);
        PG8_WAIT_V(6); PG8_BAR;
    }
    for (;;) {
        const bool has_next = S.next(ui + 1, nxt);
        const char* nA = has_next ? (const char*)g.A + (size_t)nxt.pm * tstep : cA; const char* nB = has_next ? (const char*)g.Bt + (size_t)nxt.pn * tstep : cB;
        for (int t = 0; t < nt; t += 2) {
            const bool last = (t == nt - 2);
            const char* a1 = cA + (size_t)(t + 1) * kstep;
            const char* a2 = last ? nA : cA + (size_t)(t + 2) * kstep; const char* b2 = last ? nB : cB + (size_t)(t + 2) * kstep;
            const char* a3 = a2 + kstep; const char* b3 = b2 + kstep;
            if (last && has_next) S.a_ready(nxt);
            if constexpr (SP2) {
            PG8_LDB(B0, 0, 0); PG8_LDB(B1, 0, 1); PG8_SCHED; PG8_LDA(At, 0, 0); PG8_STAGE(PG8_SA(1, 1), a1 + hstep, voffA);
            PG8_WAIT_V(8); PG8_WAIT_L(0); PG8_BAR; PG8_MMA(0, 0, At, B0); PG8_MMA(0, 1, At, B1); PG8_BAR; PG8_SCHED;
            PG8_LDA(At, 0, 1); PG8_STAGE(PG8_SB(0, 0), b2, voffB); PG8_STAGE(PG8_SB(0, 1), b2 + hstep, voffB); PG8_STAGE(PG8_SA(0, 0), a2, voffA);
            PG8_WAIT_V(8); PG8_WAIT_L(0); PG8_BAR; PG8_MMA(1, 0, At, B0); PG8_MMA(1, 1, At, B1); PG8_BAR; PG8_SCHED;
            PG8_LDB(B0, 1, 0); PG8_LDB(B1, 1, 1); PG8_SCHED; PG8_LDA(At, 1, 0); PG8_STAGE(PG8_SA(0, 1), a2 + hstep, voffA);
            PG8_WAIT_V(8); PG8_WAIT_L(0); PG8_BAR; PG8_MMA(0, 0, At, B0); PG8_MMA(0, 1, At, B1); PG8_BAR; PG8_SCHED;
            PG8_LDA(At, 1, 1); PG8_STAGE(PG8_SB(1, 0), b3, voffB); PG8_STAGE(PG8_SB(1, 1), b3 + hstep, voffB); PG8_STAGE(PG8_SA(1, 0), a3, voffA);
            PG8_WAIT_V(8); PG8_WAIT_L(0); PG8_BAR; PG8_MMA(1, 0, At, B0); PG8_MMA(1, 1, At, B1); PG8_BAR; PG8_SCHED;
            } else {
            PG8_LDB(B0, 0, 0); PG8_SCHED; PG8_LDA(At, 0, 0); PG8_STAGE(PG8_SA(1, 1), a1 + hstep, voffA);
            PG8_WAIT_L(8); PG8_BAR; PG8_WAIT_L(0); PG8_MMA(0, 0, At, B0); PG8_BAR; PG8_SCHED;
            PG8_LDB(B1, 0, 1); PG8_STAGE(PG8_SB(0, 0), b2, voffB);
            PG8_BAR; PG8_WAIT_L(0); PG8_MMA(0, 1, At, B1); PG8_BAR;
            PG8_LDA(At, 0, 1); PG8_STAGE(PG8_SA(0, 0), a2, voffA);
            PG8_BAR; PG8_WAIT_L(0); PG8_MMA(1, 0, At, B0); PG8_BAR; PG8_SCHED;
            PG8_STAGE(PG8_SB(0, 1), b2 + hstep, voffB);
            PG8_WAIT_V(6); PG8_BAR; PG8_MMA(1, 1, At, B1); PG8_BAR;
            PG8_LDB(B0, 1, 0); PG8_SCHED; PG8_LDA(At, 1, 0); PG8_STAGE(PG8_SA(0, 1), a2 + hstep, voffA);
            PG8_WAIT_L(8); PG8_BAR; PG8_WAIT_L(0); PG8_MMA(0, 0, At, B0); PG8_BAR; PG8_SCHED;
            PG8_LDB(B1, 1, 1); PG8_STAGE(PG8_SB(1, 0), b3, voffB);
            PG8_BAR; PG8_WAIT_L(0); PG8_MMA(0, 1, At, B1); PG8_BAR;
            PG8_LDA(At, 1, 1); PG8_STAGE(PG8_SA(1, 0), a3, voffA);
            PG8_BAR; PG8_WAIT_L(0); PG8_MMA(1, 0, At, B0); PG8_BAR; PG8_SCHED;
            PG8_STAGE(PG8_SB(1, 1), b3 + hstep, voffB);
            PG8_WAIT_V(6); PG8_BAR; PG8_MMA(1, 1, At, B1); PG8_BAR;
            }
        }
        if constexpr (ALIGN_EPI) { if (wr == 0) PG8_BAR; }
        if constexpr (!Epi::AFTER_DRAIN) { E(acc, cur, wr, wc, fr, fq); S.done(cur); }
        if (!has_next) break;
#pragma unroll
        for (int a = 0; a < 2; ++a)
#pragma unroll
            for (int b = 0; b < 2; ++b)
#pragma unroll
                for (int m = 0; m < 4; ++m)
#pragma unroll
                    for (int n = 0; n < 2; ++n) acc[a][b][m][n] = (f32x4){0.f, 0.f, 0.f, 0.f};
        cur = nxt; cA = nA; cB = nB; ++ui;
        if constexpr (ALIGN_EPI) { if (wr == 1) PG8_BAR; }
    }
    PG8_WAIT_V(0);
    if constexpr (!ALIGN_EPI) { if (wr == 0) PG8_BAR; }
    PG8_BAR;
    if constexpr (Epi::AFTER_DRAIN) { E.fused(acc, cur, wr, wc, fr, fq, lds, wid, lane); S.done(cur); }
#undef PG8_SA
#undef PG8_SB
#undef PG8_STAGE
#undef PG8_LDA
#undef PG8_LDB
#undef PG8_MMA
#undef PG8_WAIT_V
#undef PG8_WAIT_L
#undef PG8_BAR
#undef PG8_SCHED
}
}

#define XB_TMO      128
#define XB_XCNT(j)  (256  + 64 * (j))
#define XB_XSUB(j)  (1280 + 64 * (j))
#define XB_XGEN(j)  (2304 + 64 * (j))
#define XB_TOP      3328
#define XB_TOPGEN   3392
#define XCD_BAR_WORDS 3456
#define XB_SPIN_CAP (1u << 23)
__device__ __forceinline__ unsigned xb_ld(unsigned* p)              { return __hip_atomic_load(p, __ATOMIC_RELAXED, __HIP_MEMORY_SCOPE_AGENT); }
__device__ __forceinline__ unsigned xb_add(unsigned* p, unsigned v) { return __hip_atomic_fetch_add(p, v, __ATOMIC_RELAXED, __HIP_MEMORY_SCOPE_AGENT); }
__device__ __forceinline__ unsigned xb_xcc_id() { return (unsigned)__builtin_amdgcn_s_getreg((3 << 11) | 20) & 0xFu; }
#define XB_SPIN(cond, bar) do { unsigned _sp = 0; while (cond) { __builtin_amdgcn_s_sleep(1); \
    if ((++_sp & 255u) == 0u) { if (xb_ld(&(bar)[XB_TMO])) break; if (_sp > XB_SPIN_CAP) { atomicAdd(&(bar)[XB_TMO], 1u); break; } } } } while (0)
struct XcdBarrier { unsigned* bar; unsigned x; volatile LAS unsigned* st; };
__device__ __forceinline__ XcdBarrier xcd_barrier_post(unsigned* bar, volatile LAS unsigned* st) {
    XcdBarrier b; b.bar = bar; b.x = xb_xcc_id(); b.st = st;
    if (threadIdx.x == 0) (void)xb_add(&bar[XB_XCNT(b.x)], 1u);
    return b;
}
__device__ __forceinline__ void xcd_barrier_complete(unsigned* bar, unsigned x, unsigned& nloc, unsigned& nx) {
    const unsigned G = gridDim.x * gridDim.y * gridDim.z;
    unsigned sum, cnt, mine, sp = 0u;
    for (;;) {
        sum = 0u; cnt = 0u; mine = 0u;
#pragma unroll
        for (unsigned j = 0; j < 16; ++j) { const unsigned c = xb_ld(&bar[XB_XCNT(j)]); sum += c; cnt += (c > 0u) ? 1u : 0u; mine = (j == x) ? c : mine; }
        if (sum == G) break;
        __builtin_amdgcn_s_sleep(1);
        if ((++sp & 255u) == 0u) { if (xb_ld(&bar[XB_TMO])) break; if (sp > XB_SPIN_CAP) { atomicAdd(&bar[XB_TMO], 1u); break; } }
    }
    nloc = mine > 0u ? mine : 1u; nx = cnt > 0u ? cnt : 1u;
}
__device__ __forceinline__ void xcd_barrier(const XcdBarrier& b, const int tid_) {
    asm volatile("s_waitcnt vmcnt(0)" ::: "memory");
    __syncthreads();
    if (tid_ == 0) {
        unsigned* bar = b.bar; asm volatile("" : "+s"(bar));
        __builtin_amdgcn_s_waitcnt(0);
        unsigned nloc = b.st[0], nx = b.st[1];
        if (nloc == 0u) { xcd_barrier_complete(bar, b.x, nloc, nx); b.st[0] = nloc; b.st[1] = nx; }
        const unsigned old = xb_add(&bar[XB_XSUB(b.x)], 1u);
        const unsigned gen = old / nloc;
        if (old + 1u == (gen + 1u) * nloc) {
            __builtin_amdgcn_fence(__ATOMIC_RELEASE, "agent");
            asm volatile("s_waitcnt vmcnt(0)" ::: "memory");
            const unsigned og = xb_add(&bar[XB_TOP], 1u);
            const unsigned tg = og / nx;
            if (og + 1u == (tg + 1u) * nx) xb_add(&bar[XB_TOPGEN], 1u);
            else XB_SPIN(xb_ld(&bar[XB_TOPGEN]) == tg, bar);
            __builtin_amdgcn_fence(__ATOMIC_ACQUIRE, "agent");
            xb_add(&bar[XB_XGEN(b.x)], 1u);
            asm volatile("s_waitcnt vmcnt(0)" ::: "memory");
        } else {
            XB_SPIN(xb_ld(&bar[XB_XGEN(b.x)]) == gen, bar);
            __builtin_amdgcn_fence(__ATOMIC_ACQUIRE, "agent");
            asm volatile("s_waitcnt vmcnt(0)" ::: "memory");
        }
    }
    __syncthreads();
}

__device__ __forceinline__ float wave_sum(float v) {
#pragma unroll
    for (int o = 1; o < 64; o <<= 1) v += __shfl_xor(v, o);
    return v;
}
__device__ __forceinline__ float wave_max(float v) {
#pragma unroll
    for (int o = 1; o < 64; o <<= 1) v = fmaxf(v, __shfl_xor(v, o));
    return v;
}
__device__ __forceinline__ float bperm(float x, int srclane) { return __builtin_bit_cast(float, __builtin_amdgcn_ds_bpermute(srclane << 2, __builtin_bit_cast(int, x))); }
__device__ __forceinline__ float wave_sum_l(float v, int lane) {
#pragma unroll
    for (int o = 1; o < 64; o <<= 1) v += bperm(v, lane ^ o);
    return v;
}
__device__ __forceinline__ float wave_max_l(float v, int lane) {
#pragma unroll
    for (int o = 1; o < 64; o <<= 1) v = fmaxf(v, bperm(v, lane ^ o));
    return v;
}
__device__ __forceinline__ float siluf(float x) { return x / (1.f + expf(-x)); }
__device__ __forceinline__ float log_sigmoidf(float x) { return fminf(x, 0.f) - log1pf(expf(-fabsf(x))); }
__device__ __forceinline__ float softplusf(float x) { return fmaxf(x, 0.f) + log1pf(expf(-fabsf(x))); }

__device__ __forceinline__ const float* conv_prev(const float* MI, const float* state_conv_l, int r, int j) {
    if (r < MP) { const int b = r >> 11, i = r & 2047; const int p = i - j; if (p >= 0) return MI + (size_t)(b * 2048 + p) * LDMI + C_XBC; return MI + (size_t)(R_META + 16 + p) * LDMI + C_XBC; }
    if (r < R_META) { const int s = r - R_S, b = s >> 2, i = s & 3; const int p = i - j; if (p >= 0) return MI + (size_t)(R_S + b * 4 + p) * LDMI + C_XBC; return state_conv_l + (size_t)(b * 3 + 3 + p) * 768; }
    const int i = r - R_META, p = i - j; if (p >= 0) return MI + (size_t)(R_META + p) * LDMI + C_XBC; return nullptr;
}

struct PromptKeys { const float* KN; const float* MI; const float* FC; int b, h;
    __device__ __forceinline__ void get(int j, const float*& kp, const float*& vp, float& Fk) const { const int row = j < 16 ? R_META + j : b * 2048 + (j - 16);
        kp = KN + (size_t)row * 256 + h * 64; vp = MI + (size_t)row * LDMI + C_FV + h * 64; Fk = FC[row * 4 + h]; } };
struct SampleKeys { const float* KN; const float* MI; const float* FCS; const float* ck; const float* cv; const int* pt; int b, h, l;
    __device__ __forceinline__ void get(int j, const float*& kp, const float*& vp, float& Fk) const {
        Fk = FCS[(size_t)(b * 4 + h) * 2052 + j];
        if (j < 2048) { const int page = pt[b * 16 + (j >> 7)]; const size_t off = (((size_t)l * NPOOL + page) * 128 + (j & 127)) * 256 + h * 64; kp = ck + off; vp = cv + off; }
        else { const int row = R_S + b * 4 + (j - 2048); kp = KN + (size_t)row * 256 + h * 64; vp = MI + (size_t)row * LDMI + C_FV + h * 64; } } };

template <class Keys>
__device__ __forceinline__ void attn_row(const float* qg, float Fq, int nk, const Keys& K, bf16* outp, float* sq, float* sc, int lane) {
    sq[lane] = qg[lane];
    LDS_WAIT();
    float mx = -INFINITY;
    for (int j = lane; j < nk; j += 64) {
        const float* kp; const float* vp; float Fk; K.get(j, kp, vp, Fk);
        float s = 0.f;
#pragma unroll
        for (int d4 = 0; d4 < 16; ++d4) { const float4 a = ((const float4*)sq)[d4]; const float4 b = ((const float4*)kp)[d4]; s += a.x * b.x + a.y * b.y + a.z * b.z + a.w * b.w; }
        s = s * 0.125f + (Fq - Fk);
        sc[j] = s; mx = fmaxf(mx, s);
    }
    mx = wave_max_l(mx, lane);
    float sum = 0.f;
    for (int j = lane; j < nk; j += 64) { const float p = expf(sc[j] - mx); sc[j] = p; sum += p; }
    sum = wave_sum_l(sum, lane);
    LDS_WAIT();
    float o = 0.f;
    for (int j = 0; j < nk; ++j) { const float* kp; const float* vp; float Fk; K.get(j, kp, vp, Fk); o += sc[j] * vp[lane]; }
    outp[lane] = (bf16)f2bf(o / sum);
    LDS_WAIT();
}

namespace fa {
typedef short bf16x8 __attribute__((ext_vector_type(8)));
typedef short s16x4 __attribute__((ext_vector_type(4)));
typedef float f4 __attribute__((ext_vector_type(4)));
typedef float f32x16 __attribute__((ext_vector_type(16)));
typedef float f32x2_t __attribute__((ext_vector_type(2)));
typedef __bf16 bf16x2_t __attribute__((ext_vector_type(2)));
__device__ __forceinline__ unsigned cvtpk(float lo, float hi) { f32x2_t v = {lo, hi}; bf16x2_t b = __builtin_convertvector(v, bf16x2_t); return __builtin_bit_cast(unsigned, b); }
__device__ __forceinline__ int crow(int r, int hi) { return (r & 3) + 8 * (r >> 2) + 4 * hi; }
template <int CTRL> __device__ __forceinline__ float dpp(float x) { return __builtin_bit_cast(float, __builtin_amdgcn_mov_dpp(__builtin_bit_cast(int, x), CTRL, 0xf, 0xf, true)); }
constexpr int XOR1 = 0xB1, XOR2 = 0x4E, XOR7 = 0x141, XOR8 = 0x128;
__device__ __forceinline__ float row16_sum(float s) { s += dpp<XOR1>(s); s += dpp<XOR2>(s); s += dpp<XOR7>(s); s += dpp<XOR8>(s); return s; }
#define MFMA32(a, b, c) __builtin_amdgcn_mfma_f32_32x32x16_bf16((a), (b), (c), 0, 0, 0)

constexpr int KSTR = 144;
constexpr int L_K0 = 0, L_V0 = 2 * 64 * KSTR, L_KB = 4 * 64 * KSTR, L_WS = L_KB + 2112 * 4, L_END = L_WS + 64;
constexpr float LOG2E = 1.4426950408889634f;

__device__ __forceinline__ void fox_prompt_unit(int b, int h, int qb, const bf16* QF, const bf16* KF, const bf16* VT, const float* LF, bf16* MIXB, LAS unsigned char* lds, int tid) {
    const int lane = tid & 63, wave = __builtin_amdgcn_readfirstlane(tid >> 6), r32 = lane & 31, hi = lane >> 5;
    const int ntile = 5 + 4 * qb, nslots = 64 * ntile;
    LAS float* kb = (LAS float*)(lds + L_KB); LAS float* wsum = (LAS float*)(lds + L_WS);
    {
        float v[5]; float run = 0.f;
#pragma unroll
        for (int e = 0; e < 5; ++e) { const int slot = 5 * tid + e; float lf = 0.f;
            if (slot < 16) lf = LF[(R_META + slot) * 4 + h]; else if (slot >= 64 && slot < nslots) lf = LF[(b * 2048 + slot - 64) * 4 + h];
            run += lf; v[e] = run; }
        float x = run;
#pragma unroll
        for (int o = 1; o < 64; o <<= 1) { const float y = bperm(x, lane - o); if (lane >= o) x += y; }
        if (lane == 63) wsum[wave] = x;
        __syncthreads();
        float off = x - run;
        for (int w = 0; w < wave; ++w) off += wsum[w];
#pragma unroll
        for (int e = 0; e < 5; ++e) { const int slot = 5 * tid + e; if (slot < 2112) kb[slot] = (slot >= 16 && slot < 64) ? -INFINITY : -(off + v[e]) * LOG2E; }
    }
    const bf16* Qw = QF + ((size_t)(b * 4 + h) * 2048 + 256 * qb + 32 * wave) * 64;
    bf16x8 qr[4];
#pragma unroll
    for (int d0 = 0; d0 < 4; ++d0) qr[d0] = *(const bf16x8*)(Qw + r32 * 64 + d0 * 16 + hi * 8);
    const bf16* Kg = KF + (size_t)(b * 4 + h) * 2112 * 64 + (size_t)(tid >> 3) * 64 + (tid & 7) * 8;
    const bf16* Vg = VT + (size_t)(b * 4 + h) * 64 * 2112 + (size_t)(tid >> 3) * 2112 + (tid & 7) * 8;
    const int soff = (tid >> 3) * KSTR + (tid & 7) * 16;
    v4u kreg = *(const v4u*)Kg, vreg = *(const v4u*)Vg;
    *(LAS v4u*)(lds + L_K0 + soff) = kreg; *(LAS v4u*)(lds + L_V0 + soff) = vreg;
    __syncthreads();
    asm volatile("" : "+v"(qr[0]), "+v"(qr[1]), "+v"(qr[2]), "+v"(qr[3]));
    float m = -INFINITY, l = 0.f; f32x16 o0, o1;
#pragma unroll
    for (int i = 0; i < 16; ++i) { o0[i] = 0.f; o1[i] = 0.f; }
    const int qrow = 256 * qb + 32 * wave + r32;
    const int wave_last = 1 + (256 * qb + 32 * wave + 31) / 64;
    for (int t = 0; t < ntile; ++t) {
        const int cur = t & 1;
        if (t + 1 < ntile) { kreg = *(const v4u*)(Kg + (size_t)(t + 1) * 64 * 64); vreg = *(const v4u*)(Vg + (t + 1) * 64); }
        if (t <= wave_last) {
            LAS unsigned char* Kc = lds + L_K0 + cur * 64 * KSTR; LAS unsigned char* Vc = lds + L_V0 + cur * 64 * KSTR;
            f32x16 p0, p1;
#pragma unroll
            for (int i = 0; i < 16; ++i) { p0[i] = 0.f; p1[i] = 0.f; }
#pragma unroll
            for (int d0 = 0; d0 < 4; ++d0) {
                const bf16x8 a0 = *(const LAS bf16x8*)(Kc + r32 * KSTR + (d0 * 16 + hi * 8) * 2);
                const bf16x8 a1 = *(const LAS bf16x8*)(Kc + (32 + r32) * KSTR + (d0 * 16 + hi * 8) * 2);
                p0 = MFMA32(a0, qr[d0], p0); p1 = MFMA32(a1, qr[d0], p1);
            }
#pragma unroll
            for (int g = 0; g < 4; ++g) { const f4 b0 = *(const LAS f4*)(kb + 64 * t + 8 * g + 4 * hi); const f4 b1 = *(const LAS f4*)(kb + 64 * t + 32 + 8 * g + 4 * hi);
                p0[4 * g + 0] += b0[0]; p0[4 * g + 1] += b0[1]; p0[4 * g + 2] += b0[2]; p0[4 * g + 3] += b0[3]; p1[4 * g + 0] += b1[0]; p1[4 * g + 1] += b1[1]; p1[4 * g + 2] += b1[2]; p1[4 * g + 3] += b1[3]; }
            if (t >= 4 * qb + 1) {
                const int kbase = 64 * (t - 1);
#pragma unroll
                for (int i = 0; i < 16; ++i) { const int pk = kbase + crow(i, hi); if (pk > qrow) p0[i] = -INFINITY; if (pk + 32 > qrow) p1[i] = -INFINITY; }
            }
            float rm = fmaxf(p0[0], p1[0]);
#pragma unroll
            for (int i = 1; i < 16; ++i) rm = fmaxf(rm, fmaxf(p0[i], p1[i]));
            rm = fmaxf(rm, bperm(rm, lane ^ 32));
            const float mn = fmaxf(m, rm); const float sc = __builtin_amdgcn_exp2f(m - mn); m = mn;
            float rsum = 0.f;
#pragma unroll
            for (int i = 0; i < 16; ++i) { p0[i] = __builtin_amdgcn_exp2f(p0[i] - mn); p1[i] = __builtin_amdgcn_exp2f(p1[i] - mn); rsum += p0[i] + p1[i]; }
            l = l * sc + rsum;
#pragma unroll
            for (int i = 0; i < 16; ++i) { o0[i] *= sc; o1[i] *= sc; }
#pragma unroll
            for (int blk = 0; blk < 2; ++blk)
#pragma unroll
                for (int s2 = 0; s2 < 2; ++s2) {
                    v4u pw;
                    if (blk == 0) { pw.x = cvtpk(p0[8 * s2 + 0], p0[8 * s2 + 1]); pw.y = cvtpk(p0[8 * s2 + 2], p0[8 * s2 + 3]); pw.z = cvtpk(p0[8 * s2 + 4], p0[8 * s2 + 5]); pw.w = cvtpk(p0[8 * s2 + 6], p0[8 * s2 + 7]); }
                    else          { pw.x = cvtpk(p1[8 * s2 + 0], p1[8 * s2 + 1]); pw.y = cvtpk(p1[8 * s2 + 2], p1[8 * s2 + 3]); pw.z = cvtpk(p1[8 * s2 + 4], p1[8 * s2 + 5]); pw.w = cvtpk(p1[8 * s2 + 6], p1[8 * s2 + 7]); }
                    const bf16x8 pb = __builtin_bit_cast(bf16x8, pw);
                    const int koff = (32 * blk + 16 * s2 + 4 * hi) * 2;
                    { const s16x4 lo = *(const LAS s16x4*)(Vc + r32 * KSTR + koff), hh = *(const LAS s16x4*)(Vc + r32 * KSTR + koff + 16);
                      const bf16x8 va = {lo[0], lo[1], lo[2], lo[3], hh[0], hh[1], hh[2], hh[3]}; o0 = MFMA32(va, pb, o0); }
                    { const s16x4 lo = *(const LAS s16x4*)(Vc + (32 + r32) * KSTR + koff), hh = *(const LAS s16x4*)(Vc + (32 + r32) * KSTR + koff + 16);
                      const bf16x8 va = {lo[0], lo[1], lo[2], lo[3], hh[0], hh[1], hh[2], hh[3]}; o1 = MFMA32(va, pb, o1); }
                }
        }
        if (t + 1 < ntile) { *(LAS v4u*)(lds + L_K0 + (cur ^ 1) * 64 * KSTR + soff) = kreg; *(LAS v4u*)(lds + L_V0 + (cur ^ 1) * 64 * KSTR + soff) = vreg; }
        __syncthreads();
    }
    l += bperm(l, lane ^ 32);
    const float inv = 1.0f / l;
    bf16* orow = MIXB + (size_t)(b * 2048 + qrow) * 1024 + h * 64;
#pragma unroll
    for (int g = 0; g < 4; ++g) {
        *(uint2*)(orow + 8 * g + 4 * hi) = make_uint2(cvtpk(o0[4 * g] * inv, o0[4 * g + 1] * inv), cvtpk(o0[4 * g + 2] * inv, o0[4 * g + 3] * inv));
        *(uint2*)(orow + 32 + 8 * g + 4 * hi) = make_uint2(cvtpk(o1[4 * g] * inv, o1[4 * g + 1] * inv), cvtpk(o1[4 * g + 2] * inv, o1[4 * g + 3] * inv));
    }
}

constexpr int S_D = 0, S_WS = 32768, S_PART = 33024, S_PSTR = 68;
__device__ __forceinline__ void fox_sample_unit(int b, int l, const float* QN, const float* KN, const float* MI, const float* LF, const float* ck, const float* cv, const float* clf, const int* pt,
                                                bf16* MIXB, LAS unsigned char* lds, int tid) {
    const int lane = tid & 63, wave = __builtin_amdgcn_readfirstlane(tid >> 6), h = lane >> 4, d4 = lane & 15;
    LAS f4* Dl = (LAS f4*)(lds + S_D); LAS f4* wsum = (LAS f4*)(lds + S_WS);
    {
        const int page = pt[b * 16 + (tid >> 5)];
        const f4* src = (const f4*)(clf + (((size_t)l * NPOOL + page) * 128 + 4 * (tid & 31)) * 4);
        const f4 v0 = src[0], v1 = src[1], v2 = src[2], v3 = src[3];
        const f4 s2 = v3, s1 = v3 + v2, s0 = s1 + v1, tot = s0 + v0;
        f4 x = tot;
#pragma unroll
        for (int o = 1; o < 64; o <<= 1) { f4 y; y[0] = bperm(x[0], lane + o); y[1] = bperm(x[1], lane + o); y[2] = bperm(x[2], lane + o); y[3] = bperm(x[3], lane + o); if (lane + o < 64) x += y; }
        if (lane == 0) wsum[wave] = x;
        __syncthreads();
        f4 off = x - tot;
        for (int w = wave + 1; w < 8; ++w) off += wsum[w];
        Dl[4 * tid + 0] = s0 + off; Dl[4 * tid + 1] = s1 + off; Dl[4 * tid + 2] = s2 + off; Dl[4 * tid + 3] = off;
        __syncthreads();
    }
    float4 q[4];
#pragma unroll
    for (int i = 0; i < 4; ++i) { const float4 t = *(const float4*)(QN + (size_t)(R_S + b * 4 + i) * 256 + h * 64 + 4 * d4); q[i] = make_float4(t.x * 0.125f, t.y * 0.125f, t.z * 0.125f, t.w * 0.125f); }
    float m[4], ls[4]; float4 o[4];
#pragma unroll
    for (int i = 0; i < 4; ++i) { m[i] = -INFINITY; ls[i] = 0.f; o[i] = make_float4(0.f, 0.f, 0.f, 0.f); }
    const LAS float* Df = (const LAS float*)Dl;
    for (int p = 0; p < 16; ++p) {
        const int page = pt[b * 16 + p];
        const size_t base = (((size_t)l * NPOOL + page) * 128 + 16 * wave) * 256 + lane * 4;
#pragma unroll
        for (int hf = 0; hf < 2; ++hf) {
            pg8::f32x4 kk[8], vv[8];
#pragma unroll
            for (int j = 0; j < 8; ++j) { kk[j] = __builtin_nontemporal_load((const pg8::f32x4*)(ck + base + (size_t)(hf * 8 + j) * 256)); vv[j] = __builtin_nontemporal_load((const pg8::f32x4*)(cv + base + (size_t)(hf * 8 + j) * 256)); }
            float s[4][8];
#pragma unroll
            for (int j = 0; j < 8; ++j) { const float dk = Df[(p * 128 + 16 * wave + hf * 8 + j) * 4 + h];
#pragma unroll
                for (int i = 0; i < 4; ++i) s[i][j] = row16_sum(q[i].x * kk[j][0] + q[i].y * kk[j][1] + q[i].z * kk[j][2] + q[i].w * kk[j][3]) + dk; }
#pragma unroll
            for (int i = 0; i < 4; ++i) {
                float mx = s[i][0];
#pragma unroll
                for (int j = 1; j < 8; ++j) mx = fmaxf(mx, s[i][j]);
                const float mn = fmaxf(m[i], mx); const float sc = __expf(m[i] - mn); m[i] = mn;
                ls[i] *= sc; o[i].x *= sc; o[i].y *= sc; o[i].z *= sc; o[i].w *= sc;
#pragma unroll
                for (int j = 0; j < 8; ++j) { const float pj = __expf(s[i][j] - mn); ls[i] += pj; o[i].x += pj * vv[j][0]; o[i].y += pj * vv[j][1]; o[i].z += pj * vv[j][2]; o[i].w += pj * vv[j][3]; }
            }
        }
    }
    LAS float* part = (LAS float*)(lds + S_PART);
#pragma unroll
    for (int i = 0; i < 4; ++i) { LAS float* pp = part + ((wave * 16) + h * 4 + i) * S_PSTR; *(LAS f4*)(pp + 4 + 4 * d4) = (f4){o[i].x, o[i].y, o[i].z, o[i].w}; if (d4 == 0) { pp[0] = m[i]; pp[1] = ls[i]; } }
    __syncthreads();
    for (int u = tid; u < 1024; u += 512) {
        const int hh = u >> 8, i = (u >> 6) & 3, d = u & 63;
        const int rowq = R_S + b * 4 + i;
        float sn[4]; float G = 0.f;
#pragma unroll
        for (int j = 0; j < 4; ++j) { const int rowk = R_S + b * 4 + j; G -= LF[rowk * 4 + hh]; float dot = 0.f;
            const float* qp = QN + (size_t)rowq * 256 + hh * 64; const float* kp = KN + (size_t)rowk * 256 + hh * 64;
            for (int c = 0; c < 64; ++c) dot += qp[c] * kp[c];
            sn[j] = j <= i ? dot * 0.125f + G : -INFINITY; }
        float mt = fmaxf(fmaxf(sn[0], sn[1]), fmaxf(sn[2], sn[3]));
        for (int w = 0; w < 8; ++w) mt = fmaxf(mt, part[(w * 16 + hh * 4 + i) * S_PSTR]);
        float lt = 0.f, ot = 0.f;
        for (int w = 0; w < 8; ++w) { const LAS float* pp = part + (w * 16 + hh * 4 + i) * S_PSTR; const float e = __expf(pp[0] - mt); lt += e * pp[1]; ot += e * pp[4 + d]; }
#pragma unroll
        for (int j = 0; j < 4; ++j) { const float e = __expf(sn[j] - mt); lt += e; ot += e * MI[(size_t)(R_S + b * 4 + j) * LDMI + C_FV + hh * 64 + d]; }
        MIXB[(size_t)rowq * 1024 + hh * 64 + d] = (bf16)f2bf(ot / lt);
    }
    __syncthreads();
}
#undef MFMA32
}

namespace la {
using fa::bf16x8; using fa::s16x4; using fa::f32x16; using fa::f4; using fa::cvtpk; using fa::crow;
#define MFMA32(a, b, c) __builtin_amdgcn_mfma_f32_32x32x16_bf16((a), (b), (c), 0, 0, 0)
#define LDS_BARRIER() asm volatile("s_waitcnt lgkmcnt(0)\n\ts_barrier" ::: "memory")
__device__ __forceinline__ int seq_row(int b, int c, int t) { const int sg = 128 * c - 112 + t; return sg < 0 ? -1 : (sg < 16 ? R_META + sg : b * 2048 + sg - 16); }
__device__ __forceinline__ bf16x8 pack8(const f32x16& x, int s) { v4u p; p.x = cvtpk(x[8 * s], x[8 * s + 1]); p.y = cvtpk(x[8 * s + 2], x[8 * s + 3]); p.z = cvtpk(x[8 * s + 4], x[8 * s + 5]); p.w = cvtpk(x[8 * s + 6], x[8 * s + 7]); return __builtin_bit_cast(bf16x8, p); }
__device__ __forceinline__ bf16x8 ld16(const LAS unsigned char* p) { return *(const LAS bf16x8*)p; }
__device__ __forceinline__ bf16x8 ld8x2(const LAS unsigned char* p) { const s16x4 lo = *(const LAS s16x4*)p, hh = *(const LAS s16x4*)(p + 16); return (bf16x8){lo[0], lo[1], lo[2], lo[3], hh[0], hh[1], hh[2], hh[3]}; }
__device__ __forceinline__ float silu_f(float x) { return x * __builtin_amdgcn_rcpf(1.0f + __expf(-x)); }
__device__ __forceinline__ float bf2f(unsigned short v) { return __uint_as_float((unsigned)v << 16); }
typedef unsigned u2v __attribute__((ext_vector_type(2)));
constexpr int TPITCH = 272;
constexpr int OPITCH = 68;

constexpr int G_QL = 0, G_KL = 10240, G_KT = 20480, G_VT = 29184, G_OUT = 46592, G_BC = 81408, G_SEG = 98304, G_BL = 100352, G_BLR = 100480;
__device__ __forceinline__ void gla_prompt_unit(int b, int h, const GAS bf16* MIB, const GAS float* GLOG, const GAS float* gnorm, GAS bf16* MIXB, GAS float* state_out, LAS unsigned char* lds, int tid0) {
    int tid = tid0;
    int lane = tid & 63, wave = __builtin_amdgcn_readfirstlane(tid >> 6), r32 = lane & 31, hi = lane >> 5, vt = wave & 1, tt = wave < 4 ? (wave >> 1) : 3 - ((wave - 4) >> 1);
    LAS unsigned char* QL = lds + G_QL; LAS unsigned char* KL = lds + G_KL; LAS unsigned char* KT = lds + G_KT; LAS unsigned char* VT = lds + G_VT;
    LAS float* OUT = (LAS float*)(lds + G_OUT); LAS float* BC = (LAS float*)(lds + G_BC); LAS float* SEG = (LAS float*)(lds + G_SEG); LAS float* BL = (LAS float*)(lds + G_BL); LAS float* BLR = (LAS float*)(lds + G_BLR);
    f32x16 SK;
#pragma unroll
    for (int i = 0; i < 16; ++i) SK[i] = 0.f;
    int kk = tid & 31, seg = tid >> 5;
    f4 q0, q1, k0, k1, v4[4]; float gl[8];
#define BF4(w_) ((f4){__uint_as_float((w_)[0] << 16), __uint_as_float((w_)[0] & 0xffff0000u), __uint_as_float((w_)[1] << 16), __uint_as_float((w_)[1] & 0xffff0000u)})
#define GLA_LOAD(cc) do { const int row = seq_row(b, (cc), tid >> 2); const GAS bf16* mr = MIB + (size_t)(row >= 0 ? row : 0) * N_MAIN; const int qd_ = tid & 3; \
        const u2v a0_ = *(const GAS u2v*)(mr + CM_GQ + h * 32 + 8 * qd_), a1_ = *(const GAS u2v*)(mr + CM_GQ + h * 32 + 8 * qd_ + 4), b0_ = *(const GAS u2v*)(mr + CM_GK + h * 32 + 8 * qd_), b1_ = *(const GAS u2v*)(mr + CM_GK + h * 32 + 8 * qd_ + 4); \
        u2v c_[4]; _Pragma("unroll") for (int j4 = 0; j4 < 4; ++j4) c_[j4] = *(const GAS u2v*)(mr + CM_GV + h * 64 + 16 * qd_ + 4 * j4); \
        _Pragma("unroll") for (int e_ = 0; e_ < 8; ++e_) { const int rg_ = seq_row(b, (cc), 8 * (tid >> 5) + e_); gl[e_] = GLOG[(size_t)(rg_ >= 0 ? rg_ : 0) * 128 + h * 32 + (tid & 31)]; } \
        q0 = BF4(a0_); q1 = BF4(a1_); k0 = BF4(b0_); k1 = BF4(b1_); _Pragma("unroll") for (int j4 = 0; j4 < 4; ++j4) v4[j4] = BF4(c_[j4]); } while (0)
    GLA_LOAD(0);
    for (int c = 0; c < 17; ++c) {
        tid = tid0; asm volatile("" : "+v"(tid)); lane = tid & 63; wave = __builtin_amdgcn_readfirstlane(tid >> 6); r32 = lane & 31; hi = lane >> 5; vt = wave & 1; tt = wave < 4 ? (wave >> 1) : 3 - ((wave - 4) >> 1); kk = tid & 31; seg = tid >> 5;
        if (c == 0 && (tid >> 2) < 112) { const f4 z = (f4){0.f, 0.f, 0.f, 0.f}; q0 = z; q1 = z; k0 = z; k1 = z; v4[0] = z; v4[1] = z; v4[2] = z; v4[3] = z; }
        {
            float bcl[8]; float run = 0.f;
#pragma unroll
            for (int e = 0; e < 8; ++e) { const float gv = (c == 0 && 8 * seg + e < 112) ? 0.f : gl[e]; run += gv; bcl[e] = run; }
            SEG[seg * 32 + kk] = run;
            LDS_BARRIER();
            float off = 0.f, tot = 0.f;
#pragma unroll
            for (int s = 0; s < 16; ++s) { const float v = SEG[s * 32 + kk]; tot += v; if (s < seg) off += v; }
#pragma unroll
            for (int e = 0; e < 8; ++e) BC[(8 * seg + e) * 33 + kk] = bcl[e] + off;
            if (seg == 0) { BL[kk] = __expf(tot); BLR[kk] = tot; }
            LDS_BARRIER();
        }
        {
            const int t = tid >> 2, qd = tid & 3;
            const float q[8] = {q0[0], q0[1], q0[2], q0[3], q1[0], q1[1], q1[2], q1[3]}, k[8] = {k0[0], k0[1], k0[2], k0[3], k1[0], k1[1], k1[2], k1[3]};
            float qv[8], kv[8];
#pragma unroll
            for (int j = 0; j < 8; ++j) { const float bcv = BC[t * 33 + 8 * qd + j]; qv[j] = q[j] * 0.17677669529663687f * __expf(bcv); kv[j] = k[j] * __expf(-bcv);
                *(LAS bf16*)(KT + (8 * qd + j) * TPITCH + 2 * t) = (bf16)(cvtpk(k[j] * __expf(BLR[8 * qd + j] - bcv), 0.f) & 0xffffu); }
            *(LAS v4u*)(QL + t * 80 + qd * 16) = (v4u){cvtpk(qv[0], qv[1]), cvtpk(qv[2], qv[3]), cvtpk(qv[4], qv[5]), cvtpk(qv[6], qv[7])};
            *(LAS v4u*)(KL + t * 80 + qd * 16) = (v4u){cvtpk(kv[0], kv[1]), cvtpk(kv[2], kv[3]), cvtpk(kv[4], kv[5]), cvtpk(kv[6], kv[7])};
#pragma unroll
            for (int j4 = 0; j4 < 4; ++j4)
#pragma unroll
                for (int e = 0; e < 4; e += 2) { const unsigned w_ = cvtpk(v4[j4][e], v4[j4][e + 1]); *(LAS bf16*)(VT + (16 * qd + 4 * j4 + e) * TPITCH + 2 * t) = (bf16)(w_ & 0xffffu); *(LAS bf16*)(VT + (16 * qd + 4 * j4 + e + 1) * TPITCH + 2 * t) = (bf16)(w_ >> 16); }
        }
        float zz[16];
#pragma unroll
        for (int i = 0; i < 16; ++i) { const int row = seq_row(b, c, 16 * wave + i); zz[i] = bf2f(MIB[(size_t)(row >= 0 ? row : 0) * N_MAIN + CM_GG + h * 64 + lane]); }
        if (c + 1 < 17) GLA_LOAD(c + 1);
        LDS_BARRIER();
        {
            f32x16 y;
#pragma unroll
            for (int i = 0; i < 16; ++i) y[i] = 0.f;
            const LAS unsigned char* qrow = QL + (32 * tt + r32) * 80;
#pragma unroll
            for (int s2 = 0; s2 < 2; ++s2) y = MFMA32(pack8(SK, s2), ld8x2(qrow + (16 * s2 + 4 * hi) * 2), y);
            for (int i = 0; i <= tt; ++i) {
                f32x16 gt;
#pragma unroll
                for (int r = 0; r < 16; ++r) gt[r] = 0.f;
#pragma unroll
                for (int ks = 0; ks < 2; ++ks) gt = MFMA32(ld16(KL + (32 * i + r32) * 80 + (16 * ks + 8 * hi) * 2), ld16(qrow + (16 * ks + 8 * hi) * 2), gt);
                if (i == tt) {
#pragma unroll
                    for (int r = 0; r < 16; ++r) if (crow(r, hi) > r32) gt[r] = 0.f; }
#pragma unroll
                for (int s2 = 0; s2 < 2; ++s2) y = MFMA32(ld8x2(VT + (32 * vt + r32) * TPITCH + (32 * i + 16 * s2 + 4 * hi) * 2), pack8(gt, s2), y);
            }
#pragma unroll
            for (int r = 0; r < 16; ++r) SK[r] *= BL[crow(r, hi)];
#pragma unroll
            for (int ks = 0; ks < 8; ++ks) SK = MFMA32(ld16(KT + r32 * TPITCH + (16 * ks + 8 * hi) * 2), ld16(VT + (32 * vt + r32) * TPITCH + (16 * ks + 8 * hi) * 2), SK);
#pragma unroll
            for (int g4 = 0; g4 < 4; ++g4) *(LAS f4*)(OUT + (32 * tt + r32) * OPITCH + 32 * vt + 8 * g4 + 4 * hi) = (f4){y[4 * g4], y[4 * g4 + 1], y[4 * g4 + 2], y[4 * g4 + 3]};
        }
        LDS_BARRIER();
        {
            const float gnl = gnorm[lane];
            float ov[16], ss[16];
#pragma unroll
            for (int i = 0; i < 16; ++i) { ov[i] = OUT[(16 * wave + i) * OPITCH + lane]; ss[i] = fa::row16_sum(ov[i] * ov[i]); }
#pragma unroll
            for (int i = 0; i < 16; ++i) ss[i] += bperm(ss[i], lane ^ 16);
#pragma unroll
            for (int i = 0; i < 16; ++i) ss[i] += bperm(ss[i], lane ^ 32);
#pragma unroll
            for (int i = 0; i < 16; ++i) { const int row = seq_row(b, c, 16 * wave + i);
                if (row >= 0 && (row < MP || b == 0)) MIXB[(size_t)row * 1024 + 768 + h * 64 + lane] = (bf16)(cvtpk(ov[i] * rsqrtf(ss[i] * (1.0f / 64.0f) + EPS) * gnl * zz[i], 0.f) & 0xffffu); }
        }
        LDS_BARRIER();
    }
#undef GLA_LOAD
    if (tt == 0) {
#pragma unroll
        for (int r = 0; r < 16; ++r) state_out[crow(r, hi) * 64 + 32 * vt + r32] = SK[r]; }
}

constexpr int S_QL = 0, S_KL = 18432, S_KT = 36864, S_VT = 54272, S_OUT = 71680, S_CS = 106496, S_DT = 107008, S_TOT = 107520, S_FS = 107776;
__device__ __forceinline__ void ssd_prompt_unit(int b, int h, const GAS bf16* MIB, const GAS bf16* XC, const GAS float* DTS, float A, float Dh, GAS bf16* MIXB, GAS float* SSQH, GAS float* state_out, LAS unsigned char* lds, int tid0) {
    int tid = tid0; const int g = h >> 2;
    int lane = tid & 63, wave = __builtin_amdgcn_readfirstlane(tid >> 6), r32 = lane & 31, hi = lane >> 5, vt = wave & 1, tt = wave < 4 ? (wave >> 1) : 3 - ((wave - 4) >> 1);
    LAS unsigned char* QL = lds + S_QL; LAS unsigned char* KL = lds + S_KL; LAS unsigned char* KT = lds + S_KT; LAS unsigned char* VT = lds + S_VT;
    LAS float* OUT = (LAS float*)(lds + S_OUT); LAS float* CS = (LAS float*)(lds + S_CS); LAS float* DT = (LAS float*)(lds + S_DT); LAS float* TOT = (LAS float*)(lds + S_TOT);
    f32x16 SK0, SK1;
#pragma unroll
    for (int i = 0; i < 16; ++i) { SK0[i] = 0.f; SK1[i] = 0.f; }
    v4u pb0, pb1, pc0, pc1, px0, px1; float dr0, dr1;
#define SSD_LOAD(cc) do { const int row_ = seq_row(b, (cc), tid >> 2); const GAS bf16* xr_ = XC + (size_t)(row_ >= 0 ? row_ : 0) * 768; const int q_ = tid & 3; \
        pb0 = *(const GAS v4u*)(xr_ + 512 + 64 * g + 8 * q_); pb1 = *(const GAS v4u*)(xr_ + 512 + 64 * g + 32 + 8 * q_); pc0 = *(const GAS v4u*)(xr_ + 640 + 64 * g + 8 * q_); pc1 = *(const GAS v4u*)(xr_ + 640 + 64 * g + 32 + 8 * q_); \
        px0 = *(const GAS v4u*)(xr_ + 64 * h + 8 * q_); px1 = *(const GAS v4u*)(xr_ + 64 * h + 32 + 8 * q_); \
        const int ra_ = seq_row(b, (cc), 2 * lane), rb_ = seq_row(b, (cc), 2 * lane + 1); dr0 = DTS[(size_t)(ra_ >= 0 ? ra_ : 0) * 8 + h]; dr1 = DTS[(size_t)(rb_ >= 0 ? rb_ : 0) * 8 + h]; } while (0)
    SSD_LOAD(0);
    for (int c = 0; c < 17; ++c) {
        tid = tid0; asm volatile("" : "+v"(tid)); lane = tid & 63; wave = __builtin_amdgcn_readfirstlane(tid >> 6); r32 = lane & 31; hi = lane >> 5; vt = wave & 1; tt = wave < 4 ? (wave >> 1) : 3 - ((wave - 4) >> 1);
        {
            const int t = tid >> 2, q = tid & 3;
            const bool pad0 = c == 0 && 2 * lane < 112, pad1 = c == 0 && 2 * lane + 1 < 112;
            const float d0 = pad0 ? 0.f : dr0, d1 = pad1 ? 0.f : dr1;
            const float a0 = d0 * A, a1 = d1 * A; float x = a0 + a1;
#pragma unroll
            for (int o = 1; o < 64; o <<= 1) { const float y = bperm(x, lane - o); if (lane >= o) x += y; }
            const float csl = bperm(x, 63);
            const float cs1 = x, cs0 = x - a1;
            if (tt > 0) {
                const float R = bperm(cs1, 16 * tt - 1);
                LAS float* FSw = (LAS float*)(lds + S_FS) + wave * 128;
                *(LAS u2v*)(FSw + 2 * lane) = (u2v){__float_as_uint(__expf(fminf(R - cs0, 0.f)) * d0), __float_as_uint(__expf(fminf(R - cs1, 0.f)) * d1)}; }
            if (wave == 0) { *(LAS u2v*)(CS + 2 * lane) = (u2v){__float_as_uint(cs0), __float_as_uint(cs1)}; *(LAS u2v*)(DT + 2 * lane) = (u2v){__float_as_uint(d0), __float_as_uint(d1)}; if (lane == 0) TOT[0] = csl; }
            const int src = t >> 1; const float csa = bperm(cs0, src), csb = bperm(cs1, src), dta = bperm(d0, src), dtb_ = bperm(d1, src);
            const float cst = (t & 1) ? csb : csa, dtt = (t & 1) ? dtb_ : dta;
            const float wgt = dtt * __expf(csl - cst);
            const bool padt = c == 0 && t < 112;
            if (padt) { const v4u z = (v4u){0u, 0u, 0u, 0u}; pb0 = z; pb1 = z; pc0 = z; pc1 = z; px0 = z; px1 = z; }
            *(LAS v4u*)(KL + t * 144 + q * 16) = pb0; *(LAS v4u*)(KL + t * 144 + 64 + q * 16) = pb1;
            *(LAS v4u*)(QL + t * 144 + q * 16) = pc0; *(LAS v4u*)(QL + t * 144 + 64 + q * 16) = pc1;
            const unsigned xw[8] = {px0.x, px0.y, px0.z, px0.w, px1.x, px1.y, px1.z, px1.w};
            const unsigned bw[8] = {pb0.x, pb0.y, pb0.z, pb0.w, pb1.x, pb1.y, pb1.z, pb1.w};
#pragma unroll
            for (int j = 0; j < 8; ++j) { const int p = (j < 4 ? 8 * q : 32 + 8 * q) + 2 * (j & 3);
                *(LAS bf16*)(VT + p * TPITCH + 2 * t) = (bf16)(xw[j] & 0xffffu); *(LAS bf16*)(VT + (p + 1) * TPITCH + 2 * t) = (bf16)(xw[j] >> 16);
                const unsigned wb = cvtpk(__uint_as_float(bw[j] << 16) * wgt, __uint_as_float(bw[j] & 0xffff0000u) * wgt);
                *(LAS bf16*)(KT + p * TPITCH + 2 * t) = (bf16)(wb & 0xffffu); *(LAS bf16*)(KT + (p + 1) * TPITCH + 2 * t) = (bf16)(wb >> 16); }
        }
        LDS_BARRIER();
        float zz[16];
#pragma unroll
        for (int i = 0; i < 16; ++i) { const int row = seq_row(b, c, 16 * wave + i); zz[i] = bf2f(MIB[(size_t)(row >= 0 ? row : 0) * N_MAIN + CM_SZ + h * 64 + lane]); }
        if (c + 1 < 17) SSD_LOAD(c + 1);
        {
            f32x16 y;
#pragma unroll
            for (int i = 0; i < 16; ++i) y[i] = 0.f;
            const LAS unsigned char* qrow = QL + (32 * tt + r32) * 144;
#pragma unroll
            for (int s2 = 0; s2 < 2; ++s2) { y = MFMA32(pack8(SK0, s2), ld8x2(qrow + (16 * s2 + 4 * hi) * 2), y); y = MFMA32(pack8(SK1, s2), ld8x2(qrow + (32 + 16 * s2 + 4 * hi) * 2), y); }
            const float cst = CS[32 * tt + r32]; const float ect = __expf(cst);
#pragma unroll
            for (int i = 0; i < 16; ++i) y[i] *= ect;
            if (tt > 0) {
                const LAS float* FSw = (const LAS float*)(lds + S_FS) + wave * 128;
                f32x16 y2;
#pragma unroll
                for (int r = 0; r < 16; ++r) y2[r] = 0.f;
                for (int i = 0; i < tt; ++i) {
                    f32x16 gt;
#pragma unroll
                    for (int r = 0; r < 16; ++r) gt[r] = 0.f;
#pragma unroll
                    for (int ks = 0; ks < 4; ++ks) gt = MFMA32(ld16(KL + (32 * i + r32) * 144 + (16 * ks + 8 * hi) * 2), ld16(qrow + (16 * ks + 8 * hi) * 2), gt);
#pragma unroll
                    for (int g4 = 0; g4 < 4; ++g4) { const f4 fs4 = *(const LAS f4*)(FSw + 32 * i + 8 * g4 + 4 * hi); gt[4 * g4] *= fs4[0]; gt[4 * g4 + 1] *= fs4[1]; gt[4 * g4 + 2] *= fs4[2]; gt[4 * g4 + 3] *= fs4[3]; }
#pragma unroll
                    for (int s2 = 0; s2 < 2; ++s2) y2 = MFMA32(ld8x2(VT + (32 * vt + r32) * TPITCH + (32 * i + 16 * s2 + 4 * hi) * 2), pack8(gt, s2), y2);
                }
                const float et = __expf(fminf(cst - CS[32 * tt - 1], 0.f));
#pragma unroll
                for (int r = 0; r < 16; ++r) y[r] += et * y2[r];
            }
            {
                const int i = tt;
                f32x16 gt;
#pragma unroll
                for (int r = 0; r < 16; ++r) gt[r] = 0.f;
#pragma unroll
                for (int ks = 0; ks < 4; ++ks) gt = MFMA32(ld16(KL + (32 * i + r32) * 144 + (16 * ks + 8 * hi) * 2), ld16(qrow + (16 * ks + 8 * hi) * 2), gt);
#pragma unroll
                for (int g4 = 0; g4 < 4; ++g4) { const f4 cs4 = *(const LAS f4*)(CS + 32 * i + 8 * g4 + 4 * hi), dt4 = *(const LAS f4*)(DT + 32 * i + 8 * g4 + 4 * hi);
#pragma unroll
                    for (int e = 0; e < 4; ++e) { const bool vis = 8 * g4 + 4 * hi + e <= r32; const float wv = vis ? __expf(fminf(cst - cs4[e], 0.f)) * dt4[e] : 0.f; gt[4 * g4 + e] *= wv; } }
#pragma unroll
                for (int s2 = 0; s2 < 2; ++s2) y = MFMA32(ld8x2(VT + (32 * vt + r32) * TPITCH + (32 * i + 16 * s2 + 4 * hi) * 2), pack8(gt, s2), y);
            }
            const float ecl = __expf(TOT[0]);
#pragma unroll
            for (int r = 0; r < 16; ++r) { SK0[r] *= ecl; SK1[r] *= ecl; }
#pragma unroll 2
            for (int ks = 0; ks < 8; ++ks) { const bf16x8 xb = ld16(VT + (32 * vt + r32) * TPITCH + (16 * ks + 8 * hi) * 2);
                SK0 = MFMA32(ld16(KT + r32 * TPITCH + (16 * ks + 8 * hi) * 2), xb, SK0); SK1 = MFMA32(ld16(KT + (32 + r32) * TPITCH + (16 * ks + 8 * hi) * 2), xb, SK1); }
#pragma unroll
            for (int g4 = 0; g4 < 4; ++g4) { f4 o;
#pragma unroll
                for (int e = 0; e < 4; ++e) o[e] = y[4 * g4 + e] + Dh * bf2f(*(const LAS bf16*)(VT + (32 * vt + 8 * g4 + 4 * hi + e) * TPITCH + 2 * (32 * tt + r32)));
                *(LAS f4*)(OUT + (32 * tt + r32) * OPITCH + 32 * vt + 8 * g4 + 4 * hi) = o; }
        }
        LDS_BARRIER();
        {
            float yv[16], ss[16];
#pragma unroll
            for (int i = 0; i < 16; ++i) { yv[i] = OUT[(16 * wave + i) * OPITCH + lane] * zz[i]; ss[i] = fa::row16_sum(yv[i] * yv[i]); }
#pragma unroll
            for (int i = 0; i < 16; ++i) ss[i] += bperm(ss[i], lane ^ 16);
#pragma unroll
            for (int i = 0; i < 16; ++i) ss[i] += bperm(ss[i], lane ^ 32);
            if (c > 0) {
                const size_t row0 = (size_t)b * 2048 + 128 * (c - 1) + 16 * wave;
#pragma unroll
                for (int i = 0; i < 16; ++i) { if (lane == 0) SSQH[(row0 + i) * 8 + h] = ss[i]; MIXB[(row0 + i) * 1024 + 256 + h * 64 + lane] = (bf16)(cvtpk(yv[i], 0.f) & 0xffffu); }
            } else if (b == 0 && wave == 7) {
#pragma unroll
                for (int i = 0; i < 16; ++i) { if (lane == 0) SSQH[(size_t)(R_META + i) * 8 + h] = ss[i]; MIXB[(size_t)(R_META + i) * 1024 + 256 + h * 64 + lane] = (bf16)(cvtpk(yv[i], 0.f) & 0xffffu); }
            }
        }
        LDS_BARRIER();
    }
#undef SSD_LOAD
    if (tt == 0) {
#pragma unroll
        for (int g4 = 0; g4 < 4; ++g4) { *(GAS f4*)(state_out + (32 * vt + r32) * 64 + 8 * g4 + 4 * hi) = (f4){SK0[4 * g4], SK0[4 * g4 + 1], SK0[4 * g4 + 2], SK0[4 * g4 + 3]};
            *(GAS f4*)(state_out + (32 * vt + r32) * 64 + 32 + 8 * g4 + 4 * hi) = (f4){SK1[4 * g4], SK1[4 * g4 + 1], SK1[4 * g4 + 2], SK1[4 * g4 + 3]}; } }
}
#undef MFMA32
}

namespace eu {
using fa::f4;
constexpr int E_Q = 67840, E_K = 71936, E_V = 76032, E_LF = 80128, E_XBC = 80256, E_DT = 92544, E_GLOG = 92672, E_YS = 94720, E_GO = 102912, E_END = 107008;

__device__ __forceinline__ void sample_unit(int b, int l, const float* MI, const float* ck, const float* cv, const float* clf, const int* pt, const float* st_ssm, const float* st_conv, const float* st_gla,
        const float* qg, const float* kg, const float* fbias, const float* cw, const float* cb, const float* dtb, const float* alog, const float* dsk, const float* snorm,
        const float* wg, const float* gbias, const float* gnorm, bf16* MIXB, float* out, LAS unsigned char* lds, int tid) {
    const int lane = tid & 63, wave = __builtin_amdgcn_readfirstlane(tid >> 6);
    LAS float* EQ = (LAS float*)(lds + E_Q); LAS float* EK = (LAS float*)(lds + E_K); LAS float* EV = (LAS float*)(lds + E_V); LAS float* ELF = (LAS float*)(lds + E_LF);
    LAS float* EX = (LAS float*)(lds + E_XBC); LAS float* EDT = (LAS float*)(lds + E_DT); LAS float* EG = (LAS float*)(lds + E_GLOG); LAS float* EYS = (LAS float*)(lds + E_YS); LAS float* EGO = (LAS float*)(lds + E_GO);
    const int r0 = R_S + 4 * b;
    if (wave < 4) { const float* mi = MI + (size_t)(r0 + wave) * LDMI;
#pragma unroll
        for (int h = 0; h < 4; ++h) { const float q = mi[C_FQ + h * 64 + lane], k = mi[C_FK + h * 64 + lane], v = mi[C_FV + h * 64 + lane];
            const float qs = rsqrtf(wave_sum_l(q * q, lane) * (1.f / 64.f) + EPS), ks = rsqrtf(wave_sum_l(k * k, lane) * (1.f / 64.f) + EPS);
            EQ[wave * 256 + h * 64 + lane] = q * qs * qg[lane]; EK[wave * 256 + h * 64 + lane] = k * ks * kg[lane]; EV[wave * 256 + h * 64 + lane] = v; }
        if (lane < 4) ELF[wave * 4 + lane] = log_sigmoidf(mi[C_FF + lane] + fbias[lane]);
    }
    for (int idx = tid; idx < 3072; idx += 512) { const int i = idx / 768, c = idx - i * 768; float u[4];
#pragma unroll
        for (int j = 0; j < 4; ++j) { const int p = i - j; u[j] = p >= 0 ? MI[(size_t)(r0 + p) * LDMI + C_XBC + c] : st_conv[(size_t)(b * 3 + 3 + p) * 768 + c]; }
        const float o = cw[3 * 768 + c] * u[0] + cw[2 * 768 + c] * u[1] + cw[768 + c] * u[2] + cw[c] * u[3] + cb[c];
        EX[i * 768 + c] = siluf(o); }
    if (tid < 32) EDT[tid] = softplusf(MI[(size_t)(r0 + (tid >> 3)) * LDMI + C_DT + (tid & 7)] + dtb[tid & 7]);
    { const int i = tid >> 7, c = tid & 127; const float* lr = MI + (size_t)(r0 + i) * LDMI + C_LR; float a = gbias[c];
#pragma unroll
        for (int r = 0; r < 16; ++r) a += lr[r] * wg[r * 128 + c];
        EG[i * 128 + c] = log_sigmoidf(a) * (1.0f / 16.0f); }
    {
        const int h = lane >> 4, d4 = lane & 15;
        LAS f4* Dl = (LAS f4*)(lds + fa::S_D); LAS f4* wsum = (LAS f4*)(lds + fa::S_WS);
        {
            const int page = pt[b * 16 + (tid >> 5)];
            const f4* src = (const f4*)(clf + (((size_t)l * NPOOL + page) * 128 + 4 * (tid & 31)) * 4);
            const f4 v0 = src[0], v1 = src[1], v2 = src[2], v3 = src[3];
            const f4 s2 = v3, s1 = v3 + v2, s0 = s1 + v1, tot = s0 + v0;
            f4 x = tot;
#pragma unroll
            for (int o = 1; o < 64; o <<= 1) { f4 y; y[0] = bperm(x[0], lane + o); y[1] = bperm(x[1], lane + o); y[2] = bperm(x[2], lane + o); y[3] = bperm(x[3], lane + o); if (lane + o < 64) x += y; }
            if (lane == 0) wsum[wave] = x;
            __syncthreads();
            f4 off = x - tot;
            for (int w = wave + 1; w < 8; ++w) off += wsum[w];
            Dl[4 * tid + 0] = s0 + off; Dl[4 * tid + 1] = s1 + off; Dl[4 * tid + 2] = s2 + off; Dl[4 * tid + 3] = off;
            __syncthreads();
        }
        const int r16 = lane & 15, q4 = lane >> 4, hp = r16 >> 2, iq = lane & 3;
        f4 q[4];
#pragma unroll
        for (int i = 0; i < 4; ++i) q[i] = *(const LAS f4*)(EQ + i * 256 + h * 64 + 4 * d4) * 0.125f;
        float m = -INFINITY, ls = 0.f; f4 oc[4];
#pragma unroll
        for (int c = 0; c < 4; ++c) oc[c] = (f4){0.f, 0.f, 0.f, 0.f};
        const LAS float* Df = (const LAS float*)Dl;
        const bool b0 = lane & 1, b1 = lane & 2, mine = hp == q4;
        for (int p = 0; p < 16; ++p) {
            const int page = pt[b * 16 + p];
            const size_t base = (((size_t)l * NPOOL + page) * 128 + 16 * wave) * 256 + lane * 4;
            f4 kk[16], vv[16];
#pragma unroll
            for (int j = 0; j < 16; ++j) { kk[j] = __builtin_nontemporal_load((const f4*)(ck + base + (size_t)j * 256)); vv[j] = __builtin_nontemporal_load((const f4*)(cv + base + (size_t)j * 256)); }
            float sj[16];
#pragma unroll
            for (int j = 0; j < 16; ++j) {
                float pq[4];
#pragma unroll
                for (int i = 0; i < 4; ++i) pq[i] = q[i][0] * kk[j][0] + q[i][1] * kk[j][1] + q[i][2] * kk[j][2] + q[i][3] * kk[j][3];
                const float k0 = b0 ? pq[1] : pq[0], g0 = b0 ? pq[0] : pq[1], k1 = b0 ? pq[3] : pq[2], g1 = b0 ? pq[2] : pq[3];
                const float r0 = k0 + fa::dpp<fa::XOR1>(g0), r1 = k1 + fa::dpp<fa::XOR1>(g1);
                float t = (b1 ? r1 : r0) + fa::dpp<fa::XOR2>(b1 ? r0 : r1);
                t += fa::dpp<0x124>(t); t += fa::dpp<0x128>(t);
                sj[j] = t + Df[(p * 128 + 16 * wave + j) * 4 + h];
            }
            float mx = sj[0];
#pragma unroll
            for (int j = 1; j < 16; ++j) mx = fmaxf(mx, sj[j]);
            const float mn = fmaxf(m, mx); const float sc = __expf(m - mn); m = mn;
            float rs = 0.f;
#pragma unroll
            for (int j = 0; j < 16; ++j) { sj[j] = __expf(sj[j] - mn); rs += sj[j]; }
            ls = ls * sc + rs;
            const float scc = bperm(sc, 16 * hp + iq);
#pragma unroll
            for (int c = 0; c < 4; ++c) { oc[c][0] *= scc; oc[c][1] *= scc; oc[c][2] *= scc; oc[c][3] *= scc; }
#pragma unroll
            for (int g = 0; g < 2; ++g) {
                v4u w = (v4u){fa::cvtpk(sj[8 * g], sj[8 * g + 1]), fa::cvtpk(sj[8 * g + 2], sj[8 * g + 3]), fa::cvtpk(sj[8 * g + 4], sj[8 * g + 5]), fa::cvtpk(sj[8 * g + 6], sj[8 * g + 7])};
                if (!mine) w = (v4u){0u, 0u, 0u, 0u};
                const fa::bf16x8 pbv = __builtin_bit_cast(fa::bf16x8, w);
#pragma unroll
                for (int c = 0; c < 4; ++c) {
                    const v4u a = (v4u){fa::cvtpk(vv[8 * g][c], vv[8 * g + 1][c]), fa::cvtpk(vv[8 * g + 2][c], vv[8 * g + 3][c]), fa::cvtpk(vv[8 * g + 4][c], vv[8 * g + 5][c]), fa::cvtpk(vv[8 * g + 6][c], vv[8 * g + 7][c])};
                    oc[c] = __builtin_amdgcn_mfma_f32_16x16x32_bf16(__builtin_bit_cast(fa::bf16x8, a), pbv, oc[c], 0, 0, 0); }
            }
        }
        m = bperm(m, 16 * hp + iq); ls = bperm(ls, 16 * hp + iq);
        LAS float* part = (LAS float*)(lds + fa::S_PART);
        { LAS float* pp = part + (wave * 16 + r16) * fa::S_PSTR;
#pragma unroll
            for (int e = 0; e < 4; ++e) *(LAS f4*)(pp + 4 + 16 * q4 + 4 * e) = (f4){oc[0][e], oc[1][e], oc[2][e], oc[3][e]};
            if (q4 == 0) { pp[0] = m; pp[1] = ls; } }
        __syncthreads();
        for (int u = tid; u < 1024; u += 512) {
            const int hh = u >> 8, i = (u >> 6) & 3, d = u & 63;
            float sn[4]; float G = 0.f;
#pragma unroll
            for (int j = 0; j < 4; ++j) { G -= ELF[j * 4 + hh]; float dot = 0.f;
                for (int c = 0; c < 64; ++c) dot += EQ[i * 256 + hh * 64 + c] * EK[j * 256 + hh * 64 + c];
                sn[j] = j <= i ? dot * 0.125f + G : -INFINITY; }
            float mt = fmaxf(fmaxf(sn[0], sn[1]), fmaxf(sn[2], sn[3]));
            for (int w = 0; w < 8; ++w) mt = fmaxf(mt, part[(w * 16 + hh * 4 + i) * fa::S_PSTR]);
            float lt = 0.f, ot = 0.f;
            for (int w = 0; w < 8; ++w) { const LAS float* pp = part + (w * 16 + hh * 4 + i) * fa::S_PSTR; const float e = __expf(pp[0] - mt); lt += e * pp[1]; ot += e * pp[4 + d]; }
#pragma unroll
            for (int j = 0; j < 4; ++j) { const float e = __expf(sn[j] - mt); lt += e; ot += e * EV[j * 256 + hh * 64 + d]; }
            MIXB[(size_t)(r0 + i) * 1024 + hh * 64 + d] = (bf16)f2bf(ot / lt);
        }
    }
    {
        const int h = wave, g = h >> 2, p = lane;
        const f4* h0 = (const f4*)(st_ssm + (((size_t)b * 8 + h) * 64 + p) * 64);
        f4 hs[16];
#pragma unroll
        for (int n4 = 0; n4 < 16; ++n4) hs[n4] = h0[n4];
        const float A = -expf(alog[h]);
        for (int i = 0; i < 4; ++i) {
            const float dt = EDT[i * 8 + h]; const float dec = expf(dt * A); const float xdt = EX[i * 768 + h * 64 + p] * dt;
            float y = 0.f;
#pragma unroll
            for (int n4 = 0; n4 < 16; ++n4) { const f4 Bv = *(const LAS f4*)(EX + i * 768 + 512 + g * 64 + 4 * n4), Cv = *(const LAS f4*)(EX + i * 768 + 640 + g * 64 + 4 * n4);
                hs[n4] = hs[n4] * dec + Bv * xdt; y += Cv[0] * hs[n4][0] + Cv[1] * hs[n4][1] + Cv[2] * hs[n4][2] + Cv[3] * hs[n4][3]; }
            EYS[i * 512 + h * 64 + p] = y;
        }
        f4* ho = (f4*)(out + O_SSMS + (((size_t)(l * DEC_BATCH + b) * 8 + h) * 64 + p) * 64);
#pragma unroll
        for (int n4 = 0; n4 < 16; ++n4) ho[n4] = hs[n4];
    }
    if (wave < 4) {
        const int h = wave, v = lane;
        const float* s0 = st_gla + ((size_t)b * 4 + h) * 2048;
        float S[32];
#pragma unroll
        for (int k = 0; k < 32; ++k) S[k] = s0[k * 64 + v];
        for (int i = 0; i < 4; ++i) {
            const float* mi = MI + (size_t)(r0 + i) * LDMI;
            const float vv = mi[C_GV + h * 64 + v];
            float o = 0.f;
#pragma unroll
            for (int k4 = 0; k4 < 8; ++k4) { const f4 q4 = *(const f4*)(mi + C_GQ + h * 32 + 4 * k4), k4v = *(const f4*)(mi + C_GK + h * 32 + 4 * k4), g4 = *(const LAS f4*)(EG + i * 128 + h * 32 + 4 * k4);
#pragma unroll
                for (int e = 0; e < 4; ++e) { S[4 * k4 + e] = S[4 * k4 + e] * __expf(g4[e]) + k4v[e] * vv; o += q4[e] * 0.17677669529663687f * S[4 * k4 + e]; } }
            EGO[i * 256 + h * 64 + v] = o;
        }
        float* so = out + O_GLAS + ((size_t)(l * DEC_BATCH + b) * 4 + h) * 2048;
#pragma unroll
        for (int k = 0; k < 32; ++k) so[k * 64 + v] = S[k];
    }
    __syncthreads();
    if (wave < 4) { const int i = wave; const float* mi = MI + (size_t)(r0 + i) * LDMI;
#pragma unroll
        for (int g = 0; g < 2; ++g) { float y[4]; float s = 0.f;
#pragma unroll
            for (int e = 0; e < 4; ++e) { const int c = g * 256 + lane * 4 + e; y[e] = (EYS[i * 512 + c] + EX[i * 768 + c] * dsk[c >> 6]) * mi[C_SZ + c]; s += y[e] * y[e]; }
            const float rs = rsqrtf(wave_sum_l(s, lane) * (1.f / 256.f) + EPS);
            *(uint2*)(MIXB + (size_t)(r0 + i) * 1024 + 256 + g * 256 + lane * 4) = make_uint2(pk2(y[0] * rs * snorm[g * 256 + lane * 4], y[1] * rs * snorm[g * 256 + lane * 4 + 1]), pk2(y[2] * rs * snorm[g * 256 + lane * 4 + 2], y[3] * rs * snorm[g * 256 + lane * 4 + 3])); }
#pragma unroll
        for (int hh = 0; hh < 4; ++hh) { const float o = EGO[i * 256 + hh * 64 + lane]; const float rs = rsqrtf(wave_sum_l(o * o, lane) * (1.f / 64.f) + EPS);
            MIXB[(size_t)(r0 + i) * 1024 + 768 + hh * 64 + lane] = (bf16)f2bf(o * rs * gnorm[lane] * mi[C_GG + hh * 64 + lane]); }
    }
    __syncthreads();
}

constexpr int M_Q = 0, M_K = 16384, M_LF = 32768, M_F = 33024;
__device__ __forceinline__ void meta_unit(const float* MI, const float* qg, const float* kg, const float* fbias, bf16* MIXB, LAS unsigned char* lds, int tid) {
    const int lane = tid & 63, wave = __builtin_amdgcn_readfirstlane(tid >> 6);
    LAS float* MQ = (LAS float*)(lds + M_Q); LAS float* MK = (LAS float*)(lds + M_K); LAS float* MLF = (LAS float*)(lds + M_LF); LAS float* MF = (LAS float*)(lds + M_F);
    for (int j = wave; j < 16; j += 8) { const float* mi = MI + (size_t)(R_META + j) * LDMI;
#pragma unroll
        for (int h = 0; h < 4; ++h) { const float q = mi[C_FQ + h * 64 + lane], k = mi[C_FK + h * 64 + lane];
            const float qs = rsqrtf(wave_sum_l(q * q, lane) * (1.f / 64.f) + EPS), ks = rsqrtf(wave_sum_l(k * k, lane) * (1.f / 64.f) + EPS);
            MQ[j * 256 + h * 64 + lane] = q * qs * qg[lane]; MK[j * 256 + h * 64 + lane] = k * ks * kg[lane]; }
        if (lane < 4) MLF[j * 4 + lane] = log_sigmoidf(mi[C_FF + lane] + fbias[lane]); }
    __syncthreads();
    if (tid < 4) { float F = 0.f; for (int j = 0; j < 16; ++j) { F += MLF[j * 4 + tid]; MF[j * 4 + tid] = F; } }
    __syncthreads();
    for (int pr = wave; pr < 64; pr += 8) { const int h = pr >> 4, j = pr & 15;
        const float qv = MQ[j * 256 + h * 64 + lane];
        float sc[16]; float mx = -INFINITY;
#pragma unroll
        for (int k = 0; k < 16; ++k) { const float s = wave_sum_l(qv * MK[k * 256 + h * 64 + lane], lane) * 0.125f + (MF[j * 4 + h] - MF[k * 4 + h]); sc[k] = k <= j ? s : -INFINITY; mx = fmaxf(mx, sc[k]); }
        float sum = 0.f, o = 0.f;
#pragma unroll
        for (int k = 0; k < 16; ++k) { const float p = __expf(sc[k] - mx); sum += p; o += p * MI[(size_t)(R_META + k) * LDMI + C_FV + h * 64 + lane]; }
        MIXB[(size_t)(R_META + j) * 1024 + h * 64 + lane] = (bf16)f2bf(o / sum); }
    __syncthreads();
}
}

namespace eg {
using fa::bf16x8; using fa::f32x16; using fa::f4; using fa::crow;
template <int K, int NB>
__device__ __forceinline__ f4 egemm_tile(const bf16* A, const bf16* Bt, int row0, int col0, LAS unsigned char* lds, int tid) {
    const int lane = tid & 63, wave = __builtin_amdgcn_readfirstlane(tid >> 6), r32 = lane & 31, hi = lane >> 5;
    constexpr int KW = K / 8, NS = KW / 16, NBAT = (NS + NB - 1) / NB;
    const GAS bf16* ap = (const GAS bf16*)A + (size_t)(row0 + r32) * K + wave * KW + 8 * hi;
    const GAS bf16* bp0 = (const GAS bf16*)Bt + (size_t)(col0 + r32) * K + wave * KW + 8 * hi; const GAS bf16* bp1 = bp0 + (size_t)32 * K;
    f32x16 c0, c1;
#pragma unroll
    for (int i = 0; i < 16; ++i) { c0[i] = 0.f; c1[i] = 0.f; }
    bf16x8 fa_[2][NB], fb0[2][NB], fb1[2][NB];
#define EG_LOAD(buf, bat) do { _Pragma("unroll") for (int j = 0; j < NB; ++j) if ((bat) * NB + j < NS) { fa_[buf][j] = *(const GAS bf16x8*)(ap + ((bat) * NB + j) * 16); fb0[buf][j] = *(const GAS bf16x8*)(bp0 + ((bat) * NB + j) * 16); fb1[buf][j] = *(const GAS bf16x8*)(bp1 + ((bat) * NB + j) * 16); } } while (0)
#define EG_MMA(buf, bat) do { _Pragma("unroll") for (int j = 0; j < NB; ++j) if ((bat) * NB + j < NS) { c0 = __builtin_amdgcn_mfma_f32_32x32x16_bf16(fa_[buf][j], fb0[buf][j], c0, 0, 0, 0); c1 = __builtin_amdgcn_mfma_f32_32x32x16_bf16(fa_[buf][j], fb1[buf][j], c1, 0, 0, 0); } } while (0)
    EG_LOAD(0, 0);
#pragma unroll
    for (int bat = 0; bat < NBAT; ++bat) { if (bat + 1 < NBAT) { if ((bat + 1) & 1) EG_LOAD(1, bat + 1); else EG_LOAD(0, bat + 1); } if (bat & 1) EG_MMA(1, bat); else EG_MMA(0, bat); }
#undef EG_LOAD
#undef EG_MMA
    LAS float* red = (LAS float*)lds + wave * 2048;
#pragma unroll
    for (int i = 0; i < 16; ++i) { red[crow(i, hi) * 64 + r32] = c0[i]; red[crow(i, hi) * 64 + 32 + r32] = c1[i]; }
    __syncthreads();
    const LAS float* rp = (const LAS float*)lds + (tid >> 4) * 64 + (tid & 15) * 4;
    f4 s = *(const LAS f4*)rp;
#pragma unroll
    for (int w = 1; w < 8; ++w) s += *(const LAS f4*)(rp + w * 2048);
    __syncthreads();
    return s;
}
template <int K, int NB>
__device__ __forceinline__ void egemm_resid(const bf16* A, const bf16* Bt, float* X, bf16* XB, float* SSQP, float scale, float* out, int final_, LAS unsigned char* lds, int tid) {
    const int lane = tid & 63, wave = __builtin_amdgcn_readfirstlane(tid >> 6), r32 = lane & 31, hi = lane >> 5;
    constexpr int KW = K / 8, NS = KW / 16, NBAT = (NS + NB - 1) / NB;
    for (int u = blockIdx.x; u < 11 * 16; u += gridDim.x) {
        const int rt = u >> 4, ct = u & 15, row0 = MP + 48 * rt, col0 = 64 * ct;
        const int ra = row0 + (tid >> 4), col = col0 + (tid & 15) * 4; const bool hasb = (tid >> 4) < 16;
        GAS f4* xpa = (GAS f4*)(X + (size_t)ra * 1024 + col); GAS f4* xpb = (GAS f4*)(X + (size_t)(ra + 32) * 1024 + col);
        f4 xa = *xpa, xb = *xpb;
        const GAS bf16* ap0 = (const GAS bf16*)A + (size_t)(row0 + r32) * K + wave * KW + 8 * hi; const GAS bf16* ap1 = ap0 + (size_t)32 * K;
        const GAS bf16* bp0 = (const GAS bf16*)Bt + (size_t)(col0 + r32) * K + wave * KW + 8 * hi; const GAS bf16* bp1 = bp0 + (size_t)32 * K;
        f32x16 c00, c01, c10, c11;
#pragma unroll
        for (int i = 0; i < 16; ++i) { c00[i] = 0.f; c01[i] = 0.f; c10[i] = 0.f; c11[i] = 0.f; }
        constexpr int QB = 4, NQ = (NS + QB - 1) / QB;
        bf16x8 fa0[2][QB], fa1[2][QB], fb0[2][QB], fb1[2][QB];
#define EGR_LOAD(buf, bat) do { \
            _Pragma("unroll") for (int j = 0; j < QB; ++j) if ((bat) * QB + j < NS) fa0[buf][j] = *(const GAS bf16x8*)(ap0 + ((bat) * QB + j) * 16); \
            _Pragma("unroll") for (int j = 0; j < QB; ++j) if ((bat) * QB + j < NS) fb0[buf][j] = *(const GAS bf16x8*)(bp0 + ((bat) * QB + j) * 16); \
            _Pragma("unroll") for (int j = 0; j < QB; ++j) if ((bat) * QB + j < NS) fa1[buf][j] = *(const GAS bf16x8*)(ap1 + ((bat) * QB + j) * 16); \
            _Pragma("unroll") for (int j = 0; j < QB; ++j) if ((bat) * QB + j < NS) fb1[buf][j] = *(const GAS bf16x8*)(bp1 + ((bat) * QB + j) * 16); } while (0)
#define EGR_MMA(buf, bat) do { _Pragma("unroll") for (int j = 0; j < QB; ++j) if ((bat) * QB + j < NS) { \
            c00 = __builtin_amdgcn_mfma_f32_32x32x16_bf16(fa0[buf][j], fb0[buf][j], c00, 0, 0, 0); c01 = __builtin_amdgcn_mfma_f32_32x32x16_bf16(fa0[buf][j], fb1[buf][j], c01, 0, 0, 0); \
            c10 = __builtin_amdgcn_mfma_f32_32x32x16_bf16(fa1[buf][j], fb0[buf][j], c10, 0, 0, 0); c11 = __builtin_amdgcn_mfma_f32_32x32x16_bf16(fa1[buf][j], fb1[buf][j], c11, 0, 0, 0); } } while (0)
        EGR_LOAD(0, 0);
#pragma unroll
        for (int bat = 0; bat < NQ; ++bat) {
            if (bat + 1 < NQ) { if ((bat + 1) & 1) EGR_LOAD(1, bat + 1); else EGR_LOAD(0, bat + 1); }
            if (bat & 1) EGR_MMA(1, bat); else EGR_MMA(0, bat);
        }
#undef EGR_LOAD
#undef EGR_MMA
        LAS float* red = (LAS float*)lds + wave * 4096;
#pragma unroll
        for (int i = 0; i < 16; ++i) { red[crow(i, hi) * 64 + r32] = c00[i]; red[crow(i, hi) * 64 + 32 + r32] = c01[i]; red[(32 + crow(i, hi)) * 64 + r32] = c10[i]; red[(32 + crow(i, hi)) * 64 + 32 + r32] = c11[i]; }
        __syncthreads();
        const LAS float* rp = (const LAS float*)lds + (tid >> 4) * 64 + (tid & 15) * 4;
        f4 sa = *(const LAS f4*)rp, sb = *(const LAS f4*)(rp + 32 * 64);
#pragma unroll
        for (int w = 1; w < 8; ++w) { sa += *(const LAS f4*)(rp + w * 4096); sb += *(const LAS f4*)(rp + w * 4096 + 32 * 64); }
        __syncthreads();
#pragma unroll
        for (int hb = 0; hb < 2; ++hb) {
            if (hb == 1 && !hasb) break;
            const int row = hb ? ra + 32 : ra; f4 x = hb ? xb : xa; const f4 acc = hb ? sb : sa;
            x[0] += acc[0] * scale; x[1] += acc[1] * scale; x[2] += acc[2] * scale; x[3] += acc[3] * scale;
            *(hb ? xpb : xpa) = x;
            *(GAS la::u2v*)(XB + (size_t)row * 1024 + col) = (la::u2v){fa::cvtpk(x[0], x[1]), fa::cvtpk(x[2], x[3])};
            const float ss = fa::row16_sum((x[0] * x[0] + x[1] * x[1]) + (x[2] * x[2] + x[3] * x[3]));
            if ((tid & 15) == 0) SSQP[(size_t)row * 16 + ct] = ss;
            if (final_ && row < R_META) *(GAS f4*)(out + O_YS + (size_t)(row - R_S) * 1024 + col) = x;
        }
    }
}
}

namespace sm {
using fa::bf16x8; using fa::f32x16; using fa::crow;
__device__ __forceinline__ void smalls_gemm(const bf16* XB, const bf16* Wt, const float* SSQP, float* MI, float* LF, const float* fbias, float* out, int l, LAS unsigned char* lds, int tid, int u0, int ustep, int uend) {
    const int lane = tid & 63, wave = __builtin_amdgcn_readfirstlane(tid >> 6), r32 = lane & 31, hi = lane >> 5;
    constexpr int NU = (M_REAL + 31) / 32;
    const GAS bf16* bp = (const GAS bf16*)Wt + (size_t)r32 * 1024 + wave * 128 + 8 * hi;
    const GAS bf16* ap = (const GAS bf16*)XB + (size_t)r32 * 1024 + wave * 128 + 8 * hi;
    bf16x8 fa_[8], fb_[8];
    if (u0 < uend) {
#pragma unroll
        for (int j = 0; j < 8; ++j) fa_[j] = *(const GAS bf16x8*)(ap + (size_t)u0 * 32 * 1024 + 16 * j);
#pragma unroll
        for (int j = 0; j < 8; ++j) fb_[j] = *(const GAS bf16x8*)(bp + 16 * j); }
    for (int u = u0; u < uend; u += ustep) {
        const int row0 = 32 * u;
        f32x16 c;
#pragma unroll
        for (int i = 0; i < 16; ++i) c[i] = 0.f;
#pragma unroll
        for (int j = 0; j < 8; ++j) c = __builtin_amdgcn_mfma_f32_32x32x16_bf16(fa_[j], fb_[j], c, 0, 0, 0);
        if (u + ustep < uend) {
#pragma unroll
            for (int j = 0; j < 8; ++j) fa_[j] = *(const GAS bf16x8*)(ap + (size_t)(u + ustep) * 32 * 1024 + 16 * j); }
        const float rs = pg8::rstd_of(SSQP, row0 + (tid >> 4));
        LAS float* red = (LAS float*)lds + wave * 1024;
#pragma unroll
        for (int i = 0; i < 16; ++i) red[crow(i, hi) * 32 + r32] = c[i];
        __syncthreads();
        const int rr = tid >> 4, c0 = (tid & 15) * 2; const int row = row0 + rr;
        float v0 = 0.f, v1 = 0.f;
#pragma unroll
        for (int w = 0; w < 8; ++w) { v0 += ((const LAS float*)lds)[w * 1024 + rr * 32 + c0]; v1 += ((const LAS float*)lds)[w * 1024 + rr * 32 + c0 + 1]; }
        __syncthreads();
        v0 *= rs; v1 *= rs;
        if (c0 < 28) { MI[(size_t)row * LDMI + small2ref(c0)] = v0; MI[(size_t)row * LDMI + small2ref(c0 + 1)] = v1; }
        if (c0 < 4 && row < M_REAL) {
            const float x0 = v0 + fbias[c0], x1 = v1 + fbias[c0 + 1];
            const float l0 = fminf(x0, 0.f) - log1pf(__expf(-fabsf(x0))), l1 = fminf(x1, 0.f) - log1pf(__expf(-fabsf(x1)));
            LF[(size_t)row * 4 + c0] = l0; LF[(size_t)row * 4 + c0 + 1] = l1;
            if (row < MP) { float* o = out + O_LFP + ((size_t)(l * BATCH + (row >> 11)) * TP + 16 + (row & 2047)) * 4 + c0; o[0] = l0; o[1] = l1; }
            else if (row < R_META) { float* o = out + O_LFS + ((size_t)l * MS + (row - R_S)) * 4 + c0; o[0] = l0; o[1] = l1; }
            else for (int cc = 0; cc < BATCH; ++cc) { float* o = out + O_LFP + ((size_t)(l * BATCH + cc) * TP + (row - R_META)) * 4 + c0; o[0] = l0; o[1] = l1; }
        }
    }
}
}

struct Args { const float* in[31]; float* out; unsigned char* ws; int ph_lo, ph_hi; };

__device__ __forceinline__ void transpose_item(const float* W, int ldw, int K, const float* g, bf16* WT, int mapkind, int nblk, int item, LAS float* scr, int lane) {
    const int kb = item / nblk, nb = item % nblk, k0 = 64 * kb, n0 = 32 * nb;
    const int kr = lane >> 3, n4 = (lane & 7) * 4;
    const int nd = n0 + n4;
    int src;
    if (mapkind == 1) { const int pn = nd >> 8, s = nd & 255; src = s < 128 ? 128 * pn + s : 2816 + 128 * pn + (s - 128); }
    else if (mapkind == 2) { const int pn = nd >> 8, sl = nd & 255; src = pn < 3 ? 256 * pn + 64 * ((sl >> 5) & 3) + 32 * (sl >> 7) + (sl & 31) : main2ref(nd); if (src >= ldw) src = -1; }
    else if (mapkind == 3) src = small2ref(nd);
    else src = nd < ldw ? nd : -1;
    typedef float f4t __attribute__((ext_vector_type(4)));
    f4t wv[8];
#pragma unroll
    for (int i = 0; i < 8; ++i) wv[i] = __builtin_nontemporal_load((const f4t*)(W + (size_t)(k0 + kr + 8 * i) * ldw + (src >= 0 ? src : 0)));
#pragma unroll
    for (int i = 0; i < 8; ++i) { const int kk = kr + 8 * i; const float gv = g ? g[k0 + kk] : 1.f;
#pragma unroll
        for (int e = 0; e < 4; ++e) scr[kk * 33 + n4 + e] = src >= 0 ? wv[i][e] * gv : 0.f; }
    LDS_WAIT();
    const int c = lane & 7;
#pragma unroll
    for (int j = 0; j < 4; ++j) { const int n = (lane >> 3) + 8 * j; const LAS float* s = scr + (8 * c) * 33 + n;
        v4u o; o.x = pk2(s[0 * 33], s[1 * 33]); o.y = pk2(s[2 * 33], s[3 * 33]); o.z = pk2(s[4 * 33], s[5 * 33]); o.w = pk2(s[6 * 33], s[7 * 33]);
        *(v4u*)(WT + (size_t)(n0 + n) * K + k0 + 8 * c) = o; }
    LDS_WAIT();
}

template <class T> __device__ __forceinline__ T* as_global(T* p) { return (T*)(__attribute__((address_space(1))) T*)p; }
__device__ __forceinline__ int tid_now(int wave_s) { int t; asm volatile("v_mbcnt_lo_u32_b32 %0, -1, 0\n\tv_mbcnt_hi_u32_b32 %0, -1, %0" : "=v"(t)); return t | (wave_s << 6); }
__global__ void __launch_bounds__(NWAVES * 64, 2) fwd(Args args) {
    extern __shared__ __attribute__((aligned(16))) unsigned char lds[];
    volatile LAS unsigned* MISC = (volatile LAS unsigned*)((LAS unsigned char*)lds + MISC_OFF);
    if (threadIdx.x < 32) MISC[threadIdx.x] = 0u;
    __syncthreads();
    XcdBarrier bar = xcd_barrier_post((unsigned*)(args.ws + WS_CTL) + CW_BAR, MISC + 8);
    volatile LAS unsigned long long* PT = (volatile LAS unsigned long long*)((LAS unsigned char*)lds + MISC_OFF + 256);
    if (threadIdx.x < 31) PT[threadIdx.x] = (unsigned long long)args.in[threadIdx.x];
    __syncthreads();
#define INP(i) ((const float*)(const GAS float*)PT[i])
    const int lo = args.ph_lo, hi = args.ph_hi;
    const int wave_s = __builtin_amdgcn_readfirstlane((int)threadIdx.x >> 6);
    int ph = 0;
#define BUF(name, off) float* name = (float*)(ws_ + (off))
#define BUFH(name, off) bf16* name = (bf16*)(ws_ + (off))
#define PHASE_BEGIN_R(R) if (lo <= ph && ph < hi) for (int rep_ = 0; rep_ < (R); ++rep_) { GAS unsigned char* wsg_ = (GAS unsigned char*)args.ws; GAS float* outg_ = (GAS float*)args.out; int tid = tid_now(wave_s); asm volatile("" : "+s"(wsg_), "+s"(outg_)); unsigned char* ws_ = (unsigned char*)wsg_;         \
        const int lane = tid & 63, wave = tid >> 6; const int gw = blockIdx.x * NWAVES + wave, NGW = gridDim.x * NWAVES; float* smem = (float*)lds; float* out = (float*)outg_; (void)lane; (void)wave; (void)gw; (void)NGW; (void)smem; (void)out; \
        BUF(X, WS_X); BUFH(XB, WS_XB); BUF(SSQP, WS_SSQ); BUFH(HB, WS_HB); BUFH(MIXB, WS_MIXB); BUF(MI, WS_MI); BUF(QN, WS_QN); BUF(KN, WS_KN); BUF(LF, WS_LF); BUF(FC, WS_FC); BUF(FCS, WS_FCS); \
        BUF(XBC, WS_XBC); BUF(DTB, WS_DT); BUF(GLOG, WS_GLOG); BUF(YS, WS_YS); BUF(GO, WS_GO); BUFH(QF, WS_QF); BUFH(KF, WS_KF); BUFH(VT, WS_VT); BUF(SSQH, WS_SSQH); BUFH(XC, WS_XC); BUFH(MIB, WS_MIB); (void)MIB; (void)QF; (void)KF; (void)VT; (void)SSQH; (void)XC; \
        (void)X; (void)XB; (void)SSQP; (void)HB; (void)MIXB; (void)MI; (void)QN; (void)KN; (void)LF; (void)FC; (void)FCS; (void)XBC; (void)DTB; (void)GLOG; (void)YS; (void)GO;
#define PHASE_END_R(R) if (ph + 1 < hi || rep_ + 1 < (R)) xcd_barrier(bar, tid_now(wave_s)); } ++ph;
#define PHASE_BEGIN PHASE_BEGIN_R(1)
#define PHASE_END PHASE_END_R(1)
#define WT_(l, off) ((bf16*)(ws_ + WS_WT + (size_t)(l) * WL_SIZE + (off)))

#define CONVERT_ITEM(it_, scr_, ln_) do { constexpr int I1 = 16 * 176, I2 = 44 * 32, I3 = 16 * 88, I4 = 16 * 32, I7 = 16, IL = 2 * I1 + 2 * I2 + I3 + I4 + I7; static_assert(IL == 10384, "item space"); \
        const int lw = (it_) / IL; int r = (it_) % IL; \
        if (r < I1) { transpose_item(INP(11) + (size_t)lw * 1024 * 5632, 5632, 1024, INP(10) + lw * 1024, WT_(lw, WL_W1), 1, 176, r, scr_, ln_); break; } r -= I1; \
        if (r < I2) { transpose_item(INP(12) + (size_t)lw * 2816 * 1024, 1024, 2816, nullptr, WT_(lw, WL_W2), 0, 32, r, scr_, ln_); break; } r -= I2; \
        if (r < I3) { transpose_item(INP(14) + (size_t)lw * 1024 * N_IN, N_IN, 1024, INP(13) + lw * 1024, WT_(lw, WL_W3), 2, 88, r, scr_, ln_); break; } r -= I3; \
        if (r < I4) { transpose_item(INP(27) + (size_t)lw * 1024 * 1024, 1024, 1024, nullptr, WT_(lw, WL_W4), 0, 32, r, scr_, ln_); break; } r -= I4; \
        if (r < I1) { transpose_item(INP(29) + (size_t)lw * 1024 * 5632, 5632, 1024, INP(28) + lw * 1024, WT_(lw, WL_W5), 1, 176, r, scr_, ln_); break; } r -= I1; \
        if (r < I2) { transpose_item(INP(30) + (size_t)lw * 2816 * 1024, 1024, 2816, nullptr, WT_(lw, WL_W6), 0, 32, r, scr_, ln_); break; } r -= I2; \
        transpose_item(INP(14) + (size_t)lw * 1024 * N_IN, N_IN, 1024, INP(13) + lw * 1024, WT_(lw, WL_W7), 3, 1, r, scr_, ln_); } while (0)
#define CONVERT_RANGE(lo_, hi_, gwv_, ngwv_) do { const int tn_ = tid_now(wave_s); const int lnr_ = tn_ & 63; LAS float* scrr_ = (LAS float*)((LAS unsigned char*)lds + wave_s * 16384); \
        for (int itr_ = (lo_) + (gwv_); itr_ < (hi_); itr_ += (ngwv_)) CONVERT_ITEM(itr_, scrr_, lnr_); } while (0)
#define CONVERT_TAIL(lo_, hi_, first_) do { if (gridDim.x == 256) { if ((int)blockIdx.x >= (first_)) CONVERT_RANGE(lo_, hi_, ((int)blockIdx.x - (first_)) * NWAVES + wave_s, (256 - (first_)) * NWAVES); } \
        else CONVERT_RANGE(lo_, hi_, (int)blockIdx.x * NWAVES + wave_s, (int)gridDim.x * NWAVES); } while (0)
    PHASE_BEGIN_R(R_P0)
        CONVERT_RANGE(0, 2816, gw, NGW);
        for (int i = blockIdx.x * 512 + tid; i < 2 * 12288; i += gridDim.x * 512) { const int j = i % 12288;
            if (i < 12288) { const int bh = j / 384, sl = (j % 384) >> 3, ch = j & 7; *(v4u*)(KF + ((size_t)bh * 2112 + 16 + sl) * 64 + ch * 8) = (v4u){0u, 0u, 0u, 0u}; }
            else { const int bh = j / 384, d = (j % 384) / 6, ch = j % 6; *(v4u*)(VT + ((size_t)bh * 64 + d) * 2112 + 16 + ch * 8) = (v4u){0u, 0u, 0u, 0u}; } }
        for (int r0 = gw * 2; r0 < M_PAD; r0 += NGW * 2) {
            float4 v[2][4];
#pragma unroll
            for (int q = 0; q < 2; ++q) { const int r = r0 + q;
                const float* src = r < MP ? INP(0) + (size_t)r * 1024 : r < R_META ? INP(1) + (size_t)(r - R_S) * 1024 : r < M_REAL ? INP(9) + (size_t)(r - R_META) * 1024 : nullptr;
#pragma unroll
                for (int j = 0; j < 4; ++j) v[q][j] = src ? ((const float4*)src)[lane + 64 * j] : make_float4(0.f, 0.f, 0.f, 0.f); }
#pragma unroll
            for (int q = 0; q < 2; ++q) { const int r = r0 + q;
                float4* o = (float4*)(X + (size_t)r * 1024) + lane; uint2* ob = (uint2*)(XB + (size_t)r * 1024) + lane; float s = 0.f;
#pragma unroll
                for (int j = 0; j < 4; ++j) { const float4 w = v[q][j]; if (r >= MP) o[64 * j] = w; ob[64 * j] = make_uint2(pk2(w.x, w.y), pk2(w.z, w.w)); s += (w.x * w.x + w.y * w.y) + (w.z * w.z + w.w * w.w); }
                s = wave_sum(s);
                if (lane < 16) SSQP[(size_t)r * 16 + lane] = lane == 0 ? s : 0.f;
                if (r >= M_REAL) { uint2* m = (uint2*)(MIXB + (size_t)r * 1024) + lane;
#pragma unroll
                    for (int j = 0; j < 4; ++j) m[64 * j] = make_uint2(0u, 0u); } }
        }
    PHASE_END_R(R_P0)

    for (int l = 0; l < DEPTH; ++l) {
#define mix_norm (INP(13) + l * 1024)
#define fox_q_norm (INP(15) + l * 64)
#define fox_k_norm (INP(16) + l * 64)
#define fox_f_bias (INP(17) + l * 4)
#define conv_w (INP(18) + l * 4 * 768)
#define conv_b (INP(19) + l * 768)
#define dt_bias (INP(20) + l * 8)
#define a_log (INP(21) + l * 8)
#define ssd_d (INP(22) + l * 8)
#define ssd_norm (INP(23) + l * 512)
#define w_gate (INP(24) + l * 16 * 128)
#define gate_bias (INP(25) + l * 128)
#define gla_norm (INP(26) + l * 64)
#define cache_k (INP(2))
#define cache_v (INP(3))
#define cache_lf (INP(4))
#define state_ssm (INP(5) + (size_t)l * DEC_BATCH * 8 * 4096)
#define state_conv (INP(6) + (size_t)l * DEC_BATCH * 3 * 768)
#define state_gla (INP(7) + (size_t)l * DEC_BATCH * 4 * 2048)
#define pt ((const int*)INP(8))
        for (int half = 0; half < 2; ++half) {
            PHASE_BEGIN_R(R_G1) { pg8::Gemm g{XB, WT_(l, half ? WL_W5 : WL_W1), M_PAD, 5632, 1024}; pg8::StaticOrder S; S.init(M_PAD, 5632, (int)gridDim.x, (int)blockIdx.x);
                pg8::EpiSwiglu E{HB, SSQP}; pg8::gemm_phase<pg8::EpiSwiglu, pg8::StaticOrder, true, true>((LAS unsigned char*)lds, g, S, E, tid);
                if (l == 0 && half == 0) {
                    if (gridDim.x == 256) { if (blockIdx.x >= 194) CONVERT_RANGE(2816, 4224, ((int)blockIdx.x - 194) * NWAVES + wave_s, 62 * NWAVES); }
                    else CONVERT_RANGE(2816, 4224, (int)blockIdx.x * NWAVES + wave_s, (int)gridDim.x * NWAVES); }
                if (l == 0 && half == 1) CONVERT_TAIL(8960, 10368, 194);
                if (l == 1 && half == 0) CONVERT_TAIL(10384 + 2816, 10384 + 4224, 194);
                if (l == 1 && half == 1) CONVERT_TAIL(10384 + 8960, 10384 + 10368, 194);
                } PHASE_END_R(R_G1)
            PHASE_BEGIN { pg8::Gemm g{HB, WT_(l, half ? WL_W6 : WL_W2), MP, 1024, 2816}; pg8::StaticOrder S; S.init(MP, 1024, (int)gridDim.x, (int)blockIdx.x);
                pg8::EpiResid E{(const GAS float*)nullptr, X, XB, SSQP, 0.5f, out, (l == DEPTH - 1 && half == 1) ? 1 : 0};     pg8::gemm_phase<pg8::EpiResid, pg8::StaticOrder, true, true>((LAS unsigned char*)lds, g, S, E, tid);
                eg::egemm_resid<2816, 8>(HB, WT_(l, half ? WL_W6 : WL_W2), X, XB, SSQP, 0.5f, out, (l == DEPTH - 1 && half == 1) ? 1 : 0, (LAS unsigned char*)lds, tid_now(wave_s));
                if (l == 0 && half == 0) {
                    if (gridDim.x == 256) { if (blockIdx.x >= 176) { CONVERT_RANGE(4224, 5632, ((int)blockIdx.x - 176) * NWAVES + wave_s, 80 * NWAVES); CONVERT_RANGE(10368, 10384, ((int)blockIdx.x - 176) * NWAVES + wave_s, 80 * NWAVES); } }
                    else { CONVERT_RANGE(4224, 5632, (int)blockIdx.x * NWAVES + wave_s, (int)gridDim.x * NWAVES); CONVERT_RANGE(10368, 10384, (int)blockIdx.x * NWAVES + wave_s, (int)gridDim.x * NWAVES); } }     } PHASE_END
            if (half == 1) break;

            PHASE_BEGIN_R(R_G3) { pg8::Gemm g{XB, WT_(l, WL_W3), M_PAD, N_MAIN, 1024}; pg8::StaticOrder S; S.init(M_PAD, N_MAIN, (int)gridDim.x, (int)blockIdx.x);
                pg8::EpiMix E{MI, MIB, SSQP, QF, KF, VT, fox_q_norm, fox_k_norm, fox_f_bias, LF, out, l}; pg8::gemm_phase<pg8::EpiMix, pg8::StaticOrder, true, true>((LAS unsigned char*)lds, g, S, E, tid);
                {
                    constexpr int NUS = (M_REAL + 31) / 32; int u0 = blockIdx.x, us = gridDim.x, ue = NUS;
                    if (gridDim.x == 256) { if (blockIdx.x >= 225) { u0 = (int)blockIdx.x - 225; us = 31; ue = 310; } else { u0 = 310 + (int)blockIdx.x; us = 1024; } }
                    sm::smalls_gemm(XB, WT_(l, WL_W7), SSQP, MI, LF, fox_f_bias, out, l, (LAS unsigned char*)lds, tid_now(wave_s), u0, us, ue); }
                if (l == 0) {
                    if (gridDim.x == 256) { if (blockIdx.x >= 225) CONVERT_RANGE(5632, 6144, ((int)blockIdx.x - 225) * NWAVES + wave_s, 31 * NWAVES); }
                    else CONVERT_RANGE(5632, 6144, (int)blockIdx.x * NWAVES + wave_s, (int)gridDim.x * NWAVES); } } PHASE_END_R(R_G3)
            PHASE_BEGIN
            {
                typedef float f4v __attribute__((ext_vector_type(4)));
                LAS float* lrs = (LAS float*)((LAS unsigned char*)lds + wave * 1024);
                for (int blk = gw; blk < (NGW == 2048 ? 2048 : 2048 + 2); blk += NGW) {
                    const bool isP = blk < 2048; const int bb = blk >> 8, i0 = isP ? 8 * (blk & 255) : 8 * (blk - 2048);
                    const int rowb = isP ? bb * 2048 + i0 : R_META + i0;
                    f4v u[3][11];
#pragma unroll
                    for (int j = 0; j < 11; ++j) { const int i = i0 + j - 3; int pr;
                        if (isP) pr = i >= 0 ? bb * 2048 + i : R_META + 16 + i; else pr = i >= 0 ? R_META + i : -1;
#pragma unroll
                        for (int k = 0; k < 3; ++k) { const uint2 w = *(const uint2*)(MIB + (size_t)(pr >= 0 ? pr : 0) * N_MAIN + CM_XBC + 4 * (lane + 64 * k));
                            const f4v v = (f4v){__uint_as_float(w.x << 16), __uint_as_float(w.x & 0xffff0000u), __uint_as_float(w.y << 16), __uint_as_float(w.y & 0xffff0000u)}; u[k][j] = pr >= 0 ? v : (f4v){0.f, 0.f, 0.f, 0.f}; } }
                    const f4v lrv = lane < 32 ? *(const f4v*)(MI + (size_t)(rowb + (lane >> 2)) * LDMI + C_LR + 4 * (lane & 3)) : (f4v){0.f, 0.f, 0.f, 0.f};
                    const float dtr = MI[(size_t)(rowb + (lane >> 3)) * LDMI + C_DT + (lane & 7)];
                    if (lane < 32) *(LAS f4v*)(lrs + (lane >> 2) * 16 + 4 * (lane & 3)) = lrv;
                    DTB[(size_t)(rowb + (lane >> 3)) * 8 + (lane & 7)] = softplusf(dtr + dt_bias[lane & 7]);
#pragma unroll
                    for (int k = 0; k < 3; ++k) { const int col = 4 * (lane + 64 * k);
                        const f4v w0 = *(const f4v*)(conv_w + col), w1 = *(const f4v*)(conv_w + 768 + col), w2 = *(const f4v*)(conv_w + 2 * 768 + col), w3 = *(const f4v*)(conv_w + 3 * 768 + col), bs = *(const f4v*)(conv_b + col);
#pragma unroll
                        for (int j = 0; j < 8; ++j) { const f4v o = w3 * u[k][j + 3] + w2 * u[k][j + 2] + w1 * u[k][j + 1] + w0 * u[k][j] + bs;
                            *(uint2*)(XC + (size_t)(rowb + j) * 768 + col) = make_uint2(fa::cvtpk(pg8::silu_fast(o[0]), pg8::silu_fast(o[1])), fa::cvtpk(pg8::silu_fast(o[2]), pg8::silu_fast(o[3]))); } }
                    LDS_WAIT();
                    float wc0[16], wc1[16];
#pragma unroll
                    for (int r = 0; r < 16; ++r) { wc0[r] = w_gate[r * 128 + lane]; wc1[r] = w_gate[r * 128 + 64 + lane]; }
                    const float gb0 = gate_bias[lane], gb1 = gate_bias[64 + lane];
#pragma unroll
                    for (int j = 0; j < 8; ++j) { float a0 = gb0, a1 = gb1;
#pragma unroll
                        for (int r4 = 0; r4 < 4; ++r4) { const f4v x = *(const LAS f4v*)(lrs + j * 16 + 4 * r4);
                            a0 += x[0] * wc0[4 * r4] + x[1] * wc0[4 * r4 + 1] + x[2] * wc0[4 * r4 + 2] + x[3] * wc0[4 * r4 + 3]; a1 += x[0] * wc1[4 * r4] + x[1] * wc1[4 * r4 + 1] + x[2] * wc1[4 * r4 + 2] + x[3] * wc1[4 * r4 + 3]; }
                        GLOG[(size_t)(rowb + j) * 128 + lane] = (fminf(a0, 0.f) - __logf(1.0f + __expf(-fabsf(a0)))) * (1.0f / 16.0f);
                        GLOG[(size_t)(rowb + j) * 128 + 64 + lane] = (fminf(a1, 0.f) - __logf(1.0f + __expf(-fabsf(a1)))) * (1.0f / 16.0f); }
                    LDS_WAIT();
                }
                if (NGW == 2048 && gw < 16) {
                    const int m = gw, row = R_META + m;
                    f4v um[3][4];
#pragma unroll
                    for (int j = 0; j < 4; ++j) { const int i = m + j - 3;
#pragma unroll
                        for (int k = 0; k < 3; ++k) { const uint2 w = *(const uint2*)(MIB + (size_t)(R_META + (i >= 0 ? i : 0)) * N_MAIN + CM_XBC + 4 * (lane + 64 * k));
                            const f4v v = (f4v){__uint_as_float(w.x << 16), __uint_as_float(w.x & 0xffff0000u), __uint_as_float(w.y << 16), __uint_as_float(w.y & 0xffff0000u)}; um[k][j] = i >= 0 ? v : (f4v){0.f, 0.f, 0.f, 0.f}; } }
                    if (lane < 8) DTB[(size_t)row * 8 + lane] = softplusf(MI[(size_t)row * LDMI + C_DT + lane] + dt_bias[lane]);
#pragma unroll
                    for (int k = 0; k < 3; ++k) { const int col = 4 * (lane + 64 * k);
                        const f4v w0 = *(const f4v*)(conv_w + col), w1 = *(const f4v*)(conv_w + 768 + col), w2 = *(const f4v*)(conv_w + 2 * 768 + col), w3 = *(const f4v*)(conv_w + 3 * 768 + col), bs = *(const f4v*)(conv_b + col);
                        const f4v o = w3 * um[k][3] + w2 * um[k][2] + w1 * um[k][1] + w0 * um[k][0] + bs;
                        *(uint2*)(XC + (size_t)row * 768 + col) = make_uint2(fa::cvtpk(pg8::silu_fast(o[0]), pg8::silu_fast(o[1])), fa::cvtpk(pg8::silu_fast(o[2]), pg8::silu_fast(o[3]))); }
                    float a0 = gate_bias[lane], a1 = gate_bias[64 + lane];
#pragma unroll
                    for (int r = 0; r < 16; ++r) { const float x = MI[(size_t)row * LDMI + C_LR + r]; a0 += x * w_gate[r * 128 + lane]; a1 += x * w_gate[r * 128 + 64 + lane]; }
                    GLOG[(size_t)row * 128 + lane] = (fminf(a0, 0.f) - __logf(1.0f + __expf(-fabsf(a0)))) * (1.0f / 16.0f);
                    GLOG[(size_t)row * 128 + 64 + lane] = (fminf(a1, 0.f) - __logf(1.0f + __expf(-fabsf(a1)))) * (1.0f / 16.0f);
                }
            }
            PHASE_END
            PHASE_BEGIN_R(R_MIX)
            {
                volatile LAS unsigned* qslot = (volatile LAS unsigned*)((LAS unsigned char*)lds + MISC_OFF + 64);
                unsigned* qhead = (unsigned*)(ws_ + WS_CTL) + CW_Q + 64 * l + 8 * rep_; unsigned* ssd_done = qhead + 4;
                constexpr int U_SSDP = 0, U_GLAP = 64, U_SAMP = 96, U_PATT = 224, U_META = 480, U_END = 481;
                for (;;) {
                    __syncthreads();
                    if (tid == 0) *qslot = atomicAdd(qhead, 1u);
                    __syncthreads();
                    const int u = (int)*qslot;
                    constexpr int N_CVU = (10384 + 15) / 16;
                    if (u >= U_END) {
                        const int nfill = l == 0 ? N_CVU : 0;
                        if (u >= U_END + nfill) {
                            const int pj = u - U_END - nfill; if (pj >= 129) break;
                            if (tid == 0) { unsigned sp = 0u;
                                while (__hip_atomic_load(ssd_done, __ATOMIC_RELAXED, __HIP_MEMORY_SCOPE_AGENT) < 64u) { __builtin_amdgcn_s_sleep(16); if (++sp > (1u << 22)) break; }
                                __builtin_amdgcn_fence(__ATOMIC_ACQUIRE, "agent"); asm volatile("s_waitcnt vmcnt(0)" ::: "memory"); }
                            __syncthreads();
                            const int ln = tid_now(wave_s) & 63;
                            const float4 gn0 = *(const float4*)(ssd_norm + ln * 4), gn1 = *(const float4*)(ssd_norm + 256 + ln * 4);
                            const int nst = pj < 128 ? 4 : (wave_s < 4 ? 1 : 0);
                            for (int st = 0; st < nst; ++st) {
                                const int r0 = pj < 128 ? pj * 128 + wave_s * 16 + 4 * st : R_META + 4 * wave_s;
                                uint2 w[4][2]; float4 q[4][2];
#pragma unroll
                                for (int j = 0; j < 4; ++j) { const size_t r = (size_t)(r0 + j);
                                    q[j][0] = *(const float4*)(SSQH + r * 8); q[j][1] = *(const float4*)(SSQH + r * 8 + 4);
                                    w[j][0] = *(const uint2*)(MIXB + r * 1024 + 256 + ln * 4); w[j][1] = *(const uint2*)(MIXB + r * 1024 + 512 + ln * 4); }
#pragma unroll
                                for (int j = 0; j < 4; ++j) { const size_t r = (size_t)(r0 + j);
#pragma unroll
                                    for (int g = 0; g < 2; ++g) { const float4 qq = q[j][g]; const float rs = rsqrtf((qq.x + qq.y + qq.z + qq.w) * (1.f / 256.f) + EPS); const float4 gn = g ? gn1 : gn0; const uint2 ww = w[j][g];
                                        const float y0 = __uint_as_float(ww.x << 16) * rs * gn.x, y1 = __uint_as_float(ww.x & 0xffff0000u) * rs * gn.y, y2 = __uint_as_float(ww.y << 16) * rs * gn.z, y3 = __uint_as_float(ww.y & 0xffff0000u) * rs * gn.w;
                                        *(uint2*)(MIXB + r * 1024 + 256 + g * 256 + ln * 4) = make_uint2(pk2(y0, y1), pk2(y2, y3)); } }
                            }
                            continue;
                        }
                        const int j = 16 * (u - U_END) + 2 * wave_s; LAS float* scrq_ = (LAS float*)((LAS unsigned char*)lds + wave_s * 16384); const int lnq_ = tid_now(wave_s) & 63;
                        for (int e = 0; e < 2; ++e) { const int jj = j + e; if (jj < 10384) { const int itq_ = jj < 2816 ? 6144 + jj : jj < 5632 ? 10384 + (jj - 2816) : jj < 10368 ? 14608 + (jj - 5632) : 20752 + (jj - 10368); CONVERT_ITEM(itq_, scrq_, lnq_); } }
                        continue;
                    }
                    int tidu = tid; asm volatile("" : "+v"(tidu));
                    if (u < U_GLAP) {
                        const int b = u >> 3, h = u & 7;
                        la::ssd_prompt_unit(b, h, (const GAS bf16*)MIB, (const GAS bf16*)XC, (const GAS float*)DTB, -expf(a_log[h]), ssd_d[h], (GAS bf16*)MIXB, (GAS float*)SSQH, (GAS float*)(out + O_SSMP + ((size_t)(l * BATCH + b) * 8 + h) * 4096), (LAS unsigned char*)lds, tidu);
                        asm volatile("s_waitcnt vmcnt(0)" ::: "memory"); __syncthreads();
                        if (tid_now(wave_s) == 0) { __builtin_amdgcn_fence(__ATOMIC_RELEASE, "agent"); asm volatile("s_waitcnt vmcnt(0)" ::: "memory"); __hip_atomic_fetch_add(ssd_done, 1u, __ATOMIC_RELAXED, __HIP_MEMORY_SCOPE_AGENT); }
                    } else if (u < U_SAMP) {
                        const int b = (u - U_GLAP) >> 2, h = (u - U_GLAP) & 3;
                        la::gla_prompt_unit(b, h, (const GAS bf16*)MIB, (const GAS float*)GLOG, (const GAS float*)gla_norm, (GAS bf16*)MIXB, (GAS float*)(out + O_GLAP + ((size_t)(l * BATCH + b) * 4 + h) * 2048), (LAS unsigned char*)lds, tidu);
                    } else if (u < U_META) {
                        const int k = u - U_SAMP;
                        const int su = k < 64 ? k : ((k >= 160 && k < 224) ? k - 96 : -1);
                        if (su >= 0) {
                            eu::sample_unit(su, l, MI, cache_k, cache_v, cache_lf, pt, state_ssm, state_conv, state_gla, fox_q_norm, fox_k_norm, fox_f_bias, conv_w, conv_b, dt_bias, a_log, ssd_d, ssd_norm,
                                            w_gate, gate_bias, gla_norm, MIXB, out, (LAS unsigned char*)lds, tidu);
                        } else {
                            const int j = k < 160 ? k - 64 : k - 128; fa::fox_prompt_unit((j & 31) >> 2, j & 3, 7 - (j >> 5), QF, KF, VT, LF, MIXB, (LAS unsigned char*)lds, tidu);
                        }
                    } else {
                        eu::meta_unit(MI, fox_q_norm, fox_k_norm, fox_f_bias, MIXB, (LAS unsigned char*)lds, tidu);
                    }
                }
            }
            PHASE_END_R(R_MIX)
            PHASE_BEGIN { pg8::Gemm g{MIXB, WT_(l, WL_W4), MP, 1024, 1024}; pg8::StaticOrder S; S.init(MP, 1024, (int)gridDim.x, (int)blockIdx.x);
                pg8::EpiResid E{(const GAS float*)nullptr, X, XB, SSQP, 1.0f, out, 0}; pg8::gemm_phase<pg8::EpiResid, pg8::StaticOrder, true, true>((LAS unsigned char*)lds, g, S, E, tid);
                eg::egemm_resid<1024, 8>(MIXB, WT_(l, WL_W4), X, XB, SSQP, 1.0f, out, 0, (LAS unsigned char*)lds, tid_now(wave_s)); } PHASE_END
        }
    }
}

extern "C" void kernel_launch(void* const* d_in, const int* in_sizes, int n_in, void* d_out, int out_size, void* d_ws, size_t ws_size, hipStream_t stream) {
    static int grid = 0;
    if (grid == 0) {
        if (n_in != 31 || out_size != (int)O_END || ws_size < WS_END) { fprintf(stderr, "kernel_launch: unexpected sizes n_in %d out %d ws %zu (need %zu)\n", n_in, out_size, ws_size, (size_t)WS_END); grid = -1; return; }
        int dev = 0, cus = 0;
        if (hipGetDevice(&dev) != hipSuccess || hipDeviceGetAttribute(&cus, hipDeviceAttributeMultiprocessorCount, dev) != hipSuccess) { grid = -1; return; }
        if (hipFuncSetAttribute((const void*)fwd, hipFuncAttributeMaxDynamicSharedMemorySize, LDS_BYTES) != hipSuccess) { fprintf(stderr, "kernel_launch: hipFuncSetAttribute failed\n"); grid = -1; return; }
        (void)hipGetLastError();
        grid = cus;
    }
    if (grid < 0) return;
    (void)hipMemsetAsync((char*)d_ws + WS_CTL, 0, CTL_ZERO_BYTES, stream);
    Args a{};
    for (int i = 0; i < 31; ++i) a.in[i] = (const float*)d_in[i];
    a.out = (float*)d_out; a.ws = (unsigned char*)d_ws; a.ph_lo = 0; a.ph_hi = 1000;
    hipLaunchKernelGGL(fwd, dim3(grid), dim3(NWAVES * 64), LDS_BYTES, stream, a);
}
```

```cpp
#include <hip/hip_runtime.h>
#include <cstdio>
#include <cstdint>

constexpr int D_MODEL = 1024, BATCH = 8, SEQ = 2048, DEPTH = 2, DEC_BATCH = 128, DEC_SEQ = 4, PAST = 2048, PAGE = 128, NPAGES = 16, NPOOL = 2560;
constexpr int N_META = 16, TP = N_META + SEQ;
constexpr int D_FF = 2816;
constexpr float EPS = 1e-6f;
constexpr int N_IN = 2844, LDMI = 2848;
constexpr int C_FQ = 0, C_FK = 256, C_FV = 512, C_FF = 768, C_SZ = 772, C_XBC = 1284, C_DT = 2052, C_GQ = 2060, C_GK = 2188, C_GV = 2316, C_LR = 2572, C_GG = 2588;
constexpr int N_MAIN = 2816, CM_SZ = 768, CM_XBC = 1280, CM_GQ = 2048, CM_GK = 2176, CM_GV = 2304, CM_GG = 2560;
__host__ __device__ constexpr int main2ref(int c) { return c < 768 ? c : (c < 2048 ? c + 4 : (c < 2560 ? c + 12 : c + 28)); }
__host__ __device__ constexpr int small2ref(int j) { return j < 4 ? C_FF + j : (j < 12 ? C_DT + (j - 4) : (j < 28 ? C_LR + (j - 12) : -1)); }
constexpr int MP = BATCH * SEQ, MS = DEC_BATCH * DEC_SEQ, R_S = MP, R_META = MP + MS, M_REAL = R_META + N_META, M_PAD = 17152;
constexpr size_t O_YP = 0;
constexpr size_t O_YS = O_YP + (size_t)BATCH * SEQ * D_MODEL;
constexpr size_t O_KP = O_YS + (size_t)MS * D_MODEL;
constexpr size_t O_VP = O_KP + (size_t)DEPTH * BATCH * TP * 256;
constexpr size_t O_LFP = O_VP + (size_t)DEPTH * BATCH * TP * 256;
constexpr size_t O_SSMP = O_LFP + (size_t)DEPTH * BATCH * TP * 4;
constexpr size_t O_CONVP = O_SSMP + (size_t)DEPTH * BATCH * 8 * 64 * 64;
constexpr size_t O_GLAP = O_CONVP + (size_t)DEPTH * BATCH * 3 * 768;
constexpr size_t O_KS = O_GLAP + (size_t)DEPTH * BATCH * 4 * 32 * 64;
constexpr size_t O_VS = O_KS + (size_t)DEPTH * MS * 256;
constexpr size_t O_LFS = O_VS + (size_t)DEPTH * MS * 256;
constexpr size_t O_SSMS = O_LFS + (size_t)DEPTH * MS * 4;
constexpr size_t O_CONVS = O_SSMS + (size_t)DEPTH * DEC_BATCH * 8 * 64 * 64;
constexpr size_t O_GLAS = O_CONVS + (size_t)DEPTH * DEC_BATCH * 3 * 768;
constexpr size_t O_END = O_GLAS + (size_t)DEPTH * DEC_BATCH * 4 * 32 * 64;
static_assert(O_END == 46638080, "output size");

constexpr size_t MiB = 1u << 20;
constexpr size_t WS_CTL = 0, CTL_ZERO_BYTES = 64 * 1024;
constexpr size_t SZ_W1 = (size_t)5632 * 1024 * 2, SZ_W2 = (size_t)1024 * 2816 * 2, SZ_W3 = (size_t)2816 * 1024 * 2, SZ_W7 = (size_t)32 * 1024 * 2, SZ_W4 = (size_t)1024 * 1024 * 2;
constexpr size_t WL_W1 = 0, WL_W2 = WL_W1 + SZ_W1, WL_W3 = WL_W2 + SZ_W2, WL_W4 = WL_W3 + SZ_W3, WL_W5 = WL_W4 + SZ_W4, WL_W6 = WL_W5 + SZ_W1, WL_W7 = WL_W6 + SZ_W2, WL_SIZE = WL_W7 + SZ_W7;
constexpr size_t WS_WT = 2 * MiB;
constexpr size_t WS_X = WS_WT + 2 * WL_SIZE;
constexpr size_t WS_XB = WS_X + (size_t)M_PAD * 1024 * 4;
constexpr size_t WS_SSQ = WS_XB + (size_t)M_PAD * 1024 * 2;
constexpr size_t WS_HB = WS_SSQ + (size_t)M_PAD * 16 * 4;
constexpr size_t WS_MIXB = WS_HB + (size_t)M_PAD * 2816 * 2;
constexpr size_t WS_MI = WS_MIXB + (size_t)M_PAD * 1024 * 2;
constexpr size_t WS_QN = WS_MI + (size_t)M_PAD * LDMI * 4;
constexpr size_t WS_KN = WS_QN + (size_t)M_PAD * 256 * 4;
constexpr size_t WS_LF = WS_KN + (size_t)M_PAD * 256 * 4;
constexpr size_t WS_FC = WS_LF + (size_t)M_PAD * 4 * 4;
constexpr size_t WS_FCS = WS_FC + (size_t)M_PAD * 4 * 4;
constexpr size_t WS_XBC = WS_FCS + (size_t)128 * 4 * 2052 * 4 + 4096;
constexpr size_t WS_DT = WS_XBC + (size_t)M_PAD * 768 * 4;
constexpr size_t WS_GLOG = WS_DT + (size_t)M_PAD * 8 * 4;
constexpr size_t WS_YS = WS_GLOG + (size_t)M_PAD * 128 * 4;
constexpr size_t WS_GO = WS_YS + (size_t)M_PAD * 512 * 4;
constexpr size_t WS_QF = WS_GO + (size_t)M_PAD * 256 * 4;
constexpr size_t WS_KF = WS_QF + (size_t)32 * 2048 * 64 * 2;
constexpr size_t WS_VT = WS_KF + (size_t)32 * 2112 * 64 * 2;
constexpr size_t WS_SSQH = WS_VT + (size_t)32 * 2112 * 64 * 2;
constexpr size_t WS_XC = WS_SSQH + (size_t)M_PAD * 8 * 4;
constexpr size_t WS_MIB = WS_XC + (size_t)M_PAD * 768 * 2;
constexpr size_t WS_END = WS_MIB + (size_t)M_PAD * LDMI * 2;
static_assert(WS_X % 256 == 0 && WS_XB % 256 == 0 && WS_SSQ % 256 == 0 && WS_HB % 256 == 0 && WS_MIXB % 256 == 0 && WS_MI % 256 == 0, "alignment");

#ifndef R_P0
#define R_P0 1
#endif
#ifndef R_G1
#define R_G1 1
#endif
#ifndef R_G3
#define R_G3 1
#endif
#ifndef R_PREP
#define R_PREP 1
#endif
#ifndef R_MIX
#define R_MIX 1
#endif
#ifndef R_BAR
#define R_BAR 0
#endif
constexpr int CW_BAR = 4096, CW_Q = 8192;
constexpr int NWAVES = 8;
constexpr int LDS_BYTES = 147456;
constexpr int MISC_OFF = 131072 + 320;

#define LAS __attribute__((address_space(3)))
#define GAS __attribute__((address_space(1)))
#define LDS_WAIT() asm volatile("s_waitcnt lgkmcnt(0)" ::: "memory")
typedef unsigned short bf16;
typedef unsigned v4u __attribute__((ext_vector_type(4)));
__device__ __forceinline__ unsigned f2bf(float f) { unsigned u = __builtin_bit_cast(unsigned, f); return (u + 0x7fffu + ((u >> 16) & 1u)) >> 16; }
__device__ __forceinline__ unsigned pk2(float lo, float hi) { return f2bf(lo) | (f2bf(hi) << 16); }

__device__ __forceinline__ float bperm(float x, int srclane);
namespace pg8 {
#define PG8_LAS __attribute__((address_space(3)))
typedef unsigned short bf16_t;
typedef short bf16x8 __attribute__((ext_vector_type(8)));
typedef float f32x4 __attribute__((ext_vector_type(4)));
typedef unsigned u32x4 __attribute__((ext_vector_type(4)));
constexpr int BM = 256, BK = 64, HALF = 128, HTB = HALF * BK * 2  , STAGE_BYTES = 8 * HTB, NXCD = 8, WGM = 8;

__host__ __device__ __forceinline__ int lds_byte(int r, int c) { const int st = (r >> 4) * 2 + (c >> 5), rr = r & 15, cc = c & 31, ob = rr * 64 + cc * 2; return st * 1024 + (ob ^ (((ob >> 9) & 1) << 5)); }
__host__ __device__ __forceinline__ void stage_rc(int b, int& R, int& C) { const int st = b / 1024, sb = b % 1024, swz = sb ^ (((sb >> 9) & 1) << 5); R = (st >> 1) * 16 + swz / 64; C = (st & 1) * 32 + (swz % 64) / 2; }
__host__ __device__ __forceinline__ int perm32(int rho) { const int n = rho >> 4, i = rho & 15; return 8 * (i >> 2) + 4 * n + (i & 3); }

struct Unit { int pm, pn; };
struct Gemm { const bf16_t* A; const bf16_t* Bt; int M, N, K; };

struct StaticOrder {
    int nM, nN, nwg, G, c;
    __host__ __device__ void init(int M, int N, int G_, int c_) { nM = M / BM; nN = N / BM; nwg = nM * nN; G = G_; c = c_; }
    __host__ __device__ bool next(int i, Unit& u) const {
        const long L = (long)i * G + c; if (L >= nwg) return false;
        int wgid = (int)L; { const int q = nwg / NXCD, r = nwg % NXCD, xcd = wgid % NXCD, off = wgid / NXCD; wgid = (xcd < r ? xcd * (q + 1) : r * (q + 1) + (xcd - r) * q) + off; }
        const int nig = WGM * nN, gid = wgid / nig, fm = gid * WGM, gsz = (nM - fm) < WGM ? (nM - fm) : WGM;
        u.pm = fm + ((wgid % nig) % gsz); u.pn = (wgid % nig) / gsz; return true;
    }
    __device__ __forceinline__ void a_ready(const Unit&) const {}
    __device__ __forceinline__ void done(const Unit&) const {}
};

__device__ __forceinline__ unsigned cvt_pk_bf16(float lo, float hi) { unsigned r; asm volatile("v_cvt_pk_bf16_f32 %0, %1, %2" : "=v"(r) : "v"(lo), "v"(hi)); return r; }
typedef float f32x2 __attribute__((ext_vector_type(2)));
__device__ __forceinline__ f32x2 gelu_pk(f32x2 v) {
    const f32x2 av = __builtin_elementwise_abs(v), d = av * 0.2316418882f + 1.0f;
    f32x2 t; t.x = __builtin_amdgcn_rcpf(d.x); t.y = __builtin_amdgcn_rcpf(d.y);
    f32x2 q = t * 0.5307027145f + (-0.7265760135f); q = q * t + 0.7107068705f; q = q * t + (-0.142248368f); q = q * t + 0.127414796f; q = q * t;
    const f32x2 s = (v * v) * (-0.72134752044f);
    f32x2 e; e.x = __builtin_amdgcn_exp2f(s.x); e.y = __builtin_amdgcn_exp2f(s.y);
    const f32x2 m = v * (q * e), r = v - m;
    f32x2 o; o.x = v.x < 0.f ? m.x : r.x; o.y = v.y < 0.f ? m.y : r.y; return o;
}


__device__ __forceinline__ float rstd_of(const float* SSQP, int row) {
    const f32x4* p = (const f32x4*)(SSQP + (size_t)row * 16);
    const f32x4 a = p[0], b = p[1], c = p[2], d = p[3];
    const float s = ((a[0] + a[1]) + (a[2] + a[3])) + ((b[0] + b[1]) + (b[2] + b[3])) + ((c[0] + c[1]) + (c[2] + c[3])) + ((d[0] + d[1]) + (d[2] + d[3]));
    return __builtin_amdgcn_rsqf(s * (1.0f / 1024.0f) + 1e-6f);
}
__device__ __forceinline__ float silu_fast(float x) { return x * __builtin_amdgcn_rcpf(1.0f + __expf(-x)); }
struct EpiSwiglu {
    static constexpr bool PERM = true, AFTER_DRAIN = false;
    bf16_t* H; const float* SSQP;
    __device__ __forceinline__ void operator()(const f32x4 (&acc)[2][2][4][2], const Unit& u, int wr, int wc, int fr, int fq) const {
        const int row0 = u.pm * BM + wr * 64 + fr, col0 = u.pn * 128 + wc * 32 + 8 * fq;
#pragma unroll
        for (int ai = 0; ai < 2; ++ai)
#pragma unroll
            for (int m = 0; m < 4; ++m) { const int row = row0 + ai * HALF + m * 16; const float rs = rstd_of(SSQP, row);
                const f32x4 g0 = acc[ai][0][m][0], g1 = acc[ai][0][m][1], u0 = acc[ai][1][m][0], u1 = acc[ai][1][m][1]; const float rs2 = rs * rs;
#define SWG(g, u) (silu_fast((g) * rs) * (u) * rs)
                u32x4 w; w.x = cvt_pk_bf16(SWG(g0[0], u0[0]), SWG(g0[1], u0[1])); w.y = cvt_pk_bf16(SWG(g0[2], u0[2]), SWG(g0[3], u0[3]));
                w.z = cvt_pk_bf16(SWG(g1[0], u1[0]), SWG(g1[1], u1[1])); w.w = cvt_pk_bf16(SWG(g1[2], u1[2]), SWG(g1[3], u1[3])); (void)rs2;
#undef SWG
                *(u32x4*)(H + (size_t)row * 2816 + col0) = w; }
    }
};
struct EpiResid {
    static constexpr bool PERM = true, AFTER_DRAIN = false;
    const GAS float* Xin; float* X; bf16_t* XB; float* SSQP; float scale; float* out; int final_;
    __device__ __forceinline__ void operator()(const f32x4 (&acc)[2][2][4][2], const Unit& u, int wr, int wc, int fr, int fq) const {
        const int row0 = u.pm * BM + wr * 64 + fr;
#pragma unroll
        for (int ai = 0; ai < 2; ++ai)
#pragma unroll
            for (int m = 0; m < 4; ++m) { const int row = row0 + ai * HALF + m * 16; float ss = 0.f;
#pragma unroll
                for (int bj = 0; bj < 2; ++bj) { const int col = u.pn * BM + bj * HALF + wc * 32 + 8 * fq;
                    const f32x4 a0 = acc[ai][bj][m][0], a1 = acc[ai][bj][m][1]; f32x4 x0, x1;
                    if (Xin) { const GAS f32x4* xi = (const GAS f32x4*)(Xin + (size_t)row * 1024 + col); x0 = xi[0]; x1 = xi[1]; }
                    else { const u32x4 wb = *(const u32x4*)(XB + (size_t)row * 1024 + col);
                        x0[0] = __uint_as_float(wb.x << 16); x0[1] = __uint_as_float(wb.x & 0xffff0000u); x0[2] = __uint_as_float(wb.y << 16); x0[3] = __uint_as_float(wb.y & 0xffff0000u);
                        x1[0] = __uint_as_float(wb.z << 16); x1[1] = __uint_as_float(wb.z & 0xffff0000u); x1[2] = __uint_as_float(wb.w << 16); x1[3] = __uint_as_float(wb.w & 0xffff0000u); }
                    x0[0] += a0[0] * scale; x0[1] += a0[1] * scale; x0[2] += a0[2] * scale; x0[3] += a0[3] * scale; x1[0] += a1[0] * scale; x1[1] += a1[1] * scale; x1[2] += a1[2] * scale; x1[3] += a1[3] * scale;
                    if (!final_) {
                    u32x4 w; w.x = cvt_pk_bf16(x0[0], x0[1]); w.y = cvt_pk_bf16(x0[2], x0[3]); w.z = cvt_pk_bf16(x1[0], x1[1]); w.w = cvt_pk_bf16(x1[2], x1[3]);
                    *(u32x4*)(XB + (size_t)row * 1024 + col) = w;
                    ss += (x0[0] * x0[0] + x0[1] * x0[1]) + (x0[2] * x0[2] + x0[3] * x0[3]) + (x1[0] * x1[0] + x1[1] * x1[1]) + (x1[2] * x1[2] + x1[3] * x1[3]); }
                    if (final_) { float* o = nullptr; if (row < MP) o = out + O_YP + (size_t)row * 1024 + col; else if (row < R_META) o = out + O_YS + (size_t)(row - R_S) * 1024 + col;
                        if (o) { ((f32x4*)o)[0] = x0; ((f32x4*)o)[1] = x1; } } }
                ss += bperm(ss, (fq * 16 + fr) ^ 16); ss += bperm(ss, (fq * 16 + fr) ^ 32);
                if (fq == 0 && !final_) SSQP[(size_t)row * 16 + u.pn * 4 + wc] = ss; }
    }
};
struct EpiMix {
    static constexpr bool PERM = true, AFTER_DRAIN = false;
    float* MI; bf16_t* MIB; const float* SSQP; bf16_t* QF; bf16_t* KF; bf16_t* VT; const float* qg; const float* kg; const float* fbias; float* LF; float* out; int l;
    __device__ __forceinline__ void operator()(const f32x4 (&acc)[2][2][4][2], const Unit& u, int wr, int wc, int fr_, int fq_) const {
        int ln_; asm volatile("v_mbcnt_lo_u32_b32 %0, -1, 0\n\tv_mbcnt_hi_u32_b32 %0, -1, %0" : "=v"(ln_)); const int fr = ln_ & 15, fq = ln_ >> 4; (void)fr_; (void)fq_;
        const int row0 = u.pm * BM + wr * 64 + fr;
        if (u.pn < 3) {
            f32x4 gn[2][2];
            const float* gp = u.pn == 0 ? qg : kg;
#pragma unroll
            for (int bj = 0; bj < 2; ++bj)
#pragma unroll
                for (int n = 0; n < 2; ++n) gn[bj][n] = u.pn < 2 ? *(const f32x4*)(gp + 32 * bj + 8 * fq + 4 * n) : (f32x4){1.f, 1.f, 1.f, 1.f};
            const float qs = u.pn == 0 ? 0.18033688011112042f : 1.0f;
#pragma unroll
            for (int ai = 0; ai < 2; ++ai)
#pragma unroll
                for (int m = 0; m < 4; ++m) { const int row = row0 + ai * HALF + m * 16; const float rs = rstd_of(SSQP, row);
                    float v[2][8]; float ss = 0.f;
#pragma unroll
                    for (int bj = 0; bj < 2; ++bj) { const f32x4 a0 = acc[ai][bj][m][0], a1 = acc[ai][bj][m][1];
                        v[bj][0] = a0[0] * rs; v[bj][1] = a0[1] * rs; v[bj][2] = a0[2] * rs; v[bj][3] = a0[3] * rs; v[bj][4] = a1[0] * rs; v[bj][5] = a1[1] * rs; v[bj][6] = a1[2] * rs; v[bj][7] = a1[3] * rs;
                        if (row >= MP) { f32x4* o = (f32x4*)(MI + (size_t)row * LDMI + u.pn * 256 + wc * 64 + bj * 32 + 8 * fq);
                            o[0] = (f32x4){v[bj][0], v[bj][1], v[bj][2], v[bj][3]}; o[1] = (f32x4){v[bj][4], v[bj][5], v[bj][6], v[bj][7]}; }
#pragma unroll
                        for (int e = 0; e < 8; ++e) ss += v[bj][e] * v[bj][e]; }
                    if (u.pn < 2) { ss += bperm(ss, (fq * 16 + fr) ^ 16); ss += bperm(ss, (fq * 16 + fr) ^ 32); const float hn = __builtin_amdgcn_rsqf(ss * (1.0f / 64.0f) + 1e-6f) * qs;
#pragma unroll
                        for (int bj = 0; bj < 2; ++bj)
#pragma unroll
                            for (int e = 0; e < 8; ++e) v[bj][e] *= hn * gn[bj][e >> 2][e & 3]; }
                    const bool isP = row < MP, isM = row >= R_META && row < M_REAL;
                    if (u.pn > 0 && row < M_REAL) {
                        float* ob; int nc = 1; size_t cs_ = 0;
                        if (isP) ob = out + (u.pn == 1 ? O_KP : O_VP) + ((size_t)(l * BATCH + (row >> 11)) * TP + 16 + (row & 2047)) * 256;
                        else if (isM) { ob = out + (u.pn == 1 ? O_KP : O_VP) + ((size_t)(l * BATCH) * TP + (row - R_META)) * 256; nc = BATCH; cs_ = (size_t)TP * 256; }
                        else ob = out + (u.pn == 1 ? O_KS : O_VS) + ((size_t)l * MS + (row - R_S)) * 256;
                        for (int c = 0; c < nc; ++c)
#pragma unroll
                            for (int bj = 0; bj < 2; ++bj) { f32x4* o = (f32x4*)(ob + c * cs_ + wc * 64 + bj * 32 + 8 * fq);
                                o[0] = (f32x4){v[bj][0], v[bj][1], v[bj][2], v[bj][3]}; o[1] = (f32x4){v[bj][4], v[bj][5], v[bj][6], v[bj][7]}; }
                    }
                    if (isP || (isM && u.pn > 0)) {
                        const int b0 = isP ? (row >> 11) : 0, nb = isP ? 1 : 8, slot = isP ? 64 + (row & 2047) : row - R_META;
                        for (int bb = b0; bb < b0 + nb; ++bb) { const int bh = bb * 4 + wc;
                            if (u.pn < 2) {
                                bf16_t* dst = u.pn == 0 ? QF + ((size_t)bh * 2048 + (row & 2047)) * 64 : KF + ((size_t)bh * 2112 + slot) * 64;
#pragma unroll
                                for (int bj = 0; bj < 2; ++bj) { u32x4 w; w.x = cvt_pk_bf16(v[bj][0], v[bj][1]); w.y = cvt_pk_bf16(v[bj][2], v[bj][3]); w.z = cvt_pk_bf16(v[bj][4], v[bj][5]); w.w = cvt_pk_bf16(v[bj][6], v[bj][7]);
                                    *(u32x4*)(dst + 32 * bj + 8 * fq) = w; }
                            } else {
#pragma unroll
                                for (int bj = 0; bj < 2; ++bj)
#pragma unroll
                                    for (int e = 0; e < 8; e += 2) { const unsigned w = cvt_pk_bf16(v[bj][e], v[bj][e + 1]); const int d = 32 * bj + 8 * fq + e;
                                        VT[((size_t)bh * 64 + d) * 2112 + slot] = (bf16_t)(w & 0xffffu); VT[((size_t)bh * 64 + d + 1) * 2112 + slot] = (bf16_t)(w >> 16); }
                            } } } }
        } else {
#pragma unroll
            for (int ai = 0; ai < 2; ++ai)
#pragma unroll
                for (int m = 0; m < 4; ++m) { const int row = row0 + ai * HALF + m * 16; const float rs = rstd_of(SSQP, row);
#pragma unroll
                    for (int bj = 0; bj < 2; ++bj) { const int colm = u.pn * BM + bj * HALF + wc * 32 + 8 * fq, col = main2ref(colm);
                        const f32x4 a0 = acc[ai][bj][m][0], a1 = acc[ai][bj][m][1];
                        f32x4 r0v = (f32x4){a0[0] * rs, a0[1] * rs, a0[2] * rs, a0[3] * rs}, r1v = (f32x4){a1[0] * rs, a1[1] * rs, a1[2] * rs, a1[3] * rs};
                        if ((colm >= CM_SZ && colm < CM_SZ + 512) || colm >= CM_GG) {
#pragma unroll
                            for (int e = 0; e < 4; ++e) { r0v[e] = silu_fast(r0v[e]); r1v[e] = silu_fast(r1v[e]); } }
                        { u32x4 w; w.x = cvt_pk_bf16(r0v[0], r0v[1]); w.y = cvt_pk_bf16(r0v[2], r0v[3]); w.z = cvt_pk_bf16(r1v[0], r1v[1]); w.w = cvt_pk_bf16(r1v[2], r1v[3]); *(u32x4*)(MIB + (size_t)row * N_MAIN + colm) = w; }
                        if (row >= MP) { f32x4* o = (f32x4*)(MI + (size_t)row * LDMI + col); o[0] = r0v; o[1] = r1v; }
                        if (colm >= CM_XBC && colm < CM_XBC + 768) {
                            float* cvo = nullptr;
                            if (row < MP) { if ((row & 2047) >= 2045) cvo = out + O_CONVP + ((size_t)(l * BATCH + (row >> 11)) * 3 + ((row & 2047) - 2045)) * 768; }
                            else if (row < R_META) { if (((row - R_S) & 3) >= 1) cvo = out + O_CONVS + ((size_t)(l * DEC_BATCH + ((row - R_S) >> 2)) * 3 + (((row - R_S) & 3) - 1)) * 768; }
                            if (cvo) { *(f32x4*)(cvo + colm - CM_XBC) = r0v; *(f32x4*)(cvo + colm - CM_XBC + 4) = r1v; } }
                    } }
        }
    }
};

template <class Epi, class Sched, bool ALIGN_EPI = false, bool SP2 = false>
__device__ __forceinline__ void gemm_phase(PG8_LAS unsigned char* lds, const Gemm g, const Sched& S, const Epi& E, const int tid) {
    const int wid = __builtin_amdgcn_readfirstlane(tid >> 6), lane = tid & 63, wr = wid >> 2, wc = wid & 3, fr = lane & 15, fq = lane >> 4;
    const int K = g.K, nt = K / BK;
    unsigned voffA[2], voffB[2];
#pragma unroll
    for (int i = 0; i < 2; ++i) { int R, C; stage_rc(tid * 16 + i * 8192, R, C); const int Rb = Epi::PERM ? ((R & ~31) + perm32(R & 31)) : R;
        voffA[i] = (unsigned)(R * K + C) * 2u; voffB[i] = (unsigned)(Rb * K + C) * 2u; }
    const size_t kstep = (size_t)(BK * 2);
    const size_t hstep = (size_t)HALF * K * 2;
    const size_t tstep = 2 * hstep;
    const unsigned ldsw = (unsigned)wid * 1024u;
    const int aoff = lds_byte(wr * 64 + fr, fq * 8), boff = lds_byte(wc * 32 + fr, fq * 8);
#define PG8_SA(b, h) (((b) * 2 + (h)) * HTB)
#define PG8_SB(b, h) ((4 + (b) * 2 + (h)) * HTB)
#define PG8_STAGE(bufoff, gbase, voff) do { _Pragma("unroll") for (int _i = 0; _i < 2; ++_i) \
        __builtin_amdgcn_global_load_lds((const unsigned*)((const char*)(gbase) + (voff)[_i]), (PG8_LAS unsigned*)(lds + (bufoff) + ldsw + _i * 8192), 16, 0, 0); } while (0)
#define PG8_LDA(dst, b, h) do { _Pragma("unroll") for (int m = 0; m < 4; ++m) _Pragma("unroll") for (int k = 0; k < 2; ++k) dst[m][k] = *(const PG8_LAS bf16x8*)(lds + PG8_SA(b, h) + aoff + m * 2048 + k * 1024); } while (0)
#define PG8_LDB(dst, b, h) do { _Pragma("unroll") for (int n = 0; n < 2; ++n) _Pragma("unroll") for (int k = 0; k < 2; ++k) dst[n][k] = *(const PG8_LAS bf16x8*)(lds + PG8_SB(b, h) + boff + n * 2048 + k * 1024); } while (0)
#define PG8_MMA(ai, bj, At, Bt) do { __builtin_amdgcn_s_setprio(1); _Pragma("unroll") for (int m = 0; m < 4; ++m) _Pragma("unroll") for (int n = 0; n < 2; ++n) _Pragma("unroll") for (int k = 0; k < 2; ++k) \
        acc[ai][bj][m][n] = __builtin_amdgcn_mfma_f32_16x16x32_bf16(Bt[n][k], At[m][k], acc[ai][bj][m][n], 0, 0, 0); __builtin_amdgcn_s_setprio(0); } while (0)
#define PG8_WAIT_V(n) asm volatile("s_waitcnt vmcnt(" #n ")" ::: "memory")
#define PG8_WAIT_L(n) asm volatile("s_waitcnt lgkmcnt(" #n ")" ::: "memory")
#define PG8_BAR __builtin_amdgcn_s_barrier()
#define PG8_SCHED __builtin_amdgcn_sched_barrier(0)
    Unit cur, nxt; int ui = 0;
    if (!S.next(0, cur)) return;
    f32x4 acc[2][2][4][2];
#pragma unroll
    for (int a = 0; a < 2; ++a)
#pragma unroll
        for (int b = 0; b < 2; ++b)
#pragma unroll
            for (int m = 0; m < 4; ++m)
#pragma unroll
                for (int n = 0; n < 2; ++n) acc[a][b][m][n] = (f32x4){0.f, 0.f, 0.f, 0.f};
    bf16x8 At[4][2], B0[2][2], B1[2][2];
    const char* cA = (const char*)g.A + (size_t)cur.pm * tstep; const char* cB = (const char*)g.Bt + (size_t)cur.pn * tstep;
    S.a_ready(cur);
    if constexpr (SP2) {
        PG8_STAGE(PG8_SB(0, 0), cB, voffB); PG8_STAGE(PG8_SB(0, 1), cB + hstep, voffB); PG8_STAGE(PG8_SA(0, 0), cA, voffA); PG8_STAGE(PG8_SA(0, 1), cA + hstep, voffA);
        if (wr == 1) PG8_BAR;
        PG8_WAIT_V(2); PG8_BAR;
        PG8_STAGE(PG8_SB(1, 0), cB + kstep, voffB); PG8_STAGE(PG8_SA(1, 0), cA + kstep, voffA); PG8_STAGE(PG8_SB(1, 1), cB + hstep + kstep, voffB);
        PG8_WAIT_V(6); PG8_BAR;
    } else {
        PG8_STAGE(PG8_SB(0, 0), cB, voffB); PG8_STAGE(PG8_SA(0, 0), cA, voffA); PG8_STAGE(PG8_SB(0, 1), cB + hstep, voffB); PG8_STAGE(PG8_SA(0, 1), cA + hstep, voffA);
        if (wr == 1) PG8_BAR;
        PG8_WAIT_V(4); PG8_BAR;
        PG8_STAGE(PG8_SB(1, 0), cB + kstep, voffB); PG8_STAGE(PG8_SA(1, 0), cA + kstep, voffA); PG8_STAGE(PG8_SB(1, 1), cB + hstep + kstep, voffB);
        PG8_WAIT_V(6); PG8_BAR;
    }
    for (;;) {
        const bool has_next = S.next(ui + 1, nxt);
        const char* nA = has_next ? (const char*)g.A + (size_t)nxt.pm * tstep : cA; const char* nB = has_next ? (const char*)g.Bt + (size_t)nxt.pn * tstep : cB;
        for (int t = 0; t < nt; t += 2) {
            const bool last = (t == nt - 2);
            const char* a1 = cA + (size_t)(t + 1) * kstep;
            const char* a2 = last ? nA : cA + (size_t)(t + 2) * kstep; const char* b2 = last ? nB : cB + (size_t)(t + 2) * kstep;
            const char* a3 = a2 + kstep; const char* b3 = b2 + kstep;
            if (last && has_next) S.a_ready(nxt);
            if constexpr (SP2) {
            PG8_LDB(B0, 0, 0); PG8_LDB(B1, 0, 1); PG8_SCHED; PG8_LDA(At, 0, 0); PG8_STAGE(PG8_SA(1, 1), a1 + hstep, voffA);
            PG8_WAIT_V(8); PG8_WAIT_L(0); PG8_BAR; PG8_MMA(0, 0, At, B0); PG8_MMA(0, 1, At, B1); PG8_BAR; PG8_SCHED;
            PG8_LDA(At, 0, 1); PG8_STAGE(PG8_SB(0, 0), b2, voffB); PG8_STAGE(PG8_SB(0, 1), b2 + hstep, voffB); PG8_STAGE(PG8_SA(0, 0), a2, voffA);
            PG8_WAIT_V(8); PG8_WAIT_L(0); PG8_BAR; PG8_MMA(1, 0, At, B0); PG8_MMA(1, 1, At, B1); PG8_BAR; PG8_SCHED;
            PG8_LDB(B0, 1, 0); PG8_LDB(B1, 1, 1); PG8_SCHED; PG8_LDA(At, 1, 0); PG8_STAGE(PG8_SA(0, 1), a2 + hstep, voffA);
            PG8_WAIT_V(8); PG8_WAIT_L(0); PG8_BAR; PG8_MMA(0, 0, At, B0); PG8_MMA(0, 1, At, B1); PG8_BAR; PG8_SCHED;
            PG8_LDA(At, 1, 1); PG8_STAGE(PG8_SB(1, 0), b3, voffB); PG8_STAGE(PG8_SB(1, 1), b3 + hstep, voffB); PG8_STAGE(PG8_SA(1, 0), a3, voffA);
            PG8_WAIT_V(8); PG8_WAIT_L(0); PG8_BAR; PG8_MMA(1, 0, At, B0); PG8_MMA(1, 1, At, B1); PG8_BAR; PG8_SCHED;
            } else {
            PG8_LDB(B0, 0, 0); PG8_SCHED; PG8_LDA(At, 0, 0); PG8_STAGE(PG8_SA(1, 1), a1 + hstep, voffA);
            PG8_WAIT_L(8); PG8_BAR; PG8_WAIT_L(0); PG8_MMA(0, 0, At, B0); PG8_BAR; PG8_SCHED;
            PG8_LDB(B1, 0, 1); PG8_STAGE(PG8_SB(0, 0), b2, voffB);
            PG8_BAR; PG8_WAIT_L(0); PG8_MMA(0, 1, At, B1); PG8_BAR;
            PG8_LDA(At, 0, 1); PG8_STAGE(PG8_SA(0, 0), a2, voffA);
            PG8_BAR; PG8_WAIT_L(0); PG8_MMA(1, 0, At, B0); PG8_BAR; PG8_SCHED;
            PG8_STAGE(PG8_SB(0, 1), b2 + hstep, voffB);
            PG8_WAIT_V(6); PG8_BAR; PG8_MMA(1, 1, At, B1); PG8_BAR;
            PG8_LDB(B0, 1, 0); PG8_SCHED; PG8_LDA(At, 1, 0); PG8_STAGE(PG8_SA(0, 1), a2 + hstep, voffA);
            PG8_WAIT_L(8); PG8_BAR; PG8_WAIT_L(0); PG8_MMA(0, 0, At, B0); PG8_BAR; PG8_SCHED;
            PG8_LDB(B1, 1, 1); PG8_STAGE(PG8_SB(1, 0), b3, voffB);
            PG8_BAR; PG8_WAIT_L(0); PG8_MMA(0, 1, At, B1); PG8_BAR;
            PG8_LDA(At, 1, 1); PG8_STAGE(PG8_SA(1, 0), a3, voffA);
            PG8_BAR; PG8_WAIT_L(0); PG8_MMA(1, 0, At, B0); PG8_BAR; PG8_SCHED;
            PG8_STAGE(PG8_SB(1, 1), b3 + hstep, voffB);
            PG8_WAIT_V(6); PG8_BAR; PG8_MMA(1, 1, At, B1); PG8_BAR;
            }
        }
        if constexpr (ALIGN_EPI) { if (wr == 0) PG8_BAR; }
        if constexpr (!Epi::AFTER_DRAIN) { E(acc, cur, wr, wc, fr, fq); S.done(cur); }
        if (!has_next) break;
#pragma unroll
        for (int a = 0; a < 2; ++a)
#pragma unroll
            for (int b = 0; b < 2; ++b)
#pragma unroll
                for (int m = 0; m < 4; ++m)
#pragma unroll
                    for (int n = 0; n < 2; ++n) acc[a][b][m][n] = (f32x4){0.f, 0.f, 0.f, 0.f};
        cur = nxt; cA = nA; cB = nB; ++ui;
        if constexpr (ALIGN_EPI) { if (wr == 1) PG8_BAR; }
    }
    PG8_WAIT_V(0);
    if constexpr (!ALIGN_EPI) { if (wr == 0) PG8_BAR; }
    PG8_BAR;
    if constexpr (Epi::AFTER_DRAIN) { E.fused(acc, cur, wr, wc, fr, fq, lds, wid, lane); S.done(cur); }
#undef PG8_SA
#undef PG8_SB
#undef PG8_STAGE
#undef PG8_LDA
#undef PG8_LDB
#undef PG8_MMA
#undef PG8_WAIT_V
#undef PG8_WAIT_L
#undef PG8_BAR
#undef PG8_SCHED
}
}

#define XB_TMO      128
#define XB_XCNT(j)  (256  + 64 * (j))
#define XB_XSUB(j)  (1280 + 64 * (j))
#define XB_XGEN(j)  (2304 + 64 * (j))
#define XB_TOP      3328
#define XB_TOPGEN   3392
#define XCD_BAR_WORDS 3456
#define XB_SPIN_CAP (1u << 23)
__device__ __forceinline__ unsigned xb_ld(unsigned* p)              { return __hip_atomic_load(p, __ATOMIC_RELAXED, __HIP_MEMORY_SCOPE_AGENT); }
__device__ __forceinline__ unsigned xb_add(unsigned* p, unsigned v) { return __hip_atomic_fetch_add(p, v, __ATOMIC_RELAXED, __HIP_MEMORY_SCOPE_AGENT); }
__device__ __forceinline__ unsigned xb_xcc_id() { return (unsigned)__builtin_amdgcn_s_getreg((3 << 11) | 20) & 0xFu; }
#define XB_SPIN(cond, bar) do { unsigned _sp = 0; while (cond) { __builtin_amdgcn_s_sleep(1); \
    if ((++_sp & 255u) == 0u) { if (xb_ld(&(bar)[XB_TMO])) break; if (_sp > XB_SPIN_CAP) { atomicAdd(&(bar)[XB_TMO], 1u); break; } } } } while (0)
struct XcdBarrier { unsigned* bar; unsigned x; volatile LAS unsigned* st; };
__device__ __forceinline__ XcdBarrier xcd_barrier_post(unsigned* bar, volatile LAS unsigned* st) {
    XcdBarrier b; b.bar = bar; b.x = xb_xcc_id(); b.st = st;
    if (threadIdx.x == 0) (void)xb_add(&bar[XB_XCNT(b.x)], 1u);
    return b;
}
__device__ __forceinline__ void xcd_barrier_complete(unsigned* bar, unsigned x, unsigned& nloc, unsigned& nx) {
    const unsigned G = gridDim.x * gridDim.y * gridDim.z;
    unsigned sum, cnt, mine, sp = 0u;
    for (;;) {
        sum = 0u; cnt = 0u; mine = 0u;
#pragma unroll
        for (unsigned j = 0; j < 16; ++j) { const unsigned c = xb_ld(&bar[XB_XCNT(j)]); sum += c; cnt += (c > 0u) ? 1u : 0u; mine = (j == x) ? c : mine; }
        if (sum == G) break;
        __builtin_amdgcn_s_sleep(1);
        if ((++sp & 255u) == 0u) { if (xb_ld(&bar[XB_TMO])) break; if (sp > XB_SPIN_CAP) { atomicAdd(&bar[XB_TMO], 1u); break; } }
    }
    nloc = mine > 0u ? mine : 1u; nx = cnt > 0u ? cnt : 1u;
}
__device__ __forceinline__ void xcd_barrier(const XcdBarrier& b, const int tid_) {
    asm volatile("s_waitcnt vmcnt(0)" ::: "memory");
    __syncthreads();
    if (tid_ == 0) {
        unsigned* bar = b.bar; asm volatile("" : "+s"(bar));
        __builtin_amdgcn_s_waitcnt(0);
        unsigned nloc = b.st[0], nx = b.st[1];
        if (nloc == 0u) { xcd_barrier_complete(bar, b.x, nloc, nx); b.st[0] = nloc; b.st[1] = nx; }
        const unsigned old = xb_add(&bar[XB_XSUB(b.x)], 1u);
        const unsigned gen = old / nloc;
        if (old + 1u == (gen + 1u) * nloc) {
            __builtin_amdgcn_fence(__ATOMIC_RELEASE, "agent");
            asm volatile("s_waitcnt vmcnt(0)" ::: "memory");
            const unsigned og = xb_add(&bar[XB_TOP], 1u);
            const unsigned tg = og / nx;
            if (og + 1u == (tg + 1u) * nx) xb_add(&bar[XB_TOPGEN], 1u);
            else XB_SPIN(xb_ld(&bar[XB_TOPGEN]) == tg, bar);
            __builtin_amdgcn_fence(__ATOMIC_ACQUIRE, "agent");
            xb_add(&bar[XB_XGEN(b.x)], 1u);
            asm volatile("s_waitcnt vmcnt(0)" ::: "memory");
        } else {
            XB_SPIN(xb_ld(&bar[XB_XGEN(b.x)]) == gen, bar);
            __builtin_amdgcn_fence(__ATOMIC_ACQUIRE, "agent");
            asm volatile("s_waitcnt vmcnt(0)" ::: "memory");
        }
    }
    __syncthreads();
}

__device__ __forceinline__ float wave_sum(float v) {
#pragma unroll
    for (int o = 1; o < 64; o <<= 1) v += __shfl_xor(v, o);
    return v;
}
__device__ __forceinline__ float wave_max(float v) {
#pragma unroll
    for (int o = 1; o < 64; o <<= 1) v = fmaxf(v, __shfl_xor(v, o));
    return v;
}
__device__ __forceinline__ float bperm(float x, int srclane) { return __builtin_bit_cast(float, __builtin_amdgcn_ds_bpermute(srclane << 2, __builtin_bit_cast(int, x))); }
__device__ __forceinline__ float wave_sum_l(float v, int lane) {
#pragma unroll
    for (int o = 1; o < 64; o <<= 1) v += bperm(v, lane ^ o);
    return v;
}
__device__ __forceinline__ float wave_max_l(float v, int lane) {
#pragma unroll
    for (int o = 1; o < 64; o <<= 1) v = fmaxf(v, bperm(v, lane ^ o));
    return v;
}
__device__ __forceinline__ float siluf(float x) { return x / (1.f + expf(-x)); }
__device__ __forceinline__ float log_sigmoidf(float x) { return fminf(x, 0.f) - log1pf(expf(-fabsf(x))); }
__device__ __forceinline__ float softplusf(float x) { return fmaxf(x, 0.f) + log1pf(expf(-fabsf(x))); }

__device__ __forceinline__ const float* conv_prev(const float* MI, const float* state_conv_l, int r, int j) {
    if (r < MP) { const int b = r >> 11, i = r & 2047; const int p = i - j; if (p >= 0) return MI + (size_t)(b * 2048 + p) * LDMI + C_XBC; return MI + (size_t)(R_META + 16 + p) * LDMI + C_XBC; }
    if (r < R_META) { const int s = r - R_S, b = s >> 2, i = s & 3; const int p = i - j; if (p >= 0) return MI + (size_t)(R_S + b * 4 + p) * LDMI + C_XBC; return state_conv_l + (size_t)(b * 3 + 3 + p) * 768; }
    const int i = r - R_META, p = i - j; if (p >= 0) return MI + (size_t)(R_META + p) * LDMI + C_XBC; return nullptr;
}

struct PromptKeys { const float* KN; const float* MI; const float* FC; int b, h;
    __device__ __forceinline__ void get(int j, const float*& kp, const float*& vp, float& Fk) const { const int row = j < 16 ? R_META + j : b * 2048 + (j - 16);
        kp = KN + (size_t)row * 256 + h * 64; vp = MI + (size_t)row * LDMI + C_FV + h * 64; Fk = FC[row * 4 + h]; } };
struct SampleKeys { const float* KN; const float* MI; const float* FCS; const float* ck; const float* cv; const int* pt; int b, h, l;
    __device__ __forceinline__ void get(int j, const float*& kp, const float*& vp, float& Fk) const {
        Fk = FCS[(size_t)(b * 4 + h) * 2052 + j];
        if (j < 2048) { const int page = pt[b * 16 + (j >> 7)]; const size_t off = (((size_t)l * NPOOL + page) * 128 + (j & 127)) * 256 + h * 64; kp = ck + off; vp = cv + off; }
        else { const int row = R_S + b * 4 + (j - 2048); kp = KN + (size_t)row * 256 + h * 64; vp = MI + (size_t)row * LDMI + C_FV + h * 64; } } };

template <class Keys>
__device__ __forceinline__ void attn_row(const float* qg, float Fq, int nk, const Keys& K, bf16* outp, float* sq, float* sc, int lane) {
    sq[lane] = qg[lane];
    LDS_WAIT();
    float mx = -INFINITY;
    for (int j = lane; j < nk; j += 64) {
        const float* kp; const float* vp; float Fk; K.get(j, kp, vp, Fk);
        float s = 0.f;
#pragma unroll
        for (int d4 = 0; d4 < 16; ++d4) { const float4 a = ((const float4*)sq)[d4]; const float4 b = ((const float4*)kp)[d4]; s += a.x * b.x + a.y * b.y + a.z * b.z + a.w * b.w; }
        s = s * 0.125f + (Fq - Fk);
        sc[j] = s; mx = fmaxf(mx, s);
    }
    mx = wave_max_l(mx, lane);
    float sum = 0.f;
    for (int j = lane; j < nk; j += 64) { const float p = expf(sc[j] - mx); sc[j] = p; sum += p; }
    sum = wave_sum_l(sum, lane);
    LDS_WAIT();
    float o = 0.f;
    for (int j = 0; j < nk; ++j) { const float* kp; const float* vp; float Fk; K.get(j, kp, vp, Fk); o += sc[j] * vp[lane]; }
    outp[lane] = (bf16)f2bf(o / sum);
    LDS_WAIT();
}

namespace fa {
typedef short bf16x8 __attribute__((ext_vector_type(8)));
typedef short s16x4 __attribute__((ext_vector_type(4)));
typedef float f4 __attribute__((ext_vector_type(4)));
typedef float f32x16 __attribute__((ext_vector_type(16)));
typedef float f32x2_t __attribute__((ext_vector_type(2)));
typedef __bf16 bf16x2_t __attribute__((ext_vector_type(2)));
__device__ __forceinline__ unsigned cvtpk(float lo, float hi) { f32x2_t v = {lo, hi}; bf16x2_t b = __builtin_convertvector(v, bf16x2_t); return __builtin_bit_cast(unsigned, b); }
__device__ __forceinline__ int crow(int r, int hi) { return (r & 3) + 8 * (r >> 2) + 4 * hi; }
template <int CTRL> __device__ __forceinline__ float dpp(float x) { return __builtin_bit_cast(float, __builtin_amdgcn_mov_dpp(__builtin_bit_cast(int, x), CTRL, 0xf, 0xf, true)); }
constexpr int XOR1 = 0xB1, XOR2 = 0x4E, XOR7 = 0x141, XOR8 = 0x128;
__device__ __forceinline__ float row16_sum(float s) { s += dpp<XOR1>(s); s += dpp<XOR2>(s); s += dpp<XOR7>(s); s += dpp<XOR8>(s); return s; }
#define MFMA32(a, b, c) __builtin_amdgcn_mfma_f32_32x32x16_bf16((a), (b), (c), 0, 0, 0)

constexpr int KSTR = 144;
constexpr int L_K0 = 0, L_V0 = 2 * 64 * KSTR, L_KB = 4 * 64 * KSTR, L_WS = L_KB + 2112 * 4, L_END = L_WS + 64;
constexpr float LOG2E = 1.4426950408889634f;

__device__ __forceinline__ void fox_prompt_unit(int b, int h, int qb, const bf16* QF, const bf16* KF, const bf16* VT, const float* LF, bf16* MIXB, LAS unsigned char* lds, int tid) {
    const int lane = tid & 63, wave = __builtin_amdgcn_readfirstlane(tid >> 6), r32 = lane & 31, hi = lane >> 5;
    const int ntile = 5 + 4 * qb, nslots = 64 * ntile;
    LAS float* kb = (LAS float*)(lds + L_KB); LAS float* wsum = (LAS float*)(lds + L_WS);
    {
        float v[5]; float run = 0.f;
#pragma unroll
        for (int e = 0; e < 5; ++e) { const int slot = 5 * tid + e; float lf = 0.f;
            if (slot < 16) lf = LF[(R_META + slot) * 4 + h]; else if (slot >= 64 && slot < nslots) lf = LF[(b * 2048 + slot - 64) * 4 + h];
            run += lf; v[e] = run; }
        float x = run;
#pragma unroll
        for (int o = 1; o < 64; o <<= 1) { const float y = bperm(x, lane - o); if (lane >= o) x += y; }
        if (lane == 63) wsum[wave] = x;
        __syncthreads();
        float off = x - run;
        for (int w = 0; w < wave; ++w) off += wsum[w];
#pragma unroll
        for (int e = 0; e < 5; ++e) { const int slot = 5 * tid + e; if (slot < 2112) kb[slot] = (slot >= 16 && slot < 64) ? -INFINITY : -(off + v[e]) * LOG2E; }
    }
    const bf16* Qw = QF + ((size_t)(b * 4 + h) * 2048 + 256 * qb + 32 * wave) * 64;
    bf16x8 qr[4];
#pragma unroll
    for (int d0 = 0; d0 < 4; ++d0) qr[d0] = *(const bf16x8*)(Qw + r32 * 64 + d0 * 16 + hi * 8);
    const bf16* Kg = KF + (size_t)(b * 4 + h) * 2112 * 64 + (size_t)(tid >> 3) * 64 + (tid & 7) * 8;
    const bf16* Vg = VT + (size_t)(b * 4 + h) * 64 * 2112 + (size_t)(tid >> 3) * 2112 + (tid & 7) * 8;
    const int soff = (tid >> 3) * KSTR + (tid & 7) * 16;
    v4u kreg = *(const v4u*)Kg, vreg = *(const v4u*)Vg;
    *(LAS v4u*)(lds + L_K0 + soff) = kreg; *(LAS v4u*)(lds + L_V0 + soff) = vreg;
    __syncthreads();
    asm volatile("" : "+v"(qr[0]), "+v"(qr[1]), "+v"(qr[2]), "+v"(qr[3]));
    float m = -INFINITY, l = 0.f; f32x16 o0, o1;
#pragma unroll
    for (int i = 0; i < 16; ++i) { o0[i] = 0.f; o1[i] = 0.f; }
    const int qrow = 256 * qb + 32 * wave + r32;
    const int wave_last = 1 + (256 * qb + 32 * wave + 31) / 64;
    for (int t = 0; t < ntile; ++t) {
        const int cur = t & 1;
        if (t + 1 < ntile) { kreg = *(const v4u*)(Kg + (size_t)(t + 1) * 64 * 64); vreg = *(const v4u*)(Vg + (t + 1) * 64); }
        if (t <= wave_last) {
            LAS unsigned char* Kc = lds + L_K0 + cur * 64 * KSTR; LAS unsigned char* Vc = lds + L_V0 + cur * 64 * KSTR;
            f32x16 p0, p1;
#pragma unroll
            for (int i = 0; i < 16; ++i) { p0[i] = 0.f; p1[i] = 0.f; }
#pragma unroll
            for (int d0 = 0; d0 < 4; ++d0) {
                const bf16x8 a0 = *(const LAS bf16x8*)(Kc + r32 * KSTR + (d0 * 16 + hi * 8) * 2);
                const bf16x8 a1 = *(const LAS bf16x8*)(Kc + (32 + r32) * KSTR + (d0 * 16 + hi * 8) * 2);
                p0 = MFMA32(a0, qr[d0], p0); p1 = MFMA32(a1, qr[d0], p1);
            }
#pragma unroll
            for (int g = 0; g < 4; ++g) { const f4 b0 = *(const LAS f4*)(kb + 64 * t + 8 * g + 4 * hi); const f4 b1 = *(const LAS f4*)(kb + 64 * t + 32 + 8 * g + 4 * hi);
                p0[4 * g + 0] += b0[0]; p0[4 * g + 1] += b0[1]; p0[4 * g + 2] += b0[2]; p0[4 * g + 3] += b0[3]; p1[4 * g + 0] += b1[0]; p1[4 * g + 1] += b1[1]; p1[4 * g + 2] += b1[2]; p1[4 * g + 3] += b1[3]; }
            if (t >= 4 * qb + 1) {
                const int kbase = 64 * (t - 1);
#pragma unroll
                for (int i = 0; i < 16; ++i) { const int pk = kbase + crow(i, hi); if (pk > qrow) p0[i] = -INFINITY; if (pk + 32 > qrow) p1[i] = -INFINITY; }
            }
            float rm = fmaxf(p0[0], p1[0]);
#pragma unroll
            for (int i = 1; i < 16; ++i) rm = fmaxf(rm, fmaxf(p0[i], p1[i]));
            rm = fmaxf(rm, bperm(rm, lane ^ 32));
            const float mn = fmaxf(m, rm); const float sc = __builtin_amdgcn_exp2f(m - mn); m = mn;
            float rsum = 0.f;
#pragma unroll
            for (int i = 0; i < 16; ++i) { p0[i] = __builtin_amdgcn_exp2f(p0[i] - mn); p1[i] = __builtin_amdgcn_exp2f(p1[i] - mn); rsum += p0[i] + p1[i]; }
            l = l * sc + rsum;
#pragma unroll
            for (int i = 0; i < 16; ++i) { o0[i] *= sc; o1[i] *= sc; }
#pragma unroll
            for (int blk = 0; blk < 2; ++blk)
#pragma unroll
                for (int s2 = 0; s2 < 2; ++s2) {
                    v4u pw;
                    if (blk == 0) { pw.x = cvtpk(p0[8 * s2 + 0], p0[8 * s2 + 1]); pw.y = cvtpk(p0[8 * s2 + 2], p0[8 * s2 + 3]); pw.z = cvtpk(p0[8 * s2 + 4], p0[8 * s2 + 5]); pw.w = cvtpk(p0[8 * s2 + 6], p0[8 * s2 + 7]); }
                    else          { pw.x = cvtpk(p1[8 * s2 + 0], p1[8 * s2 + 1]); pw.y = cvtpk(p1[8 * s2 + 2], p1[8 * s2 + 3]); pw.z = cvtpk(p1[8 * s2 + 4], p1[8 * s2 + 5]); pw.w = cvtpk(p1[8 * s2 + 6], p1[8 * s2 + 7]); }
                    const bf16x8 pb = __builtin_bit_cast(bf16x8, pw);
                    const int koff = (32 * blk + 16 * s2 + 4 * hi) * 2;
                    { const s16x4 lo = *(const LAS s16x4*)(Vc + r32 * KSTR + koff), hh = *(const LAS s16x4*)(Vc + r32 * KSTR + koff + 16);
                      const bf16x8 va = {lo[0], lo[1], lo[2], lo[3], hh[0], hh[1], hh[2], hh[3]}; o0 = MFMA32(va, pb, o0); }
                    { const s16x4 lo = *(const LAS s16x4*)(Vc + (32 + r32) * KSTR + koff), hh = *(const LAS s16x4*)(Vc + (32 + r32) * KSTR + koff + 16);
                      const bf16x8 va = {lo[0], lo[1], lo[2], lo[3], hh[0], hh[1], hh[2], hh[3]}; o1 = MFMA32(va, pb, o1); }
                }
        }
        if (t + 1 < ntile) { *(LAS v4u*)(lds + L_K0 + (cur ^ 1) * 64 * KSTR + soff) = kreg; *(LAS v4u*)(lds + L_V0 + (cur ^ 1) * 64 * KSTR + soff) = vreg; }
        __syncthreads();
    }
    l += bperm(l, lane ^ 32);
    const float inv = 1.0f / l;
    bf16* orow = MIXB + (size_t)(b * 2048 + qrow) * 1024 + h * 64;
#pragma unroll
    for (int g = 0; g < 4; ++g) {
        *(uint2*)(orow + 8 * g + 4 * hi) = make_uint2(cvtpk(o0[4 * g] * inv, o0[4 * g + 1] * inv), cvtpk(o0[4 * g + 2] * inv, o0[4 * g + 3] * inv));
        *(uint2*)(orow + 32 + 8 * g + 4 * hi) = make_uint2(cvtpk(o1[4 * g] * inv, o1[4 * g + 1] * inv), cvtpk(o1[4 * g + 2] * inv, o1[4 * g + 3] * inv));
    }
}

constexpr int S_D = 0, S_WS = 32768, S_PART = 33024, S_PSTR = 68;
__device__ __forceinline__ void fox_sample_unit(int b, int l, const float* QN, const float* KN, const float* MI, const float* LF, const float* ck, const float* cv, const float* clf, const int* pt,
                                                bf16* MIXB, LAS unsigned char* lds, int tid) {
    const int lane = tid & 63, wave = __builtin_amdgcn_readfirstlane(tid >> 6), h = lane >> 4, d4 = lane & 15;
    LAS f4* Dl = (LAS f4*)(lds + S_D); LAS f4* wsum = (LAS f4*)(lds + S_WS);
    {
        const int page = pt[b * 16 + (tid >> 5)];
        const f4* src = (const f4*)(clf + (((size_t)l * NPOOL + page) * 128 + 4 * (tid & 31)) * 4);
        const f4 v0 = src[0], v1 = src[1], v2 = src[2], v3 = src[3];
        const f4 s2 = v3, s1 = v3 + v2, s0 = s1 + v1, tot = s0 + v0;
        f4 x = tot;
#pragma unroll
        for (int o = 1; o < 64; o <<= 1) { f4 y; y[0] = bperm(x[0], lane + o); y[1] = bperm(x[1], lane + o); y[2] = bperm(x[2], lane + o); y[3] = bperm(x[3], lane + o); if (lane + o < 64) x += y; }
        if (lane == 0) wsum[wave] = x;
        __syncthreads();
        f4 off = x - tot;
        for (int w = wave + 1; w < 8; ++w) off += wsum[w];
        Dl[4 * tid + 0] = s0 + off; Dl[4 * tid + 1] = s1 + off; Dl[4 * tid + 2] = s2 + off; Dl[4 * tid + 3] = off;
        __syncthreads();
    }
    float4 q[4];
#pragma unroll
    for (int i = 0; i < 4; ++i) { const float4 t = *(const float4*)(QN + (size_t)(R_S + b * 4 + i) * 256 + h * 64 + 4 * d4); q[i] = make_float4(t.x * 0.125f, t.y * 0.125f, t.z * 0.125f, t.w * 0.125f); }
    float m[4], ls[4]; float4 o[4];
#pragma unroll
    for (int i = 0; i < 4; ++i) { m[i] = -INFINITY; ls[i] = 0.f; o[i] = make_float4(0.f, 0.f, 0.f, 0.f); }
    const LAS float* Df = (const LAS float*)Dl;
    for (int p = 0; p < 16; ++p) {
        const int page = pt[b * 16 + p];
        const size_t base = (((size_t)l * NPOOL + page) * 128 + 16 * wave) * 256 + lane * 4;
#pragma unroll
        for (int hf = 0; hf < 2; ++hf) {
            pg8::f32x4 kk[8], vv[8];
#pragma unroll
            for (int j = 0; j < 8; ++j) { kk[j] = __builtin_nontemporal_load((const pg8::f32x4*)(ck + base + (size_t)(hf * 8 + j) * 256)); vv[j] = __builtin_nontemporal_load((const pg8::f32x4*)(cv + base + (size_t)(hf * 8 + j) * 256)); }
            float s[4][8];
#pragma unroll
            for (int j = 0; j < 8; ++j) { const float dk = Df[(p * 128 + 16 * wave + hf * 8 + j) * 4 + h];
#pragma unroll
                for (int i = 0; i < 4; ++i) s[i][j] = row16_sum(q[i].x * kk[j][0] + q[i].y * kk[j][1] + q[i].z * kk[j][2] + q[i].w * kk[j][3]) + dk; }
#pragma unroll
            for (int i = 0; i < 4; ++i) {
                float mx = s[i][0];
#pragma unroll
                for (int j = 1; j < 8; ++j) mx = fmaxf(mx, s[i][j]);
                const float mn = fmaxf(m[i], mx); const float sc = __expf(m[i] - mn); m[i] = mn;
                ls[i] *= sc; o[i].x *= sc; o[i].y *= sc; o[i].z *= sc; o[i].w *= sc;
#pragma unroll
                for (int j = 0; j < 8; ++j) { const float pj = __expf(s[i][j] - mn); ls[i] += pj; o[i].x += pj * vv[j][0]; o[i].y += pj * vv[j][1]; o[i].z += pj * vv[j][2]; o[i].w += pj * vv[j][3]; }
            }
        }
    }
    LAS float* part = (LAS float*)(lds + S_PART);
#pragma unroll
    for (int i = 0; i < 4; ++i) { LAS float* pp = part + ((wave * 16) + h * 4 + i) * S_PSTR; *(LAS f4*)(pp + 4 + 4 * d4) = (f4){o[i].x, o[i].y, o[i].z, o[i].w}; if (d4 == 0) { pp[0] = m[i]; pp[1] = ls[i]; } }
    __syncthreads();
    for (int u = tid; u < 1024; u += 512) {
        const int hh = u >> 8, i = (u >> 6) & 3, d = u & 63;
        const int rowq = R_S + b * 4 + i;
        float sn[4]; float G = 0.f;
#pragma unroll
        for (int j = 0; j < 4; ++j) { const int rowk = R_S + b * 4 + j; G -= LF[rowk * 4 + hh]; float dot = 0.f;
            const float* qp = QN + (size_t)rowq * 256 + hh * 64; const float* kp = KN + (size_t)rowk * 256 + hh * 64;
            for (int c = 0; c < 64; ++c) dot += qp[c] * kp[c];
            sn[j] = j <= i ? dot * 0.125f + G : -INFINITY; }
        float mt = fmaxf(fmaxf(sn[0], sn[1]), fmaxf(sn[2], sn[3]));
        for (int w = 0; w < 8; ++w) mt = fmaxf(mt, part[(w * 16 + hh * 4 + i) * S_PSTR]);
        float lt = 0.f, ot = 0.f;
        for (int w = 0; w < 8; ++w) { const LAS float* pp = part + (w * 16 + hh * 4 + i) * S_PSTR; const float e = __expf(pp[0] - mt); lt += e * pp[1]; ot += e * pp[4 + d]; }
#pragma unroll
        for (int j = 0; j < 4; ++j) { const float e = __expf(sn[j] - mt); lt += e; ot += e * MI[(size_t)(R_S + b * 4 + j) * LDMI + C_FV + hh * 64 + d]; }
        MIXB[(size_t)rowq * 1024 + hh * 64 + d] = (bf16)f2bf(ot / lt);
    }
    __syncthreads();
}
#undef MFMA32
}

namespace la {
using fa::bf16x8; using fa::s16x4; using fa::f32x16; using fa::f4; using fa::cvtpk; using fa::crow;
#define MFMA32(a, b, c) __builtin_amdgcn_mfma_f32_32x32x16_bf16((a), (b), (c), 0, 0, 0)
#define LDS_BARRIER() asm volatile("s_waitcnt lgkmcnt(0)\n\ts_barrier" ::: "memory")
__device__ __forceinline__ int seq_row(int b, int c, int t) { const int sg = 128 * c - 112 + t; return sg < 0 ? -1 : (sg < 16 ? R_META + sg : b * 2048 + sg - 16); }
__device__ __forceinline__ bf16x8 pack8(const f32x16& x, int s) { v4u p; p.x = cvtpk(x[8 * s], x[8 * s + 1]); p.y = cvtpk(x[8 * s + 2], x[8 * s + 3]); p.z = cvtpk(x[8 * s + 4], x[8 * s + 5]); p.w = cvtpk(x[8 * s + 6], x[8 * s + 7]); return __builtin_bit_cast(bf16x8, p); }
__device__ __forceinline__ bf16x8 ld16(const LAS unsigned char* p) { return *(const LAS bf16x8*)p; }
__device__ __forceinline__ bf16x8 ld8x2(const LAS unsigned char* p) { const s16x4 lo = *(const LAS s16x4*)p, hh = *(const LAS s16x4*)(p + 16); return (bf16x8){lo[0], lo[1], lo[2], lo[3], hh[0], hh[1], hh[2], hh[3]}; }
__device__ __forceinline__ float silu_f(float x) { return x * __builtin_amdgcn_rcpf(1.0f + __expf(-x)); }
__device__ __forceinline__ float bf2f(unsigned short v) { return __uint_as_float((unsigned)v << 16); }
typedef unsigned u2v __attribute__((ext_vector_type(2)));
constexpr int TPITCH = 272;
constexpr int OPITCH = 68;

constexpr int G_QL = 0, G_KL = 10240, G_KT = 20480, G_VT = 29184, G_OUT = 46592, G_BC = 81408, G_SEG = 98304, G_BL = 100352, G_BLR = 100480;
__device__ __forceinline__ void gla_prompt_unit(int b, int h, const GAS bf16* MIB, const GAS float* GLOG, const GAS float* gnorm, GAS bf16* MIXB, GAS float* state_out, LAS unsigned char* lds, int tid0) {
    int tid = tid0;
    int lane = tid & 63, wave = __builtin_amdgcn_readfirstlane(tid >> 6), r32 = lane & 31, hi = lane >> 5, vt = wave & 1, tt = wave < 4 ? (wave >> 1) : 3 - ((wave - 4) >> 1);
    LAS unsigned char* QL = lds + G_QL; LAS unsigned char* KL = lds + G_KL; LAS unsigned char* KT = lds + G_KT; LAS unsigned char* VT = lds + G_VT;
    LAS float* OUT = (LAS float*)(lds + G_OUT); LAS float* BC = (LAS float*)(lds + G_BC); LAS float* SEG = (LAS float*)(lds + G_SEG); LAS float* BL = (LAS float*)(lds + G_BL); LAS float* BLR = (LAS float*)(lds + G_BLR);
    f32x16 SK;
#pragma unroll
    for (int i = 0; i < 16; ++i) SK[i] = 0.f;
    int kk = tid & 31, seg = tid >> 5;
    f4 q0, q1, k0, k1, v4[4]; float gl[8];
#define BF4(w_) ((f4){__uint_as_float((w_)[0] << 16), __uint_as_float((w_)[0] & 0xffff0000u), __uint_as_float((w_)[1] << 16), __uint_as_float((w_)[1] & 0xffff0000u)})
#define GLA_LOAD(cc) do { const int row = seq_row(b, (cc), tid >> 2); const GAS bf16* mr = MIB + (size_t)(row >= 0 ? row : 0) * N_MAIN; const int qd_ = tid & 3; \
        const u2v a0_ = *(const GAS u2v*)(mr + CM_GQ + h * 32 + 8 * qd_), a1_ = *(const GAS u2v*)(mr + CM_GQ + h * 32 + 8 * qd_ + 4), b0_ = *(const GAS u2v*)(mr + CM_GK + h * 32 + 8 * qd_), b1_ = *(const GAS u2v*)(mr + CM_GK + h * 32 + 8 * qd_ + 4); \
        u2v c_[4]; _Pragma("unroll") for (int j4 = 0; j4 < 4; ++j4) c_[j4] = *(const GAS u2v*)(mr + CM_GV + h * 64 + 16 * qd_ + 4 * j4); \
        _Pragma("unroll") for (int e_ = 0; e_ < 8; ++e_) { const int rg_ = seq_row(b, (cc), 8 * (tid >> 5) + e_); gl[e_] = GLOG[(size_t)(rg_ >= 0 ? rg_ : 0) * 128 + h * 32 + (tid & 31)]; } \
        q0 = BF4(a0_); q1 = BF4(a1_); k0 = BF4(b0_); k1 = BF4(b1_); _Pragma("unroll") for (int j4 = 0; j4 < 4; ++j4) v4[j4] = BF4(c_[j4]); } while (0)
    GLA_LOAD(0);
    for (int c = 0; c < 17; ++c) {
        tid = tid0; asm volatile("" : "+v"(tid)); lane = tid & 63; wave = __builtin_amdgcn_readfirstlane(tid >> 6); r32 = lane & 31; hi = lane >> 5; vt = wave & 1; tt = wave < 4 ? (wave >> 1) : 3 - ((wave - 4) >> 1); kk = tid & 31; seg = tid >> 5;
        if (c == 0 && (tid >> 2) < 112) { const f4 z = (f4){0.f, 0.f, 0.f, 0.f}; q0 = z; q1 = z; k0 = z; k1 = z; v4[0] = z; v4[1] = z; v4[2] = z; v4[3] = z; }
        {
            float bcl[8]; float run = 0.f;
#pragma unroll
            for (int e = 0; e < 8; ++e) { const float gv = (c == 0 && 8 * seg + e < 112) ? 0.f : gl[e]; run += gv; bcl[e] = run; }
            SEG[seg * 32 + kk] = run;
            LDS_BARRIER();
            float off = 0.f, tot = 0.f;
#pragma unroll
            for (int s = 0; s < 16; ++s) { const float v = SEG[s * 32 + kk]; tot += v; if (s < seg) off += v; }
#pragma unroll
            for (int e = 0; e < 8; ++e) BC[(8 * seg + e) * 33 + kk] = bcl[e] + off;
            if (seg == 0) { BL[kk] = __expf(tot); BLR[kk] = tot; }
            LDS_BARRIER();
        }
        {
            const int t = tid >> 2, qd = tid & 3;
            const float q[8] = {q0[0], q0[1], q0[2], q0[3], q1[0], q1[1], q1[2], q1[3]}, k[8] = {k0[0], k0[1], k0[2], k0[3], k1[0], k1[1], k1[2], k1[3]};
            float qv[8], kv[8];
#pragma unroll
            for (int j = 0; j < 8; ++j) { const float bcv = BC[t * 33 + 8 * qd + j]; qv[j] = q[j] * 0.17677669529663687f * __expf(bcv); kv[j] = k[j] * __expf(-bcv);
                *(LAS bf16*)(KT + (8 * qd + j) * TPITCH + 2 * t) = (bf16)(cvtpk(k[j] * __expf(BLR[8 * qd + j] - bcv), 0.f) & 0xffffu); }
            *(LAS v4u*)(QL + t * 80 + qd * 16) = (v4u){cvtpk(qv[0], qv[1]), cvtpk(qv[2], qv[3]), cvtpk(qv[4], qv[5]), cvtpk(qv[6], qv[7])};
            *(LAS v4u*)(KL + t * 80 + qd * 16) = (v4u){cvtpk(kv[0], kv[1]), cvtpk(kv[2], kv[3]), cvtpk(kv[4], kv[5]), cvtpk(kv[6], kv[7])};
#pragma unroll
            for (int j4 = 0; j4 < 4; ++j4)
#pragma unroll
                for (int e = 0; e < 4; e += 2) { const unsigned w_ = cvtpk(v4[j4][e], v4[j4][e + 1]); *(LAS bf16*)(VT + (16 * qd + 4 * j4 + e) * TPITCH + 2 * t) = (bf16)(w_ & 0xffffu); *(LAS bf16*)(VT + (16 * qd + 4 * j4 + e + 1) * TPITCH + 2 * t) = (bf16)(w_ >> 16); }
        }
        float zz[16];
#pragma unroll
        for (int i = 0; i < 16; ++i) { const int row = seq_row(b, c, 16 * wave + i); zz[i] = bf2f(MIB[(size_t)(row >= 0 ? row : 0) * N_MAIN + CM_GG + h * 64 + lane]); }
        if (c + 1 < 17) GLA_LOAD(c + 1);
        LDS_BARRIER();
        {
            f32x16 y;
#pragma unroll
            for (int i = 0; i < 16; ++i) y[i] = 0.f;
            const LAS unsigned char* qrow = QL + (32 * tt + r32) * 80;
#pragma unroll
            for (int s2 = 0; s2 < 2; ++s2) y = MFMA32(pack8(SK, s2), ld8x2(qrow + (16 * s2 + 4 * hi) * 2), y);
            for (int i = 0; i <= tt; ++i) {
                f32x16 gt;
#pragma unroll
                for (int r = 0; r < 16; ++r) gt[r] = 0.f;
#pragma unroll
                for (int ks = 0; ks < 2; ++ks) gt = MFMA32(ld16(KL + (32 * i + r32) * 80 + (16 * ks + 8 * hi) * 2), ld16(qrow + (16 * ks + 8 * hi) * 2), gt);
                if (i == tt) {
#pragma unroll
                    for (int r = 0; r < 16; ++r) if (crow(r, hi) > r32) gt[r] = 0.f; }
#pragma unroll
                for (int s2 = 0; s2 < 2; ++s2) y = MFMA32(ld8x2(VT + (32 * vt + r32) * TPITCH + (32 * i + 16 * s2 + 4 * hi) * 2), pack8(gt, s2), y);
            }
#pragma unroll
            for (int r = 0; r < 16; ++r) SK[r] *= BL[crow(r, hi)];
#pragma unroll
            for (int ks = 0; ks < 8; ++ks) SK = MFMA32(ld16(KT + r32 * TPITCH + (16 * ks + 8 * hi) * 2), ld16(VT + (32 * vt + r32) * TPITCH + (16 * ks + 8 * hi) * 2), SK);
#pragma unroll
            for (int g4 = 0; g4 < 4; ++g4) *(LAS f4*)(OUT + (32 * tt + r32) * OPITCH + 32 * vt + 8 * g4 + 4 * hi) = (f4){y[4 * g4], y[4 * g4 + 1], y[4 * g4 + 2], y[4 * g4 + 3]};
        }
        LDS_BARRIER();
        {
            const float gnl = gnorm[lane];
            float ov[16], ss[16];
#pragma unroll
            for (int i = 0; i < 16; ++i) { ov[i] = OUT[(16 * wave + i) * OPITCH + lane]; ss[i] = fa::row16_sum(ov[i] * ov[i]); }
#pragma unroll
            for (int i = 0; i < 16; ++i) ss[i] += bperm(ss[i], lane ^ 16);
#pragma unroll
            for (int i = 0; i < 16; ++i) ss[i] += bperm(ss[i], lane ^ 32);
#pragma unroll
            for (int i = 0; i < 16; ++i) { const int row = seq_row(b, c, 16 * wave + i);
                if (row >= 0 && (row < MP || b == 0)) MIXB[(size_t)row * 1024 + 768 + h * 64 + lane] = (bf16)(cvtpk(ov[i] * rsqrtf(ss[i] * (1.0f / 64.0f) + EPS) * gnl * zz[i], 0.f) & 0xffffu); }
        }
        LDS_BARRIER();
    }
#undef GLA_LOAD
    if (tt == 0) {
#pragma unroll
        for (int r = 0; r < 16; ++r) state_out[crow(r, hi) * 64 + 32 * vt + r32] = SK[r]; }
}

constexpr int S_QL = 0, S_KL = 18432, S_KT = 36864, S_VT = 54272, S_OUT = 71680, S_CS = 106496, S_DT = 107008, S_TOT = 107520, S_FS = 107776;
__device__ __forceinline__ void ssd_prompt_unit(int b, int h, const GAS bf16* MIB, const GAS bf16* XC, const GAS float* DTS, float A, float Dh, GAS bf16* MIXB, GAS float* SSQH, GAS float* state_out, LAS unsigned char* lds, int tid0) {
    int tid = tid0; const int g = h >> 2;
    int lane = tid & 63, wave = __builtin_amdgcn_readfirstlane(tid >> 6), r32 = lane & 31, hi = lane >> 5, vt = wave & 1, tt = wave < 4 ? (wave >> 1) : 3 - ((wave - 4) >> 1);
    LAS unsigned char* QL = lds + S_QL; LAS unsigned char* KL = lds + S_KL; LAS unsigned char* KT = lds + S_KT; LAS unsigned char* VT = lds + S_VT;
    LAS float* OUT = (LAS float*)(lds + S_OUT); LAS float* CS = (LAS float*)(lds + S_CS); LAS float* DT = (LAS float*)(lds + S_DT); LAS float* TOT = (LAS float*)(lds + S_TOT);
    f32x16 SK0, SK1;
#pragma unroll
    for (int i = 0; i < 16; ++i) { SK0[i] = 0.f; SK1[i] = 0.f; }
    v4u pb0, pb1, pc0, pc1, px0, px1; float dr0, dr1;
#define SSD_LOAD(cc) do { const int row_ = seq_row(b, (cc), tid >> 2); const GAS bf16* xr_ = XC + (size_t)(row_ >= 0 ? row_ : 0) * 768; const int q_ = tid & 3; \
        pb0 = *(const GAS v4u*)(xr_ + 512 + 64 * g + 8 * q_); pb1 = *(const GAS v4u*)(xr_ + 512 + 64 * g + 32 + 8 * q_); pc0 = *(const GAS v4u*)(xr_ + 640 + 64 * g + 8 * q_); pc1 = *(const GAS v4u*)(xr_ + 640 + 64 * g + 32 + 8 * q_); \
        px0 = *(const GAS v4u*)(xr_ + 64 * h + 8 * q_); px1 = *(const GAS v4u*)(xr_ + 64 * h + 32 + 8 * q_); \
        const int ra_ = seq_row(b, (cc), 2 * lane), rb_ = seq_row(b, (cc), 2 * lane + 1); dr0 = DTS[(size_t)(ra_ >= 0 ? ra_ : 0) * 8 + h]; dr1 = DTS[(size_t)(rb_ >= 0 ? rb_ : 0) * 8 + h]; } while (0)
    SSD_LOAD(0);
    for (int c = 0; c < 17; ++c) {
        tid = tid0; asm volatile("" : "+v"(tid)); lane = tid & 63; wave = __builtin_amdgcn_readfirstlane(tid >> 6); r32 = lane & 31; hi = lane >> 5; vt = wave & 1; tt = wave < 4 ? (wave >> 1) : 3 - ((wave - 4) >> 1);
        {
            const int t = tid >> 2, q = tid & 3;
            const bool pad0 = c == 0 && 2 * lane < 112, pad1 = c == 0 && 2 * lane + 1 < 112;
            const float d0 = pad0 ? 0.f : dr0, d1 = pad1 ? 0.f : dr1;
            const float a0 = d0 * A, a1 = d1 * A; float x = a0 + a1;
#pragma unroll
            for (int o = 1; o < 64; o <<= 1) { const float y = bperm(x, lane - o); if (lane >= o) x += y; }
            const float csl = bperm(x, 63);
            const float cs1 = x, cs0 = x - a1;
            if (tt > 0) {
                const float R = bperm(cs1, 16 * tt - 1);
                LAS float* FSw = (LAS float*)(lds + S_FS) + wave * 128;
                *(LAS u2v*)(FSw + 2 * lane) = (u2v){__float_as_uint(__expf(fminf(R - cs0, 0.f)) * d0), __float_as_uint(__expf(fminf(R - cs1, 0.f)) * d1)}; }
            if (wave == 0) { *(LAS u2v*)(CS + 2 * lane) = (u2v){__float_as_uint(cs0), __float_as_uint(cs1)}; *(LAS u2v*)(DT + 2 * lane) = (u2v){__float_as_uint(d0), __float_as_uint(d1)}; if (lane == 0) TOT[0] = csl; }
            const int src = t >> 1; const float csa = bperm(cs0, src), csb = bperm(cs1, src), dta = bperm(d0, src), dtb_ = bperm(d1, src);
            const float cst = (t & 1) ? csb : csa, dtt = (t & 1) ? dtb_ : dta;
            const float wgt = dtt * __expf(csl - cst);
            const bool padt = c == 0 && t < 112;
            if (padt) { const v4u z = (v4u){0u, 0u, 0u, 0u}; pb0 = z; pb1 = z; pc0 = z; pc1 = z; px0 = z; px1 = z; }
            *(LAS v4u*)(KL + t * 144 + q * 16) = pb0; *(LAS v4u*)(KL + t * 144 + 64 + q * 16) = pb1;
            *(LAS v4u*)(QL + t * 144 + q * 16) = pc0; *(LAS v4u*)(QL + t * 144 + 64 + q * 16) = pc1;
            const unsigned xw[8] = {px0.x, px0.y, px0.z, px0.w, px1.x, px1.y, px1.z, px1.w};
            const unsigned bw[8] = {pb0.x, pb0.y, pb0.z, pb0.w, pb1.x, pb1.y, pb1.z, pb1.w};
#pragma unroll
            for (int j = 0; j < 8; ++j) { const int p = (j < 4 ? 8 * q : 32 + 8 * q) + 2 * (j & 3);
                *(LAS bf16*)(VT + p * TPITCH + 2 * t) = (bf16)(xw[j] & 0xffffu); *(LAS bf16*)(VT + (p + 1) * TPITCH + 2 * t) = (bf16)(xw[j] >> 16);
                const unsigned wb = cvtpk(__uint_as_float(bw[j] << 16) * wgt, __uint_as_float(bw[j] & 0xffff0000u) * wgt);
                *(LAS bf16*)(KT + p * TPITCH + 2 * t) = (bf16)(wb & 0xffffu); *(LAS bf16*)(KT + (p + 1) * TPITCH + 2 * t) = (bf16)(wb >> 16); }
        }
        LDS_BARRIER();
        float zz[16];
#pragma unroll
        for (int i = 0; i < 16; ++i) { const int row = seq_row(b, c, 16 * wave + i); zz[i] = bf2f(MIB[(size_t)(row >= 0 ? row : 0) * N_MAIN + CM_SZ + h * 64 + lane]); }
        if (c + 1 < 17) SSD_LOAD(c + 1);
        {
            f32x16 y;
#pragma unroll
            for (int i = 0; i < 16; ++i) y[i] = 0.f;
            const LAS unsigned char* qrow = QL + (32 * tt + r32) * 144;
#pragma unroll
            for (int s2 = 0; s2 < 2; ++s2) { y = MFMA32(pack8(SK0, s2), ld8x2(qrow + (16 * s2 + 4 * hi) * 2), y); y = MFMA32(pack8(SK1, s2), ld8x2(qrow + (32 + 16 * s2 + 4 * hi) * 2), y); }
            const float cst = CS[32 * tt + r32]; const float ect = __expf(cst);
#pragma unroll
            for (int i = 0; i < 16; ++i) y[i] *= ect;
            if (tt > 0) {
                const LAS float* FSw = (const LAS float*)(lds + S_FS) + wave * 128;
                f32x16 y2;
#pragma unroll
                for (int r = 0; r < 16; ++r) y2[r] = 0.f;
                for (int i = 0; i < tt; ++i) {
                    f32x16 gt;
#pragma unroll
                    for (int r = 0; r < 16; ++r) gt[r] = 0.f;
#pragma unroll
                    for (int ks = 0; ks < 4; ++ks) gt = MFMA32(ld16(KL + (32 * i + r32) * 144 + (16 * ks + 8 * hi) * 2), ld16(qrow + (16 * ks + 8 * hi) * 2), gt);
#pragma unroll
                    for (int g4 = 0; g4 < 4; ++g4) { const f4 fs4 = *(const LAS f4*)(FSw + 32 * i + 8 * g4 + 4 * hi); gt[4 * g4] *= fs4[0]; gt[4 * g4 + 1] *= fs4[1]; gt[4 * g4 + 2] *= fs4[2]; gt[4 * g4 + 3] *= fs4[3]; }
#pragma unroll
                    for (int s2 = 0; s2 < 2; ++s2) y2 = MFMA32(ld8x2(VT + (32 * vt + r32) * TPITCH + (32 * i + 16 * s2 + 4 * hi) * 2), pack8(gt, s2), y2);
                }
                const float et = __expf(fminf(cst - CS[32 * tt - 1], 0.f));
#pragma unroll
                for (int r = 0; r < 16; ++r) y[r] += et * y2[r];
            }
            {
                const int i = tt;
                f32x16 gt;
#pragma unroll
                for (int r = 0; r < 16; ++r) gt[r] = 0.f;
#pragma unroll
                for (int ks = 0; ks < 4; ++ks) gt = MFMA32(ld16(KL + (32 * i + r32) * 144 + (16 * ks + 8 * hi) * 2), ld16(qrow + (16 * ks + 8 * hi) * 2), gt);
#pragma unroll
                for (int g4 = 0; g4 < 4; ++g4) { const f4 cs4 = *(const LAS f4*)(CS + 32 * i + 8 * g4 + 4 * hi), dt4 = *(const LAS f4*)(DT + 32 * i + 8 * g4 + 4 * hi);
#pragma unroll
                    for (int e = 0; e < 4; ++e) { const bool vis = 8 * g4 + 4 * hi + e <= r32; const float wv = vis ? __expf(fminf(cst - cs4[e], 0.f)) * dt4[e] : 0.f; gt[4 * g4 + e] *= wv; } }
#pragma unroll
                for (int s2 = 0; s2 < 2; ++s2) y = MFMA32(ld8x2(VT + (32 * vt + r32) * TPITCH + (32 * i + 16 * s2 + 4 * hi) * 2), pack8(gt, s2), y);
            }
            const float ecl = __expf(TOT[0]);
#pragma unroll
            for (int r = 0; r < 16; ++r) { SK0[r] *= ecl; SK1[r] *= ecl; }
#pragma unroll 2
            for (int ks = 0; ks < 8; ++ks) { const bf16x8 xb = ld16(VT + (32 * vt + r32) * TPITCH + (16 * ks + 8 * hi) * 2);
                SK0 = MFMA32(ld16(KT + r32 * TPITCH + (16 * ks + 8 * hi) * 2), xb, SK0); SK1 = MFMA32(ld16(KT + (32 + r32) * TPITCH + (16 * ks + 8 * hi) * 2), xb, SK1); }
#pragma unroll
            for (int g4 = 0; g4 < 4; ++g4) { f4 o;
#pragma unroll
                for (int e = 0; e < 4; ++e) o[e] = y[4 * g4 + e] + Dh * bf2f(*(const LAS bf16*)(VT + (32 * vt + 8 * g4 + 4 * hi + e) * TPITCH + 2 * (32 * tt + r32)));
                *(LAS f4*)(OUT + (32 * tt + r32) * OPITCH + 32 * vt + 8 * g4 + 4 * hi) = o; }
        }
        LDS_BARRIER();
        {
            float yv[16], ss[16];
#pragma unroll
            for (int i = 0; i < 16; ++i) { yv[i] = OUT[(16 * wave + i) * OPITCH + lane] * zz[i]; ss[i] = fa::row16_sum(yv[i] * yv[i]); }
#pragma unroll
            for (int i = 0; i < 16; ++i) ss[i] += bperm(ss[i], lane ^ 16);
#pragma unroll
            for (int i = 0; i < 16; ++i) ss[i] += bperm(ss[i], lane ^ 32);
            if (c > 0) {
                const size_t row0 = (size_t)b * 2048 + 128 * (c - 1) + 16 * wave;
#pragma unroll
                for (int i = 0; i < 16; ++i) { if (lane == 0) SSQH[(row0 + i) * 8 + h] = ss[i]; MIXB[(row0 + i) * 1024 + 256 + h * 64 + lane] = (bf16)(cvtpk(yv[i], 0.f) & 0xffffu); }
            } else if (b == 0 && wave == 7) {
#pragma unroll
                for (int i = 0; i < 16; ++i) { if (lane == 0) SSQH[(size_t)(R_META + i) * 8 + h] = ss[i]; MIXB[(size_t)(R_META + i) * 1024 + 256 + h * 64 + lane] = (bf16)(cvtpk(yv[i], 0.f) & 0xffffu); }
            }
        }
        LDS_BARRIER();
    }
#undef SSD_LOAD
    if (tt == 0) {
#pragma unroll
        for (int g4 = 0; g4 < 4; ++g4) { *(GAS f4*)(state_out + (32 * vt + r32) * 64 + 8 * g4 + 4 * hi) = (f4){SK0[4 * g4], SK0[4 * g4 + 1], SK0[4 * g4 + 2], SK0[4 * g4 + 3]};
            *(GAS f4*)(state_out + (32 * vt + r32) * 64 + 32 + 8 * g4 + 4 * hi) = (f4){SK1[4 * g4], SK1[4 * g4 + 1], SK1[4 * g4 + 2], SK1[4 * g4 + 3]}; } }
}
#undef MFMA32
}

namespace eu {
using fa::f4;
constexpr int E_Q = 67840, E_K = 71936, E_V = 76032, E_LF = 80128, E_XBC = 80256, E_DT = 92544, E_GLOG = 92672, E_YS = 94720, E_GO = 102912, E_END = 107008;

__device__ __forceinline__ void sample_unit(int b, int l, const float* MI, const float* ck, const float* cv, const float* clf, const int* pt, const float* st_ssm, const float* st_conv, const float* st_gla,
        const float* qg, const float* kg, const float* fbias, const float* cw, const float* cb, const float* dtb, const float* alog, const float* dsk, const float* snorm,
        const float* wg, const float* gbias, const float* gnorm, bf16* MIXB, float* out, LAS unsigned char* lds, int tid) {
    const int lane = tid & 63, wave = __builtin_amdgcn_readfirstlane(tid >> 6);
    LAS float* EQ = (LAS float*)(lds + E_Q); LAS float* EK = (LAS float*)(lds + E_K); LAS float* EV = (LAS float*)(lds + E_V); LAS float* ELF = (LAS float*)(lds + E_LF);
    LAS float* EX = (LAS float*)(lds + E_XBC); LAS float* EDT = (LAS float*)(lds + E_DT); LAS float* EG = (LAS float*)(lds + E_GLOG); LAS float* EYS = (LAS float*)(lds + E_YS); LAS float* EGO = (LAS float*)(lds + E_GO);
    const int r0 = R_S + 4 * b;
    if (wave < 4) { const float* mi = MI + (size_t)(r0 + wave) * LDMI;
#pragma unroll
        for (int h = 0; h < 4; ++h) { const float q = mi[C_FQ + h * 64 + lane], k = mi[C_FK + h * 64 + lane], v = mi[C_FV + h * 64 + lane];
            const float qs = rsqrtf(wave_sum_l(q * q, lane) * (1.f / 64.f) + EPS), ks = rsqrtf(wave_sum_l(k * k, lane) * (1.f / 64.f) + EPS);
            EQ[wave * 256 + h * 64 + lane] = q * qs * qg[lane]; EK[wave * 256 + h * 64 + lane] = k * ks * kg[lane]; EV[wave * 256 + h * 64 + lane] = v; }
        if (lane < 4) ELF[wave * 4 + lane] = log_sigmoidf(mi[C_FF + lane] + fbias[lane]);
    }
    for (int idx = tid; idx < 3072; idx += 512) { const int i = idx / 768, c = idx - i * 768; float u[4];
#pragma unroll
        for (int j = 0; j < 4; ++j) { const int p = i - j; u[j] = p >= 0 ? MI[(size_t)(r0 + p) * LDMI + C_XBC + c] : st_conv[(size_t)(b * 3 + 3 + p) * 768 + c]; }
        const float o = cw[3 * 768 + c] * u[0] + cw[2 * 768 + c] * u[1] + cw[768 + c] * u[2] + cw[c] * u[3] + cb[c];
        EX[i * 768 + c] = siluf(o); }
    if (tid < 32) EDT[tid] = softplusf(MI[(size_t)(r0 + (tid >> 3)) * LDMI + C_DT + (tid & 7)] + dtb[tid & 7]);
    { const int i = tid >> 7, c = tid & 127; const float* lr = MI + (size_t)(r0 + i) * LDMI + C_LR; float a = gbias[c];
#pragma unroll
        for (int r = 0; r < 16; ++r) a += lr[r] * wg[r * 128 + c];
        EG[i * 128 + c] = log_sigmoidf(a) * (1.0f / 16.0f); }
    {
        const int h = lane >> 4, d4 = lane & 15;
        LAS f4* Dl = (LAS f4*)(lds + fa::S_D); LAS f4* wsum = (LAS f4*)(lds + fa::S_WS);
        {
            const int page = pt[b * 16 + (tid >> 5)];
            const f4* src = (const f4*)(clf + (((size_t)l * NPOOL + page) * 128 + 4 * (tid & 31)) * 4);
            const f4 v0 = src[0], v1 = src[1], v2 = src[2], v3 = src[3];
            const f4 s2 = v3, s1 = v3 + v2, s0 = s1 + v1, tot = s0 + v0;
            f4 x = tot;
#pragma unroll
            for (int o = 1; o < 64; o <<= 1) { f4 y; y[0] = bperm(x[0], lane + o); y[1] = bperm(x[1], lane + o); y[2] = bperm(x[2], lane + o); y[3] = bperm(x[3], lane + o); if (lane + o < 64) x += y; }
            if (lane == 0) wsum[wave] = x;
            __syncthreads();
            f4 off = x - tot;
            for (int w = wave + 1; w < 8; ++w) off += wsum[w];
            Dl[4 * tid + 0] = s0 + off; Dl[4 * tid + 1] = s1 + off; Dl[4 * tid + 2] = s2 + off; Dl[4 * tid + 3] = off;
            __syncthreads();
        }
        const int r16 = lane & 15, q4 = lane >> 4, hp = r16 >> 2, iq = lane & 3;
        f4 q[4];
#pragma unroll
        for (int i = 0; i < 4; ++i) q[i] = *(const LAS f4*)(EQ + i * 256 + h * 64 + 4 * d4) * 0.125f;
        float m = -INFINITY, ls = 0.f; f4 oc[4];
#pragma unroll
        for (int c = 0; c < 4; ++c) oc[c] = (f4){0.f, 0.f, 0.f, 0.f};
        const LAS float* Df = (const LAS float*)Dl;
        const bool b0 = lane & 1, b1 = lane & 2, mine = hp == q4;
        for (int p = 0; p < 16; ++p) {
            const int page = pt[b * 16 + p];
            const size_t base = (((size_t)l * NPOOL + page) * 128 + 16 * wave) * 256 + lane * 4;
            f4 kk[16], vv[16];
#pragma unroll
            for (int j = 0; j < 16; ++j) { kk[j] = __builtin_nontemporal_load((const f4*)(ck + base + (size_t)j * 256)); vv[j] = __builtin_nontemporal_load((const f4*)(cv + base + (size_t)j * 256)); }
            float sj[16];
#pragma unroll
            for (int j = 0; j < 16; ++j) {
                float pq[4];
#pragma unroll
                for (int i = 0; i < 4; ++i) pq[i] = q[i][0] * kk[j][0] + q[i][1] * kk[j][1] + q[i][2] * kk[j][2] + q[i][3] * kk[j][3];
                const float k0 = b0 ? pq[1] : pq[0], g0 = b0 ? pq[0] : pq[1], k1 = b0 ? pq[3] : pq[2], g1 = b0 ? pq[2] : pq[3];
                const float r0 = k0 + fa::dpp<fa::XOR1>(g0), r1 = k1 + fa::dpp<fa::XOR1>(g1);
                float t = (b1 ? r1 : r0) + fa::dpp<fa::XOR2>(b1 ? r0 : r1);
                t += fa::dpp<0x124>(t); t += fa::dpp<0x128>(t);
                sj[j] = t + Df[(p * 128 + 16 * wave + j) * 4 + h];
            }
            float mx = sj[0];
#pragma unroll
            for (int j = 1; j < 16; ++j) mx = fmaxf(mx, sj[j]);
            const float mn = fmaxf(m, mx); const float sc = __expf(m - mn); m = mn;
            float rs = 0.f;
#pragma unroll
            for (int j = 0; j < 16; ++j) { sj[j] = __expf(sj[j] - mn); rs += sj[j]; }
            ls = ls * sc + rs;
            const float scc = bperm(sc, 16 * hp + iq);
#pragma unroll
            for (int c = 0; c < 4; ++c) { oc[c][0] *= scc; oc[c][1] *= scc; oc[c][2] *= scc; oc[c][3] *= scc; }
#pragma unroll
            for (int g = 0; g < 2; ++g) {
                v4u w = (v4u){fa::cvtpk(sj[8 * g], sj[8 * g + 1]), fa::cvtpk(sj[8 * g + 2], sj[8 * g + 3]), fa::cvtpk(sj[8 * g + 4], sj[8 * g + 5]), fa::cvtpk(sj[8 * g + 6], sj[8 * g + 7])};
                if (!mine) w = (v4u){0u, 0u, 0u, 0u};
                const fa::bf16x8 pbv = __builtin_bit_cast(fa::bf16x8, w);
#pragma unroll
                for (int c = 0; c < 4; ++c) {
                    const v4u a = (v4u){fa::cvtpk(vv[8 * g][c], vv[8 * g + 1][c]), fa::cvtpk(vv[8 * g + 2][c], vv[8 * g + 3][c]), fa::cvtpk(vv[8 * g + 4][c], vv[8 * g + 5][c]), fa::cvtpk(vv[8 * g + 6][c], vv[8 * g + 7][c])};
                    oc[c] = __builtin_amdgcn_mfma_f32_16x16x32_bf16(__builtin_bit_cast(fa::bf16x8, a), pbv, oc[c], 0, 0, 0); }
            }
        }
        m = bperm(m, 16 * hp + iq); ls = bperm(ls, 16 * hp + iq);
        LAS float* part = (LAS float*)(lds + fa::S_PART);
        { LAS float* pp = part + (wave * 16 + r16) * fa::S_PSTR;
#pragma unroll
            for (int e = 0; e < 4; ++e) *(LAS f4*)(pp + 4 + 16 * q4 + 4 * e) = (f4){oc[0][e], oc[1][e], oc[2][e], oc[3][e]};
            if (q4 == 0) { pp[0] = m; pp[1] = ls; } }
        __syncthreads();
        for (int u = tid; u < 1024; u += 512) {
            const int hh = u >> 8, i = (u >> 6) & 3, d = u & 63;
            float sn[4]; float G = 0.f;
#pragma unroll
            for (int j = 0; j < 4; ++j) { G -= ELF[j * 4 + hh]; float dot = 0.f;
                for (int c = 0; c < 64; ++c) dot += EQ[i * 256 + hh * 64 + c] * EK[j * 256 + hh * 64 + c];
                sn[j] = j <= i ? dot * 0.125f + G : -INFINITY; }
            float mt = fmaxf(fmaxf(sn[0], sn[1]), fmaxf(sn[2], sn[3]));
            for (int w = 0; w < 8; ++w) mt = fmaxf(mt, part[(w * 16 + hh * 4 + i) * fa::S_PSTR]);
            float lt = 0.f, ot = 0.f;
            for (int w = 0; w < 8; ++w) { const LAS float* pp = part + (w * 16 + hh * 4 + i) * fa::S_PSTR; const float e = __expf(pp[0] - mt); lt += e * pp[1]; ot += e * pp[4 + d]; }
#pragma unroll
            for (int j = 0; j < 4; ++j) { const float e = __expf(sn[j] - mt); lt += e; ot += e * EV[j * 256 + hh * 64 + d]; }
            MIXB[(size_t)(r0 + i) * 1024 + hh * 64 + d] = (bf16)f2bf(ot / lt);
        }
    }
    {
        const int h = wave, g = h >> 2, p = lane;
        const f4* h0 = (const f4*)(st_ssm + (((size_t)b * 8 + h) * 64 + p) * 64);
        f4 hs[16];
#pragma unroll
        for (int n4 = 0; n4 < 16; ++n4) hs[n4] = h0[n4];
        const float A = -expf(alog[h]);
        for (int i = 0; i < 4; ++i) {
            const float dt = EDT[i * 8 + h]; const float dec = expf(dt * A); const float xdt = EX[i * 768 + h * 64 + p] * dt;
            float y = 0.f;
#pragma unroll
            for (int n4 = 0; n4 < 16; ++n4) { const f4 Bv = *(const LAS f4*)(EX + i * 768 + 512 + g * 64 + 4 * n4), Cv = *(const LAS f4*)(EX + i * 768 + 640 + g * 64 + 4 * n4);
                hs[n4] = hs[n4] * dec + Bv * xdt; y += Cv[0] * hs[n4][0] + Cv[1] * hs[n4][1] + Cv[2] * hs[n4][2] + Cv[3] * hs[n4][3]; }
            EYS[i * 512 + h * 64 + p] = y;
        }
        f4* ho = (f4*)(out + O_SSMS + (((size_t)(l * DEC_BATCH + b) * 8 + h) * 64 + p) * 64);
#pragma unroll
        for (int n4 = 0; n4 < 16; ++n4) ho[n4] = hs[n4];
    }
    if (wave < 4) {
        const int h = wave, v = lane;
        const float* s0 = st_gla + ((size_t)b * 4 + h) * 2048;
        float S[32];
#pragma unroll
        for (int k = 0; k < 32; ++k) S[k] = s0[k * 64 + v];
        for (int i = 0; i < 4; ++i) {
            const float* mi = MI + (size_t)(r0 + i) * LDMI;
            const float vv = mi[C_GV + h * 64 + v];
            float o = 0.f;
#pragma unroll
            for (int k4 = 0; k4 < 8; ++k4) { const f4 q4 = *(const f4*)(mi + C_GQ + h * 32 + 4 * k4), k4v = *(const f4*)(mi + C_GK + h * 32 + 4 * k4), g4 = *(const LAS f4*)(EG + i * 128 + h * 32 + 4 * k4);
#pragma unroll
                for (int e = 0; e < 4; ++e) { S[4 * k4 + e] = S[4 * k4 + e] * __expf(g4[e]) + k4v[e] * vv; o += q4[e] * 0.17677669529663687f * S[4 * k4 + e]; } }
            EGO[i * 256 + h * 64 + v] = o;
        }
        float* so = out + O_GLAS + ((size_t)(l * DEC_BATCH + b) * 4 + h) * 2048;
#pragma unroll
        for (int k = 0; k < 32; ++k) so[k * 64 + v] = S[k];
    }
    __syncthreads();
    if (wave < 4) { const int i = wave; const float* mi = MI + (size_t)(r0 + i) * LDMI;
#pragma unroll
        for (int g = 0; g < 2; ++g) { float y[4]; float s = 0.f;
#pragma unroll
            for (int e = 0; e < 4; ++e) { const int c = g * 256 + lane * 4 + e; y[e] = (EYS[i * 512 + c] + EX[i * 768 + c] * dsk[c >> 6]) * mi[C_SZ + c]; s += y[e] * y[e]; }
            const float rs = rsqrtf(wave_sum_l(s, lane) * (1.f / 256.f) + EPS);
            *(uint2*)(MIXB + (size_t)(r0 + i) * 1024 + 256 + g * 256 + lane * 4) = make_uint2(pk2(y[0] * rs * snorm[g * 256 + lane * 4], y[1] * rs * snorm[g * 256 + lane * 4 + 1]), pk2(y[2] * rs * snorm[g * 256 + lane * 4 + 2], y[3] * rs * snorm[g * 256 + lane * 4 + 3])); }
#pragma unroll
        for (int hh = 0; hh < 4; ++hh) { const float o = EGO[i * 256 + hh * 64 + lane]; const float rs = rsqrtf(wave_sum_l(o * o, lane) * (1.f / 64.f) + EPS);
            MIXB[(size_t)(r0 + i) * 1024 + 768 + hh * 64 + lane] = (bf16)f2bf(o * rs * gnorm[lane] * mi[C_GG + hh * 64 + lane]); }
    }
    __syncthreads();
}

constexpr int M_Q = 0, M_K = 16384, M_LF = 32768, M_F = 33024;
__device__ __forceinline__ void meta_unit(const float* MI, const float* qg, const float* kg, const float* fbias, bf16* MIXB, LAS unsigned char* lds, int tid) {
    const int lane = tid & 63, wave = __builtin_amdgcn_readfirstlane(tid >> 6);
    LAS float* MQ = (LAS float*)(lds + M_Q); LAS float* MK = (LAS float*)(lds + M_K); LAS float* MLF = (LAS float*)(lds + M_LF); LAS float* MF = (LAS float*)(lds + M_F);
    for (int j = wave; j < 16; j += 8) { const float* mi = MI + (size_t)(R_META + j) * LDMI;
#pragma unroll
        for (int h = 0; h < 4; ++h) { const float q = mi[C_FQ + h * 64 + lane], k = mi[C_FK + h * 64 + lane];
            const float qs = rsqrtf(wave_sum_l(q * q, lane) * (1.f / 64.f) + EPS), ks = rsqrtf(wave_sum_l(k * k, lane) * (1.f / 64.f) + EPS);
            MQ[j * 256 + h * 64 + lane] = q * qs * qg[lane]; MK[j * 256 + h * 64 + lane] = k * ks * kg[lane]; }
        if (lane < 4) MLF[j * 4 + lane] = log_sigmoidf(mi[C_FF + lane] + fbias[lane]); }
    __syncthreads();
    if (tid < 4) { float F = 0.f; for (int j = 0; j < 16; ++j) { F += MLF[j * 4 + tid]; MF[j * 4 + tid] = F; } }
    __syncthreads();
    for (int pr = wave; pr < 64; pr += 8) { const int h = pr >> 4, j = pr & 15;
        const float qv = MQ[j * 256 + h * 64 + lane];
        float sc[16]; float mx = -INFINITY;
#pragma unroll
        for (int k = 0; k < 16; ++k) { const float s = wave_sum_l(qv * MK[k * 256 + h * 64 + lane], lane) * 0.125f + (MF[j * 4 + h] - MF[k * 4 + h]); sc[k] = k <= j ? s : -INFINITY; mx = fmaxf(mx, sc[k]); }
        float sum = 0.f, o = 0.f;
#pragma unroll
        for (int k = 0; k < 16; ++k) { const float p = __expf(sc[k] - mx); sum += p; o += p * MI[(size_t)(R_META + k) * LDMI + C_FV + h * 64 + lane]; }
        MIXB[(size_t)(R_META + j) * 1024 + h * 64 + lane] = (bf16)f2bf(o / sum); }
    __syncthreads();
}
}

namespace eg {
using fa::bf16x8; using fa::f32x16; using fa::f4; using fa::crow;
template <int K, int NB>
__device__ __forceinline__ f4 egemm_tile(const bf16* A, const bf16* Bt, int row0, int col0, LAS unsigned char* lds, int tid) {
    const int lane = tid & 63, wave = __builtin_amdgcn_readfirstlane(tid >> 6), r32 = lane & 31, hi = lane >> 5;
    constexpr int KW = K / 8, NS = KW / 16, NBAT = (NS + NB - 1) / NB;
    const GAS bf16* ap = (const GAS bf16*)A + (size_t)(row0 + r32) * K + wave * KW + 8 * hi;
    const GAS bf16* bp0 = (const GAS bf16*)Bt + (size_t)(col0 + r32) * K + wave * KW + 8 * hi; const GAS bf16* bp1 = bp0 + (size_t)32 * K;
    f32x16 c0, c1;
#pragma unroll
    for (int i = 0; i < 16; ++i) { c0[i] = 0.f; c1[i] = 0.f; }
    bf16x8 fa_[2][NB], fb0[2][NB], fb1[2][NB];
#define EG_LOAD(buf, bat) do { _Pragma("unroll") for (int j = 0; j < NB; ++j) if ((bat) * NB + j < NS) { fa_[buf][j] = *(const GAS bf16x8*)(ap + ((bat) * NB + j) * 16); fb0[buf][j] = *(const GAS bf16x8*)(bp0 + ((bat) * NB + j) * 16); fb1[buf][j] = *(const GAS bf16x8*)(bp1 + ((bat) * NB + j) * 16); } } while (0)
#define EG_MMA(buf, bat) do { _Pragma("unroll") for (int j = 0; j < NB; ++j) if ((bat) * NB + j < NS) { c0 = __builtin_amdgcn_mfma_f32_32x32x16_bf16(fa_[buf][j], fb0[buf][j], c0, 0, 0, 0); c1 = __builtin_amdgcn_mfma_f32_32x32x16_bf16(fa_[buf][j], fb1[buf][j], c1, 0, 0, 0); } } while (0)
    EG_LOAD(0, 0);
#pragma unroll
    for (int bat = 0; bat < NBAT; ++bat) { if (bat + 1 < NBAT) { if ((bat + 1) & 1) EG_LOAD(1, bat + 1); else EG_LOAD(0, bat + 1); } if (bat & 1) EG_MMA(1, bat); else EG_MMA(0, bat); }
#undef EG_LOAD
#undef EG_MMA
    LAS float* red = (LAS float*)lds + wave * 2048;
#pragma unroll
    for (int i = 0; i < 16; ++i) { red[crow(i, hi) * 64 + r32] = c0[i]; red[crow(i, hi) * 64 + 32 + r32] = c1[i]; }
    __syncthreads();
    const LAS float* rp = (const LAS float*)lds + (tid >> 4) * 64 + (tid & 15) * 4;
    f4 s = *(const LAS f4*)rp;
#pragma unroll
    for (int w = 1; w < 8; ++w) s += *(const LAS f4*)(rp + w * 2048);
    __syncthreads();
    return s;
}
template <int K, int NB>
__device__ __forceinline__ void egemm_resid(const bf16* A, const bf16* Bt, float* X, bf16* XB, float* SSQP, float scale, float* out, int final_, LAS unsigned char* lds, int tid) {
    const int lane = tid & 63, wave = __builtin_amdgcn_readfirstlane(tid >> 6), r32 = lane & 31, hi = lane >> 5;
    constexpr int KW = K / 8, NS = KW / 16, NBAT = (NS + NB - 1) / NB;
    for (int u = blockIdx.x; u < 11 * 16; u += gridDim.x) {
        const int rt = u >> 4, ct = u & 15, row0 = MP + 48 * rt, col0 = 64 * ct;
        const int ra = row0 + (tid >> 4), col = col0 + (tid & 15) * 4; const bool hasb = (tid >> 4) < 16;
        GAS f4* xpa = (GAS f4*)(X + (size_t)ra * 1024 + col); GAS f4* xpb = (GAS f4*)(X + (size_t)(ra + 32) * 1024 + col);
        f4 xa = *xpa, xb = *xpb;
        const GAS bf16* ap0 = (const GAS bf16*)A + (size_t)(row0 + r32) * K + wave * KW + 8 * hi; const GAS bf16* ap1 = ap0 + (size_t)32 * K;
        const GAS bf16* bp0 = (const GAS bf16*)Bt + (size_t)(col0 + r32) * K + wave * KW + 8 * hi; const GAS bf16* bp1 = bp0 + (size_t)32 * K;
        f32x16 c00, c01, c10, c11;
#pragma unroll
        for (int i = 0; i < 16; ++i) { c00[i] = 0.f; c01[i] = 0.f; c10[i] = 0.f; c11[i] = 0.f; }
        constexpr int QB = 4, NQ = (NS + QB - 1) / QB;
        bf16x8 fa0[2][QB], fa1[2][QB], fb0[2][QB], fb1[2][QB];
#define EGR_LOAD(buf, bat) do { \
            _Pragma("unroll") for (int j = 0; j < QB; ++j) if ((bat) * QB + j < NS) fa0[buf][j] = *(const GAS bf16x8*)(ap0 + ((bat) * QB + j) * 16); \
            _Pragma("unroll") for (int j = 0; j < QB; ++j) if ((bat) * QB + j < NS) fb0[buf][j] = *(const GAS bf16x8*)(bp0 + ((bat) * QB + j) * 16); \
            _Pragma("unroll") for (int j = 0; j < QB; ++j) if ((bat) * QB + j < NS) fa1[buf][j] = *(const GAS bf16x8*)(ap1 + ((bat) * QB + j) * 16); \
            _Pragma("unroll") for (int j = 0; j < QB; ++j) if ((bat) * QB + j < NS) fb1[buf][j] = *(const GAS bf16x8*)(bp1 + ((bat) * QB + j) * 16); } while (0)
#define EGR_MMA(buf, bat) do { _Pragma("unroll") for (int j = 0; j < QB; ++j) if ((bat) * QB + j < NS) { \
            c00 = __builtin_amdgcn_mfma_f32_32x32x16_bf16(fa0[buf][j], fb0[buf][j], c00, 0, 0, 0); c01 = __builtin_amdgcn_mfma_f32_32x32x16_bf16(fa0[buf][j], fb1[buf][j], c01, 0, 0, 0); \
            c10 = __builtin_amdgcn_mfma_f32_32x32x16_bf16(fa1[buf][j], fb0[buf][j], c10, 0, 0, 0); c11 = __builtin_amdgcn_mfma_f32_32x32x16_bf16(fa1[buf][j], fb1[buf][j], c11, 0, 0, 0); } } while (0)
        EGR_LOAD(0, 0);
#pragma unroll
        for (int bat = 0; bat < NQ; ++bat) {
            if (bat + 1 < NQ) { if ((bat + 1) & 1) EGR_LOAD(1, bat + 1); else EGR_LOAD(0, bat + 1); }
            if (bat & 1) EGR_MMA(1, bat); else EGR_MMA(0, bat);
        }
#undef EGR_LOAD
#undef EGR_MMA
        LAS float* red = (LAS float*)lds + wave * 4096;
#pragma unroll
        for (int i = 0; i < 16; ++i) { red[crow(i, hi) * 64 + r32] = c00[i]; red[crow(i, hi) * 64 + 32 + r32] = c01[i]; red[(32 + crow(i, hi)) * 64 + r32] = c10[i]; red[(32 + crow(i, hi)) * 64 + 32 + r32] = c11[i]; }
        __syncthreads();
        const LAS float* rp = (const LAS float*)lds + (tid >> 4) * 64 + (tid & 15) * 4;
        f4 sa = *(const LAS f4*)rp, sb = *(const LAS f4*)(rp + 32 * 64);
#pragma unroll
        for (int w = 1; w < 8; ++w) { sa += *(const LAS f4*)(rp + w * 4096); sb += *(const LAS f4*)(rp + w * 4096 + 32 * 64); }
        __syncthreads();
#pragma unroll
        for (int hb = 0; hb < 2; ++hb) {
            if (hb == 1 && !hasb) break;
            const int row = hb ? ra + 32 : ra; f4 x = hb ? xb : xa; const f4 acc = hb ? sb : sa;
            x[0] += acc[0] * scale; x[1] += acc[1] * scale; x[2] += acc[2] * scale; x[3] += acc[3] * scale;
            *(hb ? xpb : xpa) = x;
            *(GAS la::u2v*)(XB + (size_t)row * 1024 + col) = (la::u2v){fa::cvtpk(x[0], x[1]), fa::cvtpk(x[2], x[3])};
            const float ss = fa::row16_sum((x[0] * x[0] + x[1] * x[1]) + (x[2] * x[2] + x[3] * x[3]));
            if ((tid & 15) == 0) SSQP[(size_t)row * 16 + ct] = ss;
            if (final_ && row < R_META) *(GAS f4*)(out + O_YS + (size_t)(row - R_S) * 1024 + col) = x;
        }
    }
}
}

namespace sm {
using fa::bf16x8; using fa::f32x16; using fa::crow;
__device__ __forceinline__ void smalls_gemm(const bf16* XB, const bf16* Wt, const float* SSQP, float* MI, float* LF, const float* fbias, float* out, int l, LAS unsigned char* lds, int tid, int u0, int ustep, int uend) {
    const int lane = tid & 63, wave = __builtin_amdgcn_readfirstlane(tid >> 6), r32 = lane & 31, hi = lane >> 5;
    constexpr int NU = (M_REAL + 31) / 32;
    const GAS bf16* bp = (const GAS bf16*)Wt + (size_t)r32 * 1024 + wave * 128 + 8 * hi;
    const GAS bf16* ap = (const GAS bf16*)XB + (size_t)r32 * 1024 + wave * 128 + 8 * hi;
    bf16x8 fa_[8], fb_[8];
    if (u0 < uend) {
#pragma unroll
        for (int j = 0; j < 8; ++j) fa_[j] = *(const GAS bf16x8*)(ap + (size_t)u0 * 32 * 1024 + 16 * j);
#pragma unroll
        for (int j = 0; j < 8; ++j) fb_[j] = *(const GAS bf16x8*)(bp + 16 * j); }
    for (int u = u0; u < uend; u += ustep) {
        const int row0 = 32 * u;
        f32x16 c;
#pragma unroll
        for (int i = 0; i < 16; ++i) c[i] = 0.f;
#pragma unroll
        for (int j = 0; j < 8; ++j) c = __builtin_amdgcn_mfma_f32_32x32x16_bf16(fa_[j], fb_[j], c, 0, 0, 0);
        if (u + ustep < uend) {
#pragma unroll
            for (int j = 0; j < 8; ++j) fa_[j] = *(const GAS bf16x8*)(ap + (size_t)(u + ustep) * 32 * 1024 + 16 * j); }
        const float rs = pg8::rstd_of(SSQP, row0 + (tid >> 4));
        LAS float* red = (LAS float*)lds + wave * 1024;
#pragma unroll
        for (int i = 0; i < 16; ++i) red[crow(i, hi) * 32 + r32] = c[i];
        __syncthreads();
        const int rr = tid >> 4, c0 = (tid & 15) * 2; const int row = row0 + rr;
        float v0 = 0.f, v1 = 0.f;
#pragma unroll
        for (int w = 0; w < 8; ++w) { v0 += ((const LAS float*)lds)[w * 1024 + rr * 32 + c0]; v1 += ((const LAS float*)lds)[w * 1024 + rr * 32 + c0 + 1]; }
        __syncthreads();
        v0 *= rs; v1 *= rs;
        if (c0 < 28) { MI[(size_t)row * LDMI + small2ref(c0)] = v0; MI[(size_t)row * LDMI + small2ref(c0 + 1)] = v1; }
        if (c0 < 4 && row < M_REAL) {
            const float x0 = v0 + fbias[c0], x1 = v1 + fbias[c0 + 1];
            const float l0 = fminf(x0, 0.f) - log1pf(__expf(-fabsf(x0))), l1 = fminf(x1, 0.f) - log1pf(__expf(-fabsf(x1)));
            LF[(size_t)row * 4 + c0] = l0; LF[(size_t)row * 4 + c0 + 1] = l1;
            if (row < MP) { float* o = out + O_LFP + ((size_t)(l * BATCH + (row >> 11)) * TP + 16 + (row & 2047)) * 4 + c0; o[0] = l0; o[1] = l1; }
            else if (row < R_META) { float* o = out + O_LFS + ((size_t)l * MS + (row - R_S)) * 4 + c0; o[0] = l0; o[1] = l1; }
            else for (int cc = 0; cc < BATCH; ++cc) { float* o = out + O_LFP + ((size_t)(l * BATCH + cc) * TP + (row - R_META)) * 4 + c0; o[0] = l0; o[1] = l1; }
        }
    }
}
}

struct Args { const float* in[31]; float* out; unsigned char* ws; int ph_lo, ph_hi; };

__device__ __forceinline__ void transpose_item(const float* W, int ldw, int K, const float* g, bf16* WT, int mapkind, int nblk, int item, LAS float* scr, int lane) {
    const int kb = item / nblk, nb = item % nblk, k0 = 64 * kb, n0 = 32 * nb;
    const int kr = lane >> 3, n4 = (lane & 7) * 4;
    const int nd = n0 + n4;
    int src;
    if (mapkind == 1) { const int pn = nd >> 8, s = nd & 255; src = s < 128 ? 128 * pn + s : 2816 + 128 * pn + (s - 128); }
    else if (mapkind == 2) { const int pn = nd >> 8, sl = nd & 255; src = pn < 3 ? 256 * pn + 64 * ((sl >> 5) & 3) + 32 * (sl >> 7) + (sl & 31) : main2ref(nd); if (src >= ldw) src = -1; }
    else if (mapkind == 3) src = small2ref(nd);
    else src = nd < ldw ? nd : -1;
    typedef float f4t __attribute__((ext_vector_type(4)));
    f4t wv[8];
#pragma unroll
    for (int i = 0; i < 8; ++i) wv[i] = __builtin_nontemporal_load((const f4t*)(W + (size_t)(k0 + kr + 8 * i) * ldw + (src >= 0 ? src : 0)));
#pragma unroll
    for (int i = 0; i < 8; ++i) { const int kk = kr + 8 * i; const float gv = g ? g[k0 + kk] : 1.f;
#pragma unroll
        for (int e = 0; e < 4; ++e) scr[kk * 33 + n4 + e] = src >= 0 ? wv[i][e] * gv : 0.f; }
    LDS_WAIT();
    const int c = lane & 7;
#pragma unroll
    for (int j = 0; j < 4; ++j) { const int n = (lane >> 3) + 8 * j; const LAS float* s = scr + (8 * c) * 33 + n;
        v4u o; o.x = pk2(s[0 * 33], s[1 * 33]); o.y = pk2(s[2 * 33], s[3 * 33]); o.z = pk2(s[4 * 33], s[5 * 33]); o.w = pk2(s[6 * 33], s[7 * 33]);
        *(v4u*)(WT + (size_t)(n0 + n) * K + k0 + 8 * c) = o; }
    LDS_WAIT();
}

template <class T> __device__ __forceinline__ T* as_global(T* p) { return (T*)(__attribute__((address_space(1))) T*)p; }
__device__ __forceinline__ int tid_now(int wave_s) { int t; asm volatile("v_mbcnt_lo_u32_b32 %0, -1, 0\n\tv_mbcnt_hi_u32_b32 %0, -1, %0" : "=v"(t)); return t | (wave_s << 6); }
__global__ void __launch_bounds__(NWAVES * 64, 2) fwd(Args args) {
    extern __shared__ __attribute__((aligned(16))) unsigned char lds[];
    volatile LAS unsigned* MISC = (volatile LAS unsigned*)((LAS unsigned char*)lds + MISC_OFF);
    if (threadIdx.x < 32) MISC[threadIdx.x] = 0u;
    __syncthreads();
    XcdBarrier bar = xcd_barrier_post((unsigned*)(args.ws + WS_CTL) + CW_BAR, MISC + 8);
    volatile LAS unsigned long long* PT = (volatile LAS unsigned long long*)((LAS unsigned char*)lds + MISC_OFF + 256);
    if (threadIdx.x < 31) PT[threadIdx.x] = (unsigned long long)args.in[threadIdx.x];
    __syncthreads();
#define INP(i) ((const float*)(const GAS float*)PT[i])
    const int lo = args.ph_lo, hi = args.ph_hi;
    const int wave_s = __builtin_amdgcn_readfirstlane((int)threadIdx.x >> 6);
    int ph = 0;
#define BUF(name, off) float* name = (float*)(ws_ + (off))
#define BUFH(name, off) bf16* name = (bf16*)(ws_ + (off))
#define PHASE_BEGIN_R(R) if (lo <= ph && ph < hi) for (int rep_ = 0; rep_ < (R); ++rep_) { GAS unsigned char* wsg_ = (GAS unsigned char*)args.ws; GAS float* outg_ = (GAS float*)args.out; int tid = tid_now(wave_s); asm volatile("" : "+s"(wsg_), "+s"(outg_)); unsigned char* ws_ = (unsigned char*)wsg_;         \
        const int lane = tid & 63, wave = tid >> 6; const int gw = blockIdx.x * NWAVES + wave, NGW = gridDim.x * NWAVES; float* smem = (float*)lds; float* out = (float*)outg_; (void)lane; (void)wave; (void)gw; (void)NGW; (void)smem; (void)out; \
        BUF(X, WS_X); BUFH(XB, WS_XB); BUF(SSQP, WS_SSQ); BUFH(HB, WS_HB); BUFH(MIXB, WS_MIXB); BUF(MI, WS_MI); BUF(QN, WS_QN); BUF(KN, WS_KN); BUF(LF, WS_LF); BUF(FC, WS_FC); BUF(FCS, WS_FCS); \
        BUF(XBC, WS_XBC); BUF(DTB, WS_DT); BUF(GLOG, WS_GLOG); BUF(YS, WS_YS); BUF(GO, WS_GO); BUFH(QF, WS_QF); BUFH(KF, WS_KF); BUFH(VT, WS_VT); BUF(SSQH, WS_SSQH); BUFH(XC, WS_XC); BUFH(MIB, WS_MIB); (void)MIB; (void)QF; (void)KF; (void)VT; (void)SSQH; (void)XC; \
        (void)X; (void)XB; (void)SSQP; (void)HB; (void)MIXB; (void)MI; (void)QN; (void)KN; (void)LF; (void)FC; (void)FCS; (void)XBC; (void)DTB; (void)GLOG; (void)YS; (void)GO;
#define PHASE_END_R(R) if (ph + 1 < hi || rep_ + 1 < (R)) xcd_barrier(bar, tid_now(wave_s)); } ++ph;
#define PHASE_BEGIN PHASE_BEGIN_R(1)
#define PHASE_END PHASE_END_R(1)
#define WT_(l, off) ((bf16*)(ws_ + WS_WT + (size_t)(l) * WL_SIZE + (off)))

#define CONVERT_ITEM(it_, scr_, ln_) do { constexpr int I1 = 16 * 176, I2 = 44 * 32, I3 = 16 * 88, I4 = 16 * 32, I7 = 16, IL = 2 * I1 + 2 * I2 + I3 + I4 + I7; static_assert(IL == 10384, "item space"); \
        const int lw = (it_) / IL; int r = (it_) % IL; \
        if (r < I1) { transpose_item(INP(11) + (size_t)lw * 1024 * 5632, 5632, 1024, INP(10) + lw * 1024, WT_(lw, WL_W1), 1, 176, r, scr_, ln_); break; } r -= I1; \
        if (r < I2) { transpose_item(INP(12) + (size_t)lw * 2816 * 1024, 1024, 2816, nullptr, WT_(lw, WL_W2), 0, 32, r, scr_, ln_); break; } r -= I2; \
        if (r < I3) { transpose_item(INP(14) + (size_t)lw * 1024 * N_IN, N_IN, 1024, INP(13) + lw * 1024, WT_(lw, WL_W3), 2, 88, r, scr_, ln_); break; } r -= I3; \
        if (r < I4) { transpose_item(INP(27) + (size_t)lw * 1024 * 1024, 1024, 1024, nullptr, WT_(lw, WL_W4), 0, 32, r, scr_, ln_); break; } r -= I4; \
        if (r < I1) { transpose_item(INP(29) + (size_t)lw * 1024 * 5632, 5632, 1024, INP(28) + lw * 1024, WT_(lw, WL_W5), 1, 176, r, scr_, ln_); break; } r -= I1; \
        if (r < I2) { transpose_item(INP(30) + (size_t)lw * 2816 * 1024, 1024, 2816, nullptr, WT_(lw, WL_W6), 0, 32, r, scr_, ln_); break; } r -= I2; \
        transpose_item(INP(14) + (size_t)lw * 1024 * N_IN, N_IN, 1024, INP(13) + lw * 1024, WT_(lw, WL_W7), 3, 1, r, scr_, ln_); } while (0)
#define CONVERT_RANGE(lo_, hi_, gwv_, ngwv_) do { const int tn_ = tid_now(wave_s); const int lnr_ = tn_ & 63; LAS float* scrr_ = (LAS float*)((LAS unsigned char*)lds + wave_s * 16384); \
        for (int itr_ = (lo_) + (gwv_); itr_ < (hi_); itr_ += (ngwv_)) CONVERT_ITEM(itr_, scrr_, lnr_); } while (0)
#define CONVERT_TAIL(lo_, hi_, first_) do { if (gridDim.x == 256) { if ((int)blockIdx.x >= (first_)) CONVERT_RANGE(lo_, hi_, ((int)blockIdx.x - (first_)) * NWAVES + wave_s, (256 - (first_)) * NWAVES); } \
        else CONVERT_RANGE(lo_, hi_, (int)blockIdx.x * NWAVES + wave_s, (int)gridDim.x * NWAVES); } while (0)
    PHASE_BEGIN_R(R_P0)
        CONVERT_RANGE(0, 2816, gw, NGW);
        for (int i = blockIdx.x * 512 + tid; i < 2 * 12288; i += gridDim.x * 512) { const int j = i % 12288;
            if (i < 12288) { const int bh = j / 384, sl = (j % 384) >> 3, ch = j & 7; *(v4u*)(KF + ((size_t)bh * 2112 + 16 + sl) * 64 + ch * 8) = (v4u){0u, 0u, 0u, 0u}; }
            else { const int bh = j / 384, d = (j % 384) / 6, ch = j % 6; *(v4u*)(VT + ((size_t)bh * 64 + d) * 2112 + 16 + ch * 8) = (v4u){0u, 0u, 0u, 0u}; } }
        for (int r0 = gw * 2; r0 < M_PAD; r0 += NGW * 2) {
            float4 v[2][4];
#pragma unroll
            for (int q = 0; q < 2; ++q) { const int r = r0 + q;
                const float* src = r < MP ? INP(0) + (size_t)r * 1024 : r < R_META ? INP(1) + (size_t)(r - R_S) * 1024 : r < M_REAL ? INP(9) + (size_t)(r - R_META) * 1024 : nullptr;
#pragma unroll
                for (int j = 0; j < 4; ++j) v[q][j] = src ? ((const float4*)src)[lane + 64 * j] : make_float4(0.f, 0.f, 0.f, 0.f); }
#pragma unroll
            for (int q = 0; q < 2; ++q) { const int r = r0 + q;
                float4* o = (float4*)(X + (size_t)r * 1024) + lane; uint2* ob = (uint2*)(XB + (size_t)r * 1024) + lane; float s = 0.f;
#pragma unroll
                for (int j = 0; j < 4; ++j) { const float4 w = v[q][j]; if (r >= MP) o[64 * j] = w; ob[64 * j] = make_uint2(pk2(w.x, w.y), pk2(w.z, w.w)); s += (w.x * w.x + w.y * w.y) + (w.z * w.z + w.w * w.w); }
                s = wave_sum(s);
                if (lane < 16) SSQP[(size_t)r * 16 + lane] = lane == 0 ? s : 0.f;
                if (r >= M_REAL) { uint2* m = (uint2*)(MIXB + (size_t)r * 1024) + lane;
#pragma unroll
                    for (int j = 0; j < 4; ++j) m[64 * j] = make_uint2(0u, 0u); } }
        }
    PHASE_END_R(R_P0)

    for (int l = 0; l < DEPTH; ++l) {
#define mix_norm (INP(13) + l * 1024)
#define fox_q_norm (INP(15) + l * 64)
#define fox_k_norm (INP(16) + l * 64)
#define fox_f_bias (INP(17) + l * 4)
#define conv_w (INP(18) + l * 4 * 768)
#define conv_b (INP(19) + l * 768)
#define dt_bias (INP(20) + l * 8)
#define a_log (INP(21) + l * 8)
#define ssd_d (INP(22) + l * 8)
#define ssd_norm (INP(23) + l * 512)
#define w_gate (INP(24) + l * 16 * 128)
#define gate_bias (INP(25) + l * 128)
#define gla_norm (INP(26) + l * 64)
#define cache_k (INP(2))
#define cache_v (INP(3))
#define cache_lf (INP(4))
#define state_ssm (INP(5) + (size_t)l * DEC_BATCH * 8 * 4096)
#define state_conv (INP(6) + (size_t)l * DEC_BATCH * 3 * 768)
#define state_gla (INP(7) + (size_t)l * DEC_BATCH * 4 * 2048)
#define pt ((const int*)INP(8))
        for (int half = 0; half < 2; ++half) {
            PHASE_BEGIN_R(R_G1) { pg8::Gemm g{XB, WT_(l, half ? WL_W5 : WL_W1), M_PAD, 5632, 1024}; pg8::StaticOrder S; S.init(M_PAD, 5632, (int)gridDim.x, (int)blockIdx.x);
                pg8::EpiSwiglu E{HB, SSQP}; pg8::gemm_phase<pg8::EpiSwiglu, pg8::StaticOrder, true, true>((LAS unsigned char*)lds, g, S, E, tid);
                if (l == 0 && half == 0) {
                    if (gridDim.x == 256) { if (blockIdx.x >= 194) CONVERT_RANGE(2816, 4224, ((int)blockIdx.x - 194) * NWAVES + wave_s, 62 * NWAVES); }
                    else CONVERT_RANGE(2816, 4224, (int)blockIdx.x * NWAVES + wave_s, (int)gridDim.x * NWAVES); }
                if (l == 0 && half == 1) CONVERT_TAIL(8960, 10368, 194);
                if (l == 1 && half == 0) CONVERT_TAIL(10384 + 2816, 10384 + 4224, 194);
                if (l == 1 && half == 1) CONVERT_TAIL(10384 + 8960, 10384 + 10368, 194);
                } PHASE_END_R(R_G1)
            PHASE_BEGIN { pg8::Gemm g{HB, WT_(l, half ? WL_W6 : WL_W2), MP, 1024, 2816}; pg8::StaticOrder S; S.init(MP, 1024, (int)gridDim.x, (int)blockIdx.x);
                pg8::EpiResid E{(const GAS float*)nullptr, X, XB, SSQP, 0.5f, out, (l == DEPTH - 1 && half == 1) ? 1 : 0};     pg8::gemm_phase<pg8::EpiResid, pg8::StaticOrder, true, true>((LAS unsigned char*)lds, g, S, E, tid);
                eg::egemm_resid<2816, 8>(HB, WT_(l, half ? WL_W6 : WL_W2), X, XB, SSQP, 0.5f, out, (l == DEPTH - 1 && half == 1) ? 1 : 0, (LAS unsigned char*)lds, tid_now(wave_s));
                if (l == 0 && half == 0) {
                    if (gridDim.x == 256) { if (blockIdx.x >= 176) { CONVERT_RANGE(4224, 5632, ((int)blockIdx.x - 176) * NWAVES + wave_s, 80 * NWAVES); CONVERT_RANGE(10368, 10384, ((int)blockIdx.x - 176) * NWAVES + wave_s, 80 * NWAVES); } }
                    else { CONVERT_RANGE(4224, 5632, (int)blockIdx.x * NWAVES + wave_s, (int)gridDim.x * NWAVES); CONVERT_RANGE(10368, 10384, (int)blockIdx.x * NWAVES + wave_s, (int)gridDim.x * NWAVES); } }     } PHASE_END
            if (half == 1) break;

            PHASE_BEGIN_R(R_G3) { pg8::Gemm g{XB, WT_(l, WL_W3), M_PAD, N_MAIN, 1024}; pg8::StaticOrder S; S.init(M_PAD, N_MAIN, (int)gridDim.x, (int)blockIdx.x);
                pg8::EpiMix E{MI, MIB, SSQP, QF, KF, VT, fox_q_norm, fox_k_norm, fox_f_bias, LF, out, l}; pg8::gemm_phase<pg8::EpiMix, pg8::StaticOrder, true, true>((LAS unsigned char*)lds, g, S, E, tid);
                {
                    constexpr int NUS = (M_REAL + 31) / 32; int u0 = blockIdx.x, us = gridDim.x, ue = NUS;
                    if (gridDim.x == 256) { if (blockIdx.x >= 225) { u0 = (int)blockIdx.x - 225; us = 31; ue = 310; } else { u0 = 310 + (int)blockIdx.x; us = 1024; } }
                    sm::smalls_gemm(XB, WT_(l, WL_W7), SSQP, MI, LF, fox_f_bias, out, l, (LAS unsigned char*)lds, tid_now(wave_s), u0, us, ue); }
                if (l == 0) {
                    if (gridDim.x == 256) { if (blockIdx.x >= 225) CONVERT_RANGE(5632, 6144, ((int)blockIdx.x - 225) * NWAVES + wave_s, 31 * NWAVES); }
                    else CONVERT_RANGE(5632, 6144, (int)blockIdx.x * NWAVES + wave_s, (int)gridDim.x * NWAVES); } } PHASE_END_R(R_G3)
            PHASE_BEGIN
            {
                typedef float f4v __attribute__((ext_vector_type(4)));
                LAS float* lrs = (LAS float*)((LAS unsigned char*)lds + wave * 1024);
                for (int blk = gw; blk < (NGW == 2048 ? 2048 : 2048 + 2); blk += NGW) {
                    const bool isP = blk < 2048; const int bb = blk >> 8, i0 = isP ? 8 * (blk & 255) : 8 * (blk - 2048);
                    const int rowb = isP ? bb * 2048 + i0 : R_META + i0;
                    f4v u[3][11];
#pragma unroll
                    for (int j = 0; j < 11; ++j) { const int i = i0 + j - 3; int pr;
                        if (isP) pr = i >= 0 ? bb * 2048 + i : R_META + 16 + i; else pr = i >= 0 ? R_META + i : -1;
#pragma unroll
                        for (int k = 0; k < 3; ++k) { const uint2 w = *(const uint2*)(MIB + (size_t)(pr >= 0 ? pr : 0) * N_MAIN + CM_XBC + 4 * (lane + 64 * k));
                            const f4v v = (f4v){__uint_as_float(w.x << 16), __uint_as_float(w.x & 0xffff0000u), __uint_as_float(w.y << 16), __uint_as_float(w.y & 0xffff0000u)}; u[k][j] = pr >= 0 ? v : (f4v){0.f, 0.f, 0.f, 0.f}; } }
                    const f4v lrv = lane < 32 ? *(const f4v*)(MI + (size_t)(rowb + (lane >> 2)) * LDMI + C_LR + 4 * (lane & 3)) : (f4v){0.f, 0.f, 0.f, 0.f};
                    const float dtr = MI[(size_t)(rowb + (lane >> 3)) * LDMI + C_DT + (lane & 7)];
                    if (lane < 32) *(LAS f4v*)(lrs + (lane >> 2) * 16 + 4 * (lane & 3)) = lrv;
                    DTB[(size_t)(rowb + (lane >> 3)) * 8 + (lane & 7)] = softplusf(dtr + dt_bias[lane & 7]);
#pragma unroll
                    for (int k = 0; k < 3; ++k) { const int col = 4 * (lane + 64 * k);
                        const f4v w0 = *(const f4v*)(conv_w + col), w1 = *(const f4v*)(conv_w + 768 + col), w2 = *(const f4v*)(conv_w + 2 * 768 + col), w3 = *(const f4v*)(conv_w + 3 * 768 + col), bs = *(const f4v*)(conv_b + col);
#pragma unroll
                        for (int j = 0; j < 8; ++j) { const f4v o = w3 * u[k][j + 3] + w2 * u[k][j + 2] + w1 * u[k][j + 1] + w0 * u[k][j] + bs;
                            *(uint2*)(XC + (size_t)(rowb + j) * 768 + col) = make_uint2(fa::cvtpk(pg8::silu_fast(o[0]), pg8::silu_fast(o[1])), fa::cvtpk(pg8::silu_fast(o[2]), pg8::silu_fast(o[3]))); } }
                    LDS_WAIT();
                    float wc0[16], wc1[16];
#pragma unroll
                    for (int r = 0; r < 16; ++r) { wc0[r] = w_gate[r * 128 + lane]; wc1[r] = w_gate[r * 128 + 64 + lane]; }
                    const float gb0 = gate_bias[lane], gb1 = gate_bias[64 + lane];
#pragma unroll
                    for (int j = 0; j < 8; ++j) { float a0 = gb0, a1 = gb1;
#pragma unroll
                        for (int r4 = 0; r4 < 4; ++r4) { const f4v x = *(const LAS f4v*)(lrs + j * 16 + 4 * r4);
                            a0 += x[0] * wc0[4 * r4] + x[1] * wc0[4 * r4 + 1] + x[2] * wc0[4 * r4 + 2] + x[3] * wc0[4 * r4 + 3]; a1 += x[0] * wc1[4 * r4] + x[1] * wc1[4 * r4 + 1] + x[2] * wc1[4 * r4 + 2] + x[3] * wc1[4 * r4 + 3]; }
                        GLOG[(size_t)(rowb + j) * 128 + lane] = (fminf(a0, 0.f) - __logf(1.0f + __expf(-fabsf(a0)))) * (1.0f / 16.0f);
                        GLOG[(size_t)(rowb + j) * 128 + 64 + lane] = (fminf(a1, 0.f) - __logf(1.0f + __expf(-fabsf(a1)))) * (1.0f / 16.0f); }
                    LDS_WAIT();
                }
                if (NGW == 2048 && gw < 16) {
                    const int m = gw, row = R_META + m;
                    f4v um[3][4];
#pragma unroll
                    for (int j = 0; j < 4; ++j) { const int i = m + j - 3;
#pragma unroll
                        for (int k = 0; k < 3; ++k) { const uint2 w = *(const uint2*)(MIB + (size_t)(R_META + (i >= 0 ? i : 0)) * N_MAIN + CM_XBC + 4 * (lane + 64 * k));
                            const f4v v = (f4v){__uint_as_float(w.x << 16), __uint_as_float(w.x & 0xffff0000u), __uint_as_float(w.y << 16), __uint_as_float(w.y & 0xffff0000u)}; um[k][j] = i >= 0 ? v : (f4v){0.f, 0.f, 0.f, 0.f}; } }
                    if (lane < 8) DTB[(size_t)row * 8 + lane] = softplusf(MI[(size_t)row * LDMI + C_DT + lane] + dt_bias[lane]);
#pragma unroll
                    for (int k = 0; k < 3; ++k) { const int col = 4 * (lane + 64 * k);
                        const f4v w0 = *(const f4v*)(conv_w + col), w1 = *(const f4v*)(conv_w + 768 + col), w2 = *(const f4v*)(conv_w + 2 * 768 + col), w3 = *(const f4v*)(conv_w + 3 * 768 + col), bs = *(const f4v*)(conv_b + col);
                        const f4v o = w3 * um[k][3] + w2 * um[k][2] + w1 * um[k][1] + w0 * um[k][0] + bs;
                        *(uint2*)(XC + (size_t)row * 768 + col) = make_uint2(fa::cvtpk(pg8::silu_fast(o[0]), pg8::silu_fast(o[1])), fa::cvtpk(pg8::silu_fast(o[2]), pg8::silu_fast(o[3]))); }
                    float a0 = gate_bias[lane], a1 = gate_bias[64 + lane];
#pragma unroll
                    for (int r = 0; r < 16; ++r) { const float x = MI[(size_t)row * LDMI + C_LR + r]; a0 += x * w_gate[r * 128 + lane]; a1 += x * w_gate[r * 128 + 64 + lane]; }
                    GLOG[(size_t)row * 128 + lane] = (fminf(a0, 0.f) - __logf(1.0f + __expf(-fabsf(a0)))) * (1.0f / 16.0f);
                    GLOG[(size_t)row * 128 + 64 + lane] = (fminf(a1, 0.f) - __logf(1.0f + __expf(-fabsf(a1)))) * (1.0f / 16.0f);
                }
            }
            PHASE_END
            PHASE_BEGIN_R(R_MIX)
            {
                volatile LAS unsigned* qslot = (volatile LAS unsigned*)((LAS unsigned char*)lds + MISC_OFF + 64);
                unsigned* qhead = (unsigned*)(ws_ + WS_CTL) + CW_Q + 64 * l + 8 * rep_; unsigned* ssd_done = qhead + 4;
                constexpr int U_SSDP = 0, U_GLAP = 64, U_SAMP = 96, U_PATT = 224, U_META = 480, U_END = 481;
                for (;;) {
                    __syncthreads();
                    if (tid == 0) *qslot = atomicAdd(qhead, 1u);
                    __syncthreads();
                    const int u = (int)*qslot;
                    constexpr int N_CVU = (10384 + 15) / 16;
                    if (u >= U_END) {
                        const int nfill = l == 0 ? N_CVU : 0;
                        if (u >= U_END + nfill) {
                            const int pj = u - U_END - nfill; if (pj >= 129) break;
                            if (tid == 0) { unsigned sp = 0u;
                                while (__hip_atomic_load(ssd_done, __ATOMIC_RELAXED, __HIP_MEMORY_SCOPE_AGENT) < 64u) { __builtin_amdgcn_s_sleep(16); if (++sp > (1u << 22)) break; }
                                __builtin_amdgcn_fence(__ATOMIC_ACQUIRE, "agent"); asm volatile("s_waitcnt vmcnt(0)" ::: "memory"); }
                            __syncthreads();
                            const int ln = tid_now(wave_s) & 63;
                            const float4 gn0 = *(const float4*)(ssd_norm + ln * 4), gn1 = *(const float4*)(ssd_norm + 256 + ln * 4);
                            const int nst = pj < 128 ? 4 : (wave_s < 4 ? 1 : 0);
                            for (int st = 0; st < nst; ++st) {
                                const int r0 = pj < 128 ? pj * 128 + wave_s * 16 + 4 * st : R_META + 4 * wave_s;
                                uint2 w[4][2]; float4 q[4][2];
#pragma unroll
                                for (int j = 0; j < 4; ++j) { const size_t r = (size_t)(r0 + j);
                                    q[j][0] = *(const float4*)(SSQH + r * 8); q[j][1] = *(const float4*)(SSQH + r * 8 + 4);
                                    w[j][0] = *(const uint2*)(MIXB + r * 1024 + 256 + ln * 4); w[j][1] = *(const uint2*)(MIXB + r * 1024 + 512 + ln * 4); }
#pragma unroll
                                for (int j = 0; j < 4; ++j) { const size_t r = (size_t)(r0 + j);
#pragma unroll
                                    for (int g = 0; g < 2; ++g) { const float4 qq = q[j][g]; const float rs = rsqrtf((qq.x + qq.y + qq.z + qq.w) * (1.f / 256.f) + EPS); const float4 gn = g ? gn1 : gn0; const uint2 ww = w[j][g];
                                        const float y0 = __uint_as_float(ww.x << 16) * rs * gn.x, y1 = __uint_as_float(ww.x & 0xffff0000u) * rs * gn.y, y2 = __uint_as_float(ww.y << 16) * rs * gn.z, y3 = __uint_as_float(ww.y & 0xffff0000u) * rs * gn.w;
                                        *(uint2*)(MIXB + r * 1024 + 256 + g * 256 + ln * 4) = make_uint2(pk2(y0, y1), pk2(y2, y3)); } }
                            }
                            continue;
                        }
                        const int j = 16 * (u - U_END) + 2 * wave_s; LAS float* scrq_ = (LAS float*)((LAS unsigned char*)lds + wave_s * 16384); const int lnq_ = tid_now(wave_s) & 63;
                        for (int e = 0; e < 2; ++e) { const int jj = j + e; if (jj < 10384) { const int itq_ = jj < 2816 ? 6144 + jj : jj < 5632 ? 10384 + (jj - 2816) : jj < 10368 ? 14608 + (jj - 5632) : 20752 + (jj - 10368); CONVERT_ITEM(itq_, scrq_, lnq_); } }
                        continue;
                    }
                    int tidu = tid; asm volatile("" : "+v"(tidu));
                    if (u < U_GLAP) {
                        const int b = u >> 3, h = u & 7;
                        la::ssd_prompt_unit(b, h, (const GAS bf16*)MIB, (const GAS bf16*)XC, (const GAS float*)DTB, -expf(a_log[h]), ssd_d[h], (GAS bf16*)MIXB, (GAS float*)SSQH, (GAS float*)(out + O_SSMP + ((size_t)(l * BATCH + b) * 8 + h) * 4096), (LAS unsigned char*)lds, tidu);
                        asm volatile("s_waitcnt vmcnt(0)" ::: "memory"); __syncthreads();
                        if (tid_now(wave_s) == 0) { __builtin_amdgcn_fence(__ATOMIC_RELEASE, "agent"); asm volatile("s_waitcnt vmcnt(0)" ::: "memory"); __hip_atomic_fetch_add(ssd_done, 1u, __ATOMIC_RELAXED, __HIP_MEMORY_SCOPE_AGENT); }
                    } else if (u < U_SAMP) {
                        const int b = (u - U_GLAP) >> 2, h = (u - U_GLAP) & 3;
                        la::gla_prompt_unit(b, h, (const GAS bf16*)MIB, (const GAS float*)GLOG, (const GAS float*)gla_norm, (GAS bf16*)MIXB, (GAS float*)(out + O_GLAP + ((size_t)(l * BATCH + b) * 4 + h) * 2048), (LAS unsigned char*)lds, tidu);
                    } else if (u < U_META) {
                        const int k = u - U_SAMP;
                        const int su = k < 64 ? k : ((k >= 160 && k < 224) ? k - 96 : -1);
                        if (su >= 0) {
                            eu::sample_unit(su, l, MI, cache_k, cache_v, cache_lf, pt, state_ssm, state_conv, state_gla, fox_q_norm, fox_k_norm, fox_f_bias, conv_w, conv_b, dt_bias, a_log, ssd_d, ssd_norm,
                                            w_gate, gate_bias, gla_norm, MIXB, out, (LAS unsigned char*)lds, tidu);
                        } else {
                            const int j = k < 160 ? k - 64 : k - 128; fa::fox_prompt_unit((j & 31) >> 2, j & 3, 7 - (j >> 5), QF, KF, VT, LF, MIXB, (LAS unsigned char*)lds, tidu);
                        }
                    } else {
                        eu::meta_unit(MI, fox_q_norm, fox_k_norm, fox_f_bias, MIXB, (LAS unsigned char*)lds, tidu);
                    }
                }
            }
            PHASE_END_R(R_MIX)
            PHASE_BEGIN { pg8::Gemm g{MIXB, WT_(l, WL_W4), MP, 1024, 1024}; pg8::StaticOrder S; S.init(MP, 1024, (int)gridDim.x, (int)blockIdx.x);
                pg8::EpiResid E{(const GAS float*)nullptr, X, XB, SSQP, 1.0f, out, 0}; pg8::gemm_phase<pg8::EpiResid, pg8::StaticOrder, true, true>((LAS unsigned char*)lds, g, S, E, tid);
                eg::egemm_resid<1024, 8>(MIXB, WT_(l, WL_W4), X, XB, SSQP, 1.0f, out, 0, (LAS unsigned char*)lds, tid_now(wave_s)); } PHASE_END
        }
    }
}

extern "C" void kernel_launch(void* const* d_in, const int* in_sizes, int n_in, void* d_out, int out_size, void* d_ws, size_t ws_size, hipStream_t stream) {
    static int grid = 0;
    if (grid == 0) {
        if (n_in != 31 || out_size != (int)O_END || ws_size < WS_END) { fprintf(stderr, "kernel_launch: unexpected sizes n_in %d out %d ws %zu (need %zu)\n", n_in, out_size, ws_size, (size_t)WS_END); grid = -1; return; }
        int dev = 0, cus = 0;
        if (hipGetDevice(&dev) != hipSuccess || hipDeviceGetAttribute(&cus, hipDeviceAttributeMultiprocessorCount, dev) != hipSuccess) { grid = -1; return; }
        if (hipFuncSetAttribute((const void*)fwd, hipFuncAttributeMaxDynamicSharedMemorySize, LDS_BYTES) != hipSuccess) { fprintf(stderr, "kernel_launch: hipFuncSetAttribute failed\n"); grid = -1; return; }
        (void)hipGetLastError();
        grid = cus;
    }
    if (grid < 0) return;
    (void)hipMemsetAsync((char*)d_ws + WS_CTL, 0, CTL_ZERO_BYTES, stream);
    Args a{};
    for (int i = 0; i < 31; ++i) a.in[i] = (const float*)d_in[i];
    a.out = (float*)d_out; a.ws = (unsigned char*)d_ws; a.ph_lo = 0; a.ph_hi = 1000;
    hipLaunchKernelGGL(fwd, dim3(grid), dim3(NWAVES * 64), LDS_BYTES, stream, a);
}
```
